# Optimizing an MI355X kernel written in HIP

```python
import math
import jax, jax.numpy as jnp
from jax import lax
import numpy as np

D_MODEL = 2048
BATCH = 2
SEQ = 16384
DEPTH = 2

N_HEADS = 32
N_KV_GROUPS = 4
HEADS_PER_GROUP = N_HEADS // N_KV_GROUPS
D_K = 96
D_V = 64
CMP_BLOCK = 32
CMP_STRIDE = 16
CMP_HIDDEN = 256
SLC_BLOCK = 64
N_SLC = 16
WINDOW = 512
Q_BLOCK = 128
N_BUCKETS = 32
MAX_DISTANCE = 128
POOL_WINDOWS = (2, 4, 8, 16)
N_POOL_GROUPS = len(POOL_WINDOWS)
POOL_GROUP = D_MODEL // N_POOL_GROUPS
D_FF = -(-8 * D_MODEL // (3 * 256)) * 256
EPS = 1e-6
NEG_INF = -1e30
FORCE_SCORE = 1e9
N_NSA_LAYERS = (DEPTH + 1) // 2
N_POOL_LAYERS = DEPTH // 2
Q_WIDTH = N_HEADS * D_K
K_WIDTH = N_KV_GROUPS * D_K
V_WIDTH = N_KV_GROUPS * D_V
GATE_WIDTH = 3 * N_HEADS
NSA_SPLITS = (Q_WIDTH, K_WIDTH, V_WIDTH, K_WIDTH, V_WIDTH, K_WIDTH, V_WIDTH, GATE_WIDTH)
NSA_PROJ = sum(NSA_SPLITS)

kernel_name = 'nsa_pool_interleaved_hybrid'


def rms_norm(x, g):
    x32 = x.astype(jnp.float32)
    y = x32 * lax.rsqrt(jnp.mean(x32 * x32, axis=-1, keepdims=True) + EPS)
    return (y * g.astype(jnp.float32)).astype(x.dtype)


def rel_bucket(dist):
    n = jnp.maximum(dist, 0)
    max_exact = N_BUCKETS // 2
    nf = jnp.maximum(n, 1).astype(jnp.float32)
    large = max_exact + (jnp.log(nf / max_exact) / math.log(MAX_DISTANCE / max_exact)
                         * (N_BUCKETS - max_exact)).astype(jnp.int32)
    large = jnp.minimum(large, N_BUCKETS - 1)
    return jnp.where(n < max_exact, n, large)


def masked_softmax(logits, valid):
    p = jax.nn.softmax(jnp.where(valid, logits, NEG_INF), axis=-1)
    return p * valid


def compress(kv, pos, w1, b1, w2):
    B, S, G, dh = kv.shape
    chunks = kv.reshape(B, S // CMP_STRIDE, CMP_STRIDE, G, dh)
    blocks = jnp.concatenate([chunks[:, :-1], chunks[:, 1:]], axis=2)
    blocks = blocks + pos[None, None, :, None, :]
    nc = blocks.shape[1]
    flat = blocks.transpose(0, 1, 3, 2, 4).reshape(B, nc, G, CMP_BLOCK * dh)
    hid = jax.nn.gelu(flat @ w1 + b1)
    return hid @ w2


def selection_overlap(n_cmp, n_slc):
    i = jnp.arange(n_cmp)[:, None]
    j = jnp.arange(n_slc)[None, :]
    ratio = SLC_BLOCK // CMP_STRIDE
    diff = i - ratio * j
    w = jnp.zeros((n_cmp, n_slc), jnp.float32)
    for n in range(CMP_BLOCK // CMP_STRIDE):
        w = w + ((diff + n >= 0) & (diff + n < ratio)).astype(jnp.float32)
    return w


def nsa_mixer(h, w_in, pos_k, pos_v, ck_w1, ck_b1, ck_w2, cv_w1, cv_b1, cv_w2, w_out, rel_bias):
    B, S, _ = h.shape
    G, HG = N_KV_GROUPS, HEADS_PER_GROUP
    proj = h @ w_in
    offs = []
    acc = 0
    for wdt in NSA_SPLITS[:-1]:
        acc += wdt
        offs.append(acc)
    q, k_c, v_c, k_s, v_s, k_w, v_w, g = jnp.split(proj, offs, axis=-1)
    q = q.reshape(B, S, G, HG, D_K) * (D_K ** -0.5)
    gates = jax.nn.sigmoid(g).reshape(B, S, 3, G, HG)
    k_cmp = compress(k_c.reshape(B, S, G, D_K), pos_k, ck_w1, ck_b1, ck_w2)
    v_cmp = compress(v_c.reshape(B, S, G, D_V), pos_v, cv_w1, cv_b1, cv_w2)
    n_cmp = k_cmp.shape[1]
    n_slc = S // SLC_BLOCK
    n_sel = min(N_SLC, n_slc)
    cmp_end = jnp.arange(n_cmp) * CMP_STRIDE + CMP_BLOCK - 1
    overlap = selection_overlap(n_cmp, n_slc)
    k_sb = k_s.reshape(B, n_slc, SLC_BLOCK, G, D_K).transpose(0, 3, 1, 2, 4)
    v_sb = v_s.reshape(B, n_slc, SLC_BLOCK, G, D_V).transpose(0, 3, 1, 2, 4)
    k_wp = jnp.pad(k_w.reshape(B, S, G, D_K), ((0, 0), (WINDOW, 0), (0, 0), (0, 0)))
    v_wp = jnp.pad(v_w.reshape(B, S, G, D_V), ((0, 0), (WINDOW, 0), (0, 0), (0, 0)))
    tbl = rel_bias.astype(jnp.float32).reshape(N_BUCKETS, G, HG)
    tbl_g = tbl.transpose(1, 0, 2)
    b_ix = jnp.arange(B)[:, None, None, None]
    g_ix = jnp.arange(G)[None, :, None, None]
    j_ix = jnp.arange(n_slc)

    def block(qb):
        q0 = qb * Q_BLOCK
        t = q0 + jnp.arange(Q_BLOCK)
        qblk = lax.dynamic_slice_in_dim(q, q0, Q_BLOCK, axis=1)
        gblk = lax.dynamic_slice_in_dim(gates, q0, Q_BLOCK, axis=1)
        dist_c = t[:, None] - cmp_end[None, :]
        valid_c = dist_c >= 0
        logit_c = (jnp.einsum('bqghd,bngd->bghqn', qblk, k_cmp).astype(jnp.float32)
                   + tbl[rel_bucket(dist_c)].transpose(2, 3, 0, 1))
        p_c = masked_softmax(logit_c, valid_c)
        o_c = jnp.einsum('bghqn,bngd->bqghd', p_c.astype(v_cmp.dtype), v_cmp)
        imp = jnp.einsum('bghqn,nj->bgqj', p_c, overlap)
        cur = (t // SLC_BLOCK)[:, None]
        forced = (j_ix[None, :] == 0) | (j_ix[None, :] == cur) | (j_ix[None, :] == cur - 1)
        imp = jnp.where(forced, FORCE_SCORE, imp)
        imp = jnp.where(j_ix[None, :] > cur, -1.0, imp)
        _, idx = lax.top_k(imp, n_sel)
        k_sel = k_sb[b_ix, g_ix, idx]
        v_sel = v_sb[b_ix, g_ix, idx]
        pos_s = idx[..., None] * SLC_BLOCK + jnp.arange(SLC_BLOCK)
        dist_s = t[None, None, :, None, None] - pos_s
        valid_s = (dist_s >= 0).reshape(B, G, 1, Q_BLOCK, n_sel * SLC_BLOCK)
        bias_s = tbl_g[g_ix[..., None], rel_bucket(dist_s)].transpose(0, 1, 5, 2, 3, 4)
        logit_s = (jnp.einsum('bqghd,bgqktd->bghqkt', qblk, k_sel).astype(jnp.float32) + bias_s)
        logit_s = logit_s.reshape(B, G, HG, Q_BLOCK, n_sel * SLC_BLOCK)
        p_s = masked_softmax(logit_s, valid_s)
        o_s = jnp.einsum('bghqn,bgqnd->bqghd', p_s.astype(v_sel.dtype),
                         v_sel.reshape(B, G, Q_BLOCK, n_sel * SLC_BLOCK, D_V))
        k_blk = lax.dynamic_slice_in_dim(k_wp, q0, Q_BLOCK + WINDOW, axis=1)
        v_blk = lax.dynamic_slice_in_dim(v_wp, q0, Q_BLOCK + WINDOW, axis=1)
        s = q0 - WINDOW + jnp.arange(Q_BLOCK + WINDOW)
        dist_w = t[:, None] - s[None, :]
        valid_w = (s[None, :] >= 0) & (dist_w >= 0) & (dist_w < WINDOW)
        logit_w = (jnp.einsum('bqghd,bkgd->bghqk', qblk, k_blk).astype(jnp.float32)
                   + tbl[rel_bucket(dist_w)].transpose(2, 3, 0, 1))
        p_w = masked_softmax(logit_w, valid_w)
        o_w = jnp.einsum('bghqk,bkgd->bqghd', p_w.astype(v_blk.dtype), v_blk)
        return (gblk[:, :, 0, :, :, None] * o_c + gblk[:, :, 1, :, :, None] * o_s
                + gblk[:, :, 2, :, :, None] * o_w)

    outs = lax.map(block, jnp.arange(S // Q_BLOCK))
    o = outs.transpose(1, 0, 2, 3, 4, 5).reshape(B, S, N_HEADS * D_V)
    return o @ w_out


def pool_mixer(h, w_in, w_grp, scale, w_out):
    B, S, D = h.shape
    u = (h @ w_in).astype(jnp.float32)
    cs = jnp.pad(jnp.cumsum(u, axis=1), ((0, 0), (1, 0), (0, 0)))
    t = jnp.arange(S)
    groups = []
    for gi, w in enumerate(POOL_WINDOWS):
        lo, hi = gi * POOL_GROUP, (gi + 1) * POOL_GROUP
        start = jnp.maximum(t + 1 - w, 0)
        total = cs[:, 1:, lo:hi] - cs[:, start, lo:hi]
        cnt = (t + 1 - start).astype(jnp.float32)
        groups.append(total / cnt[None, :, None] - u[:, :, lo:hi])
    pooled = jnp.stack(groups, axis=2)
    mixed = jnp.einsum('bsgc,gcd->bsgd', pooled, w_grp.astype(jnp.float32)).reshape(B, S, D)
    mixed = (mixed * scale.astype(jnp.float32)).astype(h.dtype)
    return mixed @ w_out


def swiglu(h, w_gu, w_down):
    gu = h @ w_gu
    gate, up = gu[..., :D_FF], gu[..., D_FF:]
    return (jax.nn.silu(gate) * up) @ w_down


def _normal(key, shape, scale):
    return jax.random.normal(key, shape, jnp.float32) * scale


def setup_inputs(seed: int = 0) -> dict:
    key = jax.random.key(seed)
    ks = jax.random.split(key, 24)
    A, P = N_NSA_LAYERS, N_POOL_LAYERS
    return {
        'x': _normal(ks[0], (BATCH, SEQ, D_MODEL), 1.0),
        'norm_mix': 1.0 + _normal(ks[1], (DEPTH, D_MODEL), 0.02),
        'norm_ffn': 1.0 + _normal(ks[2], (DEPTH, D_MODEL), 0.02),
        'norm_final': 1.0 + _normal(ks[3], (D_MODEL,), 0.02),
        'rel_bias': _normal(ks[4], (N_BUCKETS, N_HEADS), 0.2),
        'nsa_w_in': _normal(ks[5], (A, D_MODEL, NSA_PROJ), D_MODEL ** -0.5),
        'nsa_pos_k': _normal(ks[6], (A, CMP_BLOCK, D_K), 0.1),
        'nsa_pos_v': _normal(ks[7], (A, CMP_BLOCK, D_V), 0.1),
        'nsa_ck_w1': _normal(ks[8], (A, CMP_BLOCK * D_K, CMP_HIDDEN), (CMP_BLOCK * D_K) ** -0.5),
        'nsa_ck_b1': _normal(ks[9], (A, CMP_HIDDEN), 0.01),
        'nsa_ck_w2': _normal(ks[10], (A, CMP_HIDDEN, D_K), CMP_HIDDEN ** -0.5),
        'nsa_cv_w1': _normal(ks[11], (A, CMP_BLOCK * D_V, CMP_HIDDEN), (CMP_BLOCK * D_V) ** -0.5),
        'nsa_cv_b1': _normal(ks[12], (A, CMP_HIDDEN), 0.01),
        'nsa_cv_w2': _normal(ks[13], (A, CMP_HIDDEN, D_V), CMP_HIDDEN ** -0.5),
        'nsa_w_out': _normal(ks[14], (A, N_HEADS * D_V, D_MODEL), (N_HEADS * D_V) ** -0.5),
        'pool_w_in': _normal(ks[15], (P, D_MODEL, D_MODEL), D_MODEL ** -0.5),
        'pool_w_grp': _normal(ks[16], (P, N_POOL_GROUPS, POOL_GROUP, POOL_GROUP), POOL_GROUP ** -0.5),
        'pool_scale': 1.0 + _normal(ks[17], (P, D_MODEL), 0.1),
        'pool_w_out': _normal(ks[18], (P, D_MODEL, D_MODEL), D_MODEL ** -0.5),
        'ffn_w_gu': _normal(ks[19], (DEPTH, D_MODEL, 2 * D_FF), D_MODEL ** -0.5),
        'ffn_w_down': _normal(ks[20], (DEPTH, D_FF, D_MODEL), D_FF ** -0.5),
    }


def reference(x, norm_mix, norm_ffn, norm_final, rel_bias, nsa_w_in, nsa_pos_k, nsa_pos_v,
              nsa_ck_w1, nsa_ck_b1, nsa_ck_w2, nsa_cv_w1, nsa_cv_b1, nsa_cv_w2, nsa_w_out,
              pool_w_in, pool_w_grp, pool_scale, pool_w_out, ffn_w_gu, ffn_w_down):
    for i in range(DEPTH):
        h = rms_norm(x, norm_mix[i])
        li = i // 2
        if i % 2 == 0:
            x = x + nsa_mixer(h, nsa_w_in[li], nsa_pos_k[li], nsa_pos_v[li],
                              nsa_ck_w1[li], nsa_ck_b1[li], nsa_ck_w2[li],
                              nsa_cv_w1[li], nsa_cv_b1[li], nsa_cv_w2[li],
                              nsa_w_out[li], rel_bias)
        else:
            x = x + pool_mixer(h, pool_w_in[li], pool_w_grp[li], pool_scale[li], pool_w_out[li])
        h = rms_norm(x, norm_ffn[i])
        x = x + swiglu(h, ffn_w_gu[i], ffn_w_down[i])
    return rms_norm(x, norm_final)
```

```cpp
#include <hip/hip_runtime.h>
#include <hip/hip_cooperative_groups.h>
#include <cstdio>
#include <cstdint>
namespace cg = cooperative_groups;

#define LAS __attribute__((address_space(3)))
typedef unsigned short bf16_t;
typedef short bf16x8 __attribute__((ext_vector_type(8)));
typedef float f32x4 __attribute__((ext_vector_type(4)));
typedef float f32x2 __attribute__((ext_vector_type(2)));
typedef unsigned u32x4 __attribute__((ext_vector_type(4)));
typedef unsigned u32x2 __attribute__((ext_vector_type(2)));

constexpr int BATCH = 2, SEQ = 16384, DM = 2048, MT = BATCH * SEQ;
constexpr int NG = 4, HG = 8, DK = 96, DV = 64;
constexpr int NPROJ = 5120;
constexpr int C_VC = 3072, C_VS = 3328, C_VW = 3584, C_KC = 3840, C_KS = 4224, C_KW = 4608, C_GATE = 4992;
constexpr int DFF = 5632;
constexpr int NCMP = 1024;
constexpr float EPS = 1e-6f;
constexpr float NEGF = -1e30f;

constexpr size_t MiB = 1u << 20;
constexpr size_t WS_SSQ = 0;
constexpr size_t WS_W_IN = 1 * MiB;
constexpr size_t WS_W_OUT = 21 * MiB;
constexpr size_t WS_W_GU0 = 29 * MiB, WS_W_GU1 = 73 * MiB;
constexpr size_t WS_W_DN0 = 117 * MiB, WS_W_DN1 = 139 * MiB;
constexpr size_t WS_P_IN = 161 * MiB, WS_P_GRP = 169 * MiB, WS_P_OUT = 171 * MiB;
constexpr size_t WS_CK1 = 179 * MiB, WS_CV1 = 181 * MiB, WS_CK2 = 182 * MiB, WS_CV2 = 182 * MiB + 65536;
constexpr size_t WS_KCMP = 183 * MiB, WS_VCMP = 185 * MiB, WS_SELM = 186 * MiB;
constexpr size_t WS_XB = 190 * MiB;
constexpr size_t WS_O = 318 * MiB;
constexpr size_t WS_BIG = 446 * MiB;
constexpr size_t WS_END = 798 * MiB;

typedef __bf16 bf16x2_t __attribute__((ext_vector_type(2)));
__device__ __forceinline__ unsigned cvt_pk_bf16(float lo, float hi) { const f32x2 v = {lo, hi}; const bf16x2_t b = __builtin_convertvector(v, bf16x2_t); return __builtin_bit_cast(unsigned, b); }
__device__ __forceinline__ float bf_lo(unsigned u) { return __uint_as_float(u << 16); }
__device__ __forceinline__ float bf_hi(unsigned u) { return __uint_as_float(u & 0xffff0000u); }
__device__ __forceinline__ float wave_sum(float v) {
#pragma unroll
    for (int o = 1; o < 64; o <<= 1) v += __shfl_xor(v, o);
    return v;
}

namespace pg8 {
constexpr int BM = 256, BK = 64, HALF = 128, HTB = HALF * BK * 2, STAGE_BYTES = 8 * HTB, NXCD = 8, WGM = 8;
__host__ __device__ __forceinline__ int lds_byte(int r, int c) { const int st = (r >> 4) * 2 + (c >> 5), rr = r & 15, cc = c & 31, ob = rr * 64 + cc * 2; return st * 1024 + (ob ^ (((ob >> 9) & 1) << 5)); }
__host__ __device__ __forceinline__ void stage_rc(int b, int& R, int& C) { const int st = b / 1024, sb = b % 1024, swz = sb ^ (((sb >> 9) & 1) << 5); R = (st >> 1) * 16 + swz / 64; C = (st & 1) * 32 + (swz % 64) / 2; }
__host__ __device__ __forceinline__ int perm32(int rho) { const int n = rho >> 4, i = rho & 15; return 8 * (i >> 2) + 4 * n + (i & 3); }

struct Unit { int pm, pn; };
struct Gemm { const bf16_t* A; const bf16_t* Bt; int lda, ldb, M, N, K; int acolb; };

struct StaticOrder {
    int nM, nN, nwg, G, c;
    __device__ void init(int M, int N, int G_, int c_) { nM = M / BM; nN = N / BM; nwg = nM * nN; G = G_; c = c_; }
    __device__ bool next(int i, Unit& u) const {
        const long L = (long)i * G + c; if (L >= nwg) return false;
        int wgid = (int)L; { const int q = nwg / NXCD, r = nwg % NXCD, xcd = wgid % NXCD, off = wgid / NXCD; wgid = (xcd < r ? xcd * (q + 1) : r * (q + 1) + (xcd - r) * q) + off; }
        const int nig = WGM * nN, gid = wgid / nig, fm = gid * WGM, gsz = (nM - fm) < WGM ? (nM - fm) : WGM;
        u.pm = fm + ((wgid % nig) % gsz); u.pn = (wgid % nig) / gsz; return true;
    }
};

template <class Epi>
__device__ __forceinline__ void gemm_phase(LAS unsigned char* lds, const Gemm g, const StaticOrder& S, const Epi& E) {
    const int tid = threadIdx.x, wid = __builtin_amdgcn_readfirstlane(tid >> 6), lane = tid & 63, wr = wid >> 2, wc = wid & 3, fr = lane & 15, fq = lane >> 4;
    const int K = g.K, nt = K / BK;
    unsigned voffA[2], voffB[2];
#pragma unroll
    for (int i = 0; i < 2; ++i) { int R, C; stage_rc(tid * 16 + i * 8192, R, C); const int Rb = (R & ~31) + perm32(R & 31);
        voffA[i] = (unsigned)(R * g.lda + C) * 2u; voffB[i] = (unsigned)(Rb * g.ldb + C) * 2u; }
    const size_t kstep = (size_t)(BK * 2);
    const size_t hstepA = (size_t)HALF * g.lda * 2, hstepB = (size_t)HALF * g.ldb * 2;
    const size_t tstepA = 2 * hstepA, tstepB = 2 * hstepB;
    const unsigned ldsw = (unsigned)wid * 1024u;
    const int aoff = lds_byte(wr * 64 + fr, fq * 8), boff = lds_byte(wc * 32 + fr, fq * 8);
#define PG8_SA(b, h) (((b) * 2 + (h)) * HTB)
#define PG8_SB(b, h) ((4 + (b) * 2 + (h)) * HTB)
#define PG8_STAGE(bufoff, gbase, voff) do { _Pragma("unroll") for (int _i = 0; _i < 2; ++_i) \
        __builtin_amdgcn_global_load_lds((const unsigned*)((const char*)(gbase) + (voff)[_i]), (LAS unsigned*)(lds + (bufoff) + ldsw + _i * 8192), 16, 0, 0); } while (0)
#define PG8_LDA(dst, b, h) do { _Pragma("unroll") for (int m = 0; m < 4; ++m) _Pragma("unroll") for (int k = 0; k < 2; ++k) dst[m][k] = *(const LAS bf16x8*)(lds + PG8_SA(b, h) + aoff + m * 2048 + k * 1024); } while (0)
#define PG8_LDB(dst, b, h) do { _Pragma("unroll") for (int n = 0; n < 2; ++n) _Pragma("unroll") for (int k = 0; k < 2; ++k) dst[n][k] = *(const LAS bf16x8*)(lds + PG8_SB(b, h) + boff + n * 2048 + k * 1024); } while (0)
#define PG8_MMA(ai, bj, At, Bt) do { __builtin_amdgcn_s_setprio(1); _Pragma("unroll") for (int m = 0; m < 4; ++m) _Pragma("unroll") for (int n = 0; n < 2; ++n) _Pragma("unroll") for (int k = 0; k < 2; ++k) \
        acc[ai][bj][m][n] = __builtin_amdgcn_mfma_f32_16x16x32_bf16(Bt[n][k], At[m][k], acc[ai][bj][m][n], 0, 0, 0); __builtin_amdgcn_s_setprio(0); } while (0)
#define PG8_WAIT_V(n) asm volatile("s_waitcnt vmcnt(" #n ")" ::: "memory")
#define PG8_WAIT_L(n) asm volatile("s_waitcnt lgkmcnt(" #n ")" ::: "memory")
#define PG8_BAR __builtin_amdgcn_s_barrier()
#define PG8_SCHED __builtin_amdgcn_sched_barrier(0)
#define PG8_APTR(u) ((const char*)g.A + (size_t)(u).pm * tstepA + (size_t)((u).pn >> 1) * (size_t)g.acolb)
#define PG8_BPTR(u) ((const char*)g.Bt + (size_t)(u).pn * tstepB)
    Unit cur, nxt; int ui = 0;
    if (!S.next(0, cur)) return;
    f32x4 acc[2][2][4][2];
#pragma unroll
    for (int a = 0; a < 2; ++a)
#pragma unroll
        for (int b = 0; b < 2; ++b)
#pragma unroll
            for (int m = 0; m < 4; ++m)
#pragma unroll
                for (int n = 0; n < 2; ++n) acc[a][b][m][n] = (f32x4){0.f, 0.f, 0.f, 0.f};
    bf16x8 At[4][2], B0[2][2], B1[2][2];
    const char* cA = PG8_APTR(cur); const char* cB = PG8_BPTR(cur);
    PG8_STAGE(PG8_SB(0, 0), cB, voffB); PG8_STAGE(PG8_SB(0, 1), cB + hstepB, voffB); PG8_STAGE(PG8_SA(0, 0), cA, voffA); PG8_STAGE(PG8_SA(0, 1), cA + hstepA, voffA);
    if (wr == 1) PG8_BAR;
    PG8_WAIT_V(2); PG8_BAR;
    PG8_STAGE(PG8_SB(1, 0), cB + kstep, voffB); PG8_STAGE(PG8_SA(1, 0), cA + kstep, voffA); PG8_STAGE(PG8_SB(1, 1), cB + hstepB + kstep, voffB);
    PG8_WAIT_V(6); PG8_BAR;
    for (;;) {
        const bool has_next = S.next(ui + 1, nxt);
        const char* nA = has_next ? PG8_APTR(nxt) : cA; const char* nB = has_next ? PG8_BPTR(nxt) : cB;
        for (int t = 0; t < nt; t += 2) {
            const bool last = (t == nt - 2);
            const char* a1 = cA + (size_t)(t + 1) * kstep;
            const char* a2 = last ? nA : cA + (size_t)(t + 2) * kstep; const char* b2 = last ? nB : cB + (size_t)(t + 2) * kstep;
            const char* a3 = a2 + kstep; const char* b3 = b2 + kstep;
            PG8_LDB(B0, 0, 0); PG8_LDB(B1, 0, 1); PG8_SCHED; PG8_LDA(At, 0, 0); PG8_STAGE(PG8_SA(1, 1), a1 + hstepA, voffA);
            PG8_WAIT_V(8); PG8_WAIT_L(0); PG8_BAR; PG8_MMA(0, 0, At, B0); PG8_MMA(0, 1, At, B1); PG8_BAR; PG8_SCHED;
            PG8_LDA(At, 0, 1); PG8_STAGE(PG8_SB(0, 0), b2, voffB); PG8_STAGE(PG8_SB(0, 1), b2 + hstepB, voffB); PG8_STAGE(PG8_SA(0, 0), a2, voffA);
            PG8_WAIT_V(8); PG8_WAIT_L(0); PG8_BAR; PG8_MMA(1, 0, At, B0); PG8_MMA(1, 1, At, B1); PG8_BAR; PG8_SCHED;
            PG8_LDB(B0, 1, 0); PG8_LDB(B1, 1, 1); PG8_SCHED; PG8_LDA(At, 1, 0); PG8_STAGE(PG8_SA(0, 1), a2 + hstepA, voffA);
            PG8_WAIT_V(8); PG8_WAIT_L(0); PG8_BAR; PG8_MMA(0, 0, At, B0); PG8_MMA(0, 1, At, B1); PG8_BAR; PG8_SCHED;
            PG8_LDA(At, 1, 1); PG8_STAGE(PG8_SB(1, 0), b3, voffB); PG8_STAGE(PG8_SB(1, 1), b3 + hstepB, voffB); PG8_STAGE(PG8_SA(1, 0), a3, voffA);
            PG8_WAIT_V(8); PG8_WAIT_L(0); PG8_BAR; PG8_MMA(1, 0, At, B0); PG8_MMA(1, 1, At, B1); PG8_BAR; PG8_SCHED;
        }
        if (wr == 0) PG8_BAR;
        E(acc, cur, wr, wc, fr, fq);
        if (!has_next) break;
#pragma unroll
        for (int a = 0; a < 2; ++a)
#pragma unroll
            for (int b = 0; b < 2; ++b)
#pragma unroll
                for (int m = 0; m < 4; ++m)
#pragma unroll
                    for (int n = 0; n < 2; ++n) acc[a][b][m][n] = (f32x4){0.f, 0.f, 0.f, 0.f};
        cur = nxt; cA = nA; cB = nB; ++ui;
        if (wr == 1) PG8_BAR;
    }
    PG8_WAIT_V(0);
    PG8_BAR;
#undef PG8_SA
#undef PG8_SB
#undef PG8_STAGE
#undef PG8_LDA
#undef PG8_LDB
#undef PG8_MMA
#undef PG8_WAIT_V
#undef PG8_WAIT_L
#undef PG8_BAR
#undef PG8_SCHED
#undef PG8_APTR
#undef PG8_BPTR
}

#define EPI_ROW(u, ai, m) ((u).pm * BM + (ai) * HALF + wr * 64 + (m) * 16 + fr)
__device__ __forceinline__ u32x4 pack8(f32x4 v0, f32x4 v1) { u32x4 w; w.x = cvt_pk_bf16(v0[0], v0[1]); w.y = cvt_pk_bf16(v0[2], v0[3]); w.z = cvt_pk_bf16(v1[0], v1[1]); w.w = cvt_pk_bf16(v1[2], v1[3]); return w; }

struct EpiProj {
    bf16_t* O; const float* ssq;
    __device__ __forceinline__ void operator()(const f32x4 (&acc)[2][2][4][2], const Unit& u, int wr, int wc, int fr, int fq) const {
        const float qs = (u.pn < 12) ? 0.10206207261596577f : 1.0f;
#pragma unroll
        for (int ai = 0; ai < 2; ++ai)
#pragma unroll
            for (int m = 0; m < 4; ++m) { const int row = EPI_ROW(u, ai, m); const float rs = rsqrtf(ssq[row] * (1.0f / DM) + EPS) * qs;
#pragma unroll
                for (int bj = 0; bj < 2; ++bj) { const int c0 = u.pn * BM + bj * HALF + wc * 32 + 8 * fq;
                    *(u32x4*)(O + (size_t)row * NPROJ + c0) = pack8(acc[ai][bj][m][0] * rs, acc[ai][bj][m][1] * rs); } }
    }
};
struct EpiRowScale {
    bf16_t* O; const float* ssq;
    __device__ __forceinline__ void operator()(const f32x4 (&acc)[2][2][4][2], const Unit& u, int wr, int wc, int fr, int fq) const {
#pragma unroll
        for (int ai = 0; ai < 2; ++ai)
#pragma unroll
            for (int m = 0; m < 4; ++m) { const int row = EPI_ROW(u, ai, m); const float rs = rsqrtf(ssq[row] * (1.0f / DM) + EPS);
#pragma unroll
                for (int bj = 0; bj < 2; ++bj) { const int c0 = u.pn * BM + bj * HALF + wc * 32 + 8 * fq;
                    *(u32x4*)(O + (size_t)row * DM + c0) = pack8(acc[ai][bj][m][0] * rs, acc[ai][bj][m][1] * rs); } }
    }
};
struct EpiColScale {
    bf16_t* O; const float* scale;
    __device__ __forceinline__ void operator()(const f32x4 (&acc)[2][2][4][2], const Unit& u, int wr, int wc, int fr, int fq) const {
#pragma unroll
        for (int bj = 0; bj < 2; ++bj) { const int c0 = u.pn * BM + bj * HALF + wc * 32 + 8 * fq;
            const f32x4 s0 = *(const f32x4*)(scale + c0), s1 = *(const f32x4*)(scale + c0 + 4);
#pragma unroll
            for (int ai = 0; ai < 2; ++ai)
#pragma unroll
                for (int m = 0; m < 4; ++m) { const int row = EPI_ROW(u, ai, m);
                    *(u32x4*)(O + (size_t)row * DM + c0) = pack8(acc[ai][bj][m][0] * s0, acc[ai][bj][m][1] * s1); } }
    }
};
struct EpiSwiglu {
    bf16_t* O; const float* ssq;
    __device__ __forceinline__ void operator()(const f32x4 (&acc)[2][2][4][2], const Unit& u, int wr, int wc, int fr, int fq) const {
        const int c0 = u.pn * HALF + wc * 32 + 8 * fq;
#pragma unroll
        for (int ai = 0; ai < 2; ++ai)
#pragma unroll
            for (int m = 0; m < 4; ++m) { const int row = EPI_ROW(u, ai, m); const float rs = rsqrtf(ssq[row] * (1.0f / DM) + EPS);
                f32x4 r[2];
#pragma unroll
                for (int n = 0; n < 2; ++n)
#pragma unroll
                    for (int j = 0; j < 4; ++j) { const float gt = acc[ai][0][m][n][j] * rs, up = acc[ai][1][m][n][j] * rs; r[n][j] = gt * up * __builtin_amdgcn_rcpf(1.0f + __expf(-gt)); }
                *(u32x4*)(O + (size_t)row * DFF + c0) = pack8(r[0], r[1]); }
    }
};
struct EpiRes {
    const float* src; float* dst; bf16_t* xb; float* ssq_out;
    __device__ __forceinline__ void operator()(const f32x4 (&acc)[2][2][4][2], const Unit& u, int wr, int wc, int fr, int fq) const {
#pragma unroll
        for (int ai = 0; ai < 2; ++ai)
#pragma unroll
            for (int m = 0; m < 4; ++m) { const int row = EPI_ROW(u, ai, m); float ss = 0.f;
#pragma unroll
                for (int bj = 0; bj < 2; ++bj) { const size_t off = (size_t)row * DM + u.pn * BM + bj * HALF + wc * 32 + 8 * fq;
                    const f32x4 x0 = *(const f32x4*)(src + off) + acc[ai][bj][m][0], x1 = *(const f32x4*)(src + off + 4) + acc[ai][bj][m][1];
                    *(f32x4*)(dst + off) = x0; *(f32x4*)(dst + off + 4) = x1; *(u32x4*)(xb + off) = pack8(x0, x1);
                    ss += (x0[0] * x0[0] + x0[1] * x0[1]) + (x0[2] * x0[2] + x0[3] * x0[3]) + (x1[0] * x1[0] + x1[1] * x1[1]) + (x1[2] * x1[2] + x1[3] * x1[3]); }
                ss += __shfl_xor(ss, 16); ss += __shfl_xor(ss, 32);
                if (fq == 0) atomicAdd(ssq_out + row, ss); }
    }
};
}

struct Params {
    const float* x; const float* norm_mix; const float* norm_ffn; const float* norm_final; const float* rel_bias;
    const float* nsa_w_in; const float* pos_k; const float* pos_v; const float* ck_w1; const float* ck_b1; const float* ck_w2;
    const float* cv_w1; const float* cv_b1; const float* cv_w2; const float* nsa_w_out;
    const float* pool_w_in; const float* pool_w_grp; const float* pool_scale; const float* pool_w_out; const float* ffn_w_gu; const float* ffn_w_down;
    float* out; unsigned char* ws;
};

constexpr int NTHR = 512, NWAVES = 8;
constexpr int LDS_BYTES = 135168;

__device__ __forceinline__ int nsa_map(int n0) {
    if (n0 < 3072) return n0;
    if (n0 < 3456) return C_KC + (n0 - 3072);
    if (n0 < 3712) return C_VC + (n0 - 3456);
    if (n0 < 4096) return C_KS + (n0 - 3712);
    if (n0 < 4352) return C_VS + (n0 - 4096);
    if (n0 < 4736) return C_KW + (n0 - 4352);
    if (n0 < 4992) return C_VW + (n0 - 4736);
    return C_GATE + (n0 - 4992);
}
__device__ __forceinline__ int gu_map(int n0) { return n0 < DFF ? (n0 >> 7) * 256 + (n0 & 127) : ((n0 - DFF) >> 7) * 256 + 128 + ((n0 - DFF) & 127); }

template <int MAP>
__device__ __forceinline__ void transpose_items(const float* W, int K, int N, bf16_t* WT, int ldd, int row_off, const float* fold, LAS float* scr, int gw, int ngw, int lane) {
    const int nblk = N / 32, nitems = (K / 64) * nblk;
    for (int item = gw; item < nitems; item += ngw) {
        const int kb = item / nblk, nb = item % nblk, k0 = 64 * kb, n0 = 32 * nb;
        const int d0 = row_off + (MAP == 1 ? nsa_map(n0) : (MAP == 2 ? gu_map(n0) : n0));
#pragma unroll 8
        for (int i = 0; i < 32; ++i) { const int kk = 2 * i + (lane >> 5); float v = W[(size_t)(k0 + kk) * N + n0 + (lane & 31)]; if (fold) v *= fold[k0 + kk]; scr[kk * 33 + (lane & 31)] = v; }
        asm volatile("s_waitcnt lgkmcnt(0)" ::: "memory");
        const int c = lane & 7;
#pragma unroll
        for (int j = 0; j < 4; ++j) { const int n = (lane >> 3) + 8 * j; const LAS float* s = scr + (8 * c) * 33 + n;
            u32x4 o; o.x = cvt_pk_bf16(s[0 * 33], s[1 * 33]); o.y = cvt_pk_bf16(s[2 * 33], s[3 * 33]); o.z = cvt_pk_bf16(s[4 * 33], s[5 * 33]); o.w = cvt_pk_bf16(s[6 * 33], s[7 * 33]);
            *(u32x4*)(WT + (size_t)(d0 + n) * ldd + k0 + 8 * c) = o; }
        asm volatile("s_waitcnt lgkmcnt(0)" ::: "memory");
    }
}

__device__ __forceinline__ void phase_prologue(const Params& p, LAS unsigned char* lds) {
    const int tid = threadIdx.x, lane = tid & 63, wave = tid >> 6;
    const int gw = blockIdx.x * NWAVES + wave, ngw = gridDim.x * NWAVES;
    LAS float* scr = (LAS float*)(lds + wave * 8704);
    unsigned char* ws = p.ws;
    { float* ssq = (float*)(ws + WS_SSQ); for (int i = blockIdx.x * NTHR + tid; i < 4 * MT; i += gridDim.x * NTHR) ssq[MT + i] = 0.f; }
    transpose_items<1>(p.nsa_w_in, DM, 5088, (bf16_t*)(ws + WS_W_IN), DM, 0, p.norm_mix, scr, gw, ngw, lane);
    transpose_items<0>(p.nsa_w_out, DM, DM, (bf16_t*)(ws + WS_W_OUT), DM, 0, nullptr, scr, gw, ngw, lane);
    transpose_items<2>(p.ffn_w_gu, DM, 2 * DFF, (bf16_t*)(ws + WS_W_GU0), DM, 0, p.norm_ffn, scr, gw, ngw, lane);
    transpose_items<2>(p.ffn_w_gu + (size_t)DM * 2 * DFF, DM, 2 * DFF, (bf16_t*)(ws + WS_W_GU1), DM, 0, p.norm_ffn + DM, scr, gw, ngw, lane);
    transpose_items<0>(p.ffn_w_down, DFF, DM, (bf16_t*)(ws + WS_W_DN0), DFF, 0, nullptr, scr, gw, ngw, lane);
    transpose_items<0>(p.ffn_w_down + (size_t)DFF * DM, DFF, DM, (bf16_t*)(ws + WS_W_DN1), DFF, 0, nullptr, scr, gw, ngw, lane);
    transpose_items<0>(p.pool_w_in, DM, DM, (bf16_t*)(ws + WS_P_IN), DM, 0, p.norm_mix + DM, scr, gw, ngw, lane);
#pragma unroll 1
    for (int gi = 0; gi < 4; ++gi) transpose_items<0>(p.pool_w_grp + (size_t)gi * 512 * 512, 512, 512, (bf16_t*)(ws + WS_P_GRP), 512, gi * 512, nullptr, scr, gw, ngw, lane);
    transpose_items<0>(p.pool_w_out, DM, DM, (bf16_t*)(ws + WS_P_OUT), DM, 0, nullptr, scr, gw, ngw, lane);
    transpose_items<0>(p.ck_w1, 32 * DK, 256, (bf16_t*)(ws + WS_CK1), 32 * DK, 0, nullptr, scr, gw, ngw, lane);
    transpose_items<0>(p.cv_w1, 32 * DV, 256, (bf16_t*)(ws + WS_CV1), 32 * DV, 0, nullptr, scr, gw, ngw, lane);
    transpose_items<0>(p.ck_w2, 256, DK, (bf16_t*)(ws + WS_CK2), 256, 0, nullptr, scr, gw, ngw, lane);
    transpose_items<0>(p.cv_w2, 256, DV, (bf16_t*)(ws + WS_CV2), 256, 0, nullptr, scr, gw, ngw, lane);
    float* ssq0 = (float*)(ws + WS_SSQ); bf16_t* xb = (bf16_t*)(ws + WS_XB);
    for (int row = gw; row < MT; row += ngw) {
        const f32x4* xr = (const f32x4*)(p.x + (size_t)row * DM) + lane; u32x2* o = (u32x2*)(xb + (size_t)row * DM) + lane;
        float s = 0.f;
#pragma unroll
        for (int j = 0; j < 8; ++j) { const f32x4 v = xr[64 * j]; s += (v[0] * v[0] + v[1] * v[1]) + (v[2] * v[2] + v[3] * v[3]); u32x2 w; w.x = cvt_pk_bf16(v[0], v[1]); w.y = cvt_pk_bf16(v[2], v[3]); o[64 * j] = w; }
        s = wave_sum(s);
        if (lane == 0) ssq0[row] = s;
    }
}

__device__ __forceinline__ float gelu_tanh(float x) { const float u = 0.7978845608028654f * (x + 0.044715f * x * x * x); return 0.5f * x * (1.0f + tanhf(u)); }

template <int DH>
__device__ __forceinline__ void compress_unit(const Params& p, LAS unsigned char* lds, int b, int n0, int colbase, const float* pos, const bf16_t* w1t, const float* b1, const bf16_t* w2t, bf16_t* outp) {
    constexpr int KC = 32 * DH;
    const int tid = threadIdx.x, lane = tid & 63, wave = __builtin_amdgcn_readfirstlane(tid >> 6), c = lane & 15, kq = lane >> 4;
    const bf16_t* proj = (const bf16_t*)(p.ws + WS_BIG);
    LAS unsigned char* As = lds; LAS unsigned char* Bs = lds + 5120; LAS unsigned char* Hs = lds + 32768;
    const int arow = tid >> 2, ach = tid & 3;
    const int ag = arow >> 4, an = n0 + (arow & 15);
    u32x4 areg = {0, 0, 0, 0}, breg[2];
#define CMP_LOAD(k0_) do { const int k0v = (k0_); \
        if (tid < 256) { const int kk = k0v + ach * 8, l = kk / DH, d = kk % DH; int tok = 16 * an + l; tok = tok < SEQ ? tok : SEQ - 1; \
            const u32x4 raw = *(const u32x4*)(proj + (size_t)(b * SEQ + tok) * NPROJ + colbase + ag * DH + d); \
            const f32x4 p0 = *(const f32x4*)(pos + l * DH + d), p1 = *(const f32x4*)(pos + l * DH + d + 4); \
            areg.x = cvt_pk_bf16(bf_lo(raw.x) + p0[0], bf_hi(raw.x) + p0[1]); areg.y = cvt_pk_bf16(bf_lo(raw.y) + p0[2], bf_hi(raw.y) + p0[3]); \
            areg.z = cvt_pk_bf16(bf_lo(raw.z) + p1[0], bf_hi(raw.z) + p1[1]); areg.w = cvt_pk_bf16(bf_lo(raw.w) + p1[2], bf_hi(raw.w) + p1[3]); } \
        _Pragma("unroll") for (int i_ = 0; i_ < 2; ++i_) { const int idx = tid + 512 * i_; breg[i_] = *(const u32x4*)(w1t + (size_t)(idx >> 2) * KC + k0v + (idx & 3) * 8); } } while (0)
    f32x4 acc[4][2];
#pragma unroll
    for (int m = 0; m < 4; ++m) { acc[m][0] = (f32x4){0.f, 0.f, 0.f, 0.f}; acc[m][1] = (f32x4){0.f, 0.f, 0.f, 0.f}; }
    CMP_LOAD(0);
    for (int k0 = 0; k0 < KC; k0 += 32) {
        __syncthreads();
        if (tid < 256) *(LAS u32x4*)(As + arow * 80 + ach * 16) = areg;
#pragma unroll
        for (int i = 0; i < 2; ++i) { const int idx = tid + 512 * i; *(LAS u32x4*)(Bs + (idx >> 2) * 80 + (idx & 3) * 16) = breg[i]; }
        __syncthreads();
        if (k0 + 32 < KC) CMP_LOAD(k0 + 32);
        bf16x8 af[4], bfr[2];
#pragma unroll
        for (int m = 0; m < 4; ++m) af[m] = *(const LAS bf16x8*)(As + (16 * m + c) * 80 + kq * 16);
#pragma unroll
        for (int n = 0; n < 2; ++n) bfr[n] = *(const LAS bf16x8*)(Bs + (32 * wave + 16 * n + c) * 80 + kq * 16);
#pragma unroll
        for (int m = 0; m < 4; ++m)
#pragma unroll
            for (int n = 0; n < 2; ++n) acc[m][n] = __builtin_amdgcn_mfma_f32_16x16x32_bf16(af[m], bfr[n], acc[m][n], 0, 0, 0);
    }
#pragma unroll
    for (int n = 0; n < 2; ++n) { const int col = 32 * wave + 16 * n + c; const float bb = b1[col];
#pragma unroll
        for (int m = 0; m < 4; ++m)
#pragma unroll
            for (int i = 0; i < 4; ++i) { const float h = gelu_tanh(acc[m][n][i] + bb); *(LAS bf16_t*)(Hs + (16 * m + 4 * kq + i) * 528 + col * 2) = (bf16_t)(cvt_pk_bf16(h, 0.f) & 0xffffu); } }
    __syncthreads();
    constexpr int NT2 = 4 * (DH / 16);
    for (int idx = wave; idx < NT2; idx += 8) {
        const int m2 = idx & 3, n2 = idx >> 2;
        f32x4 a2 = {0.f, 0.f, 0.f, 0.f};
#pragma unroll
        for (int ks = 0; ks < 8; ++ks) { const bf16x8 a = *(const LAS bf16x8*)(Hs + (16 * m2 + c) * 528 + (32 * ks + 8 * kq) * 2);
            const bf16x8 bb = *(const bf16x8*)(w2t + (size_t)(16 * n2 + c) * 256 + 32 * ks + 8 * kq);
            a2 = __builtin_amdgcn_mfma_f32_16x16x32_bf16(a, bb, a2, 0, 0, 0); }
#pragma unroll
        for (int i = 0; i < 4; ++i) outp[((size_t)(b * NG + m2) * NCMP + n0 + 4 * kq + i) * DH + 16 * n2 + c] = (bf16_t)(cvt_pk_bf16(a2[i], 0.f) & 0xffffu);
    }
    __syncthreads();
}

__device__ __forceinline__ void phase_compress(const Params& p, LAS unsigned char* lds) {
    unsigned char* ws = p.ws;
    for (int u = blockIdx.x; u < 256; u += gridDim.x) {
        const int which = u >> 7, b = (u >> 6) & 1, n0 = (u & 63) * 16;
        if (which == 0) compress_unit<DK>(p, lds, b, n0, C_KC, p.pos_k, (const bf16_t*)(ws + WS_CK1), p.ck_b1, (const bf16_t*)(ws + WS_CK2), (bf16_t*)(ws + WS_KCMP));
        else compress_unit<DV>(p, lds, b, n0, C_VC, p.pos_v, (const bf16_t*)(ws + WS_CV1), p.cv_b1, (const bf16_t*)(ws + WS_CV2), (bf16_t*)(ws + WS_VCMP));
    }
}

constexpr int KT_STRIDE = 208, KT_BYTES = 64 * KT_STRIDE;
constexpr int VT_STRIDE = 144, VT_BYTES = 64 * VT_STRIDE;
constexpr int L_K = 0, L_V = 2 * KT_BYTES, L_BIAS = L_V + 2 * VT_BYTES, L_IMP = L_BIAS + 4 * 8 * 132 * 4, L_SELM = L_IMP + 32 * 256 * 4, L_ATT_END = L_SELM + 2048;
static_assert(L_ATT_END <= 131072, "attention LDS map");

struct PairState { f32x4 o[4]; float m, l; bf16x8 q[3]; };
struct TileSrc { const bf16_t* K; const bf16_t* V; int kld, vld; };
struct StageRegs { u32x4 k0, k1, v; };

__device__ __forceinline__ void stage_load(StageRegs& r, const TileSrc& s, int key0, int tid) {
    { const int key = tid / 12, ch = tid % 12; r.k0 = *(const u32x4*)(s.K + (size_t)(key0 + key) * s.kld + ch * 8); }
    if (tid < 256) { const int idx = 512 + tid, key = idx / 12, ch = idx % 12; r.k1 = *(const u32x4*)(s.K + (size_t)(key0 + key) * s.kld + ch * 8); }
    { const int key = tid >> 3, ch = tid & 7; r.v = *(const u32x4*)(s.V + (size_t)(key0 + key) * s.vld + ch * 8); }
}
__device__ __forceinline__ void stage_store(const StageRegs& r, LAS unsigned char* lds, int buf, int tid) {
    LAS unsigned char* Kt = lds + L_K + buf * KT_BYTES; LAS unsigned char* Vt = lds + L_V + buf * VT_BYTES;
    { const int key = tid / 12, ch = tid % 12; *(LAS u32x4*)(Kt + key * KT_STRIDE + ch * 16) = r.k0; }
    if (tid < 256) { const int idx = 512 + tid, key = idx / 12, ch = idx % 12; *(LAS u32x4*)(Kt + key * KT_STRIDE + ch * 16) = r.k1; }
    { const int key = tid >> 3, ch = tid & 7; const int kk = key & 31; const int slot = (key & 32) + 8 * ((kk & 15) >> 2) + 4 * (kk >> 4) + (kk & 3);
        LAS unsigned char* base = Vt + (ch * 8) * VT_STRIDE + slot * 2; const unsigned w[4] = {r.v.x, r.v.y, r.v.z, r.v.w};
#pragma unroll
        for (int e = 0; e < 4; ++e) { *(LAS bf16_t*)(base + (2 * e) * VT_STRIDE) = (bf16_t)(w[e] & 0xffffu); *(LAS bf16_t*)(base + (2 * e + 1) * VT_STRIDE) = (bf16_t)(w[e] >> 16); } }
}

template <int MODE>
__device__ __forceinline__ void pair_tile(PairState& st, const LAS unsigned char* Kt, const LAS unsigned char* Vt, int tadj, int kstride, int maxdist, bool rowsel, bool far,
                                          const LAS float* biasrow, float bias_far, LAS float* improw, int jj0, int lane) {
    const int c = lane & 15, kq = lane >> 4;
    f32x4 s[4];
#pragma unroll
    for (int kt = 0; kt < 4; ++kt) { s[kt] = (f32x4){0.f, 0.f, 0.f, 0.f};
#pragma unroll
        for (int ds = 0; ds < 3; ++ds) { const bf16x8 a = *(const LAS bf16x8*)(Kt + (16 * kt + c) * KT_STRIDE + (32 * ds + 8 * kq) * 2);
            s[kt] = __builtin_amdgcn_mfma_f32_16x16x32_bf16(a, st.q[ds], s[kt], 0, 0, 0); } }
    if (far) {
#pragma unroll
        for (int kt = 0; kt < 4; ++kt) s[kt] = s[kt] + bias_far;
    } else {
#pragma unroll
        for (int kt = 0; kt < 4; ++kt)
#pragma unroll
            for (int i = 0; i < 4; ++i) { const int d = tadj - (16 * kt + 4 * kq + i) * kstride; const bool valid = (d >= 0) && (d < maxdist) && rowsel;
                const int bi = d < 0 ? 0 : (d > 128 ? 128 : d); s[kt][i] = valid ? s[kt][i] + biasrow[bi] : NEGF; }
    }
    float mref, scale;
    if (MODE == 1) { mref = st.m; scale = st.l; }
    else {
        float mx = NEGF;
#pragma unroll
        for (int kt = 0; kt < 4; ++kt) mx = fmaxf(fmaxf(fmaxf(s[kt][0], s[kt][1]), fmaxf(s[kt][2], s[kt][3])), mx);
        mx = fmaxf(mx, __shfl_xor(mx, 16)); mx = fmaxf(mx, __shfl_xor(mx, 32));
        const float mnew = fmaxf(st.m, mx); const float alpha = __expf(st.m - mnew);
        st.l *= alpha; st.m = mnew; mref = mnew; scale = 1.0f;
        if (MODE == 2) {
#pragma unroll
            for (int dt = 0; dt < 4; ++dt) st.o[dt] = st.o[dt] * alpha;
        }
    }
    float psum = 0.f;
#pragma unroll
    for (int kt = 0; kt < 4; ++kt)
#pragma unroll
        for (int i = 0; i < 4; ++i) { const float pv = (s[kt][i] <= -1e29f) ? 0.f : __expf(s[kt][i] - mref) * scale; s[kt][i] = pv; psum += pv; }
    if (MODE != 1) st.l += psum;
    if (MODE == 0) return;
#pragma unroll
    for (int s2 = 0; s2 < 2; ++s2) {
        u32x4 pw; pw.x = cvt_pk_bf16(s[2 * s2][0], s[2 * s2][1]); pw.y = cvt_pk_bf16(s[2 * s2][2], s[2 * s2][3]); pw.z = cvt_pk_bf16(s[2 * s2 + 1][0], s[2 * s2 + 1][1]); pw.w = cvt_pk_bf16(s[2 * s2 + 1][2], s[2 * s2 + 1][3]);
        const bf16x8 pb = __builtin_bit_cast(bf16x8, pw);
#pragma unroll
        for (int dt = 0; dt < 4; ++dt) { const bf16x8 a = *(const LAS bf16x8*)(Vt + (16 * dt + c) * VT_STRIDE + (32 * s2 + 8 * kq) * 2);
            st.o[dt] = __builtin_amdgcn_mfma_f32_16x16x32_bf16(a, pb, st.o[dt], 0, 0, 0); }
    }
    if (MODE == 1) {
#pragma unroll
        for (int kt = 0; kt < 4; ++kt) {
            float u0 = 2.0f * (s[kt][0] + s[kt][1] + s[kt][2]) + s[kt][3], u1 = s[kt][3];
            u0 += __shfl_xor(u0, 1); u1 += __shfl_xor(u1, 1); u0 += __shfl_xor(u0, 2); u1 += __shfl_xor(u1, 2); u0 += __shfl_xor(u0, 4); u1 += __shfl_xor(u1, 4);
            if ((lane & 7) == 0) { const int jj = jj0 + 4 * kt + kq;
                __hip_atomic_fetch_add(improw + jj, u0, __ATOMIC_RELAXED, __HIP_MEMORY_SCOPE_WORKGROUP);
                if (jj + 1 < 256) __hip_atomic_fetch_add(improw + jj + 1, u1, __ATOMIC_RELAXED, __HIP_MEMORY_SCOPE_WORKGROUP); }
        }
    }
}

__device__ __forceinline__ int t5_bucket(int n) {
    if (n < 16) return n;
    int bk = 16;
    bk += (n >= 19); bk += (n >= 21); bk += (n >= 24); bk += (n >= 27); bk += (n >= 31); bk += (n >= 35); bk += (n >= 40); bk += (n >= 46);
    bk += (n >= 52); bk += (n >= 59); bk += (n >= 67); bk += (n >= 77); bk += (n >= 87); bk += (n >= 99); bk += (n >= 113);
    return bk;
}
__device__ __forceinline__ void build_bias(const Params& p, LAS unsigned char* lds) {
    LAS float* bt = (LAS float*)(lds + L_BIAS);
    for (int i = threadIdx.x; i < 32 * 129; i += NTHR) { const int h = i / 129, d = i % 129; bt[h * 132 + d] = p.rel_bias[t5_bucket(d) * 32 + h]; }
    __syncthreads();
}

__device__ __forceinline__ void load_q(PairState& st, const bf16_t* proj, int b, int g, int tq0, int lane) {
    const int c = lane & 15, kq = lane >> 4; const size_t row = (size_t)b * SEQ + tq0 + (c >> 3);
#pragma unroll
    for (int ds = 0; ds < 3; ++ds) st.q[ds] = *(const bf16x8*)(proj + row * NPROJ + (g * 8 + (c & 7)) * DK + 32 * ds + 8 * kq);
}
__device__ __forceinline__ void reset_state(PairState& st) {
#pragma unroll
    for (int dt = 0; dt < 4; ++dt) st.o[dt] = (f32x4){0.f, 0.f, 0.f, 0.f};
    st.m = NEGF; st.l = 0.f;
}
template <bool ACCUM>
__device__ __forceinline__ void write_out(const PairState& st, float inv, const bf16_t* proj, bf16_t* obuf, int b, int g, int tq0, int br, int lane) {
    const int c = lane & 15, kq = lane >> 4; const size_t row = (size_t)b * SEQ + tq0 + (c >> 3);
    const float gl = bf_lo((unsigned)proj[row * NPROJ + C_GATE + br * 32 + g * 8 + (c & 7)]);
    const float sc = inv * __builtin_amdgcn_rcpf(1.0f + __expf(-gl));
    bf16_t* op = obuf + row * DM + (g * 8 + (c & 7)) * DV + 4 * kq;
#pragma unroll
    for (int dt = 0; dt < 4; ++dt) { f32x4 v = st.o[dt] * sc;
        if (ACCUM) { const u32x2 old = *(const u32x2*)(op + 16 * dt); v[0] += bf_lo(old.x); v[1] += bf_hi(old.x); v[2] += bf_lo(old.y); v[3] += bf_hi(old.y); }
        u32x2 w; w.x = cvt_pk_bf16(v[0], v[1]); w.y = cvt_pk_bf16(v[2], v[3]); *(u32x2*)(op + 16 * dt) = w; }
}

__device__ __forceinline__ void phase_cmp(const Params& p, LAS unsigned char* lds) {
    const int tid = threadIdx.x, lane = tid & 63, wave = __builtin_amdgcn_readfirstlane(tid >> 6), c = lane & 15;
    const bf16_t* proj = (const bf16_t*)(p.ws + WS_BIG); bf16_t* obuf = (bf16_t*)(p.ws + WS_O); unsigned* selm = (unsigned*)(p.ws + WS_SELM);
    build_bias(p, lds);
    LAS float* imp = (LAS float*)(lds + L_IMP);
    for (int u = blockIdx.x; u < 4096; u += gridDim.x) {
        const int bg = u & 7, b = bg >> 2, g = bg & 3, t0 = (511 - (u >> 3)) * 32;
        TileSrc src; src.K = (const bf16_t*)(p.ws + WS_KCMP) + (size_t)bg * NCMP * DK; src.V = (const bf16_t*)(p.ws + WS_VCMP) + (size_t)bg * NCMP * DV; src.kld = DK; src.vld = DV;
#ifdef EXP_SRC_S
        src.K = proj + (size_t)b * SEQ * NPROJ + C_KS + g * DK; src.V = proj + (size_t)b * SEQ * NPROJ + C_VS + g * DV; src.kld = NPROJ; src.vld = NPROJ;
#endif
        const int nt = t0 / 1024 + 1;
        const LAS float* biasrow = (const LAS float*)(lds + L_BIAS) + (g * 8 + (c & 7)) * 132; const float bias_far = biasrow[128];
        PairState st[2];
#pragma unroll
        for (int pi = 0; pi < 2; ++pi) { reset_state(st[pi]); load_q(st[pi], proj, b, g, t0 + 4 * wave + 2 * pi, lane); }
#pragma unroll
        for (int i = 0; i < 16; ++i) imp[(4 * wave) * 256 + i * 64 + lane] = 0.f;
        StageRegs sr;
#pragma unroll 1
        for (int pass = 0; pass < 2; ++pass) {
            if (pass == 1) {
#pragma unroll
                for (int pi = 0; pi < 2; ++pi) { float lt = st[pi].l; lt += __shfl_xor(lt, 16); lt += __shfl_xor(lt, 32); st[pi].l = lt > 0.f ? 1.0f / lt : 0.f; }
            }
            stage_load(sr, src, 0, tid); stage_store(sr, lds, 0, tid); __syncthreads();
#pragma unroll 1
            for (int i = 0; i < nt; ++i) {
                if (i + 1 < nt) stage_load(sr, src, 64 * (i + 1), tid);
                const LAS unsigned char* Kt = lds + L_K + (i & 1) * KT_BYTES; const LAS unsigned char* Vt = lds + L_V + (i & 1) * VT_BYTES;
#pragma unroll
                for (int pi = 0; pi < 2; ++pi) { const int tq0 = t0 + 4 * wave + 2 * pi; const int P0 = 16 * 64 * i + 31;
                    if (tq0 + 1 < P0) continue;
                    const bool far = (tq0 - (P0 + 63 * 16)) >= 113;
                    const int tadj = tq0 + (c >> 3) - P0;
                    if (pass == 0) pair_tile<0>(st[pi], Kt, Vt, tadj, 16, 1 << 30, true, far, biasrow, bias_far, nullptr, 0, lane);
                    else pair_tile<1>(st[pi], Kt, Vt, tadj, 16, 1 << 30, true, far, biasrow, bias_far, imp + (4 * wave + 2 * pi + (c >> 3)) * 256, 16 * i, lane); }
                if (i + 1 < nt) stage_store(sr, lds, (i + 1) & 1, tid);
                __syncthreads();
            }
        }
#pragma unroll
        for (int pi = 0; pi < 2; ++pi) write_out<false>(st[pi], 1.0f, proj, obuf, b, g, t0 + 4 * wave + 2 * pi, 0, lane);
        asm volatile("s_waitcnt lgkmcnt(0)" ::: "memory");
#pragma unroll 1
        for (int qq = 0; qq < 4; ++qq) {
            const int t = t0 + 4 * wave + qq, cur = t >> 6;
            unsigned long long key[4]; bool sel[4];
#pragma unroll
            for (int i = 0; i < 4; ++i) { const int j = lane + 64 * i; const float v = imp[(4 * wave + qq) * 256 + j];
                sel[i] = (j == 0) || (j == cur) || (j == cur - 1);
                const bool cand = (j >= 1) && (j <= cur - 2);
                key[i] = cand ? (((unsigned long long)__float_as_uint(v) << 32) | (unsigned)(256 - j)) : 0ull; }
            const int need = 16 - (1 + (cur >= 1) + (cur >= 2));
#pragma unroll 1
            for (int it = 0; it < need; ++it) {
                unsigned long long best = key[0] > key[1] ? key[0] : key[1]; { const unsigned long long b2 = key[2] > key[3] ? key[2] : key[3]; best = best > b2 ? best : b2; }
#pragma unroll
                for (int o = 1; o < 64; o <<= 1) { const unsigned long long ot = __shfl_xor(best, o); best = best > ot ? best : ot; }
                if (best == 0ull) break;
                const int jb = 256 - (int)(unsigned)(best & 0xffffffffull);
#pragma unroll
                for (int i = 0; i < 4; ++i) if (jb == lane + 64 * i) { key[i] = 0ull; sel[i] = true; }
            }
            unsigned* mrow = selm + ((size_t)bg * SEQ + t) * 8;
#pragma unroll
            for (int i = 0; i < 4; ++i) { const unsigned long long bal = __ballot(sel[i]); if (lane == 0) { mrow[2 * i] = (unsigned)bal; mrow[2 * i + 1] = (unsigned)(bal >> 32); } }
        }
    }
}

template <bool WIN, int NP>
__device__ __forceinline__ void phase_ws(const Params& p, LAS unsigned char* lds) {
    constexpr int QW = 2 * NP, QU = 8 * QW, NUNIT = MT * NG / QU;
    const int tid = threadIdx.x, lane = tid & 63, wave = __builtin_amdgcn_readfirstlane(tid >> 6), c = lane & 15;
    const bf16_t* proj = (const bf16_t*)(p.ws + WS_BIG); bf16_t* obuf = (bf16_t*)(p.ws + WS_O); const unsigned* selm = (const unsigned*)(p.ws + WS_SELM);
    build_bias(p, lds);
    LAS unsigned* lsel = (LAS unsigned*)(lds + L_SELM);
    for (int u = blockIdx.x; u < NUNIT; u += gridDim.x) {
        const int bg = u & 7, b = bg >> 2, g = bg & 3, t0 = (SEQ / QU - 1 - (u >> 3)) * QU;
        TileSrc src; src.kld = NPROJ; src.vld = NPROJ;
        src.K = proj + (size_t)b * SEQ * NPROJ + (WIN ? C_KW : C_KS) + g * DK; src.V = proj + (size_t)b * SEQ * NPROJ + (WIN ? C_VW : C_VS) + g * DV;
        const int cb = t0 >> 6;
        const int kstart = WIN ? (cb >= 8 ? (cb - 8) * 64 : 0) : 0;
        const int nt = cb + 1 - kstart / 64;
        const LAS float* biasrow = (const LAS float*)(lds + L_BIAS) + (g * 8 + (c & 7)) * 132; const float bias_far = biasrow[128];
        if (!WIN) { if (tid < QU * 8) lsel[tid] = selm[((size_t)bg * SEQ + t0) * 8 + tid]; }
        PairState st[NP];
#pragma unroll
        for (int pi = 0; pi < NP; ++pi) { reset_state(st[pi]); load_q(st[pi], proj, b, g, t0 + QW * wave + 2 * pi, lane); }
        StageRegs sr;
        stage_load(sr, src, kstart, tid); stage_store(sr, lds, 0, tid); __syncthreads();
#pragma unroll 1
        for (int i = 0; i < nt; ++i) {
            if (i + 1 < nt) stage_load(sr, src, kstart + 64 * (i + 1), tid);
            const LAS unsigned char* Kt = lds + L_K + (i & 1) * KT_BYTES; const LAS unsigned char* Vt = lds + L_V + (i & 1) * VT_BYTES;
            const int P0 = kstart + 64 * i;
#pragma unroll
            for (int pi = 0; pi < NP; ++pi) { const int tq0 = t0 + QW * wave + 2 * pi;
                bool rowsel = true; bool allsel = true;
                if (!WIN) { const unsigned w = lsel[(QW * wave + 2 * pi + (c >> 3)) * 8 + (i >> 5)]; rowsel = (w >> (i & 31)) & 1u;
                    const unsigned long long bal = __ballot(rowsel); if (bal == 0ull) continue; allsel = (bal == ~0ull); }
                else { if (tq0 + 1 < P0 || tq0 - (P0 + 63) >= 512) continue; }
                const bool far = allsel && (tq0 - (P0 + 63) >= 113) && (!WIN || (tq0 + 1 - P0 < 512));
                pair_tile<2>(st[pi], Kt, Vt, tq0 + (c >> 3) - P0, 1, WIN ? 512 : (1 << 30), rowsel, far, biasrow, bias_far, nullptr, 0, lane); }
            if (i + 1 < nt) stage_store(sr, lds, (i + 1) & 1, tid);
            __syncthreads();
        }
#pragma unroll
        for (int pi = 0; pi < NP; ++pi) { float lt = st[pi].l; lt += __shfl_xor(lt, 16); lt += __shfl_xor(lt, 32);
            write_out<true>(st[pi], lt > 0.f ? 1.0f / lt : 0.f, proj, obuf, b, g, t0 + QW * wave + 2 * pi, WIN ? 2 : 1, lane); }
    }
}

__device__ __forceinline__ void phase_pool(const Params& p) {
    const bf16_t* ub = (const bf16_t*)(p.ws + WS_BIG); bf16_t* pooled = (bf16_t*)(p.ws + WS_BIG + 128 * MiB);
    const int nthr = gridDim.x * NTHR;
    for (int it = blockIdx.x * NTHR + threadIdx.x; it < MT * 256; it += nthr) {
        const int row = it >> 8, ch = it & 255, t = row & (SEQ - 1); const int w = 2 << (ch >> 6);
        const int cnt = (t + 1 < w) ? t + 1 : w;
        float acc[8] = {0.f, 0.f, 0.f, 0.f, 0.f, 0.f, 0.f, 0.f}; u32x4 self = {0, 0, 0, 0};
        for (int k = 0; k < cnt; ++k) { const u32x4 v = *(const u32x4*)(ub + (size_t)(row - k) * DM + ch * 8); if (k == 0) self = v;
            acc[0] += bf_lo(v.x); acc[1] += bf_hi(v.x); acc[2] += bf_lo(v.y); acc[3] += bf_hi(v.y); acc[4] += bf_lo(v.z); acc[5] += bf_hi(v.z); acc[6] += bf_lo(v.w); acc[7] += bf_hi(v.w); }
        const float ic = 1.0f / (float)cnt;
        u32x4 o; o.x = cvt_pk_bf16(acc[0] * ic - bf_lo(self.x), acc[1] * ic - bf_hi(self.x)); o.y = cvt_pk_bf16(acc[2] * ic - bf_lo(self.y), acc[3] * ic - bf_hi(self.y));
        o.z = cvt_pk_bf16(acc[4] * ic - bf_lo(self.z), acc[5] * ic - bf_hi(self.z)); o.w = cvt_pk_bf16(acc[6] * ic - bf_lo(self.w), acc[7] * ic - bf_hi(self.w));
        *(u32x4*)(pooled + (size_t)row * DM + ch * 8) = o;
    }
}
__device__ __forceinline__ void phase_final(const Params& p) {
    const int lane = threadIdx.x & 63, wave = threadIdx.x >> 6; const int gw = blockIdx.x * NWAVES + wave, ngw = gridDim.x * NWAVES;
    const float* ssq = (const float*)(p.ws + WS_SSQ) + 4 * (size_t)MT;
    for (int row = gw; row < MT; row += ngw) { const float rs = rsqrtf(ssq[row] * (1.0f / DM) + EPS);
        f32x4* xr = (f32x4*)(p.out + (size_t)row * DM) + lane; const f32x4* gr = (const f32x4*)p.norm_final + lane;
#pragma unroll
        for (int j = 0; j < 8; ++j) xr[64 * j] = xr[64 * j] * rs * gr[64 * j]; }
}

#ifndef ATT_MASK
#define ATT_MASK 7
#endif
#define GSYNC() do { asm volatile("s_waitcnt vmcnt(0) lgkmcnt(0)" ::: "memory"); __builtin_amdgcn_fence(__ATOMIC_RELEASE, "agent"); grid.sync(); __builtin_amdgcn_fence(__ATOMIC_ACQUIRE, "agent"); } while (0)
__global__ void __launch_bounds__(NTHR, 2) fwd_megakernel(Params p) {
    extern __shared__ __attribute__((aligned(16))) unsigned char lds_raw[];
    LAS unsigned char* lds = (LAS unsigned char*)lds_raw;
    cg::grid_group grid = cg::this_grid();
    unsigned char* ws = p.ws;
    float* ssq = (float*)(ws + WS_SSQ);
    bf16_t* xb = (bf16_t*)(ws + WS_XB); bf16_t* obuf = (bf16_t*)(ws + WS_O); bf16_t* big = (bf16_t*)(ws + WS_BIG);
    const int G = gridDim.x, cidx = blockIdx.x;
    pg8::StaticOrder S;

    phase_prologue(p, lds);
    GSYNC();
    { pg8::Gemm g{xb, (const bf16_t*)(ws + WS_W_IN), DM, DM, MT, NPROJ, DM, 0}; S.init(MT, NPROJ, G, cidx); pg8::EpiProj E{big, ssq}; pg8::gemm_phase(lds, g, S, E); }
    GSYNC();
    phase_compress(p, lds);
    GSYNC();
    if (ATT_MASK & 1) phase_cmp(p, lds);
    else { for (size_t i = (size_t)blockIdx.x * NTHR + threadIdx.x; i < (size_t)MT * DM / 8; i += (size_t)gridDim.x * NTHR) ((u32x4*)obuf)[i] = (u32x4){0, 0, 0, 0}; }
    GSYNC();
    if (ATT_MASK & 4) phase_ws<true, 2>(p, lds);
    if (ATT_MASK & 2) phase_ws<false, 2>(p, lds);
    GSYNC();
    { pg8::Gemm g{obuf, (const bf16_t*)(ws + WS_W_OUT), DM, DM, MT, DM, DM, 0}; S.init(MT, DM, G, cidx); pg8::EpiRes E{p.x, p.out, xb, ssq + MT}; pg8::gemm_phase(lds, g, S, E); }
    GSYNC();
    { pg8::Gemm g{xb, (const bf16_t*)(ws + WS_W_GU0), DM, DM, MT, 2 * DFF, DM, 0}; S.init(MT, 2 * DFF, G, cidx); pg8::EpiSwiglu E{big, ssq + MT}; pg8::gemm_phase(lds, g, S, E); }
    GSYNC();
    { pg8::Gemm g{big, (const bf16_t*)(ws + WS_W_DN0), DFF, DFF, MT, DM, DFF, 0}; S.init(MT, DM, G, cidx); pg8::EpiRes E{p.out, p.out, xb, ssq + 2 * MT}; pg8::gemm_phase(lds, g, S, E); }
    GSYNC();
    { pg8::Gemm g{xb, (const bf16_t*)(ws + WS_P_IN), DM, DM, MT, DM, DM, 0}; S.init(MT, DM, G, cidx); pg8::EpiRowScale E{big, ssq + 2 * MT}; pg8::gemm_phase(lds, g, S, E); }
    GSYNC();
    phase_pool(p);
    GSYNC();
    { pg8::Gemm g{(const bf16_t*)(ws + WS_BIG + 128 * MiB), (const bf16_t*)(ws + WS_P_GRP), DM, 512, MT, DM, 512, 1024}; S.init(MT, DM, G, cidx); pg8::EpiColScale E{obuf, p.pool_scale}; pg8::gemm_phase(lds, g, S, E); }
    GSYNC();
    { pg8::Gemm g{obuf, (const bf16_t*)(ws + WS_P_OUT), DM, DM, MT, DM, DM, 0}; S.init(MT, DM, G, cidx); pg8::EpiRes E{p.out, p.out, xb, ssq + 3 * MT}; pg8::gemm_phase(lds, g, S, E); }
    GSYNC();
    { pg8::Gemm g{xb, (const bf16_t*)(ws + WS_W_GU1), DM, DM, MT, 2 * DFF, DM, 0}; S.init(MT, 2 * DFF, G, cidx); pg8::EpiSwiglu E{big, ssq + 3 * MT}; pg8::gemm_phase(lds, g, S, E); }
    GSYNC();
    { pg8::Gemm g{big, (const bf16_t*)(ws + WS_W_DN1), DFF, DFF, MT, DM, DFF, 0}; S.init(MT, DM, G, cidx); pg8::EpiRes E{p.out, p.out, xb, ssq + 4 * MT}; pg8::gemm_phase(lds, g, S, E); }
    GSYNC();
    phase_final(p);
}

extern "C" void kernel_launch(void* const* d_in, const int* in_sizes, int n_in, void* d_out, int out_size, void* d_ws, size_t ws_size, hipStream_t stream) {
    static int grid_blocks = 0;
    if (grid_blocks == 0) {
        if (n_in != 21 || ws_size < WS_END) { fprintf(stderr, "kernel_launch: unexpected inputs (n_in %d, ws %zu)\n", n_in, ws_size); grid_blocks = -1; return; }
        int dev = 0, cus = 0, per_cu = 0;
        hipGetDevice(&dev); hipDeviceGetAttribute(&cus, hipDeviceAttributeMultiprocessorCount, dev);
        if (hipFuncSetAttribute((const void*)fwd_megakernel, hipFuncAttributeMaxDynamicSharedMemorySize, LDS_BYTES) != hipSuccess) { fprintf(stderr, "kernel_launch: hipFuncSetAttribute failed\n"); grid_blocks = -1; return; }
        if (hipOccupancyMaxActiveBlocksPerMultiprocessor(&per_cu, (const void*)fwd_megakernel, NTHR, LDS_BYTES) != hipSuccess || per_cu < 1) { fprintf(stderr, "kernel_launch: occupancy query failed (%d)\n", per_cu); (void)hipGetLastError(); per_cu = 1; }
        grid_blocks = cus * 1;
    }
    if (grid_blocks < 0) return;
    Params p{};
    p.x = (const float*)d_in[0]; p.norm_mix = (const float*)d_in[1]; p.norm_ffn = (const float*)d_in[2]; p.norm_final = (const float*)d_in[3]; p.rel_bias = (const float*)d_in[4];
    p.nsa_w_in = (const float*)d_in[5]; p.pos_k = (const float*)d_in[6]; p.pos_v = (const float*)d_in[7]; p.ck_w1 = (const float*)d_in[8]; p.ck_b1 = (const float*)d_in[9]; p.ck_w2 = (const float*)d_in[10];
    p.cv_w1 = (const float*)d_in[11]; p.cv_b1 = (const float*)d_in[12]; p.cv_w2 = (const float*)d_in[13]; p.nsa_w_out = (const float*)d_in[14];
    p.pool_w_in = (const float*)d_in[15]; p.pool_w_grp = (const float*)d_in[16]; p.pool_scale = (const float*)d_in[17]; p.pool_w_out = (const float*)d_in[18]; p.ffn_w_gu = (const float*)d_in[19]; p.ffn_w_down = (const float*)d_in[20];
    p.out = (float*)d_out; p.ws = (unsigned char*)d_ws;
    void* args[] = {&p};
    hipError_t e = hipLaunchCooperativeKernel((const void*)fwd_megakernel, dim3(grid_blocks), dim3(NTHR), args, LDS_BYTES, stream);
    if (e != hipSuccess) fprintf(stderr, "cooperative launch failed: %s (grid %d)\n", hipGetErrorString(e), grid_blocks);
}
```

```cpp
#include <hip/hip_runtime.h>
#include <hip/hip_cooperative_groups.h>
#include <cstdio>
#include <cstdint>
namespace cg = cooperative_groups;

#define LAS __attribute__((address_space(3)))
typedef unsigned short bf16_t;
typedef short bf16x8 __attribute__((ext_vector_type(8)));
typedef float f32x4 __attribute__((ext_vector_type(4)));
typedef float f32x2 __attribute__((ext_vector_type(2)));
typedef unsigned u32x4 __attribute__((ext_vector_type(4)));
typedef unsigned u32x2 __attribute__((ext_vector_type(2)));

constexpr int BATCH = 2, SEQ = 16384, DM = 2048, MT = BATCH * SEQ;
constexpr int NG = 4, HG = 8, DK = 96, DV = 64;
constexpr int NPROJ = 5120;
constexpr int C_VC = 3072, C_VS = 3328, C_VW = 3584, C_KC = 3840, C_KS = 4224, C_KW = 4608, C_GATE = 4992;
constexpr int DFF = 5632;
constexpr int NCMP = 1024;
constexpr float EPS = 1e-6f;
constexpr float NEGF = -1e30f;

constexpr size_t MiB = 1u << 20;
constexpr size_t WS_SSQ = 0;
constexpr size_t WS_KMAX = 900 * 1024;
constexpr size_t WS_W_IN = 1 * MiB;
constexpr size_t WS_W_OUT = 21 * MiB;
constexpr size_t WS_W_GU0 = 29 * MiB, WS_W_GU1 = 73 * MiB;
constexpr size_t WS_W_DN0 = 117 * MiB, WS_W_DN1 = 139 * MiB;
constexpr size_t WS_P_IN = 161 * MiB, WS_P_GRP = 169 * MiB, WS_P_OUT = 171 * MiB;
constexpr size_t WS_CK1 = 179 * MiB, WS_CV1 = 181 * MiB, WS_CK2 = 182 * MiB, WS_CV2 = 182 * MiB + 65536;
constexpr size_t WS_KCMP = 183 * MiB, WS_VCMP = 185 * MiB, WS_SELM = 186 * MiB;
constexpr size_t WS_XB = 190 * MiB;
constexpr size_t WS_O = 318 * MiB;
constexpr size_t WS_BIG = 446 * MiB;
constexpr size_t WS_END = 798 * MiB;

typedef __bf16 bf16x2_t __attribute__((ext_vector_type(2)));
__device__ __forceinline__ unsigned cvt_pk_bf16(float lo, float hi) { const f32x2 v = {lo, hi}; const bf16x2_t b = __builtin_convertvector(v, bf16x2_t); return __builtin_bit_cast(unsigned, b); }
__device__ __forceinline__ float bf_lo(unsigned u) { return __uint_as_float(u << 16); }
__device__ __forceinline__ float bf_hi(unsigned u) { return __uint_as_float(u & 0xffff0000u); }
__device__ __forceinline__ float wave_sum(float v) {
#pragma unroll
    for (int o = 1; o < 64; o <<= 1) v += __shfl_xor(v, o);
    return v;
}

namespace pg8 {
constexpr int BM = 256, BK = 64, HALF = 128, HTB = HALF * BK * 2, STAGE_BYTES = 8 * HTB, NXCD = 8, WGM = 8;
__host__ __device__ __forceinline__ int lds_byte(int r, int c) { const int st = (r >> 4) * 2 + (c >> 5), rr = r & 15, cc = c & 31, ob = rr * 64 + cc * 2; return st * 1024 + (ob ^ (((ob >> 9) & 1) << 5)); }
__host__ __device__ __forceinline__ void stage_rc(int b, int& R, int& C) { const int st = b / 1024, sb = b % 1024, swz = sb ^ (((sb >> 9) & 1) << 5); R = (st >> 1) * 16 + swz / 64; C = (st & 1) * 32 + (swz % 64) / 2; }
__host__ __device__ __forceinline__ int perm32(int rho) { const int n = rho >> 4, i = rho & 15; return 8 * (i >> 2) + 4 * n + (i & 3); }

struct Unit { int pm, pn; };
struct Gemm { const bf16_t* A; const bf16_t* Bt; int lda, ldb, M, N, K; int acolb; };

struct StaticOrder {
    int nM, nN, nwg, G, c;
    __device__ void init(int M, int N, int G_, int c_) { nM = M / BM; nN = N / BM; nwg = nM * nN; G = G_; c = c_; }
    __device__ bool next(int i, Unit& u) const {
        const long L = (long)i * G + c; if (L >= nwg) return false;
        int wgid = (int)L; { const int q = nwg / NXCD, r = nwg % NXCD, xcd = wgid % NXCD, off = wgid / NXCD; wgid = (xcd < r ? xcd * (q + 1) : r * (q + 1) + (xcd - r) * q) + off; }
        const int nig = WGM * nN, gid = wgid / nig, fm = gid * WGM, gsz = (nM - fm) < WGM ? (nM - fm) : WGM;
        u.pm = fm + ((wgid % nig) % gsz); u.pn = (wgid % nig) / gsz; return true;
    }
};

template <class Epi>
__device__ __forceinline__ void gemm_phase(LAS unsigned char* lds, const Gemm g, const StaticOrder& S, const Epi& E) {
    const int tid = threadIdx.x, wid = __builtin_amdgcn_readfirstlane(tid >> 6), lane = tid & 63, wr = wid >> 2, wc = wid & 3, fr = lane & 15, fq = lane >> 4;
    const int K = g.K, nt = K / BK;
    unsigned voffA[2], voffB[2];
#pragma unroll
    for (int i = 0; i < 2; ++i) { int R, C; stage_rc(tid * 16 + i * 8192, R, C); const int Rb = (R & ~31) + perm32(R & 31);
        voffA[i] = (unsigned)(R * g.lda + C) * 2u; voffB[i] = (unsigned)(Rb * g.ldb + C) * 2u; }
    const size_t kstep = (size_t)(BK * 2);
    const size_t hstepA = (size_t)HALF * g.lda * 2, hstepB = (size_t)HALF * g.ldb * 2;
    const size_t tstepA = 2 * hstepA, tstepB = 2 * hstepB;
    const unsigned ldsw = (unsigned)wid * 1024u;
    const int aoff = lds_byte(wr * 64 + fr, fq * 8), boff = lds_byte(wc * 32 + fr, fq * 8);
#define PG8_SA(b, h) (((b) * 2 + (h)) * HTB)
#define PG8_SB(b, h) ((4 + (b) * 2 + (h)) * HTB)
#define PG8_STAGE(bufoff, gbase, voff) do { _Pragma("unroll") for (int _i = 0; _i < 2; ++_i) \
        __builtin_amdgcn_global_load_lds((const unsigned*)((const char*)(gbase) + (voff)[_i]), (LAS unsigned*)(lds + (bufoff) + ldsw + _i * 8192), 16, 0, 0); } while (0)
#define PG8_LDA(dst, b, h) do { _Pragma("unroll") for (int m = 0; m < 4; ++m) _Pragma("unroll") for (int k = 0; k < 2; ++k) dst[m][k] = *(const LAS bf16x8*)(lds + PG8_SA(b, h) + aoff + m * 2048 + k * 1024); } while (0)
#define PG8_LDB(dst, b, h) do { _Pragma("unroll") for (int n = 0; n < 2; ++n) _Pragma("unroll") for (int k = 0; k < 2; ++k) dst[n][k] = *(const LAS bf16x8*)(lds + PG8_SB(b, h) + boff + n * 2048 + k * 1024); } while (0)
#define PG8_MMA(ai, bj, At, Bt) do { __builtin_amdgcn_s_setprio(1); _Pragma("unroll") for (int m = 0; m < 4; ++m) _Pragma("unroll") for (int n = 0; n < 2; ++n) _Pragma("unroll") for (int k = 0; k < 2; ++k) \
        acc[ai][bj][m][n] = __builtin_amdgcn_mfma_f32_16x16x32_bf16(Bt[n][k], At[m][k], acc[ai][bj][m][n], 0, 0, 0); __builtin_amdgcn_s_setprio(0); } while (0)
#define PG8_WAIT_V(n) asm volatile("s_waitcnt vmcnt(" #n ")" ::: "memory")
#define PG8_WAIT_L(n) asm volatile("s_waitcnt lgkmcnt(" #n ")" ::: "memory")
#define PG8_BAR __builtin_amdgcn_s_barrier()
#define PG8_SCHED __builtin_amdgcn_sched_barrier(0)
#define PG8_APTR(u) ((const char*)g.A + (size_t)(u).pm * tstepA + (size_t)((u).pn >> 1) * (size_t)g.acolb)
#define PG8_BPTR(u) ((const char*)g.Bt + (size_t)(u).pn * tstepB)
    Unit cur, nxt; int ui = 0;
    if (!S.next(0, cur)) return;
    f32x4 acc[2][2][4][2];
#pragma unroll
    for (int a = 0; a < 2; ++a)
#pragma unroll
        for (int b = 0; b < 2; ++b)
#pragma unroll
            for (int m = 0; m < 4; ++m)
#pragma unroll
                for (int n = 0; n < 2; ++n) acc[a][b][m][n] = (f32x4){0.f, 0.f, 0.f, 0.f};
    bf16x8 At[4][2], B0[2][2], B1[2][2];
    const char* cA = PG8_APTR(cur); const char* cB = PG8_BPTR(cur);
    PG8_STAGE(PG8_SB(0, 0), cB, voffB); PG8_STAGE(PG8_SB(0, 1), cB + hstepB, voffB); PG8_STAGE(PG8_SA(0, 0), cA, voffA); PG8_STAGE(PG8_SA(0, 1), cA + hstepA, voffA);
    if (wr == 1) PG8_BAR;
    PG8_WAIT_V(2); PG8_BAR;
    PG8_STAGE(PG8_SB(1, 0), cB + kstep, voffB); PG8_STAGE(PG8_SA(1, 0), cA + kstep, voffA); PG8_STAGE(PG8_SB(1, 1), cB + hstepB + kstep, voffB);
    PG8_WAIT_V(6); PG8_BAR;
    for (;;) {
        const bool has_next = S.next(ui + 1, nxt);
        const char* nA = has_next ? PG8_APTR(nxt) : cA; const char* nB = has_next ? PG8_BPTR(nxt) : cB;
        for (int t = 0; t < nt; t += 2) {
            const bool last = (t == nt - 2);
            const char* a1 = cA + (size_t)(t + 1) * kstep;
            const char* a2 = last ? nA : cA + (size_t)(t + 2) * kstep; const char* b2 = last ? nB : cB + (size_t)(t + 2) * kstep;
            const char* a3 = a2 + kstep; const char* b3 = b2 + kstep;
            PG8_LDB(B0, 0, 0); PG8_LDB(B1, 0, 1); PG8_SCHED; PG8_LDA(At, 0, 0); PG8_STAGE(PG8_SA(1, 1), a1 + hstepA, voffA);
            PG8_WAIT_V(8); PG8_WAIT_L(0); PG8_BAR; PG8_MMA(0, 0, At, B0); PG8_MMA(0, 1, At, B1); PG8_BAR; PG8_SCHED;
            PG8_LDA(At, 0, 1); PG8_STAGE(PG8_SB(0, 0), b2, voffB); PG8_STAGE(PG8_SB(0, 1), b2 + hstepB, voffB); PG8_STAGE(PG8_SA(0, 0), a2, voffA);
            PG8_WAIT_V(8); PG8_WAIT_L(0); PG8_BAR; PG8_MMA(1, 0, At, B0); PG8_MMA(1, 1, At, B1); PG8_BAR; PG8_SCHED;
            PG8_LDB(B0, 1, 0); PG8_LDB(B1, 1, 1); PG8_SCHED; PG8_LDA(At, 1, 0); PG8_STAGE(PG8_SA(0, 1), a2 + hstepA, voffA);
            PG8_WAIT_V(8); PG8_WAIT_L(0); PG8_BAR; PG8_MMA(0, 0, At, B0); PG8_MMA(0, 1, At, B1); PG8_BAR; PG8_SCHED;
            PG8_LDA(At, 1, 1); PG8_STAGE(PG8_SB(1, 0), b3, voffB); PG8_STAGE(PG8_SB(1, 1), b3 + hstepB, voffB); PG8_STAGE(PG8_SA(1, 0), a3, voffA);
            PG8_WAIT_V(8); PG8_WAIT_L(0); PG8_BAR; PG8_MMA(1, 0, At, B0); PG8_MMA(1, 1, At, B1); PG8_BAR; PG8_SCHED;
        }
        if (wr == 0) PG8_BAR;
        E(acc, cur, wr, wc, fr, fq);
        if (!has_next) break;
#pragma unroll
        for (int a = 0; a < 2; ++a)
#pragma unroll
            for (int b = 0; b < 2; ++b)
#pragma unroll
                for (int m = 0; m < 4; ++m)
#pragma unroll
                    for (int n = 0; n < 2; ++n) acc[a][b][m][n] = (f32x4){0.f, 0.f, 0.f, 0.f};
        cur = nxt; cA = nA; cB = nB; ++ui;
        if (wr == 1) PG8_BAR;
    }
    PG8_WAIT_V(0);
    PG8_BAR;
#undef PG8_SA
#undef PG8_SB
#undef PG8_STAGE
#undef PG8_LDA
#undef PG8_LDB
#undef PG8_MMA
#undef PG8_WAIT_V
#undef PG8_WAIT_L
#undef PG8_BAR
#undef PG8_SCHED
#undef PG8_APTR
#undef PG8_BPTR
}

#define EPI_ROW(u, ai, m) ((u).pm * BM + (ai) * HALF + wr * 64 + (m) * 16 + fr)
__device__ __forceinline__ u32x4 pack8(f32x4 v0, f32x4 v1) { u32x4 w; w.x = cvt_pk_bf16(v0[0], v0[1]); w.y = cvt_pk_bf16(v0[2], v0[3]); w.z = cvt_pk_bf16(v1[0], v1[1]); w.w = cvt_pk_bf16(v1[2], v1[3]); return w; }

struct EpiProj {
    bf16_t* O; const float* ssq;
    __device__ __forceinline__ void operator()(const f32x4 (&acc)[2][2][4][2], const Unit& u, int wr, int wc, int fr, int fq) const {
        const float qs = (u.pn < 12) ? 0.10206207261596577f * 1.4426950408889634f : 1.0f;
#pragma unroll
        for (int ai = 0; ai < 2; ++ai)
#pragma unroll
            for (int m = 0; m < 4; ++m) { const int row = EPI_ROW(u, ai, m); const float rs = rsqrtf(ssq[row] * (1.0f / DM) + EPS) * qs;
#pragma unroll
                for (int bj = 0; bj < 2; ++bj) { const int c0 = u.pn * BM + bj * HALF + wc * 32 + 8 * fq;
                    *(u32x4*)(O + (size_t)row * NPROJ + c0) = pack8(acc[ai][bj][m][0] * rs, acc[ai][bj][m][1] * rs); } }
    }
};
struct EpiRowScale {
    bf16_t* O; const float* ssq;
    __device__ __forceinline__ void operator()(const f32x4 (&acc)[2][2][4][2], const Unit& u, int wr, int wc, int fr, int fq) const {
#pragma unroll
        for (int ai = 0; ai < 2; ++ai)
#pragma unroll
            for (int m = 0; m < 4; ++m) { const int row = EPI_ROW(u, ai, m); const float rs = rsqrtf(ssq[row] * (1.0f / DM) + EPS);
#pragma unroll
                for (int bj = 0; bj < 2; ++bj) { const int c0 = u.pn * BM + bj * HALF + wc * 32 + 8 * fq;
                    *(u32x4*)(O + (size_t)row * DM + c0) = pack8(acc[ai][bj][m][0] * rs, acc[ai][bj][m][1] * rs); } }
    }
};
struct EpiColScale {
    bf16_t* O; const float* scale;
    __device__ __forceinline__ void operator()(const f32x4 (&acc)[2][2][4][2], const Unit& u, int wr, int wc, int fr, int fq) const {
#pragma unroll
        for (int bj = 0; bj < 2; ++bj) { const int c0 = u.pn * BM + bj * HALF + wc * 32 + 8 * fq;
            const f32x4 s0 = *(const f32x4*)(scale + c0), s1 = *(const f32x4*)(scale + c0 + 4);
#pragma unroll
            for (int ai = 0; ai < 2; ++ai)
#pragma unroll
                for (int m = 0; m < 4; ++m) { const int row = EPI_ROW(u, ai, m);
                    *(u32x4*)(O + (size_t)row * DM + c0) = pack8(acc[ai][bj][m][0] * s0, acc[ai][bj][m][1] * s1); } }
    }
};
struct EpiSwiglu {
    bf16_t* O; const float* ssq;
    __device__ __forceinline__ void operator()(const f32x4 (&acc)[2][2][4][2], const Unit& u, int wr, int wc, int fr, int fq) const {
        const int c0 = u.pn * HALF + wc * 32 + 8 * fq;
#pragma unroll
        for (int ai = 0; ai < 2; ++ai)
#pragma unroll
            for (int m = 0; m < 4; ++m) { const int row = EPI_ROW(u, ai, m); const float rs = rsqrtf(ssq[row] * (1.0f / DM) + EPS);
                f32x4 r[2];
#pragma unroll
                for (int n = 0; n < 2; ++n)
#pragma unroll
                    for (int j = 0; j < 4; ++j) { const float gt = acc[ai][0][m][n][j] * rs, up = acc[ai][1][m][n][j] * rs; r[n][j] = gt * up * __builtin_amdgcn_rcpf(1.0f + __expf(-gt)); }
                *(u32x4*)(O + (size_t)row * DFF + c0) = pack8(r[0], r[1]); }
    }
};
struct EpiRes {
    const float* src; float* dst; bf16_t* xb; float* ssq_out;
    __device__ __forceinline__ void operator()(const f32x4 (&acc)[2][2][4][2], const Unit& u, int wr, int wc, int fr, int fq) const {
#pragma unroll
        for (int ai = 0; ai < 2; ++ai)
#pragma unroll
            for (int m = 0; m < 4; ++m) { const int row = EPI_ROW(u, ai, m); float ss = 0.f;
#pragma unroll
                for (int bj = 0; bj < 2; ++bj) { const size_t off = (size_t)row * DM + u.pn * BM + bj * HALF + wc * 32 + 8 * fq;
                    const f32x4 x0 = *(const f32x4*)(src + off) + acc[ai][bj][m][0], x1 = *(const f32x4*)(src + off + 4) + acc[ai][bj][m][1];
                    *(f32x4*)(dst + off) = x0; *(f32x4*)(dst + off + 4) = x1; *(u32x4*)(xb + off) = pack8(x0, x1);
                    ss += (x0[0] * x0[0] + x0[1] * x0[1]) + (x0[2] * x0[2] + x0[3] * x0[3]) + (x1[0] * x1[0] + x1[1] * x1[1]) + (x1[2] * x1[2] + x1[3] * x1[3]); }
                ss += __shfl_xor(ss, 16); ss += __shfl_xor(ss, 32);
                if (fq == 0) atomicAdd(ssq_out + row, ss); }
    }
};
}

struct Params {
    const float* x; const float* norm_mix; const float* norm_ffn; const float* norm_final; const float* rel_bias;
    const float* nsa_w_in; const float* pos_k; const float* pos_v; const float* ck_w1; const float* ck_b1; const float* ck_w2;
    const float* cv_w1; const float* cv_b1; const float* cv_w2; const float* nsa_w_out;
    const float* pool_w_in; const float* pool_w_grp; const float* pool_scale; const float* pool_w_out; const float* ffn_w_gu; const float* ffn_w_down;
    float* out; unsigned char* ws;
};

constexpr int NTHR = 512, NWAVES = 8;
constexpr int LDS_BYTES = 163840;

__device__ __forceinline__ int nsa_map(int n0) {
    if (n0 < 3072) return n0;
    if (n0 < 3456) return C_KC + (n0 - 3072);
    if (n0 < 3712) return C_VC + (n0 - 3456);
    if (n0 < 4096) return C_KS + (n0 - 3712);
    if (n0 < 4352) return C_VS + (n0 - 4096);
    if (n0 < 4736) return C_KW + (n0 - 4352);
    if (n0 < 4992) return C_VW + (n0 - 4736);
    return C_GATE + (n0 - 4992);
}
__device__ __forceinline__ int gu_map(int n0) { return n0 < DFF ? (n0 >> 7) * 256 + (n0 & 127) : ((n0 - DFF) >> 7) * 256 + 128 + ((n0 - DFF) & 127); }

template <int MAP>
__device__ __forceinline__ void transpose_items(const float* W, int K, int N, bf16_t* WT, int ldd, int row_off, const float* fold, LAS float* scr, int gw, int ngw, int lane) {
    const int nblk = N / 32, nitems = (K / 64) * nblk;
    for (int item = gw; item < nitems; item += ngw) {
        const int kb = item / nblk, nb = item % nblk, k0 = 64 * kb, n0 = 32 * nb;
        const int d0 = row_off + (MAP == 1 ? nsa_map(n0) : (MAP == 2 ? gu_map(n0) : n0));
#pragma unroll 8
        for (int i = 0; i < 32; ++i) { const int kk = 2 * i + (lane >> 5); float v = W[(size_t)(k0 + kk) * N + n0 + (lane & 31)]; if (fold) v *= fold[k0 + kk]; scr[kk * 33 + (lane & 31)] = v; }
        asm volatile("s_waitcnt lgkmcnt(0)" ::: "memory");
        const int c = lane & 7;
#pragma unroll
        for (int j = 0; j < 4; ++j) { const int n = (lane >> 3) + 8 * j; const LAS float* s = scr + (8 * c) * 33 + n;
            u32x4 o; o.x = cvt_pk_bf16(s[0 * 33], s[1 * 33]); o.y = cvt_pk_bf16(s[2 * 33], s[3 * 33]); o.z = cvt_pk_bf16(s[4 * 33], s[5 * 33]); o.w = cvt_pk_bf16(s[6 * 33], s[7 * 33]);
            *(u32x4*)(WT + (size_t)(d0 + n) * ldd + k0 + 8 * c) = o; }
        asm volatile("s_waitcnt lgkmcnt(0)" ::: "memory");
    }
}

__device__ __forceinline__ void phase_prologue(const Params& p, LAS unsigned char* lds) {
    const int tid = threadIdx.x, lane = tid & 63, wave = tid >> 6;
    const int gw = blockIdx.x * NWAVES + wave, ngw = gridDim.x * NWAVES;
    LAS float* scr = (LAS float*)(lds + wave * 8704);
    unsigned char* ws = p.ws;
    if (blockIdx.x == 0 && tid < 16) ((unsigned*)(ws + WS_KMAX))[tid] = 0u;
    { float* ssq = (float*)(ws + WS_SSQ); for (int i = blockIdx.x * NTHR + tid; i < 4 * MT; i += gridDim.x * NTHR) ssq[MT + i] = 0.f; }
    transpose_items<1>(p.nsa_w_in, DM, 5088, (bf16_t*)(ws + WS_W_IN), DM, 0, p.norm_mix, scr, gw, ngw, lane);
    transpose_items<0>(p.nsa_w_out, DM, DM, (bf16_t*)(ws + WS_W_OUT), DM, 0, nullptr, scr, gw, ngw, lane);
    transpose_items<2>(p.ffn_w_gu, DM, 2 * DFF, (bf16_t*)(ws + WS_W_GU0), DM, 0, p.norm_ffn, scr, gw, ngw, lane);
    transpose_items<2>(p.ffn_w_gu + (size_t)DM * 2 * DFF, DM, 2 * DFF, (bf16_t*)(ws + WS_W_GU1), DM, 0, p.norm_ffn + DM, scr, gw, ngw, lane);
    transpose_items<0>(p.ffn_w_down, DFF, DM, (bf16_t*)(ws + WS_W_DN0), DFF, 0, nullptr, scr, gw, ngw, lane);
    transpose_items<0>(p.ffn_w_down + (size_t)DFF * DM, DFF, DM, (bf16_t*)(ws + WS_W_DN1), DFF, 0, nullptr, scr, gw, ngw, lane);
    transpose_items<0>(p.pool_w_in, DM, DM, (bf16_t*)(ws + WS_P_IN), DM, 0, p.norm_mix + DM, scr, gw, ngw, lane);
#pragma unroll 1
    for (int gi = 0; gi < 4; ++gi) transpose_items<0>(p.pool_w_grp + (size_t)gi * 512 * 512, 512, 512, (bf16_t*)(ws + WS_P_GRP), 512, gi * 512, nullptr, scr, gw, ngw, lane);
    transpose_items<0>(p.pool_w_out, DM, DM, (bf16_t*)(ws + WS_P_OUT), DM, 0, nullptr, scr, gw, ngw, lane);
    transpose_items<0>(p.ck_w1, 32 * DK, 256, (bf16_t*)(ws + WS_CK1), 32 * DK, 0, nullptr, scr, gw, ngw, lane);
    transpose_items<0>(p.cv_w1, 32 * DV, 256, (bf16_t*)(ws + WS_CV1), 32 * DV, 0, nullptr, scr, gw, ngw, lane);
    transpose_items<0>(p.ck_w2, 256, DK, (bf16_t*)(ws + WS_CK2), 256, 0, nullptr, scr, gw, ngw, lane);
    transpose_items<0>(p.cv_w2, 256, DV, (bf16_t*)(ws + WS_CV2), 256, 0, nullptr, scr, gw, ngw, lane);
    float* ssq0 = (float*)(ws + WS_SSQ); bf16_t* xb = (bf16_t*)(ws + WS_XB);
    for (int row = gw; row < MT; row += ngw) {
        const f32x4* xr = (const f32x4*)(p.x + (size_t)row * DM) + lane; u32x2* o = (u32x2*)(xb + (size_t)row * DM) + lane;
        float s = 0.f;
#pragma unroll
        for (int j = 0; j < 8; ++j) { const f32x4 v = xr[64 * j]; s += (v[0] * v[0] + v[1] * v[1]) + (v[2] * v[2] + v[3] * v[3]); u32x2 w; w.x = cvt_pk_bf16(v[0], v[1]); w.y = cvt_pk_bf16(v[2], v[3]); o[64 * j] = w; }
        s = wave_sum(s);
        if (lane == 0) ssq0[row] = s;
    }
}

__device__ __forceinline__ float gelu_tanh(float x) { const float u = 0.7978845608028654f * (x + 0.044715f * x * x * x); return 0.5f * x * (1.0f + tanhf(u)); }

template <int DH>
__device__ __forceinline__ void compress_unit(const Params& p, LAS unsigned char* lds, int b, int n0, int colbase, const float* pos, const bf16_t* w1t, const float* b1, const bf16_t* w2t, bf16_t* outp) {
    constexpr int KC = 32 * DH;
    const int tid = threadIdx.x, lane = tid & 63, wave = __builtin_amdgcn_readfirstlane(tid >> 6), c = lane & 15, kq = lane >> 4;
    const bf16_t* proj = (const bf16_t*)(p.ws + WS_BIG);
    LAS unsigned char* As = lds; LAS unsigned char* Bs = lds + 5120; LAS unsigned char* Hs = lds + 32768;
    const int arow = tid >> 2, ach = tid & 3;
    const int ag = arow >> 4, an = n0 + (arow & 15);
    u32x4 areg = {0, 0, 0, 0}, breg[2];
#define CMP_LOAD(k0_) do { const int k0v = (k0_); \
        if (tid < 256) { const int kk = k0v + ach * 8, l = kk / DH, d = kk % DH; int tok = 16 * an + l; tok = tok < SEQ ? tok : SEQ - 1; \
            const u32x4 raw = *(const u32x4*)(proj + (size_t)(b * SEQ + tok) * NPROJ + colbase + ag * DH + d); \
            const f32x4 p0 = *(const f32x4*)(pos + l * DH + d), p1 = *(const f32x4*)(pos + l * DH + d + 4); \
            areg.x = cvt_pk_bf16(bf_lo(raw.x) + p0[0], bf_hi(raw.x) + p0[1]); areg.y = cvt_pk_bf16(bf_lo(raw.y) + p0[2], bf_hi(raw.y) + p0[3]); \
            areg.z = cvt_pk_bf16(bf_lo(raw.z) + p1[0], bf_hi(raw.z) + p1[1]); areg.w = cvt_pk_bf16(bf_lo(raw.w) + p1[2], bf_hi(raw.w) + p1[3]); } \
        _Pragma("unroll") for (int i_ = 0; i_ < 2; ++i_) { const int idx = tid + 512 * i_; breg[i_] = *(const u32x4*)(w1t + (size_t)(idx >> 2) * KC + k0v + (idx & 3) * 8); } } while (0)
    f32x4 acc[4][2];
#pragma unroll
    for (int m = 0; m < 4; ++m) { acc[m][0] = (f32x4){0.f, 0.f, 0.f, 0.f}; acc[m][1] = (f32x4){0.f, 0.f, 0.f, 0.f}; }
    CMP_LOAD(0);
    for (int k0 = 0; k0 < KC; k0 += 32) {
        __syncthreads();
        if (tid < 256) *(LAS u32x4*)(As + arow * 80 + ach * 16) = areg;
#pragma unroll
        for (int i = 0; i < 2; ++i) { const int idx = tid + 512 * i; *(LAS u32x4*)(Bs + (idx >> 2) * 80 + (idx & 3) * 16) = breg[i]; }
        __syncthreads();
        if (k0 + 32 < KC) CMP_LOAD(k0 + 32);
        bf16x8 af[4], bfr[2];
#pragma unroll
        for (int m = 0; m < 4; ++m) af[m] = *(const LAS bf16x8*)(As + (16 * m + c) * 80 + kq * 16);
#pragma unroll
        for (int n = 0; n < 2; ++n) bfr[n] = *(const LAS bf16x8*)(Bs + (32 * wave + 16 * n + c) * 80 + kq * 16);
#pragma unroll
        for (int m = 0; m < 4; ++m)
#pragma unroll
            for (int n = 0; n < 2; ++n) acc[m][n] = __builtin_amdgcn_mfma_f32_16x16x32_bf16(af[m], bfr[n], acc[m][n], 0, 0, 0);
    }
#pragma unroll
    for (int n = 0; n < 2; ++n) { const int col = 32 * wave + 16 * n + c; const float bb = b1[col];
#pragma unroll
        for (int m = 0; m < 4; ++m)
#pragma unroll
            for (int i = 0; i < 4; ++i) { const float h = gelu_tanh(acc[m][n][i] + bb); *(LAS bf16_t*)(Hs + (16 * m + 4 * kq + i) * 528 + col * 2) = (bf16_t)(cvt_pk_bf16(h, 0.f) & 0xffffu); } }
    __syncthreads();
    constexpr int NT2 = 4 * (DH / 16);
    for (int idx = wave; idx < NT2; idx += 8) {
        const int m2 = idx & 3, n2 = idx >> 2;
        f32x4 a2 = {0.f, 0.f, 0.f, 0.f};
#pragma unroll
        for (int ks = 0; ks < 8; ++ks) { const bf16x8 a = *(const LAS bf16x8*)(Hs + (16 * m2 + c) * 528 + (32 * ks + 8 * kq) * 2);
            const bf16x8 bb = *(const bf16x8*)(w2t + (size_t)(16 * n2 + c) * 256 + 32 * ks + 8 * kq);
            a2 = __builtin_amdgcn_mfma_f32_16x16x32_bf16(a, bb, a2, 0, 0, 0); }
#pragma unroll
        for (int i = 0; i < 4; ++i) outp[((size_t)(b * NG + m2) * NCMP + n0 + 4 * kq + i) * DH + 16 * n2 + c] = (bf16_t)(cvt_pk_bf16(a2[i], 0.f) & 0xffffu);
    }
    __syncthreads();
}

__device__ __forceinline__ void phase_compress(const Params& p, LAS unsigned char* lds) {
    unsigned char* ws = p.ws;
    for (int u = blockIdx.x; u < 256; u += gridDim.x) {
        const int which = u >> 7, b = (u >> 6) & 1, n0 = (u & 63) * 16;
        if (which == 0) compress_unit<DK>(p, lds, b, n0, C_KC, p.pos_k, (const bf16_t*)(ws + WS_CK1), p.ck_b1, (const bf16_t*)(ws + WS_CK2), (bf16_t*)(ws + WS_KCMP));
        else compress_unit<DV>(p, lds, b, n0, C_VC, p.pos_v, (const bf16_t*)(ws + WS_CV1), p.cv_b1, (const bf16_t*)(ws + WS_CV2), (bf16_t*)(ws + WS_VCMP));
    }
    { const bf16_t* proj = (const bf16_t*)(ws + WS_BIG); unsigned* kmaxp = (unsigned*)(ws + WS_KMAX); const int lane = threadIdx.x & 63;
      for (int it = blockIdx.x * NTHR + threadIdx.x; it < MT * 8; it += gridDim.x * NTHR) { const int row = it >> 3, sg = it & 7, br = sg >> 2, g = sg & 3;
        const u32x4* kp = (const u32x4*)(proj + (size_t)row * NPROJ + (br ? C_KW : C_KS) + g * DK); float n2 = 0.f;
#pragma unroll
        for (int ch = 0; ch < 12; ++ch) { const u32x4 w = kp[ch];
            n2 += bf_lo(w.x) * bf_lo(w.x) + bf_hi(w.x) * bf_hi(w.x) + bf_lo(w.y) * bf_lo(w.y) + bf_hi(w.y) * bf_hi(w.y) + bf_lo(w.z) * bf_lo(w.z) + bf_hi(w.z) * bf_hi(w.z) + bf_lo(w.w) * bf_lo(w.w) + bf_hi(w.w) * bf_hi(w.w); }
        n2 = fmaxf(n2, __shfl_xor(n2, 8)); n2 = fmaxf(n2, __shfl_xor(n2, 16)); n2 = fmaxf(n2, __shfl_xor(n2, 32));
        if (lane < 8) atomicMax(kmaxp + br * 8 + (row >> 14) * 4 + g, __float_as_uint(sqrtf(n2))); } }
}

constexpr int KT_STRIDE = 208, SLOT_K = 64 * KT_STRIDE;
constexpr int VT_STRIDE = 144, SLOT_V = 64 * VT_STRIDE;
constexpr int SLOT_BYTES = SLOT_K + SLOT_V, RING = 5, PD = RING - 1;
constexpr int RING_WS = 6;
constexpr int L_RING = 0, L_IMP = RING * SLOT_BYTES, L_BIAS = LDS_BYTES - 4 * 8 * 132 * 4, L_SELM = L_BIAS - 2048;
static_assert(L_IMP + 32 * 256 * 4 <= L_BIAS && RING_WS * SLOT_BYTES <= L_SELM, "attention LDS map");

struct PairState { f32x4 o[4]; float m, l; bf16x8 q[3]; };
struct TileSrc { const bf16_t* K; const bf16_t* V; int kld, vld; };
struct DmaPlan { int off[3]; };

__device__ __forceinline__ void glds16(const void* gsrc, unsigned lds_dst) { unsigned keep;
    asm volatile("s_mov_b32 %0, m0\n\ts_mov_b32 m0, %2\n\ts_nop 0\n\tglobal_load_lds_dwordx4 %1, off\n\ts_mov_b32 m0, %0" : "=&s"(keep) : "v"(gsrc), "s"(lds_dst) : "memory"); }
#define ATT_WAIT_BAR(N) asm volatile("s_waitcnt vmcnt(" #N ") lgkmcnt(0)\n\ts_barrier" ::: "memory")
__device__ __forceinline__ void att_wait_bar(int rem) { if (rem <= 0) ATT_WAIT_BAR(0); else if (rem == 1) ATT_WAIT_BAR(3); else if (rem == 2) ATT_WAIT_BAR(6); else ATT_WAIT_BAR(9); }
__device__ __forceinline__ bool piece_is_k(int s) { return s < 13 || s >= 22; }
__device__ __forceinline__ int piece_grp(int s) { return s < 13 ? s : (s >= 22 ? s - 22 : s - 13); }
__device__ __forceinline__ void make_plan(DmaPlan& pl, const TileSrc& src, int wave, int lane) {
#pragma unroll
    for (int j = 0; j < 3; ++j) { const int sidx = wave + 8 * j, ci = 64 * piece_grp(sidx) + lane;
        if (piece_is_k(sidx)) { const int key = ci / 13, ch = ci % 13; pl.off[j] = key * src.kld + (ch < 12 ? ch : 11) * 8; }
        else { const int key = ci / 9, ch = ci % 9; pl.off[j] = key * src.vld + (ch < 8 ? ch : 7) * 8; } }
}
__device__ __forceinline__ void issue_tile(const DmaPlan& pl, const TileSrc& src, int key0, unsigned slot_addr, int wave) {
#pragma unroll
    for (int j = 0; j < 3; ++j) { const int sidx = wave + 8 * j; const bool isk = piece_is_k(sidx);
        const bf16_t* gp = (isk ? src.K + (size_t)key0 * src.kld : src.V + (size_t)key0 * src.vld) + pl.off[j];
        glds16(gp, slot_addr + (isk ? 0u : (unsigned)SLOT_K) + 1024u * (unsigned)piece_grp(sidx)); }
}
typedef short s16x4 __attribute__((ext_vector_type(4)));
__device__ __forceinline__ s16x4 vtr(const LAS unsigned char* p) { return __builtin_bit_cast(s16x4, __builtin_amdgcn_ds_read_tr16_b64_v4i16((LAS s16x4*)p)); }

template <int MODE, bool FAR>
__device__ __forceinline__ void pair_tile(PairState& st, const LAS unsigned char* Kt, const LAS unsigned char* Vt, int tadj, int kstride, int maxdist, bool rowsel,
                                          const LAS float* biasrow, float bias_far, LAS float* improw, int jj0, int lane) {
    const int c = lane & 15, kq = lane >> 4;
    f32x4 s[4];
    float bv[4][4];
    if (!FAR) {
#pragma unroll
        for (int kt = 0; kt < 4; ++kt)
#pragma unroll
            for (int i = 0; i < 4; ++i) { const int d = tadj - (16 * kt + 4 * kq + i) * kstride; const int bi = d < 0 ? 0 : (d > 128 ? 128 : d); bv[kt][i] = biasrow[bi]; }
    }
    const float init = (FAR ? bias_far : 0.f) - st.m;
#pragma unroll
    for (int kt = 0; kt < 4; ++kt) { s[kt] = (f32x4){init, init, init, init};
#pragma unroll
        for (int ds = 0; ds < 3; ++ds) { const bf16x8 a = *(const LAS bf16x8*)(Kt + (16 * kt + c) * KT_STRIDE + (32 * ds + 8 * kq) * 2);
            s[kt] = __builtin_amdgcn_mfma_f32_16x16x32_bf16(a, st.q[ds], s[kt], 0, 0, 0); } }
    if (!FAR) {
#pragma unroll
        for (int kt = 0; kt < 4; ++kt)
#pragma unroll
            for (int i = 0; i < 4; ++i) { const int d = tadj - (16 * kt + 4 * kq + i) * kstride; const bool valid = ((unsigned)d < (unsigned)maxdist) && rowsel;
                s[kt][i] = valid ? s[kt][i] + bv[kt][i] : NEGF; }
    }
    float psum = 0.f;
#pragma unroll
    for (int kt = 0; kt < 4; ++kt)
#pragma unroll
        for (int i = 0; i < 4; ++i) { const float pv = __builtin_amdgcn_exp2f(s[kt][i]); s[kt][i] = pv; psum += pv; }
    if (MODE != 1) st.l += psum;
    if (MODE == 0) return;
#pragma unroll
    for (int s2 = 0; s2 < 2; ++s2) {
        u32x4 pw; pw.x = cvt_pk_bf16(s[2 * s2][0], s[2 * s2][1]); pw.y = cvt_pk_bf16(s[2 * s2][2], s[2 * s2][3]); pw.z = cvt_pk_bf16(s[2 * s2 + 1][0], s[2 * s2 + 1][1]); pw.w = cvt_pk_bf16(s[2 * s2 + 1][2], s[2 * s2 + 1][3]);
        const bf16x8 pb = __builtin_bit_cast(bf16x8, pw);
#pragma unroll
        for (int dt = 0; dt < 4; ++dt) { const LAS unsigned char* vp = Vt + (32 * s2 + 4 * kq + (c >> 2)) * VT_STRIDE + (16 * dt + 4 * (c & 3)) * 2;
            const s16x4 lo = vtr(vp), hi = vtr(vp + 16 * VT_STRIDE); const bf16x8 a = {lo[0], lo[1], lo[2], lo[3], hi[0], hi[1], hi[2], hi[3]};
            st.o[dt] = __builtin_amdgcn_mfma_f32_16x16x32_bf16(a, pb, st.o[dt], 0, 0, 0); }
    }
    if (MODE == 1) {
#pragma unroll
        for (int kt = 0; kt < 4; ++kt) {
            float u0 = 2.0f * (s[kt][0] + s[kt][1] + s[kt][2]) + s[kt][3], u1 = s[kt][3];
            u0 += __shfl_xor(u0, 1); u1 += __shfl_xor(u1, 1); u0 += __shfl_xor(u0, 2); u1 += __shfl_xor(u1, 2); u0 += __shfl_xor(u0, 4); u1 += __shfl_xor(u1, 4);
            if ((lane & 7) == 0) { const int jj = jj0 + 4 * kt + kq;
                __hip_atomic_fetch_add(improw + jj, u0, __ATOMIC_RELAXED, __HIP_MEMORY_SCOPE_WORKGROUP);
                if (jj + 1 < 256) __hip_atomic_fetch_add(improw + jj + 1, u1, __ATOMIC_RELAXED, __HIP_MEMORY_SCOPE_WORKGROUP); }
        }
    }
}
#define PAIR_TILE(MODE, far, ...) do { if (far) pair_tile<MODE, true>(__VA_ARGS__); else pair_tile<MODE, false>(__VA_ARGS__); } while (0)

__device__ __forceinline__ int t5_bucket(int n) {
    if (n < 16) return n;
    int bk = 16;
    bk += (n >= 19); bk += (n >= 21); bk += (n >= 24); bk += (n >= 27); bk += (n >= 31); bk += (n >= 35); bk += (n >= 40); bk += (n >= 46);
    bk += (n >= 52); bk += (n >= 59); bk += (n >= 67); bk += (n >= 77); bk += (n >= 87); bk += (n >= 99); bk += (n >= 113);
    return bk;
}
__device__ __forceinline__ void build_bias(const Params& p, LAS unsigned char* lds) {
    LAS float* bt = (LAS float*)(lds + L_BIAS);
    for (int i = threadIdx.x; i < 32 * 129; i += NTHR) { const int h = i / 129, d = i % 129; bt[h * 132 + d] = p.rel_bias[t5_bucket(d) * 32 + h] * 1.4426950408889634f; }
    __syncthreads();
    if (threadIdx.x < 32) { float mx = bt[threadIdx.x * 132]; for (int d = 1; d < 129; ++d) mx = fmaxf(mx, bt[threadIdx.x * 132 + d]); bt[threadIdx.x * 132 + 129] = mx; }
    __syncthreads();
}

__device__ __forceinline__ void load_q(PairState& st, const bf16_t* proj, int b, int g, int tq0, int lane, float kmx, float bmax) {
    const int c = lane & 15, kq = lane >> 4; const size_t row = (size_t)b * SEQ + tq0 + (c >> 3);
#pragma unroll
    for (int ds = 0; ds < 3; ++ds) st.q[ds] = *(const bf16x8*)(proj + row * NPROJ + (g * 8 + (c & 7)) * DK + 32 * ds + 8 * kq);
    asm volatile("" : "+v"(st.q[0]), "+v"(st.q[1]), "+v"(st.q[2]));
    float qq = 0.f;
#pragma unroll
    for (int ds = 0; ds < 3; ++ds) { const u32x4 w = __builtin_bit_cast(u32x4, st.q[ds]);
        qq += bf_lo(w.x) * bf_lo(w.x) + bf_hi(w.x) * bf_hi(w.x) + bf_lo(w.y) * bf_lo(w.y) + bf_hi(w.y) * bf_hi(w.y) + bf_lo(w.z) * bf_lo(w.z) + bf_hi(w.z) * bf_hi(w.z) + bf_lo(w.w) * bf_lo(w.w) + bf_hi(w.w) * bf_hi(w.w); }
    qq += __shfl_xor(qq, 16); qq += __shfl_xor(qq, 32);
    st.m = sqrtf(qq) * kmx + bmax + 0.25f;
}
__device__ __forceinline__ void reset_state(PairState& st) {
#pragma unroll
    for (int dt = 0; dt < 4; ++dt) st.o[dt] = (f32x4){0.f, 0.f, 0.f, 0.f};
    st.l = 0.f;
}
template <bool ACCUM>
__device__ __forceinline__ void write_out(const PairState& st, float inv, const bf16_t* proj, bf16_t* obuf, int b, int g, int tq0, int br, int lane) {
    const int c = lane & 15, kq = lane >> 4; const size_t row = (size_t)b * SEQ + tq0 + (c >> 3);
    const float gl = bf_lo((unsigned)proj[row * NPROJ + C_GATE + br * 32 + g * 8 + (c & 7)]);
    const float sc = inv * __builtin_amdgcn_rcpf(1.0f + __expf(-gl));
    bf16_t* op = obuf + row * DM + (g * 8 + (c & 7)) * DV + 4 * kq;
#pragma unroll
    for (int dt = 0; dt < 4; ++dt) { f32x4 v = st.o[dt] * sc;
        if (ACCUM) { const u32x2 old = *(const u32x2*)(op + 16 * dt); v[0] += bf_lo(old.x); v[1] += bf_hi(old.x); v[2] += bf_lo(old.y); v[3] += bf_hi(old.y); }
        u32x2 w; w.x = cvt_pk_bf16(v[0], v[1]); w.y = cvt_pk_bf16(v[2], v[3]); *(u32x2*)(op + 16 * dt) = w; }
}

__device__ __forceinline__ void phase_cmp(const Params& p, LAS unsigned char* lds) {
    const int tid = threadIdx.x, lane = tid & 63, wave = __builtin_amdgcn_readfirstlane(tid >> 6), c = lane & 15;
    const bf16_t* proj = (const bf16_t*)(p.ws + WS_BIG); bf16_t* obuf = (bf16_t*)(p.ws + WS_O); unsigned* selm = (unsigned*)(p.ws + WS_SELM);
    build_bias(p, lds);
    { LAS float* bt = (LAS float*)(lds + L_BIAS); const u32x4* kc = (const u32x4*)(p.ws + WS_KCMP) + (size_t)wave * NCMP * 12; float n2m = 0.f;
      for (int r = lane; r < NCMP; r += 64) { float n2 = 0.f;
#pragma unroll
        for (int ch = 0; ch < 12; ++ch) { const u32x4 w = kc[r * 12 + ch];
            n2 += bf_lo(w.x) * bf_lo(w.x) + bf_hi(w.x) * bf_hi(w.x) + bf_lo(w.y) * bf_lo(w.y) + bf_hi(w.y) * bf_hi(w.y) + bf_lo(w.z) * bf_lo(w.z) + bf_hi(w.z) * bf_hi(w.z) + bf_lo(w.w) * bf_lo(w.w) + bf_hi(w.w) * bf_hi(w.w); }
        n2m = fmaxf(n2m, n2); }
#pragma unroll
      for (int o = 1; o < 64; o <<= 1) n2m = fmaxf(n2m, __shfl_xor(n2m, o));
      if (lane == 0) bt[wave * 132 + 130] = sqrtf(n2m);
      __syncthreads(); }
    LAS float* imp = (LAS float*)(lds + L_IMP);
    for (int u = blockIdx.x; u < 4096; u += gridDim.x) {
        const int bg = u & 7, b = bg >> 2, g = bg & 3, t0 = (511 - (u >> 3)) * 32;
        TileSrc src; src.K = (const bf16_t*)(p.ws + WS_KCMP) + (size_t)bg * NCMP * DK; src.V = (const bf16_t*)(p.ws + WS_VCMP) + (size_t)bg * NCMP * DV; src.kld = DK; src.vld = DV;
#ifdef EXP_SRC_S
        src.K = proj + (size_t)b * SEQ * NPROJ + C_KS + g * DK; src.V = proj + (size_t)b * SEQ * NPROJ + C_VS + g * DV; src.kld = NPROJ; src.vld = NPROJ;
#endif
        const int nt = t0 / 1024 + 1;
        const LAS float* biasrow = (const LAS float*)(lds + L_BIAS) + (g * 8 + (c & 7)) * 132; const float bias_far = biasrow[128];
        PairState st[2];
#pragma unroll
        for (int pi = 0; pi < 2; ++pi) { reset_state(st[pi]); load_q(st[pi], proj, b, g, t0 + 4 * wave + 2 * pi, lane, ((const LAS float*)(lds + L_BIAS))[bg * 132 + 130], biasrow[129]); }
#pragma unroll
        for (int i = 0; i < 16; ++i) imp[(4 * wave) * 256 + i * 64 + lane] = 0.f;
        DmaPlan pl; make_plan(pl, src, wave, lane);
        const unsigned ring = (unsigned)(size_t)(lds + L_RING);
#pragma unroll 1
        for (int pass = 0; pass < 2; ++pass) {
            if (pass == 1) {
#pragma unroll
                for (int pi = 0; pi < 2; ++pi) { float lt = st[pi].l; lt += __shfl_xor(lt, 16); lt += __shfl_xor(lt, 32); if (lt > 0.f) st[pi].m += __builtin_amdgcn_logf(lt); }
            }
            for (int d = 0; d < PD && d < nt; ++d) issue_tile(pl, src, 64 * d, ring + d * SLOT_BYTES, wave);
            int slot = 0, islot = PD;
#pragma unroll 1
            for (int i = 0; i < nt; ++i) {
                { int rem = nt - 1 - i; rem = rem < PD - 1 ? rem : PD - 1; att_wait_bar(rem); }
                if (i + PD < nt) issue_tile(pl, src, 64 * (i + PD), ring + islot * SLOT_BYTES, wave);
                const LAS unsigned char* Kt = lds + L_RING + slot * SLOT_BYTES; const LAS unsigned char* Vt = Kt + SLOT_K;
#pragma unroll
                for (int pi = 0; pi < 2; ++pi) { const int tq0 = t0 + 4 * wave + 2 * pi; const int P0 = 16 * 64 * i + 31;
                    if (tq0 + 1 < P0) continue;
                    const bool far = (tq0 - (P0 + 63 * 16)) >= 113;
                    const int tadj = tq0 + (c >> 3) - P0;
                    if (pass == 0) PAIR_TILE(0, far, st[pi], Kt, Vt, tadj, 16, 1 << 30, true, biasrow, bias_far, nullptr, 0, lane);
                    else PAIR_TILE(1, far, st[pi], Kt, Vt, tadj, 16, 1 << 30, true, biasrow, bias_far, imp + (4 * wave + 2 * pi + (c >> 3)) * 256, 16 * i, lane); }
                slot = slot + 1 == RING ? 0 : slot + 1; islot = islot + 1 == RING ? 0 : islot + 1;
            }
            ATT_WAIT_BAR(0);
        }
#pragma unroll
        for (int pi = 0; pi < 2; ++pi) write_out<false>(st[pi], 1.0f, proj, obuf, b, g, t0 + 4 * wave + 2 * pi, 0, lane);
        asm volatile("s_waitcnt lgkmcnt(0)" ::: "memory");
#pragma unroll 1
        for (int qq = 0; qq < 4; ++qq) {
            const int t = t0 + 4 * wave + qq, cur = t >> 6;
            unsigned long long key[4]; bool sel[4];
#pragma unroll
            for (int i = 0; i < 4; ++i) { const int j = lane + 64 * i; const float v = imp[(4 * wave + qq) * 256 + j];
                sel[i] = (j == 0) || (j == cur) || (j == cur - 1);
                const bool cand = (j >= 1) && (j <= cur - 2);
                key[i] = cand ? (((unsigned long long)__float_as_uint(v) << 8) | (unsigned long long)(256 - j)) : 0ull; }
            const int need = 16 - (1 + (cur >= 1) + (cur >= 2));
            unsigned long long T = 0ull;
#pragma unroll 1
            for (int bit = 39; bit >= 0; --bit) { const unsigned long long cand = T | (1ull << bit);
                const int cnt = __popcll(__ballot(key[0] >= cand)) + __popcll(__ballot(key[1] >= cand)) + __popcll(__ballot(key[2] >= cand)) + __popcll(__ballot(key[3] >= cand));
                if (cnt >= need) T = cand; }
            if (T == 0ull) T = 1ull;
#pragma unroll
            for (int i = 0; i < 4; ++i) sel[i] = sel[i] || (key[i] >= T);
            unsigned* mrow = selm + ((size_t)bg * SEQ + t) * 8;
#pragma unroll
            for (int i = 0; i < 4; ++i) { const unsigned long long bal = __ballot(sel[i]); if (lane == 0) { mrow[2 * i] = (unsigned)bal; mrow[2 * i + 1] = (unsigned)(bal >> 32); } }
        }
    }
}

__device__ __forceinline__ void build_order(const LAS unsigned* lsel, LAS unsigned char* ord, LAS int* cnt, int cb, int nq, int lane) {
    int base = 0;
#pragma unroll 1
    for (int r = 0; 64 * r <= cb; ++r) { const int j = lane + 64 * r; unsigned m = 0u;
        for (int q = 0; q < nq; ++q) m |= lsel[q * 8 + (j >> 5)];
        const bool need = (j <= cb) && ((m >> (j & 31)) & 1u);
        const unsigned long long bal = __ballot(need);
        if (need) ord[base + __popcll(bal & ((1ull << lane) - 1ull))] = (unsigned char)j;
        base += __popcll(bal); }
    if (lane == 0) *cnt = base;
}

template <bool WIN, int NP>
__device__ __forceinline__ void phase_ws(const Params& p, LAS unsigned char* lds) {
    constexpr int QW = 2 * NP, QU = 8 * QW, NUNIT = MT * NG / QU;
    const int tid = threadIdx.x, lane = tid & 63, wave = __builtin_amdgcn_readfirstlane(tid >> 6), c = lane & 15;
    const bf16_t* proj = (const bf16_t*)(p.ws + WS_BIG); bf16_t* obuf = (bf16_t*)(p.ws + WS_O); const unsigned* selm = (const unsigned*)(p.ws + WS_SELM);
    build_bias(p, lds);
    LAS unsigned* lsel = (LAS unsigned*)(lds + L_SELM);
    for (int u = blockIdx.x; u < NUNIT; u += gridDim.x) {
        const int bg = u & 7, b = bg >> 2, g = bg & 3, t0 = (SEQ / QU - 1 - (u >> 3)) * QU;
        TileSrc src; src.kld = NPROJ; src.vld = NPROJ;
        src.K = proj + (size_t)b * SEQ * NPROJ + (WIN ? C_KW : C_KS) + g * DK; src.V = proj + (size_t)b * SEQ * NPROJ + (WIN ? C_VW : C_VS) + g * DV;
        const int cb = t0 >> 6;
        const int kstart = WIN ? (cb >= 8 ? (cb - 8) * 64 : 0) : 0;
        const int nt = cb + 1 - kstart / 64;
        const LAS float* biasrow = (const LAS float*)(lds + L_BIAS) + (g * 8 + (c & 7)) * 132; const float bias_far = biasrow[128];
        const float kmx = __uint_as_float(((const unsigned*)(p.ws + WS_KMAX))[(WIN ? 8 : 0) + bg]);
        LAS unsigned char* ord = (LAS unsigned char*)(lds + L_SELM + 1024);
        int npos = nt;
        if (!WIN) { if (tid < QU * 8) lsel[tid] = selm[((size_t)bg * SEQ + t0) * 8 + tid];
            __syncthreads();
            if (wave == 0) build_order(lsel, ord, (LAS int*)(lds + L_SELM + 1024 + 256), cb, QU, lane);
            __syncthreads();
            npos = *(LAS int*)(lds + L_SELM + 1024 + 256); }
        PairState st[NP];
#pragma unroll
        for (int pi = 0; pi < NP; ++pi) { reset_state(st[pi]); load_q(st[pi], proj, b, g, t0 + QW * wave + 2 * pi, lane, kmx, biasrow[129]); }
        DmaPlan pl; make_plan(pl, src, wave, lane);
        const unsigned ring = (unsigned)(size_t)(lds + L_RING);
#define WS_TILE(pos) (WIN ? (pos) : (int)ord[pos])
        for (int d = 0; d < 4 && d < npos; ++d) issue_tile(pl, src, kstart + 64 * WS_TILE(d), ring + d * SLOT_BYTES, wave);
        int slot = 0, islot = 4;
#pragma unroll 1
        for (int i0 = 0; i0 < npos; i0 += 2) {
            { const int issued = npos < i0 + 4 ? npos : i0 + 4, done = npos < i0 + 2 ? npos : i0 + 2; att_wait_bar(issued - done); }
#pragma unroll
            for (int e = 0; e < 2; ++e) { if (i0 + 4 + e < npos) issue_tile(pl, src, kstart + 64 * WS_TILE(i0 + 4 + e), ring + islot * SLOT_BYTES, wave); islot = islot + 1 == RING_WS ? 0 : islot + 1; }
#pragma unroll 1
            for (int e = 0; e < 2; ++e) { if (i0 + e >= npos) break; const int i = WS_TILE(i0 + e);
                const LAS unsigned char* Kt = lds + L_RING + slot * SLOT_BYTES; const LAS unsigned char* Vt = Kt + SLOT_K;
                slot = slot + 1 == RING_WS ? 0 : slot + 1;
                const int P0 = kstart + 64 * i;
#pragma unroll
                for (int pi = 0; pi < NP; ++pi) { const int tq0 = t0 + QW * wave + 2 * pi;
                    bool rowsel = true; bool allsel = true;
                    if (!WIN) { const unsigned w = lsel[(QW * wave + 2 * pi + (c >> 3)) * 8 + (i >> 5)]; rowsel = (w >> (i & 31)) & 1u;
                        const unsigned long long bal = __ballot(rowsel); if (bal == 0ull) continue; allsel = (bal == ~0ull); }
                    else { if (tq0 + 1 < P0 || tq0 - (P0 + 63) >= 512) continue; }
                    const bool far = allsel && (tq0 - (P0 + 63) >= 113) && (!WIN || (tq0 + 1 - P0 < 512));
                    PAIR_TILE(2, far, st[pi], Kt, Vt, tq0 + (c >> 3) - P0, 1, WIN ? 512 : (1 << 30), rowsel, biasrow, bias_far, nullptr, 0, lane); } }
        }
#undef WS_TILE
        ATT_WAIT_BAR(0);
#pragma unroll
        for (int pi = 0; pi < NP; ++pi) { float lt = st[pi].l; lt += __shfl_xor(lt, 16); lt += __shfl_xor(lt, 32);
            write_out<true>(st[pi], lt > 0.f ? 1.0f / lt : 0.f, proj, obuf, b, g, t0 + QW * wave + 2 * pi, WIN ? 2 : 1, lane); }
    }
}

__device__ __forceinline__ void phase_pool(const Params& p) {
    const bf16_t* ub = (const bf16_t*)(p.ws + WS_BIG); bf16_t* pooled = (bf16_t*)(p.ws + WS_BIG + 128 * MiB);
    const int nthr = gridDim.x * NTHR;
    for (int it = blockIdx.x * NTHR + threadIdx.x; it < MT * 256; it += nthr) {
        const int row = it >> 8, ch = it & 255, t = row & (SEQ - 1); const int w = 2 << (ch >> 6);
        const int cnt = (t + 1 < w) ? t + 1 : w;
        float acc[8] = {0.f, 0.f, 0.f, 0.f, 0.f, 0.f, 0.f, 0.f}; u32x4 self = {0, 0, 0, 0};
        for (int k = 0; k < cnt; ++k) { const u32x4 v = *(const u32x4*)(ub + (size_t)(row - k) * DM + ch * 8); if (k == 0) self = v;
            acc[0] += bf_lo(v.x); acc[1] += bf_hi(v.x); acc[2] += bf_lo(v.y); acc[3] += bf_hi(v.y); acc[4] += bf_lo(v.z); acc[5] += bf_hi(v.z); acc[6] += bf_lo(v.w); acc[7] += bf_hi(v.w); }
        const float ic = 1.0f / (float)cnt;
        u32x4 o; o.x = cvt_pk_bf16(acc[0] * ic - bf_lo(self.x), acc[1] * ic - bf_hi(self.x)); o.y = cvt_pk_bf16(acc[2] * ic - bf_lo(self.y), acc[3] * ic - bf_hi(self.y));
        o.z = cvt_pk_bf16(acc[4] * ic - bf_lo(self.z), acc[5] * ic - bf_hi(self.z)); o.w = cvt_pk_bf16(acc[6] * ic - bf_lo(self.w), acc[7] * ic - bf_hi(self.w));
        *(u32x4*)(pooled + (size_t)row * DM + ch * 8) = o;
    }
}
__device__ __forceinline__ void phase_final(const Params& p) {
    const int lane = threadIdx.x & 63, wave = threadIdx.x >> 6; const int gw = blockIdx.x * NWAVES + wave, ngw = gridDim.x * NWAVES;
    const float* ssq = (const float*)(p.ws + WS_SSQ) + 4 * (size_t)MT;
    for (int row = gw; row < MT; row += ngw) { const float rs = rsqrtf(ssq[row] * (1.0f / DM) + EPS);
        f32x4* xr = (f32x4*)(p.out + (size_t)row * DM) + lane; const f32x4* gr = (const f32x4*)p.norm_final + lane;
#pragma unroll
        for (int j = 0; j < 8; ++j) xr[64 * j] = xr[64 * j] * rs * gr[64 * j]; }
}

#ifndef ATT_MASK
#define ATT_MASK 7
#endif
#define GSYNC_() do { asm volatile("s_waitcnt vmcnt(0) lgkmcnt(0)" ::: "memory"); __builtin_amdgcn_fence(__ATOMIC_RELEASE, "agent"); grid.sync(); __builtin_amdgcn_fence(__ATOMIC_ACQUIRE, "agent"); } while (0)
#define GSYNC() do { asm volatile("s_waitcnt vmcnt(0) lgkmcnt(0)" ::: "memory"); __builtin_amdgcn_fence(__ATOMIC_RELEASE, "agent"); grid.sync(); __builtin_amdgcn_fence(__ATOMIC_ACQUIRE, "agent"); } while (0)
#ifndef PROBE_A0
#define PROBE_A0 -1
#define PROBE_A1 -1
#define PROBE_B0 -1
#define PROBE_B1 -1
#endif
#define STAMP(k) do { if (PROBE_A0 >= 0 && blockIdx.x == 0 && threadIdx.x == 0) ((unsigned long long*)(p.ws + 960 * 1024))[k] = __builtin_amdgcn_s_memrealtime(); } while (0)
__global__ void __launch_bounds__(NTHR, 2) fwd_megakernel(Params p) {
    extern __shared__ __attribute__((aligned(16))) unsigned char lds_raw[];
    LAS unsigned char* lds = (LAS unsigned char*)lds_raw;
    cg::grid_group grid = cg::this_grid();
    unsigned char* ws = p.ws;
    float* ssq = (float*)(ws + WS_SSQ);
    bf16_t* xb = (bf16_t*)(ws + WS_XB); bf16_t* obuf = (bf16_t*)(ws + WS_O); bf16_t* big = (bf16_t*)(ws + WS_BIG);
    const int G = gridDim.x, cidx = blockIdx.x;
    pg8::StaticOrder S;

    STAMP(0);
    phase_prologue(p, lds);
#ifdef REP_PRO
    GSYNC_(); phase_prologue(p, lds);
#endif
    GSYNC();
    STAMP(1);
    { pg8::Gemm g{xb, (const bf16_t*)(ws + WS_W_IN), DM, DM, MT, NPROJ, DM, 0}; S.init(MT, NPROJ, G, cidx); pg8::EpiProj E{big, ssq}; pg8::gemm_phase(lds, g, S, E); }
    GSYNC();
    STAMP(2);
    phase_compress(p, lds);
    GSYNC();
    STAMP(3);
    if (ATT_MASK & 1) phase_cmp(p, lds);
    else { for (size_t i = (size_t)blockIdx.x * NTHR + threadIdx.x; i < (size_t)MT * DM / 8; i += (size_t)gridDim.x * NTHR) ((u32x4*)obuf)[i] = (u32x4){0, 0, 0, 0}; }
    GSYNC();
    STAMP(4);
    if (ATT_MASK & 4) phase_ws<true, 2>(p, lds);
    if (PROBE_A0 >= 0) { GSYNC_(); STAMP(16); }
    if (ATT_MASK & 2) phase_ws<false, 2>(p, lds);
    GSYNC();
    STAMP(5);
#ifdef REP_ATT
    if (ATT_MASK & 1) phase_cmp(p, lds);
    else { for (size_t i = (size_t)blockIdx.x * NTHR + threadIdx.x; i < (size_t)MT * DM / 8; i += (size_t)gridDim.x * NTHR) ((u32x4*)obuf)[i] = (u32x4){0, 0, 0, 0}; }
    GSYNC_();
    if (ATT_MASK & 4) phase_ws<true, 2>(p, lds);
    if (ATT_MASK & 2) phase_ws<false, 2>(p, lds);
    GSYNC_();
#endif
    { pg8::Gemm g{obuf, (const bf16_t*)(ws + WS_W_OUT), DM, DM, MT, DM, DM, 0}; S.init(MT, DM, G, cidx); pg8::EpiRes E{p.x, p.out, xb, ssq + MT}; pg8::gemm_phase(lds, g, S, E); }
    GSYNC();
    STAMP(6);
    { pg8::Gemm g{xb, (const bf16_t*)(ws + WS_W_GU0), DM, DM, MT, 2 * DFF, DM, 0}; S.init(MT, 2 * DFF, G, cidx); pg8::EpiSwiglu E{big, ssq + MT}; pg8::gemm_phase(lds, g, S, E); }
    GSYNC();
    STAMP(7);
    { pg8::Gemm g{big, (const bf16_t*)(ws + WS_W_DN0), DFF, DFF, MT, DM, DFF, 0}; S.init(MT, DM, G, cidx); pg8::EpiRes E{p.out, p.out, xb, ssq + 2 * MT}; pg8::gemm_phase(lds, g, S, E); }
    GSYNC();
    STAMP(8);
    { pg8::Gemm g{xb, (const bf16_t*)(ws + WS_P_IN), DM, DM, MT, DM, DM, 0}; S.init(MT, DM, G, cidx); pg8::EpiRowScale E{big, ssq + 2 * MT}; pg8::gemm_phase(lds, g, S, E); }
    GSYNC();
    STAMP(9);
    phase_pool(p);
    GSYNC();
    STAMP(10);
    { pg8::Gemm g{(const bf16_t*)(ws + WS_BIG + 128 * MiB), (const bf16_t*)(ws + WS_P_GRP), DM, 512, MT, DM, 512, 1024}; S.init(MT, DM, G, cidx); pg8::EpiColScale E{obuf, p.pool_scale}; pg8::gemm_phase(lds, g, S, E); }
    GSYNC();
    STAMP(11);
    { pg8::Gemm g{obuf, (const bf16_t*)(ws + WS_P_OUT), DM, DM, MT, DM, DM, 0}; S.init(MT, DM, G, cidx); pg8::EpiRes E{p.out, p.out, xb, ssq + 3 * MT}; pg8::gemm_phase(lds, g, S, E); }
    GSYNC();
    STAMP(12);
    { pg8::Gemm g{xb, (const bf16_t*)(ws + WS_W_GU1), DM, DM, MT, 2 * DFF, DM, 0}; S.init(MT, 2 * DFF, G, cidx); pg8::EpiSwiglu E{big, ssq + 3 * MT}; pg8::gemm_phase(lds, g, S, E); }
    GSYNC();
    STAMP(13);
    { pg8::Gemm g{big, (const bf16_t*)(ws + WS_W_DN1), DFF, DFF, MT, DM, DFF, 0}; S.init(MT, DM, G, cidx); pg8::EpiRes E{p.out, p.out, xb, ssq + 4 * MT}; pg8::gemm_phase(lds, g, S, E); }
    GSYNC();
    STAMP(14);
    phase_final(p);
    if (PROBE_A0 >= 0) { GSYNC_(); STAMP(15);
        if (blockIdx.x == 0) { const unsigned long long* ts = (const unsigned long long*)(p.ws + 960 * 1024);
            const float ta = (float)(ts[PROBE_A1] - ts[PROBE_A0]) * 0.01f, tb = (float)(ts[PROBE_B1] - ts[PROBE_B0]) * 0.001f;
            if (threadIdx.x == 0) p.out[0] = ta;
            for (int i = threadIdx.x; i < 1000000; i += NTHR) p.out[4096 + i] = tb; } }
}

extern "C" void kernel_launch(void* const* d_in, const int* in_sizes, int n_in, void* d_out, int out_size, void* d_ws, size_t ws_size, hipStream_t stream) {
    static int grid_blocks = 0;
    if (grid_blocks == 0) {
        if (n_in != 21 || ws_size < WS_END) { fprintf(stderr, "kernel_launch: unexpected inputs (n_in %d, ws %zu)\n", n_in, ws_size); grid_blocks = -1; return; }
        int dev = 0, cus = 0, per_cu = 0;
        hipGetDevice(&dev); hipDeviceGetAttribute(&cus, hipDeviceAttributeMultiprocessorCount, dev);
        if (hipFuncSetAttribute((const void*)fwd_megakernel, hipFuncAttributeMaxDynamicSharedMemorySize, LDS_BYTES) != hipSuccess) { fprintf(stderr, "kernel_launch: hipFuncSetAttribute failed\n"); grid_blocks = -1; return; }
        if (hipOccupancyMaxActiveBlocksPerMultiprocessor(&per_cu, (const void*)fwd_megakernel, NTHR, LDS_BYTES) != hipSuccess || per_cu < 1) { fprintf(stderr, "kernel_launch: occupancy query failed (%d)\n", per_cu); (void)hipGetLastError(); per_cu = 1; }
        grid_blocks = cus * 1;
    }
    if (grid_blocks < 0) return;
    Params p{};
    p.x = (const float*)d_in[0]; p.norm_mix = (const float*)d_in[1]; p.norm_ffn = (const float*)d_in[2]; p.norm_final = (const float*)d_in[3]; p.rel_bias = (const float*)d_in[4];
    p.nsa_w_in = (const float*)d_in[5]; p.pos_k = (const float*)d_in[6]; p.pos_v = (const float*)d_in[7]; p.ck_w1 = (const float*)d_in[8]; p.ck_b1 = (const float*)d_in[9]; p.ck_w2 = (const float*)d_in[10];
    p.cv_w1 = (const float*)d_in[11]; p.cv_b1 = (const float*)d_in[12]; p.cv_w2 = (const float*)d_in[13]; p.nsa_w_out = (const float*)d_in[14];
    p.pool_w_in = (const float*)d_in[15]; p.pool_w_grp = (const float*)d_in[16]; p.pool_scale = (const float*)d_in[17]; p.pool_w_out = (const float*)d_in[18]; p.ffn_w_gu = (const float*)d_in[19]; p.ffn_w_down = (const float*)d_in[20];
    p.out = (float*)d_out; p.ws = (unsigned char*)d_ws;
    void* args[] = {&p};
    hipError_t e = hipLaunchCooperativeKernel((const void*)fwd_megakernel, dim3(grid_blocks), dim3(NTHR), args, LDS_BYTES, stream);
    if (e != hipSuccess) fprintf(stderr, "cooperative launch failed: %s (grid %d)\n", hipGetErrorString(e), grid_blocks);
}
```

```cpp
#include <hip/hip_runtime.h>
#include <hip/hip_cooperative_groups.h>
#include <cstdio>
#include <cstdint>
namespace cg = cooperative_groups;

#define LAS __attribute__((address_space(3)))
typedef unsigned short bf16_t;
typedef short bf16x8 __attribute__((ext_vector_type(8)));
typedef float f32x4 __attribute__((ext_vector_type(4)));
typedef float f32x2 __attribute__((ext_vector_type(2)));
typedef unsigned u32x4 __attribute__((ext_vector_type(4)));
typedef unsigned u32x2 __attribute__((ext_vector_type(2)));

constexpr int BATCH = 2, SEQ = 16384, DM = 2048, MT = BATCH * SEQ;
constexpr int NG = 4, HG = 8, DK = 96, DV = 64;
constexpr int NPROJ = 5120;
constexpr int C_VC = 3072, C_VS = 3328, C_VW = 3584, C_KC = 3840, C_KS = 4224, C_KW = 4608, C_GATE = 4992;
constexpr int DFF = 5632;
constexpr int NCMP = 1024;
constexpr float EPS = 1e-6f;
constexpr float NEGF = -1e30f;

constexpr size_t MiB = 1u << 20;
constexpr size_t WS_SSQ = 0;
constexpr size_t WS_XBAR = 768 * 1024;
constexpr size_t WS_KMAX = 900 * 1024;
constexpr size_t WS_W_IN = 1 * MiB;
constexpr size_t WS_W_OUT = 21 * MiB;
constexpr size_t WS_W_GU0 = 29 * MiB, WS_W_GU1 = 73 * MiB;
constexpr size_t WS_W_DN0 = 117 * MiB, WS_W_DN1 = 139 * MiB;
constexpr size_t WS_P_IN = 161 * MiB, WS_P_GRP = 169 * MiB, WS_P_OUT = 171 * MiB;
constexpr size_t WS_CK1 = 179 * MiB, WS_CV1 = 181 * MiB, WS_CK2 = 182 * MiB, WS_CV2 = 182 * MiB + 65536;
constexpr size_t WS_KCMP = 183 * MiB, WS_VCMP = 185 * MiB, WS_SELM = 186 * MiB;
constexpr size_t WS_XB = 190 * MiB;
constexpr size_t WS_O = 318 * MiB;
constexpr size_t WS_BIG = 446 * MiB;
constexpr size_t WS_END = 798 * MiB;

typedef __bf16 bf16x2_t __attribute__((ext_vector_type(2)));
__device__ __forceinline__ unsigned cvt_pk_bf16(float lo, float hi) { const f32x2 v = {lo, hi}; const bf16x2_t b = __builtin_convertvector(v, bf16x2_t); return __builtin_bit_cast(unsigned, b); }
__device__ __forceinline__ float bf_lo(unsigned u) { return __uint_as_float(u << 16); }
__device__ __forceinline__ float bf_hi(unsigned u) { return __uint_as_float(u & 0xffff0000u); }
__device__ __forceinline__ float wave_sum(float v) {
#pragma unroll
    for (int o = 1; o < 64; o <<= 1) v += __shfl_xor(v, o);
    return v;
}

namespace pg8 {
constexpr int BM = 256, BK = 64, HALF = 128, HTB = HALF * BK * 2, STAGE_BYTES = 8 * HTB, NXCD = 8, WGM = 8;
__host__ __device__ __forceinline__ int lds_byte(int r, int c) { const int st = (r >> 4) * 2 + (c >> 5), rr = r & 15, cc = c & 31, ob = rr * 64 + cc * 2; return st * 1024 + (ob ^ (((ob >> 9) & 1) << 5)); }
__host__ __device__ __forceinline__ void stage_rc(int b, int& R, int& C) { const int st = b / 1024, sb = b % 1024, swz = sb ^ (((sb >> 9) & 1) << 5); R = (st >> 1) * 16 + swz / 64; C = (st & 1) * 32 + (swz % 64) / 2; }
__host__ __device__ __forceinline__ int perm32(int rho) { const int n = rho >> 4, i = rho & 15; return 8 * (i >> 2) + 4 * n + (i & 3); }

struct Unit { int pm, pn; };
struct Gemm { const bf16_t* A; const bf16_t* Bt; int lda, ldb, M, N, K; int acolb; };

struct StaticOrder {
    int nM, nN, nwg, G, c;
    __device__ void init(int M, int N, int G_, int c_) { nM = M / BM; nN = N / BM; nwg = nM * nN; G = G_; c = c_; }
    __device__ bool next(int i, Unit& u) const {
        const long L = (long)i * G + c; if (L >= nwg) return false;
        int wgid = (int)L; { const int q = nwg / NXCD, r = nwg % NXCD, xcd = wgid % NXCD, off = wgid / NXCD; wgid = (xcd < r ? xcd * (q + 1) : r * (q + 1) + (xcd - r) * q) + off; }
        const int nig = WGM * nN, gid = wgid / nig, fm = gid * WGM, gsz = (nM - fm) < WGM ? (nM - fm) : WGM;
        u.pm = fm + ((wgid % nig) % gsz); u.pn = (wgid % nig) / gsz; return true;
    }
};

template <class Epi>
__device__ __forceinline__ void gemm_phase(LAS unsigned char* lds, const Gemm g, const StaticOrder& S, const Epi& E) {
    const int tid = threadIdx.x, wid = __builtin_amdgcn_readfirstlane(tid >> 6), lane = tid & 63, wr = wid >> 2, wc = wid & 3, fr = lane & 15, fq = lane >> 4;
    const int K = g.K, nt = K / BK;
    unsigned voffA[2], voffB[2];
#pragma unroll
    for (int i = 0; i < 2; ++i) { int R, C; stage_rc(tid * 16 + i * 8192, R, C); const int Rb = (R & ~31) + perm32(R & 31);
        voffA[i] = (unsigned)(R * g.lda + C) * 2u; voffB[i] = (unsigned)(Rb * g.ldb + C) * 2u; }
    const size_t kstep = (size_t)(BK * 2);
    const size_t hstepA = (size_t)HALF * g.lda * 2, hstepB = (size_t)HALF * g.ldb * 2;
    const size_t tstepA = 2 * hstepA, tstepB = 2 * hstepB;
    const unsigned ldsw = (unsigned)wid * 1024u;
    const int aoff = lds_byte(wr * 64 + fr, fq * 8), boff = lds_byte(wc * 32 + fr, fq * 8);
#define PG8_SA(b, h) (((b) * 2 + (h)) * HTB)
#define PG8_SB(b, h) ((4 + (b) * 2 + (h)) * HTB)
#define PG8_STAGE(bufoff, gbase, voff) do { _Pragma("unroll") for (int _i = 0; _i < 2; ++_i) \
        __builtin_amdgcn_global_load_lds((const unsigned*)((const char*)(gbase) + (voff)[_i]), (LAS unsigned*)(lds + (bufoff) + ldsw + _i * 8192), 16, 0, 0); } while (0)
#define PG8_LDA(dst, b, h) do { _Pragma("unroll") for (int m = 0; m < 4; ++m) _Pragma("unroll") for (int k = 0; k < 2; ++k) dst[m][k] = *(const LAS bf16x8*)(lds + PG8_SA(b, h) + aoff + m * 2048 + k * 1024); } while (0)
#define PG8_LDB(dst, b, h) do { _Pragma("unroll") for (int n = 0; n < 2; ++n) _Pragma("unroll") for (int k = 0; k < 2; ++k) dst[n][k] = *(const LAS bf16x8*)(lds + PG8_SB(b, h) + boff + n * 2048 + k * 1024); } while (0)
#define PG8_MMA(ai, bj, At, Bt) do { __builtin_amdgcn_s_setprio(1); _Pragma("unroll") for (int m = 0; m < 4; ++m) _Pragma("unroll") for (int n = 0; n < 2; ++n) _Pragma("unroll") for (int k = 0; k < 2; ++k) \
        acc[ai][bj][m][n] = __builtin_amdgcn_mfma_f32_16x16x32_bf16(Bt[n][k], At[m][k], acc[ai][bj][m][n], 0, 0, 0); __builtin_amdgcn_s_setprio(0); } while (0)
#define PG8_WAIT_V(n) asm volatile("s_waitcnt vmcnt(" #n ")" ::: "memory")
#define PG8_WAIT_L(n) asm volatile("s_waitcnt lgkmcnt(" #n ")" ::: "memory")
#define PG8_BAR __builtin_amdgcn_s_barrier()
#define PG8_SCHED __builtin_amdgcn_sched_barrier(0)
#define PG8_APTR(u) ((const char*)g.A + (size_t)(u).pm * tstepA + (size_t)((u).pn >> 1) * (size_t)g.acolb)
#define PG8_BPTR(u) ((const char*)g.Bt + (size_t)(u).pn * tstepB)
    Unit cur, nxt; int ui = 0;
    if (!S.next(0, cur)) return;
    f32x4 acc[2][2][4][2];
#pragma unroll
    for (int a = 0; a < 2; ++a)
#pragma unroll
        for (int b = 0; b < 2; ++b)
#pragma unroll
            for (int m = 0; m < 4; ++m)
#pragma unroll
                for (int n = 0; n < 2; ++n) acc[a][b][m][n] = (f32x4){0.f, 0.f, 0.f, 0.f};
    bf16x8 At[4][2], B0[2][2], B1[2][2];
    const char* cA = PG8_APTR(cur); const char* cB = PG8_BPTR(cur);
    PG8_STAGE(PG8_SB(0, 0), cB, voffB); PG8_STAGE(PG8_SB(0, 1), cB + hstepB, voffB); PG8_STAGE(PG8_SA(0, 0), cA, voffA); PG8_STAGE(PG8_SA(0, 1), cA + hstepA, voffA);
    if (wr == 1) PG8_BAR;
    PG8_WAIT_V(2); PG8_BAR;
    PG8_STAGE(PG8_SB(1, 0), cB + kstep, voffB); PG8_STAGE(PG8_SA(1, 0), cA + kstep, voffA); PG8_STAGE(PG8_SB(1, 1), cB + hstepB + kstep, voffB);
    PG8_WAIT_V(6); PG8_BAR;
    for (;;) {
        const bool has_next = S.next(ui + 1, nxt);
        const char* nA = has_next ? PG8_APTR(nxt) : cA; const char* nB = has_next ? PG8_BPTR(nxt) : cB;
        for (int t = 0; t < nt; t += 2) {
            const bool last = (t == nt - 2);
            const char* a1 = cA + (size_t)(t + 1) * kstep;
            const char* a2 = last ? nA : cA + (size_t)(t + 2) * kstep; const char* b2 = last ? nB : cB + (size_t)(t + 2) * kstep;
            const char* a3 = a2 + kstep; const char* b3 = b2 + kstep;
            PG8_LDB(B0, 0, 0); PG8_LDB(B1, 0, 1); PG8_SCHED; PG8_LDA(At, 0, 0); PG8_STAGE(PG8_SA(1, 1), a1 + hstepA, voffA);
            PG8_WAIT_V(8); PG8_WAIT_L(0); PG8_BAR; PG8_MMA(0, 0, At, B0); PG8_MMA(0, 1, At, B1); PG8_BAR; PG8_SCHED;
            PG8_LDA(At, 0, 1); PG8_STAGE(PG8_SB(0, 0), b2, voffB); PG8_STAGE(PG8_SB(0, 1), b2 + hstepB, voffB); PG8_STAGE(PG8_SA(0, 0), a2, voffA);
            PG8_WAIT_V(8); PG8_WAIT_L(0); PG8_BAR; PG8_MMA(1, 0, At, B0); PG8_MMA(1, 1, At, B1); PG8_BAR; PG8_SCHED;
            PG8_LDB(B0, 1, 0); PG8_LDB(B1, 1, 1); PG8_SCHED; PG8_LDA(At, 1, 0); PG8_STAGE(PG8_SA(0, 1), a2 + hstepA, voffA);
            PG8_WAIT_V(8); PG8_WAIT_L(0); PG8_BAR; PG8_MMA(0, 0, At, B0); PG8_MMA(0, 1, At, B1); PG8_BAR; PG8_SCHED;
            PG8_LDA(At, 1, 1); PG8_STAGE(PG8_SB(1, 0), b3, voffB); PG8_STAGE(PG8_SB(1, 1), b3 + hstepB, voffB); PG8_STAGE(PG8_SA(1, 0), a3, voffA);
            PG8_WAIT_V(8); PG8_WAIT_L(0); PG8_BAR; PG8_MMA(1, 0, At, B0); PG8_MMA(1, 1, At, B1); PG8_BAR; PG8_SCHED;
        }
        if (wr == 0) PG8_BAR;
        E(acc, cur, wr, wc, fr, fq);
        if (!has_next) break;
#pragma unroll
        for (int a = 0; a < 2; ++a)
#pragma unroll
            for (int b = 0; b < 2; ++b)
#pragma unroll
                for (int m = 0; m < 4; ++m)
#pragma unroll
                    for (int n = 0; n < 2; ++n) acc[a][b][m][n] = (f32x4){0.f, 0.f, 0.f, 0.f};
        cur = nxt; cA = nA; cB = nB; ++ui;
        if (wr == 1) PG8_BAR;
    }
    PG8_WAIT_V(0);
    PG8_BAR;
#undef PG8_SA
#undef PG8_SB
#undef PG8_STAGE
#undef PG8_LDA
#undef PG8_LDB
#undef PG8_MMA
#undef PG8_WAIT_V
#undef PG8_WAIT_L
#undef PG8_BAR
#undef PG8_SCHED
#undef PG8_APTR
#undef PG8_BPTR
}

#define EPI_ROW(u, ai, m) ((u).pm * BM + (ai) * HALF + wr * 64 + (m) * 16 + fr)
__device__ __forceinline__ u32x4 pack8(f32x4 v0, f32x4 v1) { u32x4 w; w.x = cvt_pk_bf16(v0[0], v0[1]); w.y = cvt_pk_bf16(v0[2], v0[3]); w.z = cvt_pk_bf16(v1[0], v1[1]); w.w = cvt_pk_bf16(v1[2], v1[3]); return w; }

struct EpiProj {
    bf16_t* O; const float* ssq;
    __device__ __forceinline__ void operator()(const f32x4 (&acc)[2][2][4][2], const Unit& u, int wr, int wc, int fr, int fq) const {
        const float qs = (u.pn < 12) ? 0.10206207261596577f * 1.4426950408889634f : 1.0f;
#pragma unroll
        for (int ai = 0; ai < 2; ++ai)
#pragma unroll
            for (int m = 0; m < 4; ++m) { const int row = EPI_ROW(u, ai, m); const float rs = rsqrtf(ssq[row] * (1.0f / DM) + EPS) * qs;
#pragma unroll
                for (int bj = 0; bj < 2; ++bj) { const int c0 = u.pn * BM + bj * HALF + wc * 32 + 8 * fq;
                    *(u32x4*)(O + (size_t)row * NPROJ + c0) = pack8(acc[ai][bj][m][0] * rs, acc[ai][bj][m][1] * rs); } }
    }
};
struct EpiRowScale {
    bf16_t* O; const float* ssq;
    __device__ __forceinline__ void operator()(const f32x4 (&acc)[2][2][4][2], const Unit& u, int wr, int wc, int fr, int fq) const {
#pragma unroll
        for (int ai = 0; ai < 2; ++ai)
#pragma unroll
            for (int m = 0; m < 4; ++m) { const int row = EPI_ROW(u, ai, m); const float rs = rsqrtf(ssq[row] * (1.0f / DM) + EPS);
#pragma unroll
                for (int bj = 0; bj < 2; ++bj) { const int c0 = u.pn * BM + bj * HALF + wc * 32 + 8 * fq;
                    *(u32x4*)(O + (size_t)row * DM + c0) = pack8(acc[ai][bj][m][0] * rs, acc[ai][bj][m][1] * rs); } }
    }
};
struct EpiColScale {
    bf16_t* O; const float* scale;
    __device__ __forceinline__ void operator()(const f32x4 (&acc)[2][2][4][2], const Unit& u, int wr, int wc, int fr, int fq) const {
#pragma unroll
        for (int bj = 0; bj < 2; ++bj) { const int c0 = u.pn * BM + bj * HALF + wc * 32 + 8 * fq;
            const f32x4 s0 = *(const f32x4*)(scale + c0), s1 = *(const f32x4*)(scale + c0 + 4);
#pragma unroll
            for (int ai = 0; ai < 2; ++ai)
#pragma unroll
                for (int m = 0; m < 4; ++m) { const int row = EPI_ROW(u, ai, m);
                    *(u32x4*)(O + (size_t)row * DM + c0) = pack8(acc[ai][bj][m][0] * s0, acc[ai][bj][m][1] * s1); } }
    }
};
struct EpiSwiglu {
    bf16_t* O; const float* ssq;
    __device__ __forceinline__ void operator()(const f32x4 (&acc)[2][2][4][2], const Unit& u, int wr, int wc, int fr, int fq) const {
        const int c0 = u.pn * HALF + wc * 32 + 8 * fq;
#pragma unroll
        for (int ai = 0; ai < 2; ++ai)
#pragma unroll
            for (int m = 0; m < 4; ++m) { const int row = EPI_ROW(u, ai, m); const float rs = rsqrtf(ssq[row] * (1.0f / DM) + EPS);
                f32x4 r[2];
#pragma unroll
                for (int n = 0; n < 2; ++n)
#pragma unroll
                    for (int j = 0; j < 4; ++j) { const float gt = acc[ai][0][m][n][j] * rs, up = acc[ai][1][m][n][j] * rs; r[n][j] = gt * up * __builtin_amdgcn_rcpf(1.0f + __expf(-gt)); }
                *(u32x4*)(O + (size_t)row * DFF + c0) = pack8(r[0], r[1]); }
    }
};
struct EpiRes {
    const float* src; float* dst; bf16_t* xb; float* ssq_out;
    __device__ __forceinline__ void operator()(const f32x4 (&acc)[2][2][4][2], const Unit& u, int wr, int wc, int fr, int fq) const {
#pragma unroll
        for (int ai = 0; ai < 2; ++ai)
#pragma unroll
            for (int m = 0; m < 4; ++m) { const int row = EPI_ROW(u, ai, m); float ss = 0.f;
#pragma unroll
                for (int bj = 0; bj < 2; ++bj) { const size_t off = (size_t)row * DM + u.pn * BM + bj * HALF + wc * 32 + 8 * fq;
                    const f32x4 x0 = *(const f32x4*)(src + off) + acc[ai][bj][m][0], x1 = *(const f32x4*)(src + off + 4) + acc[ai][bj][m][1];
                    *(f32x4*)(dst + off) = x0; *(f32x4*)(dst + off + 4) = x1; *(u32x4*)(xb + off) = pack8(x0, x1);
                    ss += (x0[0] * x0[0] + x0[1] * x0[1]) + (x0[2] * x0[2] + x0[3] * x0[3]) + (x1[0] * x1[0] + x1[1] * x1[1]) + (x1[2] * x1[2] + x1[3] * x1[3]); }
                ss += __shfl_xor(ss, 16); ss += __shfl_xor(ss, 32);
                if (fq == 0) atomicAdd(ssq_out + row, ss); }
    }
};
}

struct Params {
    const float* x; const float* norm_mix; const float* norm_ffn; const float* norm_final; const float* rel_bias;
    const float* nsa_w_in; const float* pos_k; const float* pos_v; const float* ck_w1; const float* ck_b1; const float* ck_w2;
    const float* cv_w1; const float* cv_b1; const float* cv_w2; const float* nsa_w_out;
    const float* pool_w_in; const float* pool_w_grp; const float* pool_scale; const float* pool_w_out; const float* ffn_w_gu; const float* ffn_w_down;
    float* out; unsigned char* ws;
};

constexpr int NTHR = 512, NWAVES = 8;
constexpr int LDS_BYTES = 163840;

__device__ __forceinline__ int nsa_map(int n0) {
    if (n0 < 3072) return n0;
    if (n0 < 3456) return C_KC + (n0 - 3072);
    if (n0 < 3712) return C_VC + (n0 - 3456);
    if (n0 < 4096) return C_KS + (n0 - 3712);
    if (n0 < 4352) return C_VS + (n0 - 4096);
    if (n0 < 4736) return C_KW + (n0 - 4352);
    if (n0 < 4992) return C_VW + (n0 - 4736);
    return C_GATE + (n0 - 4992);
}
__device__ __forceinline__ int gu_map(int n0) { return n0 < DFF ? (n0 >> 7) * 256 + (n0 & 127) : ((n0 - DFF) >> 7) * 256 + 128 + ((n0 - DFF) & 127); }

template <int MAP>
__device__ __forceinline__ void transpose_items(const float* W, int K, int N, bf16_t* WT, int ldd, int row_off, const float* fold, LAS float* scr, int gw, int ngw, int lane) {
    const int nblk = N / 32, nitems = (K / 64) * nblk;
    for (int item = gw; item < nitems; item += ngw) {
        const int kb = item / nblk, nb = item % nblk, k0 = 64 * kb, n0 = 32 * nb;
        const int d0 = row_off + (MAP == 1 ? nsa_map(n0) : (MAP == 2 ? gu_map(n0) : n0));
        float wv[32];
#pragma unroll
        for (int i = 0; i < 32; ++i) wv[i] = W[(size_t)(k0 + 2 * i + (lane >> 5)) * N + n0 + (lane & 31)];
#pragma unroll
        for (int i = 0; i < 32; ++i) { const int kk = 2 * i + (lane >> 5); float v = wv[i]; if (fold) v *= fold[k0 + kk]; scr[kk * 33 + (lane & 31)] = v; }
        asm volatile("s_waitcnt lgkmcnt(0)" ::: "memory");
        const int c = lane & 7;
#pragma unroll
        for (int j = 0; j < 4; ++j) { const int n = (lane >> 3) + 8 * j; const LAS float* s = scr + (8 * c) * 33 + n;
            u32x4 o; o.x = cvt_pk_bf16(s[0 * 33], s[1 * 33]); o.y = cvt_pk_bf16(s[2 * 33], s[3 * 33]); o.z = cvt_pk_bf16(s[4 * 33], s[5 * 33]); o.w = cvt_pk_bf16(s[6 * 33], s[7 * 33]);
            *(u32x4*)(WT + (size_t)(d0 + n) * ldd + k0 + 8 * c) = o; }
        asm volatile("s_waitcnt lgkmcnt(0)" ::: "memory");
    }
}

__device__ __forceinline__ void phase_prologue(const Params& p, LAS unsigned char* lds) {
    const int tid = threadIdx.x, lane = tid & 63, wave = tid >> 6;
    const int gw = blockIdx.x * NWAVES + wave, ngw = gridDim.x * NWAVES;
    LAS float* scr = (LAS float*)(lds + wave * 8704);
    unsigned char* ws = p.ws;
    if (blockIdx.x == 0 && tid < 16) ((unsigned*)(ws + WS_KMAX))[tid] = 0u;
    { float* ssq = (float*)(ws + WS_SSQ); for (int i = blockIdx.x * NTHR + tid; i < 4 * MT; i += gridDim.x * NTHR) ssq[MT + i] = 0.f; }
    transpose_items<1>(p.nsa_w_in, DM, 5088, (bf16_t*)(ws + WS_W_IN), DM, 0, p.norm_mix, scr, gw, ngw, lane);
    transpose_items<0>(p.nsa_w_out, DM, DM, (bf16_t*)(ws + WS_W_OUT), DM, 0, nullptr, scr, gw, ngw, lane);
    transpose_items<2>(p.ffn_w_gu, DM, 2 * DFF, (bf16_t*)(ws + WS_W_GU0), DM, 0, p.norm_ffn, scr, gw, ngw, lane);
    transpose_items<2>(p.ffn_w_gu + (size_t)DM * 2 * DFF, DM, 2 * DFF, (bf16_t*)(ws + WS_W_GU1), DM, 0, p.norm_ffn + DM, scr, gw, ngw, lane);
    transpose_items<0>(p.ffn_w_down, DFF, DM, (bf16_t*)(ws + WS_W_DN0), DFF, 0, nullptr, scr, gw, ngw, lane);
    transpose_items<0>(p.ffn_w_down + (size_t)DFF * DM, DFF, DM, (bf16_t*)(ws + WS_W_DN1), DFF, 0, nullptr, scr, gw, ngw, lane);
    transpose_items<0>(p.pool_w_in, DM, DM, (bf16_t*)(ws + WS_P_IN), DM, 0, p.norm_mix + DM, scr, gw, ngw, lane);
#pragma unroll 1
    for (int gi = 0; gi < 4; ++gi) transpose_items<0>(p.pool_w_grp + (size_t)gi * 512 * 512, 512, 512, (bf16_t*)(ws + WS_P_GRP), 512, gi * 512, nullptr, scr, gw, ngw, lane);
    transpose_items<0>(p.pool_w_out, DM, DM, (bf16_t*)(ws + WS_P_OUT), DM, 0, nullptr, scr, gw, ngw, lane);
    transpose_items<0>(p.ck_w1, 32 * DK, 256, (bf16_t*)(ws + WS_CK1), 32 * DK, 0, nullptr, scr, gw, ngw, lane);
    transpose_items<0>(p.cv_w1, 32 * DV, 256, (bf16_t*)(ws + WS_CV1), 32 * DV, 0, nullptr, scr, gw, ngw, lane);
    transpose_items<0>(p.ck_w2, 256, DK, (bf16_t*)(ws + WS_CK2), 256, 0, nullptr, scr, gw, ngw, lane);
    transpose_items<0>(p.cv_w2, 256, DV, (bf16_t*)(ws + WS_CV2), 256, 0, nullptr, scr, gw, ngw, lane);
    float* ssq0 = (float*)(ws + WS_SSQ); bf16_t* xb = (bf16_t*)(ws + WS_XB);
    for (int row = gw; row < MT; row += ngw) {
        const f32x4* xr = (const f32x4*)(p.x + (size_t)row * DM) + lane; u32x2* o = (u32x2*)(xb + (size_t)row * DM) + lane;
        float s = 0.f;
#pragma unroll
        for (int j = 0; j < 8; ++j) { const f32x4 v = xr[64 * j]; s += (v[0] * v[0] + v[1] * v[1]) + (v[2] * v[2] + v[3] * v[3]); u32x2 w; w.x = cvt_pk_bf16(v[0], v[1]); w.y = cvt_pk_bf16(v[2], v[3]); o[64 * j] = w; }
        s = wave_sum(s);
        if (lane == 0) ssq0[row] = s;
    }
}

__device__ __forceinline__ float gelu_tanh(float x) { const float u = 0.7978845608028654f * (x + 0.044715f * x * x * x); return 0.5f * x * (1.0f + tanhf(u)); }

template <int DH>
__device__ __forceinline__ void compress_unit(const Params& p, LAS unsigned char* lds, int b, int n0, int colbase, const float* pos, const bf16_t* w1t, const float* b1, const bf16_t* w2t, bf16_t* outp) {
    constexpr int KC = 32 * DH;
    const int tid = threadIdx.x, lane = tid & 63, wave = __builtin_amdgcn_readfirstlane(tid >> 6), c = lane & 15, kq = lane >> 4;
    const bf16_t* proj = (const bf16_t*)(p.ws + WS_BIG);
    LAS unsigned char* As = lds; LAS unsigned char* Bs = lds + 5120; LAS unsigned char* Hs = lds + 32768;
    const int arow = tid >> 2, ach = tid & 3;
    const int ag = arow >> 4, an = n0 + (arow & 15);
    u32x4 areg = {0, 0, 0, 0}, breg[2];
#define CMP_LOAD(k0_) do { const int k0v = (k0_); \
        if (tid < 256) { const int kk = k0v + ach * 8, l = kk / DH, d = kk % DH; int tok = 16 * an + l; tok = tok < SEQ ? tok : SEQ - 1; \
            const u32x4 raw = *(const u32x4*)(proj + (size_t)(b * SEQ + tok) * NPROJ + colbase + ag * DH + d); \
            const f32x4 p0 = *(const f32x4*)(pos + l * DH + d), p1 = *(const f32x4*)(pos + l * DH + d + 4); \
            areg.x = cvt_pk_bf16(bf_lo(raw.x) + p0[0], bf_hi(raw.x) + p0[1]); areg.y = cvt_pk_bf16(bf_lo(raw.y) + p0[2], bf_hi(raw.y) + p0[3]); \
            areg.z = cvt_pk_bf16(bf_lo(raw.z) + p1[0], bf_hi(raw.z) + p1[1]); areg.w = cvt_pk_bf16(bf_lo(raw.w) + p1[2], bf_hi(raw.w) + p1[3]); } \
        _Pragma("unroll") for (int i_ = 0; i_ < 2; ++i_) { const int idx = tid + 512 * i_; breg[i_] = *(const u32x4*)(w1t + (size_t)(idx >> 2) * KC + k0v + (idx & 3) * 8); } } while (0)
    f32x4 acc[4][2];
#pragma unroll
    for (int m = 0; m < 4; ++m) { acc[m][0] = (f32x4){0.f, 0.f, 0.f, 0.f}; acc[m][1] = (f32x4){0.f, 0.f, 0.f, 0.f}; }
    CMP_LOAD(0);
    for (int k0 = 0; k0 < KC; k0 += 32) {
        __syncthreads();
        if (tid < 256) *(LAS u32x4*)(As + arow * 80 + ach * 16) = areg;
#pragma unroll
        for (int i = 0; i < 2; ++i) { const int idx = tid + 512 * i; *(LAS u32x4*)(Bs + (idx >> 2) * 80 + (idx & 3) * 16) = breg[i]; }
        __syncthreads();
        if (k0 + 32 < KC) CMP_LOAD(k0 + 32);
        bf16x8 af[4], bfr[2];
#pragma unroll
        for (int m = 0; m < 4; ++m) af[m] = *(const LAS bf16x8*)(As + (16 * m + c) * 80 + kq * 16);
#pragma unroll
        for (int n = 0; n < 2; ++n) bfr[n] = *(const LAS bf16x8*)(Bs + (32 * wave + 16 * n + c) * 80 + kq * 16);
#pragma unroll
        for (int m = 0; m < 4; ++m)
#pragma unroll
            for (int n = 0; n < 2; ++n) acc[m][n] = __builtin_amdgcn_mfma_f32_16x16x32_bf16(af[m], bfr[n], acc[m][n], 0, 0, 0);
    }
#pragma unroll
    for (int n = 0; n < 2; ++n) { const int col = 32 * wave + 16 * n + c; const float bb = b1[col];
#pragma unroll
        for (int m = 0; m < 4; ++m)
#pragma unroll
            for (int i = 0; i < 4; ++i) { const float h = gelu_tanh(acc[m][n][i] + bb); *(LAS bf16_t*)(Hs + (16 * m + 4 * kq + i) * 528 + col * 2) = (bf16_t)(cvt_pk_bf16(h, 0.f) & 0xffffu); } }
    __syncthreads();
    constexpr int NT2 = 4 * (DH / 16);
    for (int idx = wave; idx < NT2; idx += 8) {
        const int m2 = idx & 3, n2 = idx >> 2;
        f32x4 a2 = {0.f, 0.f, 0.f, 0.f};
#pragma unroll
        for (int ks = 0; ks < 8; ++ks) { const bf16x8 a = *(const LAS bf16x8*)(Hs + (16 * m2 + c) * 528 + (32 * ks + 8 * kq) * 2);
            const bf16x8 bb = *(const bf16x8*)(w2t + (size_t)(16 * n2 + c) * 256 + 32 * ks + 8 * kq);
            a2 = __builtin_amdgcn_mfma_f32_16x16x32_bf16(a, bb, a2, 0, 0, 0); }
#pragma unroll
        for (int i = 0; i < 4; ++i) outp[((size_t)(b * NG + m2) * NCMP + n0 + 4 * kq + i) * DH + 16 * n2 + c] = (bf16_t)(cvt_pk_bf16(a2[i], 0.f) & 0xffffu);
    }
    __syncthreads();
}

__device__ __forceinline__ void phase_compress(const Params& p, LAS unsigned char* lds) {
    unsigned char* ws = p.ws;
    for (int u = blockIdx.x; u < 256; u += gridDim.x) {
        const int which = u >> 7, b = (u >> 6) & 1, n0 = (u & 63) * 16;
        if (which == 0) compress_unit<DK>(p, lds, b, n0, C_KC, p.pos_k, (const bf16_t*)(ws + WS_CK1), p.ck_b1, (const bf16_t*)(ws + WS_CK2), (bf16_t*)(ws + WS_KCMP));
        else compress_unit<DV>(p, lds, b, n0, C_VC, p.pos_v, (const bf16_t*)(ws + WS_CV1), p.cv_b1, (const bf16_t*)(ws + WS_CV2), (bf16_t*)(ws + WS_VCMP));
    }
    { const bf16_t* proj = (const bf16_t*)(ws + WS_BIG); unsigned* kmaxp = (unsigned*)(ws + WS_KMAX); const int lane = threadIdx.x & 63;
      for (int it = blockIdx.x * NTHR + threadIdx.x; it < MT * 8; it += gridDim.x * NTHR) { const int row = it >> 3, sg = it & 7, br = sg >> 2, g = sg & 3;
        const u32x4* kp = (const u32x4*)(proj + (size_t)row * NPROJ + (br ? C_KW : C_KS) + g * DK); float n2 = 0.f;
#pragma unroll
        for (int ch = 0; ch < 12; ++ch) { const u32x4 w = kp[ch];
            n2 += bf_lo(w.x) * bf_lo(w.x) + bf_hi(w.x) * bf_hi(w.x) + bf_lo(w.y) * bf_lo(w.y) + bf_hi(w.y) * bf_hi(w.y) + bf_lo(w.z) * bf_lo(w.z) + bf_hi(w.z) * bf_hi(w.z) + bf_lo(w.w) * bf_lo(w.w) + bf_hi(w.w) * bf_hi(w.w); }
        n2 = fmaxf(n2, __shfl_xor(n2, 8)); n2 = fmaxf(n2, __shfl_xor(n2, 16)); n2 = fmaxf(n2, __shfl_xor(n2, 32));
        if (lane < 8) atomicMax(kmaxp + br * 8 + (row >> 14) * 4 + g, __float_as_uint(sqrtf(n2))); } }
}

constexpr int KT_STRIDE = 208, SLOT_K = 64 * KT_STRIDE;
constexpr int VT_STRIDE = 144, SLOT_V = 64 * VT_STRIDE;
constexpr int SLOT_BYTES = SLOT_K + SLOT_V, RING = 5, PD = RING - 1;
constexpr int RING_WS = 6;
constexpr int L_RING = 0, L_IMP = RING * SLOT_BYTES, L_BIAS = LDS_BYTES - 4 * 8 * 132 * 4, L_SELM = L_BIAS - 2048;
static_assert(L_IMP + 32 * 256 * 4 <= L_BIAS && RING_WS * SLOT_BYTES <= L_SELM, "attention LDS map");

struct PairState { f32x4 o[4]; float m, l; bf16x8 q[3]; };
struct TileSrc { const bf16_t* K; const bf16_t* V; int kld, vld; };
struct DmaPlan { int off[3]; };

__device__ __forceinline__ void glds16(const void* gsrc, unsigned lds_dst) { unsigned keep;
    asm volatile("s_mov_b32 %0, m0\n\ts_mov_b32 m0, %2\n\ts_nop 0\n\tglobal_load_lds_dwordx4 %1, off\n\ts_mov_b32 m0, %0" : "=&s"(keep) : "v"(gsrc), "s"(lds_dst) : "memory"); }
#define ATT_WAIT_BAR(N) asm volatile("s_waitcnt vmcnt(" #N ") lgkmcnt(0)\n\ts_barrier" ::: "memory")
__device__ __forceinline__ void att_wait_bar(int rem) { if (rem <= 0) ATT_WAIT_BAR(0); else if (rem == 1) ATT_WAIT_BAR(3); else if (rem == 2) ATT_WAIT_BAR(6); else ATT_WAIT_BAR(9); }
__device__ __forceinline__ bool piece_is_k(int s) { return s < 13 || s >= 22; }
__device__ __forceinline__ int piece_grp(int s) { return s < 13 ? s : (s >= 22 ? s - 22 : s - 13); }
__device__ __forceinline__ void make_plan(DmaPlan& pl, const TileSrc& src, int wave, int lane) {
#pragma unroll
    for (int j = 0; j < 3; ++j) { const int sidx = wave + 8 * j, ci = 64 * piece_grp(sidx) + lane;
        if (piece_is_k(sidx)) { const int key = ci / 13, ch = ci % 13; pl.off[j] = key * src.kld + (ch < 12 ? ch : 11) * 8; }
        else { const int key = ci / 9, ch = ci % 9; pl.off[j] = key * src.vld + (ch < 8 ? ch : 7) * 8; } }
}
__device__ __forceinline__ void issue_tile(const DmaPlan& pl, const TileSrc& src, int key0, unsigned slot_addr, int wave) {
#pragma unroll
    for (int j = 0; j < 3; ++j) { const int sidx = wave + 8 * j; const bool isk = piece_is_k(sidx);
        const bf16_t* gp = (isk ? src.K + (size_t)key0 * src.kld : src.V + (size_t)key0 * src.vld) + pl.off[j];
        glds16(gp, slot_addr + (isk ? 0u : (unsigned)SLOT_K) + 1024u * (unsigned)piece_grp(sidx)); }
}
typedef short s16x4 __attribute__((ext_vector_type(4)));
__device__ __forceinline__ s16x4 vtr(const LAS unsigned char* p) { return __builtin_bit_cast(s16x4, __builtin_amdgcn_ds_read_tr16_b64_v4i16((LAS s16x4*)p)); }

__device__ __forceinline__ float sum8_dpp(float x) {
    x += __builtin_bit_cast(float, __builtin_amdgcn_update_dpp(0, __builtin_bit_cast(int, x), 0xB1, 0xF, 0xF, true));
    x += __builtin_bit_cast(float, __builtin_amdgcn_update_dpp(0, __builtin_bit_cast(int, x), 0x4E, 0xF, 0xF, true));
    x += __builtin_bit_cast(float, __builtin_amdgcn_update_dpp(0, __builtin_bit_cast(int, x), 0x141, 0xF, 0xF, true));
    return x;
}
template <int MODE, bool FAR>
__device__ __forceinline__ void pair_tile(PairState& st, const LAS unsigned char* Kt, const LAS unsigned char* Vt, int tadj, int kstride, int maxdist, bool rowsel,
                                          const LAS float* biasrow, float bias_far, LAS float* improw, int jj0, int lane) {
    const int c = lane & 15, kq = lane >> 4;
    f32x4 s[4];
    float bv[4][4];
    if (!FAR) {
#pragma unroll
        for (int kt = 0; kt < 4; ++kt)
#pragma unroll
            for (int i = 0; i < 4; ++i) { const int d = tadj - (16 * kt + 4 * kq + i) * kstride; const int bi = d < 0 ? 0 : (d > 128 ? 128 : d); bv[kt][i] = biasrow[bi]; }
    }
    const float init = (FAR ? bias_far : 0.f) - st.m;
    const f32x4 initv = {init, init, init, init};
#pragma unroll
    for (int kt = 0; kt < 4; ++kt) {
#pragma unroll
        for (int ds = 0; ds < 3; ++ds) { const bf16x8 a = *(const LAS bf16x8*)(Kt + (16 * kt + c) * KT_STRIDE + (32 * ds + 8 * kq) * 2);
            s[kt] = __builtin_amdgcn_mfma_f32_16x16x32_bf16(a, st.q[ds], ds == 0 ? initv : s[kt], 0, 0, 0); } }
    if (!FAR) {
#pragma unroll
        for (int kt = 0; kt < 4; ++kt)
#pragma unroll
            for (int i = 0; i < 4; ++i) { const int d = tadj - (16 * kt + 4 * kq + i) * kstride; const bool valid = ((unsigned)d < (unsigned)maxdist) && rowsel;
                s[kt][i] = valid ? s[kt][i] + bv[kt][i] : NEGF; }
    }
    float psum = 0.f;
#pragma unroll
    for (int kt = 0; kt < 4; ++kt)
#pragma unroll
        for (int i = 0; i < 4; ++i) { const float pv = __builtin_amdgcn_exp2f(s[kt][i]); s[kt][i] = pv; psum += pv; }
    if (MODE != 1) st.l += psum;
    if (MODE == 0) return;
#pragma unroll
    for (int s2 = 0; s2 < 2; ++s2) {
        u32x4 pw; pw.x = cvt_pk_bf16(s[2 * s2][0], s[2 * s2][1]); pw.y = cvt_pk_bf16(s[2 * s2][2], s[2 * s2][3]); pw.z = cvt_pk_bf16(s[2 * s2 + 1][0], s[2 * s2 + 1][1]); pw.w = cvt_pk_bf16(s[2 * s2 + 1][2], s[2 * s2 + 1][3]);
        const bf16x8 pb = __builtin_bit_cast(bf16x8, pw);
#pragma unroll
        for (int dt = 0; dt < 4; ++dt) { const LAS unsigned char* vp = Vt + (32 * s2 + 4 * kq + (c >> 2)) * VT_STRIDE + (16 * dt + 4 * (c & 3)) * 2;
            const s16x4 lo = vtr(vp), hi = vtr(vp + 16 * VT_STRIDE); const bf16x8 a = {lo[0], lo[1], lo[2], lo[3], hi[0], hi[1], hi[2], hi[3]};
            st.o[dt] = __builtin_amdgcn_mfma_f32_16x16x32_bf16(a, pb, st.o[dt], 0, 0, 0); }
    }
    if (MODE == 1) {
#pragma unroll
        for (int kt = 0; kt < 4; ++kt) {
            float u0 = 2.0f * (s[kt][0] + s[kt][1] + s[kt][2]) + s[kt][3], u1 = s[kt][3];
            u0 = sum8_dpp(u0); u1 = sum8_dpp(u1);
            if ((lane & 7) == 0) { const int jj = jj0 + 4 * kt + kq;
                __hip_atomic_fetch_add(improw + jj, u0, __ATOMIC_RELAXED, __HIP_MEMORY_SCOPE_WORKGROUP);
                if (jj + 1 < 256) __hip_atomic_fetch_add(improw + jj + 1, u1, __ATOMIC_RELAXED, __HIP_MEMORY_SCOPE_WORKGROUP); }
        }
    }
}
#define PAIR_TILE(MODE, far, ...) do { if (far) pair_tile<MODE, true>(__VA_ARGS__); else pair_tile<MODE, false>(__VA_ARGS__); } while (0)

__device__ __forceinline__ int t5_bucket(int n) {
    if (n < 16) return n;
    int bk = 16;
    bk += (n >= 19); bk += (n >= 21); bk += (n >= 24); bk += (n >= 27); bk += (n >= 31); bk += (n >= 35); bk += (n >= 40); bk += (n >= 46);
    bk += (n >= 52); bk += (n >= 59); bk += (n >= 67); bk += (n >= 77); bk += (n >= 87); bk += (n >= 99); bk += (n >= 113);
    return bk;
}
__device__ __forceinline__ void build_bias(const Params& p, LAS unsigned char* lds) {
    LAS float* bt = (LAS float*)(lds + L_BIAS);
    for (int i = threadIdx.x; i < 32 * 129; i += NTHR) { const int h = i / 129, d = i % 129; bt[h * 132 + d] = p.rel_bias[t5_bucket(d) * 32 + h] * 1.4426950408889634f; }
    __syncthreads();
    if (threadIdx.x < 32) { float mx = bt[threadIdx.x * 132]; for (int d = 1; d < 129; ++d) mx = fmaxf(mx, bt[threadIdx.x * 132 + d]); bt[threadIdx.x * 132 + 129] = mx; }
    __syncthreads();
}

__device__ __forceinline__ void load_q(PairState& st, const bf16_t* proj, int b, int g, int tq0, int lane, float kmx, float bmax) {
    const int c = lane & 15, kq = lane >> 4; const size_t row = (size_t)b * SEQ + tq0 + (c >> 3);
#pragma unroll
    for (int ds = 0; ds < 3; ++ds) st.q[ds] = *(const bf16x8*)(proj + row * NPROJ + (g * 8 + (c & 7)) * DK + 32 * ds + 8 * kq);
    asm volatile("" : "+v"(st.q[0]), "+v"(st.q[1]), "+v"(st.q[2]));
    float qq = 0.f;
#pragma unroll
    for (int ds = 0; ds < 3; ++ds) { const u32x4 w = __builtin_bit_cast(u32x4, st.q[ds]);
        qq += bf_lo(w.x) * bf_lo(w.x) + bf_hi(w.x) * bf_hi(w.x) + bf_lo(w.y) * bf_lo(w.y) + bf_hi(w.y) * bf_hi(w.y) + bf_lo(w.z) * bf_lo(w.z) + bf_hi(w.z) * bf_hi(w.z) + bf_lo(w.w) * bf_lo(w.w) + bf_hi(w.w) * bf_hi(w.w); }
    qq += __shfl_xor(qq, 16); qq += __shfl_xor(qq, 32);
    st.m = sqrtf(qq) * kmx + bmax + 0.25f;
}
__device__ __forceinline__ void reset_state(PairState& st) {
#pragma unroll
    for (int dt = 0; dt < 4; ++dt) st.o[dt] = (f32x4){0.f, 0.f, 0.f, 0.f};
    st.l = 0.f;
}
template <bool ACCUM>
__device__ __forceinline__ void write_out(const PairState& st, float inv, const bf16_t* proj, bf16_t* obuf, int b, int g, int tq0, int br, int lane) {
    const int c = lane & 15, kq = lane >> 4; const size_t row = (size_t)b * SEQ + tq0 + (c >> 3);
    const float gl = bf_lo((unsigned)proj[row * NPROJ + C_GATE + br * 32 + g * 8 + (c & 7)]);
    const float sc = inv * __builtin_amdgcn_rcpf(1.0f + __expf(-gl));
    bf16_t* op = obuf + row * DM + (g * 8 + (c & 7)) * DV + 4 * kq;
#pragma unroll
    for (int dt = 0; dt < 4; ++dt) { f32x4 v = st.o[dt] * sc;
        if (ACCUM) { const u32x2 old = *(const u32x2*)(op + 16 * dt); v[0] += bf_lo(old.x); v[1] += bf_hi(old.x); v[2] += bf_lo(old.y); v[3] += bf_hi(old.y); }
        u32x2 w; w.x = cvt_pk_bf16(v[0], v[1]); w.y = cvt_pk_bf16(v[2], v[3]); *(u32x2*)(op + 16 * dt) = w; }
}

__device__ __forceinline__ void phase_cmp(const Params& p, LAS unsigned char* lds) {
    const int tid = threadIdx.x, lane = tid & 63, wave = __builtin_amdgcn_readfirstlane(tid >> 6), c = lane & 15;
    const bf16_t* proj = (const bf16_t*)(p.ws + WS_BIG); bf16_t* obuf = (bf16_t*)(p.ws + WS_O); unsigned* selm = (unsigned*)(p.ws + WS_SELM);
    build_bias(p, lds);
    { LAS float* bt = (LAS float*)(lds + L_BIAS); const u32x4* kc = (const u32x4*)(p.ws + WS_KCMP) + (size_t)wave * NCMP * 12; float n2m = 0.f;
      for (int r = lane; r < NCMP; r += 64) { float n2 = 0.f;
#pragma unroll
        for (int ch = 0; ch < 12; ++ch) { const u32x4 w = kc[r * 12 + ch];
            n2 += bf_lo(w.x) * bf_lo(w.x) + bf_hi(w.x) * bf_hi(w.x) + bf_lo(w.y) * bf_lo(w.y) + bf_hi(w.y) * bf_hi(w.y) + bf_lo(w.z) * bf_lo(w.z) + bf_hi(w.z) * bf_hi(w.z) + bf_lo(w.w) * bf_lo(w.w) + bf_hi(w.w) * bf_hi(w.w); }
        n2m = fmaxf(n2m, n2); }
#pragma unroll
      for (int o = 1; o < 64; o <<= 1) n2m = fmaxf(n2m, __shfl_xor(n2m, o));
      if (lane == 0) bt[wave * 132 + 130] = sqrtf(n2m);
      __syncthreads(); }
    LAS float* imp = (LAS float*)(lds + L_IMP);
    for (int u = blockIdx.x; u < 4096; u += gridDim.x) {
        const int bg = u & 7, b = bg >> 2, g = bg & 3, t0 = (511 - (u >> 3)) * 32;
        TileSrc src; src.K = (const bf16_t*)(p.ws + WS_KCMP) + (size_t)bg * NCMP * DK; src.V = (const bf16_t*)(p.ws + WS_VCMP) + (size_t)bg * NCMP * DV; src.kld = DK; src.vld = DV;
        const int nt = t0 / 1024 + 1;
        const LAS float* biasrow = (const LAS float*)(lds + L_BIAS) + (g * 8 + (c & 7)) * 132; const float bias_far = biasrow[128];
        PairState st[2];
#pragma unroll
        for (int pi = 0; pi < 2; ++pi) { reset_state(st[pi]); load_q(st[pi], proj, b, g, t0 + 4 * wave + 2 * pi, lane, ((const LAS float*)(lds + L_BIAS))[bg * 132 + 130], biasrow[129]); }
#pragma unroll
        for (int i = 0; i < 16; ++i) imp[(4 * wave) * 256 + i * 64 + lane] = 0.f;
        DmaPlan pl; make_plan(pl, src, wave, lane);
        const unsigned ring = (unsigned)(size_t)(lds + L_RING);
#pragma unroll 1
        for (int pass = 0; pass < 2; ++pass) {
            if (pass == 1) {
#pragma unroll
                for (int pi = 0; pi < 2; ++pi) { float lt = st[pi].l; lt += __shfl_xor(lt, 16); lt += __shfl_xor(lt, 32); if (lt > 0.f) st[pi].m += __builtin_amdgcn_logf(lt); }
            }
            for (int d = 0; d < PD && d < nt; ++d) issue_tile(pl, src, 64 * d, ring + d * SLOT_BYTES, wave);
            int slot = 0, islot = PD;
#pragma unroll 1
            for (int i = 0; i < nt; ++i) {
                { int rem = nt - 1 - i; rem = rem < PD - 1 ? rem : PD - 1; att_wait_bar(rem); }
                if (i + PD < nt) issue_tile(pl, src, 64 * (i + PD), ring + islot * SLOT_BYTES, wave);
                const LAS unsigned char* Kt = lds + L_RING + slot * SLOT_BYTES; const LAS unsigned char* Vt = Kt + SLOT_K;
#pragma unroll
                for (int pi = 0; pi < 2; ++pi) { const int tq0 = t0 + 4 * wave + 2 * pi; const int P0 = 16 * 64 * i + 31;
                    if (tq0 + 1 < P0) continue;
                    const bool far = (tq0 - (P0 + 63 * 16)) >= 113;
                    const int tadj = tq0 + (c >> 3) - P0;
                    if (pass == 0) PAIR_TILE(0, far, st[pi], Kt, Vt, tadj, 16, 1 << 30, true, biasrow, bias_far, nullptr, 0, lane);
                    else PAIR_TILE(1, far, st[pi], Kt, Vt, tadj, 16, 1 << 30, true, biasrow, bias_far, imp + (4 * wave + 2 * pi + (c >> 3)) * 256, 16 * i, lane); }
                slot = slot + 1 == RING ? 0 : slot + 1; islot = islot + 1 == RING ? 0 : islot + 1;
            }
            ATT_WAIT_BAR(0);
        }
#pragma unroll
        for (int pi = 0; pi < 2; ++pi) write_out<false>(st[pi], 1.0f, proj, obuf, b, g, t0 + 4 * wave + 2 * pi, 0, lane);
        asm volatile("s_waitcnt lgkmcnt(0)" ::: "memory");
#pragma unroll 1
        for (int qq = 0; qq < 4; ++qq) {
            const int t = t0 + 4 * wave + qq, cur = t >> 6;
            unsigned key[4]; bool sel[4];
#pragma unroll
            for (int i = 0; i < 4; ++i) { const int j = lane + 64 * i; const float v = imp[(4 * wave + qq) * 256 + j];
                sel[i] = (j == 0) || (j == cur) || (j == cur - 1);
                const bool cand = (j >= 1) && (j <= cur - 2);
                key[i] = cand ? (__float_as_uint(v) + 1u) : 0u; }
            const int need = 16 - (1 + (cur >= 1) + (cur >= 2));
            unsigned T = 0u;
#pragma unroll 1
            for (int bit = 31; bit >= 0; --bit) { const unsigned cand = T | (1u << bit);
                const int cnt = __popcll(__ballot(key[0] >= cand)) + __popcll(__ballot(key[1] >= cand)) + __popcll(__ballot(key[2] >= cand)) + __popcll(__ballot(key[3] >= cand));
                if (cnt >= need) T = cand; }
            if (T == 0u) T = 1u;
            int above = 0;
#pragma unroll
            for (int i = 0; i < 4; ++i) above += __popcll(__ballot(key[i] > T));
            int room = need - above;
#pragma unroll
            for (int i = 0; i < 4; ++i) { const unsigned long long eq = __ballot(key[i] == T); const int rank = __popcll(eq & ((1ull << lane) - 1ull));
                sel[i] = sel[i] || (key[i] > T) || (key[i] == T && rank < room); room -= __popcll(eq); }
            unsigned* mrow = selm + ((size_t)bg * SEQ + t) * 8;
#pragma unroll
            for (int i = 0; i < 4; ++i) { const unsigned long long bal = __ballot(sel[i]); if (lane == 0) { mrow[2 * i] = (unsigned)bal; mrow[2 * i + 1] = (unsigned)(bal >> 32); } }
        }
    }
}

__device__ __forceinline__ void build_order(const LAS unsigned* lsel, LAS unsigned char* ord, LAS int* cnt, int cb, int nq, int lane) {
    int base = 0;
#pragma unroll 1
    for (int r = 0; 64 * r <= cb; ++r) { const int j = lane + 64 * r; unsigned m = 0u;
        for (int q = 0; q < nq; ++q) m |= lsel[q * 8 + (j >> 5)];
        const bool need = (j <= cb) && ((m >> (j & 31)) & 1u);
        const unsigned long long bal = __ballot(need);
        if (need) ord[base + __popcll(bal & ((1ull << lane) - 1ull))] = (unsigned char)j;
        base += __popcll(bal); }
    if (lane == 0) *cnt = base;
}

template <bool WIN, int NP>
__device__ __forceinline__ void phase_ws(const Params& p, LAS unsigned char* lds) {
    constexpr int QW = 2 * NP, QU = 8 * QW, NUNIT = MT * NG / QU;
    const int tid = threadIdx.x, lane = tid & 63, wave = __builtin_amdgcn_readfirstlane(tid >> 6), c = lane & 15;
    const bf16_t* proj = (const bf16_t*)(p.ws + WS_BIG); bf16_t* obuf = (bf16_t*)(p.ws + WS_O); const unsigned* selm = (const unsigned*)(p.ws + WS_SELM);
    build_bias(p, lds);
    LAS unsigned* lsel = (LAS unsigned*)(lds + L_SELM);
    for (int u = blockIdx.x; u < NUNIT; u += gridDim.x) {
        const int bg = u & 7, b = bg >> 2, g = bg & 3, t0 = (SEQ / QU - 1 - (u >> 3)) * QU;
        TileSrc src; src.kld = NPROJ; src.vld = NPROJ;
        src.K = proj + (size_t)b * SEQ * NPROJ + (WIN ? C_KW : C_KS) + g * DK; src.V = proj + (size_t)b * SEQ * NPROJ + (WIN ? C_VW : C_VS) + g * DV;
        const int cb = t0 >> 6;
        const int kstart = WIN ? (cb >= 8 ? (cb - 8) * 64 : 0) : 0;
        const int nt = cb + 1 - kstart / 64;
        const LAS float* biasrow = (const LAS float*)(lds + L_BIAS) + (g * 8 + (c & 7)) * 132; const float bias_far = biasrow[128];
        const float kmx = __uint_as_float(((const unsigned*)(p.ws + WS_KMAX))[(WIN ? 8 : 0) + bg]);
        LAS unsigned char* ord = (LAS unsigned char*)(lds + L_SELM + 1024);
        int npos = nt;
        if (!WIN) { if (tid < QU * 8) lsel[tid] = selm[((size_t)bg * SEQ + t0) * 8 + tid];
            __syncthreads();
            if (wave == 0) build_order(lsel, ord, (LAS int*)(lds + L_SELM + 1024 + 256), cb, QU, lane);
            __syncthreads();
            npos = *(LAS int*)(lds + L_SELM + 1024 + 256); }
        PairState st[NP];
#pragma unroll
        for (int pi = 0; pi < NP; ++pi) { reset_state(st[pi]); load_q(st[pi], proj, b, g, t0 + QW * wave + 2 * pi, lane, kmx, biasrow[129]); }
        DmaPlan pl; make_plan(pl, src, wave, lane);
        const unsigned ring = (unsigned)(size_t)(lds + L_RING);
#define WS_TILE(pos) (WIN ? (pos) : (int)ord[pos])
        for (int d = 0; d < 4 && d < npos; ++d) issue_tile(pl, src, kstart + 64 * WS_TILE(d), ring + d * SLOT_BYTES, wave);
        int slot = 0, islot = 4;
#pragma unroll 1
        for (int i0 = 0; i0 < npos; i0 += 2) {
            { const int issued = npos < i0 + 4 ? npos : i0 + 4, done = npos < i0 + 2 ? npos : i0 + 2; att_wait_bar(issued - done); }
#pragma unroll 1
            for (int e = 0; e < 2; ++e) { if (i0 + e >= npos) break; const int i = WS_TILE(i0 + e);
                const LAS unsigned char* Kt = lds + L_RING + slot * SLOT_BYTES; const LAS unsigned char* Vt = Kt + SLOT_K;
                slot = slot + 1 == RING_WS ? 0 : slot + 1;
                const int P0 = kstart + 64 * i;
#pragma unroll
                for (int pi = 0; pi < NP; ++pi) { const int tq0 = t0 + QW * wave + 2 * pi;
                    bool rowsel = true; bool allsel = true;
                    if (!WIN) { const unsigned w = lsel[(QW * wave + 2 * pi + (c >> 3)) * 8 + (i >> 5)]; rowsel = (w >> (i & 31)) & 1u;
                        const unsigned long long bal = __ballot(rowsel); if (bal == 0ull) continue; allsel = (bal == ~0ull); }
                    else { if (tq0 + 1 < P0 || tq0 - (P0 + 63) >= 512) continue; }
                    const bool far = allsel && (tq0 - (P0 + 63) >= 113) && (!WIN || (tq0 + 1 - P0 < 512));
                    PAIR_TILE(2, far, st[pi], Kt, Vt, tq0 + (c >> 3) - P0, 1, WIN ? 512 : (1 << 30), rowsel, biasrow, bias_far, nullptr, 0, lane); } }
#pragma unroll
            for (int e = 0; e < 2; ++e) { if (i0 + 4 + e < npos) issue_tile(pl, src, kstart + 64 * WS_TILE(i0 + 4 + e), ring + islot * SLOT_BYTES, wave); islot = islot + 1 == RING_WS ? 0 : islot + 1; }
        }
#undef WS_TILE
        ATT_WAIT_BAR(0);
#pragma unroll
        for (int pi = 0; pi < NP; ++pi) { float lt = st[pi].l; lt += __shfl_xor(lt, 16); lt += __shfl_xor(lt, 32);
            write_out<true>(st[pi], lt > 0.f ? 1.0f / lt : 0.f, proj, obuf, b, g, t0 + QW * wave + 2 * pi, WIN ? 2 : 1, lane); }
    }
}

template <int W>
__device__ __forceinline__ void pool_item(const bf16_t* ub, bf16_t* pooled, int row, int t, int ch) {
    u32x4 v[W];
#pragma unroll
    for (int k = 0; k < W; ++k) v[k] = *(const u32x4*)(ub + (size_t)(k <= t ? row - k : row) * DM + ch * 8);
    const int cnt = (t + 1 < W) ? t + 1 : W;
    float acc[8] = {0.f, 0.f, 0.f, 0.f, 0.f, 0.f, 0.f, 0.f};
#pragma unroll
    for (int k = 0; k < W; ++k) { const float m = k < cnt ? 1.0f : 0.0f;
        acc[0] += m * bf_lo(v[k].x); acc[1] += m * bf_hi(v[k].x); acc[2] += m * bf_lo(v[k].y); acc[3] += m * bf_hi(v[k].y); acc[4] += m * bf_lo(v[k].z); acc[5] += m * bf_hi(v[k].z); acc[6] += m * bf_lo(v[k].w); acc[7] += m * bf_hi(v[k].w); }
    const float ic = 1.0f / (float)cnt; const u32x4 self = v[0];
    u32x4 o; o.x = cvt_pk_bf16(acc[0] * ic - bf_lo(self.x), acc[1] * ic - bf_hi(self.x)); o.y = cvt_pk_bf16(acc[2] * ic - bf_lo(self.y), acc[3] * ic - bf_hi(self.y));
    o.z = cvt_pk_bf16(acc[4] * ic - bf_lo(self.z), acc[5] * ic - bf_hi(self.z)); o.w = cvt_pk_bf16(acc[6] * ic - bf_lo(self.w), acc[7] * ic - bf_hi(self.w));
    *(u32x4*)(pooled + (size_t)row * DM + ch * 8) = o;
}
__device__ __forceinline__ void phase_pool(const Params& p) {
    const bf16_t* ub = (const bf16_t*)(p.ws + WS_BIG); bf16_t* pooled = (bf16_t*)(p.ws + WS_BIG + 128 * MiB);
    const int nthr = gridDim.x * NTHR;
    for (int it = blockIdx.x * NTHR + threadIdx.x; it < MT * 256; it += nthr) {
        const int row = it >> 8, ch = it & 255, t = row & (SEQ - 1); const int gi = ch >> 6;
        if (gi == 0) pool_item<2>(ub, pooled, row, t, ch); else if (gi == 1) pool_item<4>(ub, pooled, row, t, ch);
        else if (gi == 2) pool_item<8>(ub, pooled, row, t, ch); else pool_item<16>(ub, pooled, row, t, ch);
    }
}
__device__ __forceinline__ void phase_final(const Params& p) {
    const int lane = threadIdx.x & 63, wave = threadIdx.x >> 6; const int gw = blockIdx.x * NWAVES + wave, ngw = gridDim.x * NWAVES;
    const float* ssq = (const float*)(p.ws + WS_SSQ) + 4 * (size_t)MT;
    for (int row = gw; row < MT; row += ngw) { const float rs = rsqrtf(ssq[row] * (1.0f / DM) + EPS);
        f32x4* xr = (f32x4*)(p.out + (size_t)row * DM) + lane; const f32x4* gr = (const f32x4*)p.norm_final + lane;
#pragma unroll
        for (int j = 0; j < 8; ++j) xr[64 * j] = xr[64 * j] * rs * gr[64 * j]; }
}

#define XB_TMO      128
#define XB_XCNT(j)  (256  + 64 * (j))
#define XB_XSUB(j)  (1280 + 64 * (j))
#define XB_XGEN(j)  (2304 + 64 * (j))
#define XB_TOP      3328
#define XB_TOPGEN   3392
#define XCD_BAR_WORDS 3456
#define XB_SPIN_CAP (1u << 18)

__device__ __forceinline__ unsigned xb_ld(unsigned* p)              { return __hip_atomic_load(p, __ATOMIC_RELAXED, __HIP_MEMORY_SCOPE_AGENT); }
__device__ __forceinline__ unsigned xb_add(unsigned* p, unsigned v) { return __hip_atomic_fetch_add(p, v, __ATOMIC_RELAXED, __HIP_MEMORY_SCOPE_AGENT); }
__device__ __forceinline__ unsigned xb_xcc_id() { return (unsigned)__builtin_amdgcn_s_getreg((3 << 11) | 20) & 0xFu; }
#define XB_SPIN(cond, bar) do { unsigned _sp = 0; while (cond) { __builtin_amdgcn_s_sleep(1); \
    if ((++_sp & 255u) == 0u) { if (xb_ld(&(bar)[XB_TMO])) break; if (_sp > XB_SPIN_CAP) { atomicAdd(&(bar)[XB_TMO], 1u); break; } } } } while (0)

struct XcdBarrier {
    unsigned* bar; unsigned x;
    volatile LAS unsigned* st;
};

__device__ __forceinline__ XcdBarrier xcd_barrier_post(unsigned* bar, volatile LAS unsigned* st) {
    XcdBarrier b; b.bar = bar; b.x = xb_xcc_id(); b.st = st;
    if (threadIdx.x == 0) (void)xb_add(&bar[XB_XCNT(b.x)], 1u);
    return b;
}
__device__ __forceinline__ void xcd_barrier_complete(unsigned* bar, unsigned x, unsigned& nloc, unsigned& nx) {
    const unsigned G = gridDim.x * gridDim.y * gridDim.z;
    unsigned sum, cnt, mine, sp = 0u;
    for (;;) {
        sum = 0u; cnt = 0u; mine = 0u;
#pragma unroll
        for (unsigned j = 0; j < 16; ++j) { const unsigned c = xb_ld(&bar[XB_XCNT(j)]); sum += c; cnt += (c > 0u) ? 1u : 0u; mine = (j == x) ? c : mine; }
        if (sum == G) break;
        __builtin_amdgcn_s_sleep(1);
        if ((++sp & 255u) == 0u) { if (xb_ld(&bar[XB_TMO])) break; if (sp > XB_SPIN_CAP) { atomicAdd(&bar[XB_TMO], 1u); break; } }
    }
    nloc = mine > 0u ? mine : 1u; nx = cnt > 0u ? cnt : 1u;
}

__device__ __forceinline__ void xcd_barrier(const XcdBarrier& b) {
    asm volatile("s_waitcnt vmcnt(0)" ::: "memory");
    __syncthreads();
    if (threadIdx.x == 0) {
        unsigned* bar = b.bar;
        __builtin_amdgcn_s_waitcnt(0);
        unsigned nloc = b.st[0], nx = b.st[1];
        if (nloc == 0u) { xcd_barrier_complete(bar, b.x, nloc, nx); b.st[0] = nloc; b.st[1] = nx; }
        const unsigned old = xb_add(&bar[XB_XSUB(b.x)], 1u);
        const unsigned gen = old / nloc;
        if (old + 1u == (gen + 1u) * nloc) {
            __builtin_amdgcn_fence(__ATOMIC_RELEASE, "agent");
            asm volatile("s_waitcnt vmcnt(0)" ::: "memory");
            const unsigned og = xb_add(&bar[XB_TOP], 1u);
            const unsigned tg = og / nx;
            if (og + 1u == (tg + 1u) * nx) xb_add(&bar[XB_TOPGEN], 1u);
            else XB_SPIN(xb_ld(&bar[XB_TOPGEN]) == tg, bar);
            __builtin_amdgcn_fence(__ATOMIC_ACQUIRE, "agent");
            xb_add(&bar[XB_XGEN(b.x)], 1u);
            asm volatile("s_waitcnt vmcnt(0)" ::: "memory");
        } else {
            XB_SPIN(xb_ld(&bar[XB_XGEN(b.x)]) == gen, bar);
            __builtin_amdgcn_fence(__ATOMIC_ACQUIRE, "agent");
            asm volatile("s_waitcnt vmcnt(0)" ::: "memory");
        }
    }
    __syncthreads();
}

#define GSYNC_() do { asm volatile("s_waitcnt vmcnt(0) lgkmcnt(0)" ::: "memory"); __builtin_amdgcn_fence(__ATOMIC_RELEASE, "agent"); grid.sync(); __builtin_amdgcn_fence(__ATOMIC_ACQUIRE, "agent"); } while (0)
#define GSYNC() xcd_barrier(xbar)
__global__ void __launch_bounds__(NTHR, 2) fwd_megakernel(Params p) {
    extern __shared__ __attribute__((aligned(16))) unsigned char lds_raw[];
    LAS unsigned char* lds = (LAS unsigned char*)lds_raw;
    cg::grid_group grid = cg::this_grid();
    volatile LAS unsigned* xst = (volatile LAS unsigned*)(lds + 146432);
    if (threadIdx.x < 2) xst[threadIdx.x] = 0u;
    __syncthreads();
    const XcdBarrier xbar = xcd_barrier_post((unsigned*)(p.ws + WS_XBAR), xst);
    unsigned char* ws = p.ws;
    float* ssq = (float*)(ws + WS_SSQ);
    bf16_t* xb = (bf16_t*)(ws + WS_XB); bf16_t* obuf = (bf16_t*)(ws + WS_O); bf16_t* big = (bf16_t*)(ws + WS_BIG);
    const int G = gridDim.x, cidx = blockIdx.x;
    pg8::StaticOrder S;

    phase_prologue(p, lds);
    GSYNC_();
    { pg8::Gemm g{xb, (const bf16_t*)(ws + WS_W_IN), DM, DM, MT, NPROJ, DM, 0}; S.init(MT, NPROJ, G, cidx); pg8::EpiProj E{big, ssq}; pg8::gemm_phase(lds, g, S, E); }
    GSYNC();
    phase_compress(p, lds);
    GSYNC();
    phase_cmp(p, lds);
    GSYNC();
    phase_ws<true, 2>(p, lds);
    phase_ws<false, 2>(p, lds);
    GSYNC();
    { pg8::Gemm g{obuf, (const bf16_t*)(ws + WS_W_OUT), DM, DM, MT, DM, DM, 0}; S.init(MT, DM, G, cidx); pg8::EpiRes E{p.x, p.out, xb, ssq + MT}; pg8::gemm_phase(lds, g, S, E); }
    GSYNC();
    { pg8::Gemm g{xb, (const bf16_t*)(ws + WS_W_GU0), DM, DM, MT, 2 * DFF, DM, 0}; S.init(MT, 2 * DFF, G, cidx); pg8::EpiSwiglu E{big, ssq + MT}; pg8::gemm_phase(lds, g, S, E); }
    GSYNC();
    { pg8::Gemm g{big, (const bf16_t*)(ws + WS_W_DN0), DFF, DFF, MT, DM, DFF, 0}; S.init(MT, DM, G, cidx); pg8::EpiRes E{p.out, p.out, xb, ssq + 2 * MT}; pg8::gemm_phase(lds, g, S, E); }
    GSYNC();
    { pg8::Gemm g{xb, (const bf16_t*)(ws + WS_P_IN), DM, DM, MT, DM, DM, 0}; S.init(MT, DM, G, cidx); pg8::EpiRowScale E{big, ssq + 2 * MT}; pg8::gemm_phase(lds, g, S, E); }
    GSYNC();
    phase_pool(p);
    GSYNC();
    { pg8::Gemm g{(const bf16_t*)(ws + WS_BIG + 128 * MiB), (const bf16_t*)(ws + WS_P_GRP), DM, 512, MT, DM, 512, 1024}; S.init(MT, DM, G, cidx); pg8::EpiColScale E{obuf, p.pool_scale}; pg8::gemm_phase(lds, g, S, E); }
    GSYNC();
    { pg8::Gemm g{obuf, (const bf16_t*)(ws + WS_P_OUT), DM, DM, MT, DM, DM, 0}; S.init(MT, DM, G, cidx); pg8::EpiRes E{p.out, p.out, xb, ssq + 3 * MT}; pg8::gemm_phase(lds, g, S, E); }
    GSYNC();
    { pg8::Gemm g{xb, (const bf16_t*)(ws + WS_W_GU1), DM, DM, MT, 2 * DFF, DM, 0}; S.init(MT, 2 * DFF, G, cidx); pg8::EpiSwiglu E{big, ssq + 3 * MT}; pg8::gemm_phase(lds, g, S, E); }
    GSYNC();
    { pg8::Gemm g{big, (const bf16_t*)(ws + WS_W_DN1), DFF, DFF, MT, DM, DFF, 0}; S.init(MT, DM, G, cidx); pg8::EpiRes E{p.out, p.out, xb, ssq + 4 * MT}; pg8::gemm_phase(lds, g, S, E); }
    GSYNC();
    phase_final(p);
}

extern "C" void kernel_launch(void* const* d_in, const int* in_sizes, int n_in, void* d_out, int out_size, void* d_ws, size_t ws_size, hipStream_t stream) {
    static int grid_blocks = 0;
    if (grid_blocks == 0) {
        if (n_in != 21 || ws_size < WS_END) { fprintf(stderr, "kernel_launch: unexpected inputs (n_in %d, ws %zu)\n", n_in, ws_size); grid_blocks = -1; return; }
        int dev = 0, cus = 0, per_cu = 0;
        hipGetDevice(&dev); hipDeviceGetAttribute(&cus, hipDeviceAttributeMultiprocessorCount, dev);
        if (hipFuncSetAttribute((const void*)fwd_megakernel, hipFuncAttributeMaxDynamicSharedMemorySize, LDS_BYTES) != hipSuccess) { fprintf(stderr, "kernel_launch: hipFuncSetAttribute failed\n"); grid_blocks = -1; return; }
        if (hipOccupancyMaxActiveBlocksPerMultiprocessor(&per_cu, (const void*)fwd_megakernel, NTHR, LDS_BYTES) != hipSuccess || per_cu < 1) { fprintf(stderr, "kernel_launch: occupancy query failed (%d)\n", per_cu); (void)hipGetLastError(); per_cu = 1; }
        grid_blocks = cus * 1;
    }
    if (grid_blocks < 0) return;
    Params p{};
    p.x = (const float*)d_in[0]; p.norm_mix = (const float*)d_in[1]; p.norm_ffn = (const float*)d_in[2]; p.norm_final = (const float*)d_in[3]; p.rel_bias = (const float*)d_in[4];
    p.nsa_w_in = (const float*)d_in[5]; p.pos_k = (const float*)d_in[6]; p.pos_v = (const float*)d_in[7]; p.ck_w1 = (const float*)d_in[8]; p.ck_b1 = (const float*)d_in[9]; p.ck_w2 = (const float*)d_in[10];
    p.cv_w1 = (const float*)d_in[11]; p.cv_b1 = (const float*)d_in[12]; p.cv_w2 = (const float*)d_in[13]; p.nsa_w_out = (const float*)d_in[14];
    p.pool_w_in = (const float*)d_in[15]; p.pool_w_grp = (const float*)d_in[16]; p.pool_scale = (const float*)d_in[17]; p.pool_w_out = (const float*)d_in[18]; p.ffn_w_gu = (const float*)d_in[19]; p.ffn_w_down = (const float*)d_in[20];
    p.out = (float*)d_out; p.ws = (unsigned char*)d_ws;
    if (hipMemsetAsync((char*)d_ws + WS_XBAR, 0, 16384, stream) != hipSuccess) { fprintf(stderr, "kernel_launch: hipMemsetAsync failed\n"); return; }
    void* args[] = {&p};
    hipError_t e = hipLaunchCooperativeKernel((const void*)fwd_megakernel, dim3(grid_blocks), dim3(NTHR), args, LDS_BYTES, stream);
    if (e != hipSuccess) fprintf(stderr, "cooperative launch failed: %s (grid %d)\n", hipGetErrorString(e), grid_blocks);
}
```

```cpp
#include <hip/hip_runtime.h>
#include <hip/hip_cooperative_groups.h>
#include <cstdio>
#include <cstdint>
namespace cg = cooperative_groups;

#define LAS __attribute__((address_space(3)))
typedef unsigned short bf16_t;
typedef short bf16x8 __attribute__((ext_vector_type(8)));
typedef float f32x4 __attribute__((ext_vector_type(4)));
typedef float f32x2 __attribute__((ext_vector_type(2)));
typedef unsigned u32x4 __attribute__((ext_vector_type(4)));
typedef unsigned u32x2 __attribute__((ext_vector_type(2)));

constexpr int BATCH = 2, SEQ = 16384, DM = 2048, MT = BATCH * SEQ;
constexpr int NG = 4, HG = 8, DK = 96, DV = 64;
constexpr int NPROJ = 5120;
constexpr int C_VC = 3072, C_VS = 3328, C_VW = 3584, C_KC = 3840, C_KS = 4224, C_KW = 4608, C_GATE = 4992;
constexpr int DFF = 5632;
constexpr int NCMP = 1024;
constexpr float EPS = 1e-6f;
constexpr float NEGF = -1e30f;

constexpr size_t MiB = 1u << 20;
constexpr size_t WS_SSQ = 0;
constexpr size_t WS_XBAR = 768 * 1024;
constexpr size_t WS_KMAX = 900 * 1024;
constexpr size_t WS_W_IN = 1 * MiB;
constexpr size_t WS_W_OUT = 21 * MiB;
constexpr size_t WS_W_GU0 = 29 * MiB, WS_W_GU1 = 73 * MiB;
constexpr size_t WS_W_DN0 = 117 * MiB, WS_W_DN1 = 139 * MiB;
constexpr size_t WS_P_IN = 161 * MiB, WS_P_GRP = 169 * MiB, WS_P_OUT = 171 * MiB;
constexpr size_t WS_CK1 = 179 * MiB, WS_CV1 = 181 * MiB, WS_CK2 = 182 * MiB, WS_CV2 = 182 * MiB + 65536;
constexpr size_t WS_KCMP = 183 * MiB, WS_VCMP = 185 * MiB, WS_SELM = 186 * MiB;
constexpr size_t WS_XB = 190 * MiB;
constexpr size_t WS_O = 318 * MiB;
constexpr size_t WS_BIG = 446 * MiB;
constexpr size_t WS_END = 798 * MiB;

typedef __bf16 bf16x2_t __attribute__((ext_vector_type(2)));
__device__ __forceinline__ unsigned cvt_pk_bf16(float lo, float hi) { const f32x2 v = {lo, hi}; const bf16x2_t b = __builtin_convertvector(v, bf16x2_t); return __builtin_bit_cast(unsigned, b); }
__device__ __forceinline__ float bf_lo(unsigned u) { return __uint_as_float(u << 16); }
__device__ __forceinline__ float bf_hi(unsigned u) { return __uint_as_float(u & 0xffff0000u); }
__device__ __forceinline__ float wave_sum(float v) {
#pragma unroll
    for (int o = 1; o < 64; o <<= 1) v += __shfl_xor(v, o);
    return v;
}

namespace pg8 {
constexpr int BM = 256, BK = 64, HALF = 128, HTB = HALF * BK * 2, STAGE_BYTES = 8 * HTB, NXCD = 8, WGM = 8;
__host__ __device__ __forceinline__ int lds_byte(int r, int c) { const int st = (r >> 4) * 2 + (c >> 5), rr = r & 15, cc = c & 31, ob = rr * 64 + cc * 2; return st * 1024 + (ob ^ (((ob >> 9) & 1) << 5)); }
__host__ __device__ __forceinline__ void stage_rc(int b, int& R, int& C) { const int st = b / 1024, sb = b % 1024, swz = sb ^ (((sb >> 9) & 1) << 5); R = (st >> 1) * 16 + swz / 64; C = (st & 1) * 32 + (swz % 64) / 2; }
__host__ __device__ __forceinline__ int perm32(int rho) { const int n = rho >> 4, i = rho & 15; return 8 * (i >> 2) + 4 * n + (i & 3); }

struct Unit { int pm, pn; };
struct Gemm { const bf16_t* A; const bf16_t* Bt; int lda, ldb, M, N, K; int acolb; };

struct StaticOrder {
    int nM, nN, nwg, G, c;
    __device__ void init(int M, int N, int G_, int c_) { nM = M / BM; nN = N / BM; nwg = nM * nN; G = G_; c = c_; }
    __device__ bool next(int i, Unit& u) const {
        const long L = (long)i * G + c; if (L >= nwg) return false;
        int wgid = (int)L; { const int q = nwg / NXCD, r = nwg % NXCD, xcd = wgid % NXCD, off = wgid / NXCD; wgid = (xcd < r ? xcd * (q + 1) : r * (q + 1) + (xcd - r) * q) + off; }
        const int nig = WGM * nN, gid = wgid / nig, fm = gid * WGM, gsz = (nM - fm) < WGM ? (nM - fm) : WGM;
        u.pm = fm + ((wgid % nig) % gsz); u.pn = (wgid % nig) / gsz; return true;
    }
};

template <class Epi>
__device__ __forceinline__ void gemm_phase(LAS unsigned char* lds, const Gemm g, const StaticOrder& S, const Epi& E) {
    const int tid = threadIdx.x, wid = __builtin_amdgcn_readfirstlane(tid >> 6), lane = tid & 63, wr = wid >> 2, wc = wid & 3, fr = lane & 15, fq = lane >> 4;
    const int K = g.K, nt = K / BK;
    unsigned voffA[2], voffB[2];
#pragma unroll
    for (int i = 0; i < 2; ++i) { int R, C; stage_rc(tid * 16 + i * 8192, R, C); const int Rb = (R & ~31) + perm32(R & 31);
        voffA[i] = (unsigned)(R * g.lda + C) * 2u; voffB[i] = (unsigned)(Rb * g.ldb + C) * 2u; }
    const size_t kstep = (size_t)(BK * 2);
    const size_t hstepA = (size_t)HALF * g.lda * 2, hstepB = (size_t)HALF * g.ldb * 2;
    const size_t tstepA = 2 * hstepA, tstepB = 2 * hstepB;
    const unsigned ldsw = (unsigned)wid * 1024u;
    const int aoff = lds_byte(wr * 64 + fr, fq * 8), boff = lds_byte(wc * 32 + fr, fq * 8);
#define PG8_SA(b, h) (((b) * 2 + (h)) * HTB)
#define PG8_SB(b, h) ((4 + (b) * 2 + (h)) * HTB)
#define PG8_STAGE(bufoff, gbase, voff) do { _Pragma("unroll") for (int _i = 0; _i < 2; ++_i) \
        __builtin_amdgcn_global_load_lds((const unsigned*)((const char*)(gbase) + (voff)[_i]), (LAS unsigned*)(lds + (bufoff) + ldsw + _i * 8192), 16, 0, 0); } while (0)
#define PG8_LDA(dst, b, h) do { _Pragma("unroll") for (int m = 0; m < 4; ++m) _Pragma("unroll") for (int k = 0; k < 2; ++k) dst[m][k] = *(const LAS bf16x8*)(lds + PG8_SA(b, h) + aoff + m * 2048 + k * 1024); } while (0)
#define PG8_LDB(dst, b, h) do { _Pragma("unroll") for (int n = 0; n < 2; ++n) _Pragma("unroll") for (int k = 0; k < 2; ++k) dst[n][k] = *(const LAS bf16x8*)(lds + PG8_SB(b, h) + boff + n * 2048 + k * 1024); } while (0)
#define PG8_MMA(ai, bj, At, Bt) do { __builtin_amdgcn_s_setprio(1); _Pragma("unroll") for (int m = 0; m < 4; ++m) _Pragma("unroll") for (int n = 0; n < 2; ++n) _Pragma("unroll") for (int k = 0; k < 2; ++k) \
        acc[ai][bj][m][n] = __builtin_amdgcn_mfma_f32_16x16x32_bf16(Bt[n][k], At[m][k], acc[ai][bj][m][n], 0, 0, 0); __builtin_amdgcn_s_setprio(0); } while (0)
#define PG8_WAIT_V(n) asm volatile("s_waitcnt vmcnt(" #n ")" ::: "memory")
#define PG8_WAIT_L(n) asm volatile("s_waitcnt lgkmcnt(" #n ")" ::: "memory")
#define PG8_BAR __builtin_amdgcn_s_barrier()
#define PG8_SCHED __builtin_amdgcn_sched_barrier(0)
#define PG8_APTR(u) ((const char*)g.A + (size_t)(u).pm * tstepA + (size_t)((u).pn >> 1) * (size_t)g.acolb)
#define PG8_BPTR(u) ((const char*)g.Bt + (size_t)(u).pn * tstepB)
    Unit cur, nxt; int ui = 0;
    if (!S.next(0, cur)) return;
    f32x4 acc[2][2][4][2];
#pragma unroll
    for (int a = 0; a < 2; ++a)
#pragma unroll
        for (int b = 0; b < 2; ++b)
#pragma unroll
            for (int m = 0; m < 4; ++m)
#pragma unroll
                for (int n = 0; n < 2; ++n) acc[a][b][m][n] = (f32x4){0.f, 0.f, 0.f, 0.f};
    bf16x8 At[4][2], B0[2][2], B1[2][2];
    const char* cA = PG8_APTR(cur); const char* cB = PG8_BPTR(cur);
    PG8_STAGE(PG8_SB(0, 0), cB, voffB); PG8_STAGE(PG8_SB(0, 1), cB + hstepB, voffB); PG8_STAGE(PG8_SA(0, 0), cA, voffA); PG8_STAGE(PG8_SA(0, 1), cA + hstepA, voffA);
    if (wr == 1) PG8_BAR;
    PG8_WAIT_V(2); PG8_BAR;
    PG8_STAGE(PG8_SB(1, 0), cB + kstep, voffB); PG8_STAGE(PG8_SA(1, 0), cA + kstep, voffA); PG8_STAGE(PG8_SB(1, 1), cB + hstepB + kstep, voffB);
    PG8_WAIT_V(6); PG8_BAR;
    for (;;) {
        const bool has_next = S.next(ui + 1, nxt);
        const char* nA = has_next ? PG8_APTR(nxt) : cA; const char* nB = has_next ? PG8_BPTR(nxt) : cB;
        for (int t = 0; t < nt; t += 2) {
            const bool last = (t == nt - 2);
            const char* a1 = cA + (size_t)(t + 1) * kstep;
            const char* a2 = last ? nA : cA + (size_t)(t + 2) * kstep; const char* b2 = last ? nB : cB + (size_t)(t + 2) * kstep;
            const char* a3 = a2 + kstep; const char* b3 = b2 + kstep;
            PG8_LDB(B0, 0, 0); PG8_LDB(B1, 0, 1); PG8_SCHED; PG8_LDA(At, 0, 0); PG8_STAGE(PG8_SA(1, 1), a1 + hstepA, voffA);
            PG8_WAIT_V(8); PG8_WAIT_L(0); PG8_BAR; PG8_MMA(0, 0, At, B0); PG8_MMA(0, 1, At, B1); PG8_BAR; PG8_SCHED;
            PG8_LDA(At, 0, 1); PG8_STAGE(PG8_SB(0, 0), b2, voffB); PG8_STAGE(PG8_SB(0, 1), b2 + hstepB, voffB); PG8_STAGE(PG8_SA(0, 0), a2, voffA);
            PG8_WAIT_V(8); PG8_WAIT_L(0); PG8_BAR; PG8_MMA(1, 0, At, B0); PG8_MMA(1, 1, At, B1); PG8_BAR; PG8_SCHED;
            PG8_LDB(B0, 1, 0); PG8_LDB(B1, 1, 1); PG8_SCHED; PG8_LDA(At, 1, 0); PG8_STAGE(PG8_SA(0, 1), a2 + hstepA, voffA);
            PG8_WAIT_V(8); PG8_WAIT_L(0); PG8_BAR; PG8_MMA(0, 0, At, B0); PG8_MMA(0, 1, At, B1); PG8_BAR; PG8_SCHED;
            PG8_LDA(At, 1, 1); PG8_STAGE(PG8_SB(1, 0), b3, voffB); PG8_STAGE(PG8_SB(1, 1), b3 + hstepB, voffB); PG8_STAGE(PG8_SA(1, 0), a3, voffA);
            PG8_WAIT_V(8); PG8_WAIT_L(0); PG8_BAR; PG8_MMA(1, 0, At, B0); PG8_MMA(1, 1, At, B1); PG8_BAR; PG8_SCHED;
        }
        if (wr == 0) PG8_BAR;
        E(acc, cur, wr, wc, fr, fq);
        if (!has_next) break;
#pragma unroll
        for (int a = 0; a < 2; ++a)
#pragma unroll
            for (int b = 0; b < 2; ++b)
#pragma unroll
                for (int m = 0; m < 4; ++m)
#pragma unroll
                    for (int n = 0; n < 2; ++n) acc[a][b][m][n] = (f32x4){0.f, 0.f, 0.f, 0.f};
        cur = nxt; cA = nA; cB = nB; ++ui;
        if (wr == 1) PG8_BAR;
    }
    PG8_WAIT_V(0);
    PG8_BAR;
#undef PG8_SA
#undef PG8_SB
#undef PG8_STAGE
#undef PG8_LDA
#undef PG8_LDB
#undef PG8_MMA
#undef PG8_WAIT_V
#undef PG8_WAIT_L
#undef PG8_BAR
#undef PG8_SCHED
#undef PG8_APTR
#undef PG8_BPTR
}

#define EPI_ROW(u, ai, m) ((u).pm * BM + (ai) * HALF + wr * 64 + (m) * 16 + fr)
__device__ __forceinline__ u32x4 pack8(f32x4 v0, f32x4 v1) { u32x4 w; w.x = cvt_pk_bf16(v0[0], v0[1]); w.y = cvt_pk_bf16(v0[2], v0[3]); w.z = cvt_pk_bf16(v1[0], v1[1]); w.w = cvt_pk_bf16(v1[2], v1[3]); return w; }

struct EpiProj {
    bf16_t* O; const float* ssq;
    __device__ __forceinline__ void operator()(const f32x4 (&acc)[2][2][4][2], const Unit& u, int wr, int wc, int fr, int fq) const {
        const float qs = (u.pn < 12) ? 0.10206207261596577f * 1.4426950408889634f : 1.0f;
#pragma unroll
        for (int ai = 0; ai < 2; ++ai)
#pragma unroll
            for (int m = 0; m < 4; ++m) { const int row = EPI_ROW(u, ai, m); const float rs = rsqrtf(ssq[row] * (1.0f / DM) + EPS) * qs;
#pragma unroll
                for (int bj = 0; bj < 2; ++bj) { const int c0 = u.pn * BM + bj * HALF + wc * 32 + 8 * fq;
                    *(u32x4*)(O + (size_t)row * NPROJ + c0) = pack8(acc[ai][bj][m][0] * rs, acc[ai][bj][m][1] * rs); } }
    }
};
struct EpiRowScale {
    bf16_t* O; const float* ssq;
    __device__ __forceinline__ void operator()(const f32x4 (&acc)[2][2][4][2], const Unit& u, int wr, int wc, int fr, int fq) const {
#pragma unroll
        for (int ai = 0; ai < 2; ++ai)
#pragma unroll
            for (int m = 0; m < 4; ++m) { const int row = EPI_ROW(u, ai, m); const float rs = rsqrtf(ssq[row] * (1.0f / DM) + EPS);
#pragma unroll
                for (int bj = 0; bj < 2; ++bj) { const int c0 = u.pn * BM + bj * HALF + wc * 32 + 8 * fq;
                    *(u32x4*)(O + (size_t)row * DM + c0) = pack8(acc[ai][bj][m][0] * rs, acc[ai][bj][m][1] * rs); } }
    }
};
struct EpiColScale {
    bf16_t* O; const float* scale;
    __device__ __forceinline__ void operator()(const f32x4 (&acc)[2][2][4][2], const Unit& u, int wr, int wc, int fr, int fq) const {
#pragma unroll
        for (int bj = 0; bj < 2; ++bj) { const int c0 = u.pn * BM + bj * HALF + wc * 32 + 8 * fq;
            const f32x4 s0 = *(const f32x4*)(scale + c0), s1 = *(const f32x4*)(scale + c0 + 4);
#pragma unroll
            for (int ai = 0; ai < 2; ++ai)
#pragma unroll
                for (int m = 0; m < 4; ++m) { const int row = EPI_ROW(u, ai, m);
                    *(u32x4*)(O + (size_t)row * DM + c0) = pack8(acc[ai][bj][m][0] * s0, acc[ai][bj][m][1] * s1); } }
    }
};
struct EpiSwiglu {
    bf16_t* O; const float* ssq;
    __device__ __forceinline__ void operator()(const f32x4 (&acc)[2][2][4][2], const Unit& u, int wr, int wc, int fr, int fq) const {
        const int c0 = u.pn * HALF + wc * 32 + 8 * fq;
#pragma unroll
        for (int ai = 0; ai < 2; ++ai)
#pragma unroll
            for (int m = 0; m < 4; ++m) { const int row = EPI_ROW(u, ai, m); const float rs = rsqrtf(ssq[row] * (1.0f / DM) + EPS);
                f32x4 r[2];
#pragma unroll
                for (int n = 0; n < 2; ++n)
#pragma unroll
                    for (int j = 0; j < 4; ++j) { const float gt = acc[ai][0][m][n][j] * rs, up = acc[ai][1][m][n][j] * rs; r[n][j] = gt * up * __builtin_amdgcn_rcpf(1.0f + __expf(-gt)); }
                *(u32x4*)(O + (size_t)row * DFF + c0) = pack8(r[0], r[1]); }
    }
};
struct EpiRes {
    const float* src; float* dst; bf16_t* xb; float* ssq_out;
    __device__ __forceinline__ void operator()(const f32x4 (&acc)[2][2][4][2], const Unit& u, int wr, int wc, int fr, int fq) const {
#pragma unroll
        for (int ai = 0; ai < 2; ++ai)
#pragma unroll
            for (int m = 0; m < 4; ++m) { const int row = EPI_ROW(u, ai, m); float ss = 0.f;
#pragma unroll
                for (int bj = 0; bj < 2; ++bj) { const size_t off = (size_t)row * DM + u.pn * BM + bj * HALF + wc * 32 + 8 * fq;
                    const f32x4 x0 = *(const f32x4*)(src + off) + acc[ai][bj][m][0], x1 = *(const f32x4*)(src + off + 4) + acc[ai][bj][m][1];
                    *(f32x4*)(dst + off) = x0; *(f32x4*)(dst + off + 4) = x1; *(u32x4*)(xb + off) = pack8(x0, x1);
                    ss += (x0[0] * x0[0] + x0[1] * x0[1]) + (x0[2] * x0[2] + x0[3] * x0[3]) + (x1[0] * x1[0] + x1[1] * x1[1]) + (x1[2] * x1[2] + x1[3] * x1[3]); }
                ss += __shfl_xor(ss, 16); ss += __shfl_xor(ss, 32);
                if (fq == 0) atomicAdd(ssq_out + row, ss); }
    }
};
}

struct Params {
    const float* x; const float* norm_mix; const float* norm_ffn; const float* norm_final; const float* rel_bias;
    const float* nsa_w_in; const float* pos_k; const float* pos_v; const float* ck_w1; const float* ck_b1; const float* ck_w2;
    const float* cv_w1; const float* cv_b1; const float* cv_w2; const float* nsa_w_out;
    const float* pool_w_in; const float* pool_w_grp; const float* pool_scale; const float* pool_w_out; const float* ffn_w_gu; const float* ffn_w_down;
    float* out; unsigned char* ws;
};

constexpr int NTHR = 512, NWAVES = 8;
constexpr int LDS_BYTES = 163840;

__device__ __forceinline__ int nsa_map(int n0) {
    if (n0 < 3072) return n0;
    if (n0 < 3456) return C_KC + (n0 - 3072);
    if (n0 < 3712) return C_VC + (n0 - 3456);
    if (n0 < 4096) return C_KS + (n0 - 3712);
    if (n0 < 4352) return C_VS + (n0 - 4096);
    if (n0 < 4736) return C_KW + (n0 - 4352);
    if (n0 < 4992) return C_VW + (n0 - 4736);
    return C_GATE + (n0 - 4992);
}
__device__ __forceinline__ int gu_map(int n0) { return n0 < DFF ? (n0 >> 7) * 256 + (n0 & 127) : ((n0 - DFF) >> 7) * 256 + 128 + ((n0 - DFF) & 127); }

template <int MAP>
__device__ __forceinline__ void transpose_items(const float* W, int K, int N, bf16_t* WT, int ldd, int row_off, const float* fold, LAS float* scr, int gw, int ngw, int lane) {
    const int nblk = N / 32, nitems = (K / 64) * nblk;
    for (int item = gw; item < nitems; item += ngw) {
        const int kb = item / nblk, nb = item % nblk, k0 = 64 * kb, n0 = 32 * nb;
        const int d0 = row_off + (MAP == 1 ? nsa_map(n0) : (MAP == 2 ? gu_map(n0) : n0));
        float wv[32];
#pragma unroll
        for (int i = 0; i < 32; ++i) wv[i] = W[(size_t)(k0 + 2 * i + (lane >> 5)) * N + n0 + (lane & 31)];
#pragma unroll
        for (int i = 0; i < 32; ++i) { const int kk = 2 * i + (lane >> 5); float v = wv[i]; if (fold) v *= fold[k0 + kk]; scr[kk * 33 + (lane & 31)] = v; }
        asm volatile("s_waitcnt lgkmcnt(0)" ::: "memory");
        const int c = lane & 7;
#pragma unroll
        for (int j = 0; j < 4; ++j) { const int n = (lane >> 3) + 8 * j; const LAS float* s = scr + (8 * c) * 33 + n;
            u32x4 o; o.x = cvt_pk_bf16(s[0 * 33], s[1 * 33]); o.y = cvt_pk_bf16(s[2 * 33], s[3 * 33]); o.z = cvt_pk_bf16(s[4 * 33], s[5 * 33]); o.w = cvt_pk_bf16(s[6 * 33], s[7 * 33]);
            *(u32x4*)(WT + (size_t)(d0 + n) * ldd + k0 + 8 * c) = o; }
        asm volatile("s_waitcnt lgkmcnt(0)" ::: "memory");
    }
}

__device__ __forceinline__ void phase_prologue(const Params& p, LAS unsigned char* lds) {
    const int tid = threadIdx.x, lane = tid & 63, wave = tid >> 6;
    const int gw = blockIdx.x * NWAVES + wave, ngw = gridDim.x * NWAVES;
    LAS float* scr = (LAS float*)(lds + wave * 8704);
    unsigned char* ws = p.ws;
    if (blockIdx.x == 0 && tid < 16) ((unsigned*)(ws + WS_KMAX))[tid] = 0u;
    { float* ssq = (float*)(ws + WS_SSQ); for (int i = blockIdx.x * NTHR + tid; i < 4 * MT; i += gridDim.x * NTHR) ssq[MT + i] = 0.f; }
    transpose_items<1>(p.nsa_w_in, DM, 5088, (bf16_t*)(ws + WS_W_IN), DM, 0, p.norm_mix, scr, gw, ngw, lane);
    transpose_items<0>(p.nsa_w_out, DM, DM, (bf16_t*)(ws + WS_W_OUT), DM, 0, nullptr, scr, gw, ngw, lane);
    transpose_items<2>(p.ffn_w_gu, DM, 2 * DFF, (bf16_t*)(ws + WS_W_GU0), DM, 0, p.norm_ffn, scr, gw, ngw, lane);
    transpose_items<2>(p.ffn_w_gu + (size_t)DM * 2 * DFF, DM, 2 * DFF, (bf16_t*)(ws + WS_W_GU1), DM, 0, p.norm_ffn + DM, scr, gw, ngw, lane);
    transpose_items<0>(p.ffn_w_down, DFF, DM, (bf16_t*)(ws + WS_W_DN0), DFF, 0, nullptr, scr, gw, ngw, lane);
    transpose_items<0>(p.ffn_w_down + (size_t)DFF * DM, DFF, DM, (bf16_t*)(ws + WS_W_DN1), DFF, 0, nullptr, scr, gw, ngw, lane);
    transpose_items<0>(p.pool_w_in, DM, DM, (bf16_t*)(ws + WS_P_IN), DM, 0, p.norm_mix + DM, scr, gw, ngw, lane);
#pragma unroll 1
    for (int gi = 0; gi < 4; ++gi) transpose_items<0>(p.pool_w_grp + (size_t)gi * 512 * 512, 512, 512, (bf16_t*)(ws + WS_P_GRP), 512, gi * 512, nullptr, scr, gw, ngw, lane);
    transpose_items<0>(p.pool_w_out, DM, DM, (bf16_t*)(ws + WS_P_OUT), DM, 0, nullptr, scr, gw, ngw, lane);
    transpose_items<0>(p.ck_w1, 32 * DK, 256, (bf16_t*)(ws + WS_CK1), 32 * DK, 0, nullptr, scr, gw, ngw, lane);
    transpose_items<0>(p.cv_w1, 32 * DV, 256, (bf16_t*)(ws + WS_CV1), 32 * DV, 0, nullptr, scr, gw, ngw, lane);
    transpose_items<0>(p.ck_w2, 256, DK, (bf16_t*)(ws + WS_CK2), 256, 0, nullptr, scr, gw, ngw, lane);
    transpose_items<0>(p.cv_w2, 256, DV, (bf16_t*)(ws + WS_CV2), 256, 0, nullptr, scr, gw, ngw, lane);
    float* ssq0 = (float*)(ws + WS_SSQ); bf16_t* xb = (bf16_t*)(ws + WS_XB);
    for (int row = gw; row < MT; row += ngw) {
        const f32x4* xr = (const f32x4*)(p.x + (size_t)row * DM) + lane; u32x2* o = (u32x2*)(xb + (size_t)row * DM) + lane;
        float s = 0.f;
#pragma unroll
        for (int j = 0; j < 8; ++j) { const f32x4 v = xr[64 * j]; s += (v[0] * v[0] + v[1] * v[1]) + (v[2] * v[2] + v[3] * v[3]); u32x2 w; w.x = cvt_pk_bf16(v[0], v[1]); w.y = cvt_pk_bf16(v[2], v[3]); o[64 * j] = w; }
        s = wave_sum(s);
        if (lane == 0) ssq0[row] = s;
    }
}

__device__ __forceinline__ float gelu_tanh(float x) { const float u = 0.7978845608028654f * (x + 0.044715f * x * x * x); return 0.5f * x * (1.0f + tanhf(u)); }

template <int DH>
__device__ __forceinline__ void compress_unit(const Params& p, LAS unsigned char* lds, int b, int n0, int colbase, const float* pos, const bf16_t* w1t, const float* b1, const bf16_t* w2t, bf16_t* outp) {
    constexpr int KC = 32 * DH;
    const int tid = threadIdx.x, lane = tid & 63, wave = __builtin_amdgcn_readfirstlane(tid >> 6), c = lane & 15, kq = lane >> 4;
    const bf16_t* proj = (const bf16_t*)(p.ws + WS_BIG);
    LAS unsigned char* As = lds; LAS unsigned char* Bs = lds + 5120; LAS unsigned char* Hs = lds + 32768;
    const int arow = tid >> 2, ach = tid & 3;
    const int ag = arow >> 4, an = n0 + (arow & 15);
    u32x4 areg = {0, 0, 0, 0}, breg[2];
#define CMP_LOAD(k0_) do { const int k0v = (k0_); \
        if (tid < 256) { const int kk = k0v + ach * 8, l = kk / DH, d = kk % DH; int tok = 16 * an + l; tok = tok < SEQ ? tok : SEQ - 1; \
            const u32x4 raw = *(const u32x4*)(proj + (size_t)(b * SEQ + tok) * NPROJ + colbase + ag * DH + d); \
            const f32x4 p0 = *(const f32x4*)(pos + l * DH + d), p1 = *(const f32x4*)(pos + l * DH + d + 4); \
            areg.x = cvt_pk_bf16(bf_lo(raw.x) + p0[0], bf_hi(raw.x) + p0[1]); areg.y = cvt_pk_bf16(bf_lo(raw.y) + p0[2], bf_hi(raw.y) + p0[3]); \
            areg.z = cvt_pk_bf16(bf_lo(raw.z) + p1[0], bf_hi(raw.z) + p1[1]); areg.w = cvt_pk_bf16(bf_lo(raw.w) + p1[2], bf_hi(raw.w) + p1[3]); } \
        _Pragma("unroll") for (int i_ = 0; i_ < 2; ++i_) { const int idx = tid + 512 * i_; breg[i_] = *(const u32x4*)(w1t + (size_t)(idx >> 2) * KC + k0v + (idx & 3) * 8); } } while (0)
    f32x4 acc[4][2];
#pragma unroll
    for (int m = 0; m < 4; ++m) { acc[m][0] = (f32x4){0.f, 0.f, 0.f, 0.f}; acc[m][1] = (f32x4){0.f, 0.f, 0.f, 0.f}; }
    CMP_LOAD(0);
    for (int k0 = 0; k0 < KC; k0 += 32) {
        __syncthreads();
        if (tid < 256) *(LAS u32x4*)(As + arow * 80 + ach * 16) = areg;
#pragma unroll
        for (int i = 0; i < 2; ++i) { const int idx = tid + 512 * i; *(LAS u32x4*)(Bs + (idx >> 2) * 80 + (idx & 3) * 16) = breg[i]; }
        __syncthreads();
        if (k0 + 32 < KC) CMP_LOAD(k0 + 32);
        bf16x8 af[4], bfr[2];
#pragma unroll
        for (int m = 0; m < 4; ++m) af[m] = *(const LAS bf16x8*)(As + (16 * m + c) * 80 + kq * 16);
#pragma unroll
        for (int n = 0; n < 2; ++n) bfr[n] = *(const LAS bf16x8*)(Bs + (32 * wave + 16 * n + c) * 80 + kq * 16);
#pragma unroll
        for (int m = 0; m < 4; ++m)
#pragma unroll
            for (int n = 0; n < 2; ++n) acc[m][n] = __builtin_amdgcn_mfma_f32_16x16x32_bf16(af[m], bfr[n], acc[m][n], 0, 0, 0);
    }
#pragma unroll
    for (int n = 0; n < 2; ++n) { const int col = 32 * wave + 16 * n + c; const float bb = b1[col];
#pragma unroll
        for (int m = 0; m < 4; ++m)
#pragma unroll
            for (int i = 0; i < 4; ++i) { const float h = gelu_tanh(acc[m][n][i] + bb); *(LAS bf16_t*)(Hs + (16 * m + 4 * kq + i) * 528 + col * 2) = (bf16_t)(cvt_pk_bf16(h, 0.f) & 0xffffu); } }
    __syncthreads();
    constexpr int NT2 = 4 * (DH / 16);
    for (int idx = wave; idx < NT2; idx += 8) {
        const int m2 = idx & 3, n2 = idx >> 2;
        f32x4 a2 = {0.f, 0.f, 0.f, 0.f};
#pragma unroll
        for (int ks = 0; ks < 8; ++ks) { const bf16x8 a = *(const LAS bf16x8*)(Hs + (16 * m2 + c) * 528 + (32 * ks + 8 * kq) * 2);
            const bf16x8 bb = *(const bf16x8*)(w2t + (size_t)(16 * n2 + c) * 256 + 32 * ks + 8 * kq);
            a2 = __builtin_amdgcn_mfma_f32_16x16x32_bf16(a, bb, a2, 0, 0, 0); }
#pragma unroll
        for (int i = 0; i < 4; ++i) outp[((size_t)(b * NG + m2) * NCMP + n0 + 4 * kq + i) * DH + 16 * n2 + c] = (bf16_t)(cvt_pk_bf16(a2[i], 0.f) & 0xffffu);
    }
    __syncthreads();
}

__device__ __forceinline__ void phase_compress(const Params& p, LAS unsigned char* lds) {
    unsigned char* ws = p.ws;
    for (int u = blockIdx.x; u < 256; u += gridDim.x) {
        const int which = u >> 7, b = (u >> 6) & 1, n0 = (u & 63) * 16;
        if (which == 0) compress_unit<DK>(p, lds, b, n0, C_KC, p.pos_k, (const bf16_t*)(ws + WS_CK1), p.ck_b1, (const bf16_t*)(ws + WS_CK2), (bf16_t*)(ws + WS_KCMP));
        else compress_unit<DV>(p, lds, b, n0, C_VC, p.pos_v, (const bf16_t*)(ws + WS_CV1), p.cv_b1, (const bf16_t*)(ws + WS_CV2), (bf16_t*)(ws + WS_VCMP));
    }
    { const bf16_t* proj = (const bf16_t*)(ws + WS_BIG); unsigned* kmaxp = (unsigned*)(ws + WS_KMAX); const int lane = threadIdx.x & 63;
      for (int it = blockIdx.x * NTHR + threadIdx.x; it < MT * 8; it += gridDim.x * NTHR) { const int row = it >> 3, sg = it & 7, br = sg >> 2, g = sg & 3;
        const u32x4* kp = (const u32x4*)(proj + (size_t)row * NPROJ + (br ? C_KW : C_KS) + g * DK); float n2 = 0.f;
#pragma unroll
        for (int ch = 0; ch < 12; ++ch) { const u32x4 w = kp[ch];
            n2 += bf_lo(w.x) * bf_lo(w.x) + bf_hi(w.x) * bf_hi(w.x) + bf_lo(w.y) * bf_lo(w.y) + bf_hi(w.y) * bf_hi(w.y) + bf_lo(w.z) * bf_lo(w.z) + bf_hi(w.z) * bf_hi(w.z) + bf_lo(w.w) * bf_lo(w.w) + bf_hi(w.w) * bf_hi(w.w); }
        n2 = fmaxf(n2, __shfl_xor(n2, 8)); n2 = fmaxf(n2, __shfl_xor(n2, 16)); n2 = fmaxf(n2, __shfl_xor(n2, 32));
        if (lane < 8) atomicMax(kmaxp + br * 8 + (row >> 14) * 4 + g, __float_as_uint(sqrtf(n2))); } }
}

constexpr int KT_STRIDE = 208, SLOT_K = 64 * KT_STRIDE;
constexpr int VT_STRIDE = 144, SLOT_V = 64 * VT_STRIDE;
constexpr int SLOT_BYTES = SLOT_K + SLOT_V, RING = 5, PD = RING - 1;
constexpr int RING_WS = 6;
constexpr int L_RING = 0, L_IMP = RING * SLOT_BYTES, L_BIAS = LDS_BYTES - 4 * 8 * 132 * 4, L_SELM = L_BIAS - 2048;
static_assert(L_IMP + 32 * 256 * 4 <= L_BIAS && RING_WS * SLOT_BYTES <= L_SELM, "attention LDS map");

struct PairState { f32x4 o[4]; float m, l; bf16x8 q[3]; };
struct TileSrc { const bf16_t* K; const bf16_t* V; int kld, vld; };
struct DmaPlan { int off[3]; };

__device__ __forceinline__ void glds16(const void* gsrc, unsigned lds_dst) { unsigned keep;
    asm volatile("s_mov_b32 %0, m0\n\ts_mov_b32 m0, %2\n\ts_nop 0\n\tglobal_load_lds_dwordx4 %1, off\n\ts_mov_b32 m0, %0" : "=&s"(keep) : "v"(gsrc), "s"(lds_dst) : "memory"); }
#define ATT_WAIT_BAR(N) asm volatile("s_waitcnt vmcnt(" #N ") lgkmcnt(0)\n\ts_barrier" ::: "memory")
__device__ __forceinline__ void att_wait_bar(int rem) { if (rem <= 0) ATT_WAIT_BAR(0); else if (rem == 1) ATT_WAIT_BAR(3); else if (rem == 2) ATT_WAIT_BAR(6); else ATT_WAIT_BAR(9); }
__device__ __forceinline__ bool piece_is_k(int s) { return s < 13 || s >= 22; }
__device__ __forceinline__ int piece_grp(int s) { return s < 13 ? s : (s >= 22 ? s - 22 : s - 13); }
__device__ __forceinline__ void make_plan(DmaPlan& pl, const TileSrc& src, int wave, int lane) {
#pragma unroll
    for (int j = 0; j < 3; ++j) { const int sidx = wave + 8 * j, ci = 64 * piece_grp(sidx) + lane;
        if (piece_is_k(sidx)) { const int key = ci / 13, ch = ci % 13; pl.off[j] = key * src.kld + (ch < 12 ? ch : 11) * 8; }
        else { const int key = ci / 9, ch = ci % 9; pl.off[j] = key * src.vld + (ch < 8 ? ch : 7) * 8; } }
}
__device__ __forceinline__ void issue_tile(const DmaPlan& pl, const TileSrc& src, int key0, unsigned slot_addr, int wave) {
#pragma unroll
    for (int j = 0; j < 3; ++j) { const int sidx = wave + 8 * j; const bool isk = piece_is_k(sidx);
        const bf16_t* gp = (isk ? src.K + (size_t)key0 * src.kld : src.V + (size_t)key0 * src.vld) + pl.off[j];
        glds16(gp, slot_addr + (isk ? 0u : (unsigned)SLOT_K) + 1024u * (unsigned)piece_grp(sidx)); }
}
typedef short s16x4 __attribute__((ext_vector_type(4)));
__device__ __forceinline__ s16x4 vtr(const LAS unsigned char* p) { return __builtin_bit_cast(s16x4, __builtin_amdgcn_ds_read_tr16_b64_v4i16((LAS s16x4*)p)); }

__device__ __forceinline__ float sum8_dpp(float x) {
    x += __builtin_bit_cast(float, __builtin_amdgcn_update_dpp(0, __builtin_bit_cast(int, x), 0xB1, 0xF, 0xF, true));
    x += __builtin_bit_cast(float, __builtin_amdgcn_update_dpp(0, __builtin_bit_cast(int, x), 0x4E, 0xF, 0xF, true));
    x += __builtin_bit_cast(float, __builtin_amdgcn_update_dpp(0, __builtin_bit_cast(int, x), 0x141, 0xF, 0xF, true));
    return x;
}
template <int MODE, bool FAR>
__device__ __forceinline__ void pair_tile(PairState& st, const LAS unsigned char* Kt, const LAS unsigned char* Vt, int tadj, int kstride, int maxdist, bool rowsel,
                                          const LAS float* biasrow, float bias_far, LAS float* improw, int jj0, int lane) {
    const int c = lane & 15, kq = lane >> 4;
    f32x4 s[4];
    float bv[4][4];
    if (!FAR) {
#pragma unroll
        for (int kt = 0; kt < 4; ++kt)
#pragma unroll
            for (int i = 0; i < 4; ++i) { const int d = tadj - (16 * kt + 4 * kq + i) * kstride; const int bi = d < 0 ? 0 : (d > 128 ? 128 : d); bv[kt][i] = biasrow[bi]; }
    }
    const float init = (FAR ? bias_far : 0.f) - st.m;
    const f32x4 initv = {init, init, init, init};
#pragma unroll
    for (int kt = 0; kt < 4; ++kt) {
#pragma unroll
        for (int ds = 0; ds < 3; ++ds) { const bf16x8 a = *(const LAS bf16x8*)(Kt + (16 * kt + c) * KT_STRIDE + (32 * ds + 8 * kq) * 2);
            s[kt] = __builtin_amdgcn_mfma_f32_16x16x32_bf16(a, st.q[ds], ds == 0 ? initv : s[kt], 0, 0, 0); } }
    if (!FAR) {
#pragma unroll
        for (int kt = 0; kt < 4; ++kt)
#pragma unroll
            for (int i = 0; i < 4; ++i) { const int d = tadj - (16 * kt + 4 * kq + i) * kstride; const bool valid = ((unsigned)d < (unsigned)maxdist) && rowsel;
                s[kt][i] = valid ? s[kt][i] + bv[kt][i] : NEGF; }
    }
    float psum = 0.f;
#pragma unroll
    for (int kt = 0; kt < 4; ++kt)
#pragma unroll
        for (int i = 0; i < 4; ++i) { const float pv = __builtin_amdgcn_exp2f(s[kt][i]); s[kt][i] = pv; psum += pv; }
    if (MODE != 1) st.l += psum;
    if (MODE == 0) return;
#pragma unroll
    for (int s2 = 0; s2 < 2; ++s2) {
        u32x4 pw; pw.x = cvt_pk_bf16(s[2 * s2][0], s[2 * s2][1]); pw.y = cvt_pk_bf16(s[2 * s2][2], s[2 * s2][3]); pw.z = cvt_pk_bf16(s[2 * s2 + 1][0], s[2 * s2 + 1][1]); pw.w = cvt_pk_bf16(s[2 * s2 + 1][2], s[2 * s2 + 1][3]);
        const bf16x8 pb = __builtin_bit_cast(bf16x8, pw);
#pragma unroll
        for (int dt = 0; dt < 4; ++dt) { const LAS unsigned char* vp = Vt + (32 * s2 + 4 * kq + (c >> 2)) * VT_STRIDE + (16 * dt + 4 * (c & 3)) * 2;
            const s16x4 lo = vtr(vp), hi = vtr(vp + 16 * VT_STRIDE); const bf16x8 a = {lo[0], lo[1], lo[2], lo[3], hi[0], hi[1], hi[2], hi[3]};
            st.o[dt] = __builtin_amdgcn_mfma_f32_16x16x32_bf16(a, pb, st.o[dt], 0, 0, 0); }
    }
    if (MODE == 1) {
#pragma unroll
        for (int kt = 0; kt < 4; ++kt) {
            float u0 = 2.0f * (s[kt][0] + s[kt][1] + s[kt][2]) + s[kt][3], u1 = s[kt][3];
            u0 = sum8_dpp(u0); u1 = sum8_dpp(u1);
            if ((lane & 7) == 0) { const int jj = jj0 + 4 * kt + kq;
                __hip_atomic_fetch_add(improw + jj, u0, __ATOMIC_RELAXED, __HIP_MEMORY_SCOPE_WORKGROUP);
                if (jj + 1 < 256) __hip_atomic_fetch_add(improw + jj + 1, u1, __ATOMIC_RELAXED, __HIP_MEMORY_SCOPE_WORKGROUP); }
        }
    }
}
#define PAIR_TILE(MODE, far, ...) do { if (far) pair_tile<MODE, true>(__VA_ARGS__); else pair_tile<MODE, false>(__VA_ARGS__); } while (0)

__device__ __forceinline__ int t5_bucket(int n) {
    if (n < 16) return n;
    int bk = 16;
    bk += (n >= 19); bk += (n >= 21); bk += (n >= 24); bk += (n >= 27); bk += (n >= 31); bk += (n >= 35); bk += (n >= 40); bk += (n >= 46);
    bk += (n >= 52); bk += (n >= 59); bk += (n >= 67); bk += (n >= 77); bk += (n >= 87); bk += (n >= 99); bk += (n >= 113);
    return bk;
}
__device__ __forceinline__ void build_bias(const Params& p, LAS unsigned char* lds) {
    LAS float* bt = (LAS float*)(lds + L_BIAS);
    for (int i = threadIdx.x; i < 32 * 129; i += NTHR) { const int h = i / 129, d = i % 129; bt[h * 132 + d] = p.rel_bias[t5_bucket(d) * 32 + h] * 1.4426950408889634f; }
    __syncthreads();
    if (threadIdx.x < 32) { float mx = bt[threadIdx.x * 132]; for (int d = 1; d < 129; ++d) mx = fmaxf(mx, bt[threadIdx.x * 132 + d]); bt[threadIdx.x * 132 + 129] = mx; }
    __syncthreads();
}

__device__ __forceinline__ void load_q(PairState& st, const bf16_t* proj, int b, int g, int tq0, int lane, float kmx, float bmax) {
    const int c = lane & 15, kq = lane >> 4; const size_t row = (size_t)b * SEQ + tq0 + (c >> 3);
#pragma unroll
    for (int ds = 0; ds < 3; ++ds) st.q[ds] = *(const bf16x8*)(proj + row * NPROJ + (g * 8 + (c & 7)) * DK + 32 * ds + 8 * kq);
    asm volatile("" : "+v"(st.q[0]), "+v"(st.q[1]), "+v"(st.q[2]));
    float qq = 0.f;
#pragma unroll
    for (int ds = 0; ds < 3; ++ds) { const u32x4 w = __builtin_bit_cast(u32x4, st.q[ds]);
        qq += bf_lo(w.x) * bf_lo(w.x) + bf_hi(w.x) * bf_hi(w.x) + bf_lo(w.y) * bf_lo(w.y) + bf_hi(w.y) * bf_hi(w.y) + bf_lo(w.z) * bf_lo(w.z) + bf_hi(w.z) * bf_hi(w.z) + bf_lo(w.w) * bf_lo(w.w) + bf_hi(w.w) * bf_hi(w.w); }
    qq += __shfl_xor(qq, 16); qq += __shfl_xor(qq, 32);
    st.m = sqrtf(qq) * kmx + bmax + 0.25f;
}
__device__ __forceinline__ void reset_state(PairState& st) {
#pragma unroll
    for (int dt = 0; dt < 4; ++dt) st.o[dt] = (f32x4){0.f, 0.f, 0.f, 0.f};
    st.l = 0.f;
}
template <bool ACCUM>
__device__ __forceinline__ void write_out(const PairState& st, float inv, const bf16_t* proj, bf16_t* obuf, int b, int g, int tq0, int br, int lane) {
    const int c = lane & 15, kq = lane >> 4; const size_t row = (size_t)b * SEQ + tq0 + (c >> 3);
    const float gl = bf_lo((unsigned)proj[row * NPROJ + C_GATE + br * 32 + g * 8 + (c & 7)]);
    const float sc = inv * __builtin_amdgcn_rcpf(1.0f + __expf(-gl));
    bf16_t* op = obuf + row * DM + (g * 8 + (c & 7)) * DV + 4 * kq;
#pragma unroll
    for (int dt = 0; dt < 4; ++dt) { f32x4 v = st.o[dt] * sc;
        if (ACCUM) { const u32x2 old = *(const u32x2*)(op + 16 * dt); v[0] += bf_lo(old.x); v[1] += bf_hi(old.x); v[2] += bf_lo(old.y); v[3] += bf_hi(old.y); }
        u32x2 w; w.x = cvt_pk_bf16(v[0], v[1]); w.y = cvt_pk_bf16(v[2], v[3]); *(u32x2*)(op + 16 * dt) = w; }
}

constexpr size_t WS_UCTR = WS_XBAR + 14336;
#define UNIT_LOOP_BEGIN(ctrptr, NU) \
    { LAS unsigned* ubox_ = (LAS unsigned*)(lds + 146440); unsigned nxt_ = 0u; \
      if (threadIdx.x == 0) ubox_[0] = atomicAdd((ctrptr), 1u); \
      __syncthreads(); \
      for (;;) { const unsigned ul = ubox_[0]; if (ul >= (unsigned)(NU)) break; \
          __syncthreads(); \
          if (threadIdx.x == 0) nxt_ = atomicAdd((ctrptr), 1u);
#define UNIT_LOOP_END() \
          if (threadIdx.x == 0) ubox_[0] = nxt_; \
          __syncthreads(); } }

__device__ __forceinline__ void phase_cmp(const Params& p, LAS unsigned char* lds) {
    const int tid = threadIdx.x, lane = tid & 63, wave = __builtin_amdgcn_readfirstlane(tid >> 6), c = lane & 15;
    const bf16_t* proj = (const bf16_t*)(p.ws + WS_BIG); bf16_t* obuf = (bf16_t*)(p.ws + WS_O); unsigned* selm = (unsigned*)(p.ws + WS_SELM);
    build_bias(p, lds);
    { LAS float* bt = (LAS float*)(lds + L_BIAS); const u32x4* kc = (const u32x4*)(p.ws + WS_KCMP) + (size_t)wave * NCMP * 12; float n2m = 0.f;
      for (int r = lane; r < NCMP; r += 64) { float n2 = 0.f;
#pragma unroll
        for (int ch = 0; ch < 12; ++ch) { const u32x4 w = kc[r * 12 + ch];
            n2 += bf_lo(w.x) * bf_lo(w.x) + bf_hi(w.x) * bf_hi(w.x) + bf_lo(w.y) * bf_lo(w.y) + bf_hi(w.y) * bf_hi(w.y) + bf_lo(w.z) * bf_lo(w.z) + bf_hi(w.z) * bf_hi(w.z) + bf_lo(w.w) * bf_lo(w.w) + bf_hi(w.w) * bf_hi(w.w); }
        n2m = fmaxf(n2m, n2); }
#pragma unroll
      for (int o = 1; o < 64; o <<= 1) n2m = fmaxf(n2m, __shfl_xor(n2m, o));
      if (lane == 0) bt[wave * 132 + 130] = sqrtf(n2m);
      __syncthreads(); }
    LAS float* imp = (LAS float*)(lds + L_IMP);
    UNIT_LOOP_BEGIN((unsigned*)(p.ws + WS_UCTR) + (blockIdx.x & 7), 512)
        const int bg = blockIdx.x & 7, b = bg >> 2, g = bg & 3, t0 = (511 - (int)ul) * 32;
        TileSrc src; src.K = (const bf16_t*)(p.ws + WS_KCMP) + (size_t)bg * NCMP * DK; src.V = (const bf16_t*)(p.ws + WS_VCMP) + (size_t)bg * NCMP * DV; src.kld = DK; src.vld = DV;
        const int nt = t0 / 1024 + 1;
        const LAS float* biasrow = (const LAS float*)(lds + L_BIAS) + (g * 8 + (c & 7)) * 132; const float bias_far = biasrow[128];
        PairState st[2];
#pragma unroll
        for (int pi = 0; pi < 2; ++pi) { reset_state(st[pi]); load_q(st[pi], proj, b, g, t0 + 4 * wave + 2 * pi, lane, ((const LAS float*)(lds + L_BIAS))[bg * 132 + 130], biasrow[129]); }
#pragma unroll
        for (int i = 0; i < 16; ++i) imp[(4 * wave) * 256 + i * 64 + lane] = 0.f;
        DmaPlan pl; make_plan(pl, src, wave, lane);
        const unsigned ring = (unsigned)(size_t)(lds + L_RING);
#pragma unroll 1
        for (int pass = 0; pass < 2; ++pass) {
            if (pass == 1) {
#pragma unroll
                for (int pi = 0; pi < 2; ++pi) { float lt = st[pi].l; lt += __shfl_xor(lt, 16); lt += __shfl_xor(lt, 32); if (lt > 0.f) st[pi].m += __builtin_amdgcn_logf(lt); }
            }
            for (int d = 0; d < PD && d < nt; ++d) issue_tile(pl, src, 64 * d, ring + d * SLOT_BYTES, wave);
            int slot = 0, islot = PD;
#pragma unroll 1
            for (int i = 0; i < nt; ++i) {
                { int rem = nt - 1 - i; rem = rem < PD - 1 ? rem : PD - 1; att_wait_bar(rem); }
                if (i + PD < nt) issue_tile(pl, src, 64 * (i + PD), ring + islot * SLOT_BYTES, wave);
                const LAS unsigned char* Kt = lds + L_RING + slot * SLOT_BYTES; const LAS unsigned char* Vt = Kt + SLOT_K;
#pragma unroll
                for (int pi = 0; pi < 2; ++pi) { const int tq0 = t0 + 4 * wave + 2 * pi; const int P0 = 16 * 64 * i + 31;
                    if (tq0 + 1 < P0) continue;
                    const bool far = (tq0 - (P0 + 63 * 16)) >= 113;
                    const int tadj = tq0 + (c >> 3) - P0;
                    if (pass == 0) PAIR_TILE(0, far, st[pi], Kt, Vt, tadj, 16, 1 << 30, true, biasrow, bias_far, nullptr, 0, lane);
                    else PAIR_TILE(1, far, st[pi], Kt, Vt, tadj, 16, 1 << 30, true, biasrow, bias_far, imp + (4 * wave + 2 * pi + (c >> 3)) * 256, 16 * i, lane); }
                slot = slot + 1 == RING ? 0 : slot + 1; islot = islot + 1 == RING ? 0 : islot + 1;
            }
            ATT_WAIT_BAR(0);
        }
#pragma unroll
        for (int pi = 0; pi < 2; ++pi) write_out<false>(st[pi], 1.0f, proj, obuf, b, g, t0 + 4 * wave + 2 * pi, 0, lane);
        asm volatile("s_waitcnt lgkmcnt(0)" ::: "memory");
#pragma unroll 1
        for (int qq = 0; qq < 4; ++qq) {
            const int t = t0 + 4 * wave + qq, cur = t >> 6;
            unsigned key[4]; bool sel[4];
#pragma unroll
            for (int i = 0; i < 4; ++i) { const int j = lane + 64 * i; const float v = imp[(4 * wave + qq) * 256 + j];
                sel[i] = (j == 0) || (j == cur) || (j == cur - 1);
                const bool cand = (j >= 1) && (j <= cur - 2);
                key[i] = cand ? (__float_as_uint(v) + 1u) : 0u; }
            const int need = 16 - (1 + (cur >= 1) + (cur >= 2));
            unsigned T = 0u;
#pragma unroll 1
            for (int bit = 31; bit >= 0; --bit) { const unsigned cand = T | (1u << bit);
                const int cnt = __popcll(__ballot(key[0] >= cand)) + __popcll(__ballot(key[1] >= cand)) + __popcll(__ballot(key[2] >= cand)) + __popcll(__ballot(key[3] >= cand));
                if (cnt >= need) T = cand; }
            if (T == 0u) T = 1u;
            int above = 0;
#pragma unroll
            for (int i = 0; i < 4; ++i) above += __popcll(__ballot(key[i] > T));
            int room = need - above;
#pragma unroll
            for (int i = 0; i < 4; ++i) { const unsigned long long eq = __ballot(key[i] == T); const int rank = __popcll(eq & ((1ull << lane) - 1ull));
                sel[i] = sel[i] || (key[i] > T) || (key[i] == T && rank < room); room -= __popcll(eq); }
            unsigned* mrow = selm + ((size_t)bg * SEQ + t) * 8;
#pragma unroll
            for (int i = 0; i < 4; ++i) { const unsigned long long bal = __ballot(sel[i]); if (lane == 0) { mrow[2 * i] = (unsigned)bal; mrow[2 * i + 1] = (unsigned)(bal >> 32); } }
        }
    UNIT_LOOP_END()
}

__device__ __forceinline__ void build_order(const LAS unsigned* lsel, LAS unsigned char* ord, LAS int* cnt, int cb, int nq, int lane) {
    int base = 0;
#pragma unroll 1
    for (int r = 0; 64 * r <= cb; ++r) { const int j = lane + 64 * r; unsigned m = 0u;
        for (int q = 0; q < nq; ++q) m |= lsel[q * 8 + (j >> 5)];
        const bool need = (j <= cb) && ((m >> (j & 31)) & 1u);
        const unsigned long long bal = __ballot(need);
        if (need) ord[base + __popcll(bal & ((1ull << lane) - 1ull))] = (unsigned char)j;
        base += __popcll(bal); }
    if (lane == 0) *cnt = base;
}

template <bool WIN, int NP>
__device__ __forceinline__ void phase_ws(const Params& p, LAS unsigned char* lds) {
    constexpr int QW = 2 * NP, QU = 8 * QW, NUNIT = MT * NG / QU;
    const int tid = threadIdx.x, lane = tid & 63, wave = __builtin_amdgcn_readfirstlane(tid >> 6), c = lane & 15;
    const bf16_t* proj = (const bf16_t*)(p.ws + WS_BIG); bf16_t* obuf = (bf16_t*)(p.ws + WS_O); const unsigned* selm = (const unsigned*)(p.ws + WS_SELM);
    build_bias(p, lds);
    LAS unsigned* lsel = (LAS unsigned*)(lds + L_SELM);
    UNIT_LOOP_BEGIN((unsigned*)(p.ws + WS_UCTR) + (WIN ? 8 : 16) + (blockIdx.x & 7), NUNIT / 8)
        const int bg = blockIdx.x & 7, b = bg >> 2, g = bg & 3, t0 = (SEQ / QU - 1 - (int)ul) * QU;
        TileSrc src; src.kld = NPROJ; src.vld = NPROJ;
        src.K = proj + (size_t)b * SEQ * NPROJ + (WIN ? C_KW : C_KS) + g * DK; src.V = proj + (size_t)b * SEQ * NPROJ + (WIN ? C_VW : C_VS) + g * DV;
        const int cb = t0 >> 6;
        const int kstart = WIN ? (cb >= 8 ? (cb - 8) * 64 : 0) : 0;
        const int nt = cb + 1 - kstart / 64;
        const LAS float* biasrow = (const LAS float*)(lds + L_BIAS) + (g * 8 + (c & 7)) * 132; const float bias_far = biasrow[128];
        const float kmx = __uint_as_float(((const unsigned*)(p.ws + WS_KMAX))[(WIN ? 8 : 0) + bg]);
        LAS unsigned char* ord = (LAS unsigned char*)(lds + L_SELM + 1024);
        int npos = nt;
        if (!WIN) { if (tid < QU * 8) lsel[tid] = selm[((size_t)bg * SEQ + t0) * 8 + tid];
            __syncthreads();
            if (wave == 0) build_order(lsel, ord, (LAS int*)(lds + L_SELM + 1024 + 256), cb, QU, lane);
            __syncthreads();
            npos = *(LAS int*)(lds + L_SELM + 1024 + 256); }
        PairState st[NP];
#pragma unroll
        for (int pi = 0; pi < NP; ++pi) { reset_state(st[pi]); load_q(st[pi], proj, b, g, t0 + QW * wave + 2 * pi, lane, kmx, biasrow[129]); }
        DmaPlan pl; make_plan(pl, src, wave, lane);
        const unsigned ring = (unsigned)(size_t)(lds + L_RING);
#define WS_TILE(pos) (WIN ? (pos) : (int)ord[pos])
        for (int d = 0; d < 4 && d < npos; ++d) issue_tile(pl, src, kstart + 64 * WS_TILE(d), ring + d * SLOT_BYTES, wave);
        int slot = 0, islot = 4;
#pragma unroll 1
        for (int i0 = 0; i0 < npos; i0 += 2) {
            { const int issued = npos < i0 + 4 ? npos : i0 + 4, done = npos < i0 + 2 ? npos : i0 + 2; att_wait_bar(issued - done); }
#pragma unroll 1
            for (int e = 0; e < 2; ++e) { if (i0 + e >= npos) break; const int i = WS_TILE(i0 + e);
                const LAS unsigned char* Kt = lds + L_RING + slot * SLOT_BYTES; const LAS unsigned char* Vt = Kt + SLOT_K;
                slot = slot + 1 == RING_WS ? 0 : slot + 1;
                const int P0 = kstart + 64 * i;
#pragma unroll
                for (int pi = 0; pi < NP; ++pi) { const int tq0 = t0 + QW * wave + 2 * pi;
                    bool rowsel = true; bool allsel = true;
                    if (!WIN) { const unsigned w = lsel[(QW * wave + 2 * pi + (c >> 3)) * 8 + (i >> 5)]; rowsel = (w >> (i & 31)) & 1u;
                        const unsigned long long bal = __ballot(rowsel); if (bal == 0ull) continue; allsel = (bal == ~0ull); }
                    else { if (tq0 + 1 < P0 || tq0 - (P0 + 63) >= 512) continue; }
                    const bool far = allsel && (tq0 - (P0 + 63) >= 113) && (!WIN || (tq0 + 1 - P0 < 512));
                    PAIR_TILE(2, far, st[pi], Kt, Vt, tq0 + (c >> 3) - P0, 1, WIN ? 512 : (1 << 30), rowsel, biasrow, bias_far, nullptr, 0, lane); } }
#pragma unroll
            for (int e = 0; e < 2; ++e) { if (i0 + 4 + e < npos) issue_tile(pl, src, kstart + 64 * WS_TILE(i0 + 4 + e), ring + islot * SLOT_BYTES, wave); islot = islot + 1 == RING_WS ? 0 : islot + 1; }
        }
#undef WS_TILE
        ATT_WAIT_BAR(0);
#pragma unroll
        for (int pi = 0; pi < NP; ++pi) { float lt = st[pi].l; lt += __shfl_xor(lt, 16); lt += __shfl_xor(lt, 32);
            write_out<true>(st[pi], lt > 0.f ? 1.0f / lt : 0.f, proj, obuf, b, g, t0 + QW * wave + 2 * pi, WIN ? 2 : 1, lane); }
    UNIT_LOOP_END()
}

template <int W>
__device__ __forceinline__ void pool_item(const bf16_t* ub, bf16_t* pooled, int row, int t, int ch) {
    u32x4 v[W];
#pragma unroll
    for (int k = 0; k < W; ++k) v[k] = *(const u32x4*)(ub + (size_t)(k <= t ? row - k : row) * DM + ch * 8);
    const int cnt = (t + 1 < W) ? t + 1 : W;
    float acc[8] = {0.f, 0.f, 0.f, 0.f, 0.f, 0.f, 0.f, 0.f};
#pragma unroll
    for (int k = 0; k < W; ++k) { const float m = k < cnt ? 1.0f : 0.0f;
        acc[0] += m * bf_lo(v[k].x); acc[1] += m * bf_hi(v[k].x); acc[2] += m * bf_lo(v[k].y); acc[3] += m * bf_hi(v[k].y); acc[4] += m * bf_lo(v[k].z); acc[5] += m * bf_hi(v[k].z); acc[6] += m * bf_lo(v[k].w); acc[7] += m * bf_hi(v[k].w); }
    const float ic = 1.0f / (float)cnt; const u32x4 self = v[0];
    u32x4 o; o.x = cvt_pk_bf16(acc[0] * ic - bf_lo(self.x), acc[1] * ic - bf_hi(self.x)); o.y = cvt_pk_bf16(acc[2] * ic - bf_lo(self.y), acc[3] * ic - bf_hi(self.y));
    o.z = cvt_pk_bf16(acc[4] * ic - bf_lo(self.z), acc[5] * ic - bf_hi(self.z)); o.w = cvt_pk_bf16(acc[6] * ic - bf_lo(self.w), acc[7] * ic - bf_hi(self.w));
    *(u32x4*)(pooled + (size_t)row * DM + ch * 8) = o;
}
__device__ __forceinline__ void phase_pool(const Params& p) {
    const bf16_t* ub = (const bf16_t*)(p.ws + WS_BIG); bf16_t* pooled = (bf16_t*)(p.ws + WS_BIG + 128 * MiB);
    const int nthr = gridDim.x * NTHR;
    for (int it = blockIdx.x * NTHR + threadIdx.x; it < MT * 256; it += nthr) {
        const int row = it >> 8, ch = it & 255, t = row & (SEQ - 1); const int gi = ch >> 6;
        if (gi == 0) pool_item<2>(ub, pooled, row, t, ch); else if (gi == 1) pool_item<4>(ub, pooled, row, t, ch);
        else if (gi == 2) pool_item<8>(ub, pooled, row, t, ch); else pool_item<16>(ub, pooled, row, t, ch);
    }
}
__device__ __forceinline__ void phase_final(const Params& p) {
    const int lane = threadIdx.x & 63, wave = threadIdx.x >> 6; const int gw = blockIdx.x * NWAVES + wave, ngw = gridDim.x * NWAVES;
    const float* ssq = (const float*)(p.ws + WS_SSQ) + 4 * (size_t)MT;
    for (int row = gw; row < MT; row += ngw) { const float rs = rsqrtf(ssq[row] * (1.0f / DM) + EPS);
        f32x4* xr = (f32x4*)(p.out + (size_t)row * DM) + lane; const f32x4* gr = (const f32x4*)p.norm_final + lane;
#pragma unroll
        for (int j = 0; j < 8; ++j) xr[64 * j] = xr[64 * j] * rs * gr[64 * j]; }
}

#define XB_TMO      128
#define XB_XCNT(j)  (256  + 64 * (j))
#define XB_XSUB(j)  (1280 + 64 * (j))
#define XB_XGEN(j)  (2304 + 64 * (j))
#define XB_TOP      3328
#define XB_TOPGEN   3392
#define XCD_BAR_WORDS 3456
#define XB_SPIN_CAP (1u << 18)

__device__ __forceinline__ unsigned xb_ld(unsigned* p)              { return __hip_atomic_load(p, __ATOMIC_RELAXED, __HIP_MEMORY_SCOPE_AGENT); }
__device__ __forceinline__ unsigned xb_add(unsigned* p, unsigned v) { return __hip_atomic_fetch_add(p, v, __ATOMIC_RELAXED, __HIP_MEMORY_SCOPE_AGENT); }
__device__ __forceinline__ unsigned xb_xcc_id() { return (unsigned)__builtin_amdgcn_s_getreg((3 << 11) | 20) & 0xFu; }
#define XB_SPIN(cond, bar) do { unsigned _sp = 0; while (cond) { __builtin_amdgcn_s_sleep(1); \
    if ((++_sp & 255u) == 0u) { if (xb_ld(&(bar)[XB_TMO])) break; if (_sp > XB_SPIN_CAP) { atomicAdd(&(bar)[XB_TMO], 1u); break; } } } } while (0)

struct XcdBarrier {
    unsigned* bar; unsigned x;
    volatile LAS unsigned* st;
};

__device__ __forceinline__ XcdBarrier xcd_barrier_post(unsigned* bar, volatile LAS unsigned* st) {
    XcdBarrier b; b.bar = bar; b.x = xb_xcc_id(); b.st = st;
    if (threadIdx.x == 0) (void)xb_add(&bar[XB_XCNT(b.x)], 1u);
    return b;
}
__device__ __forceinline__ void xcd_barrier_complete(unsigned* bar, unsigned x, unsigned& nloc, unsigned& nx) {
    const unsigned G = gridDim.x * gridDim.y * gridDim.z;
    unsigned sum, cnt, mine, sp = 0u;
    for (;;) {
        sum = 0u; cnt = 0u; mine = 0u;
#pragma unroll
        for (unsigned j = 0; j < 16; ++j) { const unsigned c = xb_ld(&bar[XB_XCNT(j)]); sum += c; cnt += (c > 0u) ? 1u : 0u; mine = (j == x) ? c : mine; }
        if (sum == G) break;
        __builtin_amdgcn_s_sleep(1);
        if ((++sp & 255u) == 0u) { if (xb_ld(&bar[XB_TMO])) break; if (sp > XB_SPIN_CAP) { atomicAdd(&bar[XB_TMO], 1u); break; } }
    }
    nloc = mine > 0u ? mine : 1u; nx = cnt > 0u ? cnt : 1u;
}

__device__ __forceinline__ void xcd_barrier(const XcdBarrier& b) {
    asm volatile("s_waitcnt vmcnt(0)" ::: "memory");
    __syncthreads();
    if (threadIdx.x == 0) {
        unsigned* bar = b.bar;
        __builtin_amdgcn_s_waitcnt(0);
        unsigned nloc = b.st[0], nx = b.st[1];
        if (nloc == 0u) { xcd_barrier_complete(bar, b.x, nloc, nx); b.st[0] = nloc; b.st[1] = nx; }
        const unsigned old = xb_add(&bar[XB_XSUB(b.x)], 1u);
        const unsigned gen = old / nloc;
        if (old + 1u == (gen + 1u) * nloc) {
            __builtin_amdgcn_fence(__ATOMIC_RELEASE, "agent");
            asm volatile("s_waitcnt vmcnt(0)" ::: "memory");
            const unsigned og = xb_add(&bar[XB_TOP], 1u);
            const unsigned tg = og / nx;
            if (og + 1u == (tg + 1u) * nx) xb_add(&bar[XB_TOPGEN], 1u);
            else XB_SPIN(xb_ld(&bar[XB_TOPGEN]) == tg, bar);
            __builtin_amdgcn_fence(__ATOMIC_ACQUIRE, "agent");
            xb_add(&bar[XB_XGEN(b.x)], 1u);
            asm volatile("s_waitcnt vmcnt(0)" ::: "memory");
        } else {
            XB_SPIN(xb_ld(&bar[XB_XGEN(b.x)]) == gen, bar);
            __builtin_amdgcn_fence(__ATOMIC_ACQUIRE, "agent");
            asm volatile("s_waitcnt vmcnt(0)" ::: "memory");
        }
    }
    __syncthreads();
}

#define GSYNC_() do { asm volatile("s_waitcnt vmcnt(0) lgkmcnt(0)" ::: "memory"); __builtin_amdgcn_fence(__ATOMIC_RELEASE, "agent"); grid.sync(); __builtin_amdgcn_fence(__ATOMIC_ACQUIRE, "agent"); } while (0)
#define GSYNC() xcd_barrier(xbar)
__global__ void __launch_bounds__(NTHR, 2) fwd_megakernel(Params p) {
    extern __shared__ __attribute__((aligned(16))) unsigned char lds_raw[];
    LAS unsigned char* lds = (LAS unsigned char*)lds_raw;
    cg::grid_group grid = cg::this_grid();
    volatile LAS unsigned* xst = (volatile LAS unsigned*)(lds + 146432);
    if (threadIdx.x < 2) xst[threadIdx.x] = 0u;
    __syncthreads();
    const XcdBarrier xbar = xcd_barrier_post((unsigned*)(p.ws + WS_XBAR), xst);
    unsigned char* ws = p.ws;
    float* ssq = (float*)(ws + WS_SSQ);
    bf16_t* xb = (bf16_t*)(ws + WS_XB); bf16_t* obuf = (bf16_t*)(ws + WS_O); bf16_t* big = (bf16_t*)(ws + WS_BIG);
    const int G = gridDim.x, cidx = blockIdx.x;
    pg8::StaticOrder S;

    phase_prologue(p, lds);
    GSYNC_();
    { pg8::Gemm g{xb, (const bf16_t*)(ws + WS_W_IN), DM, DM, MT, NPROJ, DM, 0}; S.init(MT, NPROJ, G, cidx); pg8::EpiProj E{big, ssq}; pg8::gemm_phase(lds, g, S, E); }
    GSYNC();
    phase_compress(p, lds);
    GSYNC();
    phase_cmp(p, lds);
    GSYNC();
    phase_ws<true, 2>(p, lds);
    GSYNC();
    phase_ws<false, 2>(p, lds);
    GSYNC();
    { pg8::Gemm g{obuf, (const bf16_t*)(ws + WS_W_OUT), DM, DM, MT, DM, DM, 0}; S.init(MT, DM, G, cidx); pg8::EpiRes E{p.x, p.out, xb, ssq + MT}; pg8::gemm_phase(lds, g, S, E); }
    GSYNC();
    { pg8::Gemm g{xb, (const bf16_t*)(ws + WS_W_GU0), DM, DM, MT, 2 * DFF, DM, 0}; S.init(MT, 2 * DFF, G, cidx); pg8::EpiSwiglu E{big, ssq + MT}; pg8::gemm_phase(lds, g, S, E); }
    GSYNC();
    { pg8::Gemm g{big, (const bf16_t*)(ws + WS_W_DN0), DFF, DFF, MT, DM, DFF, 0}; S.init(MT, DM, G, cidx); pg8::EpiRes E{p.out, p.out, xb, ssq + 2 * MT}; pg8::gemm_phase(lds, g, S, E); }
    GSYNC();
    { pg8::Gemm g{xb, (const bf16_t*)(ws + WS_P_IN), DM, DM, MT, DM, DM, 0}; S.init(MT, DM, G, cidx); pg8::EpiRowScale E{big, ssq + 2 * MT}; pg8::gemm_phase(lds, g, S, E); }
    GSYNC();
    phase_pool(p);
    GSYNC();
    { pg8::Gemm g{(const bf16_t*)(ws + WS_BIG + 128 * MiB), (const bf16_t*)(ws + WS_P_GRP), DM, 512, MT, DM, 512, 1024}; S.init(MT, DM, G, cidx); pg8::EpiColScale E{obuf, p.pool_scale}; pg8::gemm_phase(lds, g, S, E); }
    GSYNC();
    { pg8::Gemm g{obuf, (const bf16_t*)(ws + WS_P_OUT), DM, DM, MT, DM, DM, 0}; S.init(MT, DM, G, cidx); pg8::EpiRes E{p.out, p.out, xb, ssq + 3 * MT}; pg8::gemm_phase(lds, g, S, E); }
    GSYNC();
    { pg8::Gemm g{xb, (const bf16_t*)(ws + WS_W_GU1), DM, DM, MT, 2 * DFF, DM, 0}; S.init(MT, 2 * DFF, G, cidx); pg8::EpiSwiglu E{big, ssq + 3 * MT}; pg8::gemm_phase(lds, g, S, E); }
    GSYNC();
    { pg8::Gemm g{big, (const bf16_t*)(ws + WS_W_DN1), DFF, DFF, MT, DM, DFF, 0}; S.init(MT, DM, G, cidx); pg8::EpiRes E{p.out, p.out, xb, ssq + 4 * MT}; pg8::gemm_phase(lds, g, S, E); }
    GSYNC();
    phase_final(p);
}

extern "C" void kernel_launch(void* const* d_in, const int* in_sizes, int n_in, void* d_out, int out_size, void* d_ws, size_t ws_size, hipStream_t stream) {
    static int grid_blocks = 0;
    if (grid_blocks == 0) {
        if (n_in != 21 || ws_size < WS_END) { fprintf(stderr, "kernel_launch: unexpected inputs (n_in %d, ws %zu)\n", n_in, ws_size); grid_blocks = -1; return; }
        int dev = 0, cus = 0, per_cu = 0;
        hipGetDevice(&dev); hipDeviceGetAttribute(&cus, hipDeviceAttributeMultiprocessorCount, dev);
        if (hipFuncSetAttribute((const void*)fwd_megakernel, hipFuncAttributeMaxDynamicSharedMemorySize, LDS_BYTES) != hipSuccess) { fprintf(stderr, "kernel_launch: hipFuncSetAttribute failed\n"); grid_blocks = -1; return; }
        if (hipOccupancyMaxActiveBlocksPerMultiprocessor(&per_cu, (const void*)fwd_megakernel, NTHR, LDS_BYTES) != hipSuccess || per_cu < 1) { fprintf(stderr, "kernel_launch: occupancy query failed (%d)\n", per_cu); (void)hipGetLastError(); per_cu = 1; }
        grid_blocks = cus * 1;
    }
    if (grid_blocks < 0) return;
    Params p{};
    p.x = (const float*)d_in[0]; p.norm_mix = (const float*)d_in[1]; p.norm_ffn = (const float*)d_in[2]; p.norm_final = (const float*)d_in[3]; p.rel_bias = (const float*)d_in[4];
    p.nsa_w_in = (const float*)d_in[5]; p.pos_k = (const float*)d_in[6]; p.pos_v = (const float*)d_in[7]; p.ck_w1 = (const float*)d_in[8]; p.ck_b1 = (const float*)d_in[9]; p.ck_w2 = (const float*)d_in[10];
    p.cv_w1 = (const float*)d_in[11]; p.cv_b1 = (const float*)d_in[12]; p.cv_w2 = (const float*)d_in[13]; p.nsa_w_out = (const float*)d_in[14];
    p.pool_w_in = (const float*)d_in[15]; p.pool_w_grp = (const float*)d_in[16]; p.pool_scale = (const float*)d_in[17]; p.pool_w_out = (const float*)d_in[18]; p.ffn_w_gu = (const float*)d_in[19]; p.ffn_w_down = (const float*)d_in[20];
    p.out = (float*)d_out; p.ws = (unsigned char*)d_ws;
    if (hipMemsetAsync((char*)d_ws + WS_XBAR, 0, 16384, stream) != hipSuccess) { fprintf(stderr, "kernel_launch: hipMemsetAsync failed\n"); return; }
    void* args[] = {&p};
    hipError_t e = hipLaunchCooperativeKernel((const void*)fwd_megakernel, dim3(grid_blocks), dim3(NTHR), args, LDS_BYTES, stream);
    if (e != hipSuccess) fprintf(stderr, "cooperative launch failed: %s (grid %d)\n", hipGetErrorString(e), grid_blocks);
}
```

```cpp
#include <hip/hip_runtime.h>
#include <hip/hip_cooperative_groups.h>
#include <cstdio>
#include <cstdint>
namespace cg = cooperative_groups;

#define LAS __attribute__((address_space(3)))
typedef unsigned short bf16_t;
typedef short bf16x8 __attribute__((ext_vector_type(8)));
typedef float f32x4 __attribute__((ext_vector_type(4)));
typedef float f32x2 __attribute__((ext_vector_type(2)));
typedef unsigned u32x4 __attribute__((ext_vector_type(4)));
typedef unsigned u32x2 __attribute__((ext_vector_type(2)));

constexpr int BATCH = 2, SEQ = 16384, DM = 2048, MT = BATCH * SEQ;
constexpr int NG = 4, HG = 8, DK = 96, DV = 64;
constexpr int NPROJ = 5120;
constexpr int C_VC = 3072, C_VS = 3328, C_VW = 3584, C_KC = 3840, C_KS = 4224, C_KW = 4608, C_GATE = 4992;
constexpr int DFF = 5632;
constexpr int NCMP = 1024;
constexpr float EPS = 1e-6f;
constexpr float NEGF = -1e30f;

constexpr size_t MiB = 1u << 20;
constexpr size_t WS_SSQ = 0;
constexpr size_t WS_XBAR = 768 * 1024;
constexpr size_t WS_KMAX = 900 * 1024;
constexpr size_t WS_W_IN = 1 * MiB;
constexpr size_t WS_W_OUT = 21 * MiB;
constexpr size_t WS_W_GU0 = 29 * MiB, WS_W_GU1 = 73 * MiB;
constexpr size_t WS_W_DN0 = 117 * MiB, WS_W_DN1 = 139 * MiB;
constexpr size_t WS_P_IN = 161 * MiB, WS_P_GRP = 169 * MiB, WS_P_OUT = 171 * MiB;
constexpr size_t WS_CK1 = 179 * MiB, WS_CV1 = 181 * MiB, WS_CK2 = 182 * MiB, WS_CV2 = 182 * MiB + 65536;
constexpr size_t WS_KCMP = 183 * MiB, WS_VCMP = 185 * MiB, WS_SELM = 186 * MiB;
constexpr size_t WS_XB = 190 * MiB;
constexpr size_t WS_O = 318 * MiB;
constexpr size_t WS_BIG = 446 * MiB;
constexpr size_t WS_END = 798 * MiB;

typedef __bf16 bf16x2_t __attribute__((ext_vector_type(2)));
__device__ __forceinline__ unsigned cvt_pk_bf16(float lo, float hi) { const f32x2 v = {lo, hi}; const bf16x2_t b = __builtin_convertvector(v, bf16x2_t); return __builtin_bit_cast(unsigned, b); }
__device__ __forceinline__ float bf_lo(unsigned u) { return __uint_as_float(u << 16); }
__device__ __forceinline__ float bf_hi(unsigned u) { return __uint_as_float(u & 0xffff0000u); }
__device__ __forceinline__ float wave_sum(float v) {
#pragma unroll
    for (int o = 1; o < 64; o <<= 1) v += __shfl_xor(v, o);
    return v;
}

namespace pg8 {
constexpr int BM = 256, BK = 64, HALF = 128, HTB = HALF * BK * 2, STAGE_BYTES = 8 * HTB, NXCD = 8, WGM = 8;
__host__ __device__ __forceinline__ int lds_byte(int r, int c) { const int st = (r >> 4) * 2 + (c >> 5), rr = r & 15, cc = c & 31, ob = rr * 64 + cc * 2; return st * 1024 + (ob ^ (((ob >> 9) & 1) << 5)); }
__host__ __device__ __forceinline__ void stage_rc(int b, int& R, int& C) { const int st = b / 1024, sb = b % 1024, swz = sb ^ (((sb >> 9) & 1) << 5); R = (st >> 1) * 16 + swz / 64; C = (st & 1) * 32 + (swz % 64) / 2; }
__host__ __device__ __forceinline__ int perm32(int rho) { const int n = rho >> 4, i = rho & 15; return 8 * (i >> 2) + 4 * n + (i & 3); }

struct Unit { int pm, pn; };
struct Gemm { const bf16_t* A; const bf16_t* Bt; int lda, ldb, M, N, K; int acolb; };

struct StaticOrder {
    int nM, nN, nwg, G, c;
    __device__ void init(int M, int N, int G_, int c_) { nM = M / BM; nN = N / BM; nwg = nM * nN; G = G_; c = c_; }
    __device__ bool next(int i, Unit& u) const {
        const long L = (long)i * G + c; if (L >= nwg) return false;
        int wgid = (int)L; { const int q = nwg / NXCD, r = nwg % NXCD, xcd = wgid % NXCD, off = wgid / NXCD; wgid = (xcd < r ? xcd * (q + 1) : r * (q + 1) + (xcd - r) * q) + off; }
        const int nig = WGM * nN, gid = wgid / nig, fm = gid * WGM, gsz = (nM - fm) < WGM ? (nM - fm) : WGM;
        u.pm = fm + ((wgid % nig) % gsz); u.pn = (wgid % nig) / gsz; return true;
    }
};

template <class Epi>
__device__ __forceinline__ void gemm_phase(LAS unsigned char* lds, const Gemm g, const StaticOrder& S, const Epi& E) {
    const int tid = threadIdx.x, wid = __builtin_amdgcn_readfirstlane(tid >> 6), lane = tid & 63, wr = wid >> 2, wc = wid & 3, fr = lane & 15, fq = lane >> 4;
    const int K = g.K, nt = K / BK;
    unsigned voffA[2], voffB[2];
#pragma unroll
    for (int i = 0; i < 2; ++i) { int R, C; stage_rc(tid * 16 + i * 8192, R, C); const int Rb = (R & ~31) + perm32(R & 31);
        voffA[i] = (unsigned)(R * g.lda + C) * 2u; voffB[i] = (unsigned)(Rb * g.ldb + C) * 2u; }
    const size_t kstep = (size_t)(BK * 2);
    const size_t hstepA = (size_t)HALF * g.lda * 2, hstepB = (size_t)HALF * g.ldb * 2;
    const size_t tstepA = 2 * hstepA, tstepB = 2 * hstepB;
    const unsigned ldsw = (unsigned)wid * 1024u;
    const int aoff = lds_byte(wr * 64 + fr, fq * 8), boff = lds_byte(wc * 32 + fr, fq * 8);
#define PG8_SA(b, h) (((b) * 2 + (h)) * HTB)
#define PG8_SB(b, h) ((4 + (b) * 2 + (h)) * HTB)
#define PG8_STAGE(bufoff, gbase, voff) do { _Pragma("unroll") for (int _i = 0; _i < 2; ++_i) \
        __builtin_amdgcn_global_load_lds((const unsigned*)((const char*)(gbase) + (voff)[_i]), (LAS unsigned*)(lds + (bufoff) + ldsw + _i * 8192), 16, 0, 0); } while (0)
#define PG8_LDA(dst, b, h) do { _Pragma("unroll") for (int m = 0; m < 4; ++m) _Pragma("unroll") for (int k = 0; k < 2; ++k) dst[m][k] = *(const LAS bf16x8*)(lds + PG8_SA(b, h) + aoff + m * 2048 + k * 1024); } while (0)
#define PG8_LDB(dst, b, h) do { _Pragma("unroll") for (int n = 0; n < 2; ++n) _Pragma("unroll") for (int k = 0; k < 2; ++k) dst[n][k] = *(const LAS bf16x8*)(lds + PG8_SB(b, h) + boff + n * 2048 + k * 1024); } while (0)
#define PG8_MMA(ai, bj, At, Bt) do { __builtin_amdgcn_s_setprio(1); _Pragma("unroll") for (int m = 0; m < 4; ++m) _Pragma("unroll") for (int n = 0; n < 2; ++n) _Pragma("unroll") for (int k = 0; k < 2; ++k) \
        acc[ai][bj][m][n] = __builtin_amdgcn_mfma_f32_16x16x32_bf16(Bt[n][k], At[m][k], acc[ai][bj][m][n], 0, 0, 0); __builtin_amdgcn_s_setprio(0); } while (0)
#define PG8_WAIT_V(n) asm volatile("s_waitcnt vmcnt(" #n ")" ::: "memory")
#define PG8_WAIT_L(n) asm volatile("s_waitcnt lgkmcnt(" #n ")" ::: "memory")
#define PG8_BAR __builtin_amdgcn_s_barrier()
#define PG8_SCHED __builtin_amdgcn_sched_barrier(0)
#define PG8_APTR(u) ((const char*)g.A + (size_t)(u).pm * tstepA + (size_t)((u).pn >> 1) * (size_t)g.acolb)
#define PG8_BPTR(u) ((const char*)g.Bt + (size_t)(u).pn * tstepB)
    Unit cur, nxt; int ui = 0;
    if (!S.next(0, cur)) return;
    f32x4 acc[2][2][4][2];
#pragma unroll
    for (int a = 0; a < 2; ++a)
#pragma unroll
        for (int b = 0; b < 2; ++b)
#pragma unroll
            for (int m = 0; m < 4; ++m)
#pragma unroll
                for (int n = 0; n < 2; ++n) acc[a][b][m][n] = (f32x4){0.f, 0.f, 0.f, 0.f};
    bf16x8 At[4][2], B0[2][2], B1[2][2];
    const char* cA = PG8_APTR(cur); const char* cB = PG8_BPTR(cur);
    PG8_STAGE(PG8_SB(0, 0), cB, voffB); PG8_STAGE(PG8_SB(0, 1), cB + hstepB, voffB); PG8_STAGE(PG8_SA(0, 0), cA, voffA); PG8_STAGE(PG8_SA(0, 1), cA + hstepA, voffA);
    if (wr == 1) PG8_BAR;
    PG8_WAIT_V(2); PG8_BAR;
    PG8_STAGE(PG8_SB(1, 0), cB + kstep, voffB); PG8_STAGE(PG8_SA(1, 0), cA + kstep, voffA); PG8_STAGE(PG8_SB(1, 1), cB + hstepB + kstep, voffB);
    PG8_WAIT_V(6); PG8_BAR;
    for (;;) {
        const bool has_next = S.next(ui + 1, nxt);
        const char* nA = has_next ? PG8_APTR(nxt) : cA; const char* nB = has_next ? PG8_BPTR(nxt) : cB;
        for (int t = 0; t < nt; t += 2) {
            const bool last = (t == nt - 2);
            const char* a1 = cA + (size_t)(t + 1) * kstep;
            const char* a2 = last ? nA : cA + (size_t)(t + 2) * kstep; const char* b2 = last ? nB : cB + (size_t)(t + 2) * kstep;
            const char* a3 = a2 + kstep; const char* b3 = b2 + kstep;
            PG8_LDB(B0, 0, 0); PG8_LDB(B1, 0, 1); PG8_SCHED; PG8_LDA(At, 0, 0); PG8_STAGE(PG8_SA(1, 1), a1 + hstepA, voffA);
            PG8_WAIT_V(8); PG8_WAIT_L(0); PG8_BAR; PG8_MMA(0, 0, At, B0); PG8_MMA(0, 1, At, B1); PG8_BAR; PG8_SCHED;
            PG8_LDA(At, 0, 1); PG8_STAGE(PG8_SB(0, 0), b2, voffB); PG8_STAGE(PG8_SB(0, 1), b2 + hstepB, voffB); PG8_STAGE(PG8_SA(0, 0), a2, voffA);
            PG8_WAIT_V(8); PG8_WAIT_L(0); PG8_BAR; PG8_MMA(1, 0, At, B0); PG8_MMA(1, 1, At, B1); PG8_BAR; PG8_SCHED;
            PG8_LDB(B0, 1, 0); PG8_LDB(B1, 1, 1); PG8_SCHED; PG8_LDA(At, 1, 0); PG8_STAGE(PG8_SA(0, 1), a2 + hstepA, voffA);
            PG8_WAIT_V(8); PG8_WAIT_L(0); PG8_BAR; PG8_MMA(0, 0, At, B0); PG8_MMA(0, 1, At, B1); PG8_BAR; PG8_SCHED;
            PG8_LDA(At, 1, 1); PG8_STAGE(PG8_SB(1, 0), b3, voffB); PG8_STAGE(PG8_SB(1, 1), b3 + hstepB, voffB); PG8_STAGE(PG8_SA(1, 0), a3, voffA);
            PG8_WAIT_V(8); PG8_WAIT_L(0); PG8_BAR; PG8_MMA(1, 0, At, B0); PG8_MMA(1, 1, At, B1); PG8_BAR; PG8_SCHED;
        }
        if (wr == 0) PG8_BAR;
        E(acc, cur, wr, wc, fr, fq);
        if (!has_next) break;
#pragma unroll
        for (int a = 0; a < 2; ++a)
#pragma unroll
            for (int b = 0; b < 2; ++b)
#pragma unroll
                for (int m = 0; m < 4; ++m)
#pragma unroll
                    for (int n = 0; n < 2; ++n) acc[a][b][m][n] = (f32x4){0.f, 0.f, 0.f, 0.f};
        cur = nxt; cA = nA; cB = nB; ++ui;
        if (wr == 1) PG8_BAR;
    }
    PG8_WAIT_V(0);
    PG8_BAR;
#undef PG8_SA
#undef PG8_SB
#undef PG8_STAGE
#undef PG8_LDA
#undef PG8_LDB
#undef PG8_MMA
#undef PG8_WAIT_V
#undef PG8_WAIT_L
#undef PG8_BAR
#undef PG8_SCHED
#undef PG8_APTR
#undef PG8_BPTR
}

#define EPI_ROW(u, ai, m) ((u).pm * BM + (ai) * HALF + wr * 64 + (m) * 16 + fr)
__device__ __forceinline__ u32x4 pack8(f32x4 v0, f32x4 v1) { u32x4 w; w.x = cvt_pk_bf16(v0[0], v0[1]); w.y = cvt_pk_bf16(v0[2], v0[3]); w.z = cvt_pk_bf16(v1[0], v1[1]); w.w = cvt_pk_bf16(v1[2], v1[3]); return w; }

struct EpiProj {
    bf16_t* O; const float* ssq;
    __device__ __forceinline__ void operator()(const f32x4 (&acc)[2][2][4][2], const Unit& u, int wr, int wc, int fr, int fq) const {
        const float qs = (u.pn < 12) ? 0.10206207261596577f * 1.4426950408889634f : 1.0f;
#pragma unroll
        for (int ai = 0; ai < 2; ++ai)
#pragma unroll
            for (int m = 0; m < 4; ++m) { const int row = EPI_ROW(u, ai, m); const float rs = rsqrtf(ssq[row] * (1.0f / DM) + EPS) * qs;
#pragma unroll
                for (int bj = 0; bj < 2; ++bj) { const int c0 = u.pn * BM + bj * HALF + wc * 32 + 8 * fq;
                    *(u32x4*)(O + (size_t)row * NPROJ + c0) = pack8(acc[ai][bj][m][0] * rs, acc[ai][bj][m][1] * rs); } }
    }
};
struct EpiRowScale {
    bf16_t* O; const float* ssq;
    __device__ __forceinline__ void operator()(const f32x4 (&acc)[2][2][4][2], const Unit& u, int wr, int wc, int fr, int fq) const {
#pragma unroll
        for (int ai = 0; ai < 2; ++ai)
#pragma unroll
            for (int m = 0; m < 4; ++m) { const int row = EPI_ROW(u, ai, m); const float rs = rsqrtf(ssq[row] * (1.0f / DM) + EPS);
#pragma unroll
                for (int bj = 0; bj < 2; ++bj) { const int c0 = u.pn * BM + bj * HALF + wc * 32 + 8 * fq;
                    *(u32x4*)(O + (size_t)row * DM + c0) = pack8(acc[ai][bj][m][0] * rs, acc[ai][bj][m][1] * rs); } }
    }
};
struct EpiColScale {
    bf16_t* O; const float* scale;
    __device__ __forceinline__ void operator()(const f32x4 (&acc)[2][2][4][2], const Unit& u, int wr, int wc, int fr, int fq) const {
#pragma unroll
        for (int bj = 0; bj < 2; ++bj) { const int c0 = u.pn * BM + bj * HALF + wc * 32 + 8 * fq;
            const f32x4 s0 = *(const f32x4*)(scale + c0), s1 = *(const f32x4*)(scale + c0 + 4);
#pragma unroll
            for (int ai = 0; ai < 2; ++ai)
#pragma unroll
                for (int m = 0; m < 4; ++m) { const int row = EPI_ROW(u, ai, m);
                    *(u32x4*)(O + (size_t)row * DM + c0) = pack8(acc[ai][bj][m][0] * s0, acc[ai][bj][m][1] * s1); } }
    }
};
struct EpiSwiglu {
    bf16_t* O; const float* ssq;
    __device__ __forceinline__ void operator()(const f32x4 (&acc)[2][2][4][2], const Unit& u, int wr, int wc, int fr, int fq) const {
        const int c0 = u.pn * HALF + wc * 32 + 8 * fq;
#pragma unroll
        for (int ai = 0; ai < 2; ++ai)
#pragma unroll
            for (int m = 0; m < 4; ++m) { const int row = EPI_ROW(u, ai, m); const float rs = rsqrtf(ssq[row] * (1.0f / DM) + EPS);
                f32x4 r[2];
#pragma unroll
                for (int n = 0; n < 2; ++n)
#pragma unroll
                    for (int j = 0; j < 4; ++j) { const float gt = acc[ai][0][m][n][j] * rs, up = acc[ai][1][m][n][j] * rs; r[n][j] = gt * up * __builtin_amdgcn_rcpf(1.0f + __expf(-gt)); }
                *(u32x4*)(O + (size_t)row * DFF + c0) = pack8(r[0], r[1]); }
    }
};
struct EpiRes {
    const float* src; float* dst; bf16_t* xb; float* ssq_out;
    __device__ __forceinline__ void operator()(const f32x4 (&acc)[2][2][4][2], const Unit& u, int wr, int wc, int fr, int fq) const {
#pragma unroll
        for (int ai = 0; ai < 2; ++ai)
#pragma unroll
            for (int m = 0; m < 4; ++m) { const int row = EPI_ROW(u, ai, m); float ss = 0.f;
#pragma unroll
                for (int bj = 0; bj < 2; ++bj) { const size_t off = (size_t)row * DM + u.pn * BM + bj * HALF + wc * 32 + 8 * fq;
                    const f32x4 x0 = *(const f32x4*)(src + off) + acc[ai][bj][m][0], x1 = *(const f32x4*)(src + off + 4) + acc[ai][bj][m][1];
                    *(f32x4*)(dst + off) = x0; *(f32x4*)(dst + off + 4) = x1; *(u32x4*)(xb + off) = pack8(x0, x1);
                    ss += (x0[0] * x0[0] + x0[1] * x0[1]) + (x0[2] * x0[2] + x0[3] * x0[3]) + (x1[0] * x1[0] + x1[1] * x1[1]) + (x1[2] * x1[2] + x1[3] * x1[3]); }
                ss += __shfl_xor(ss, 16); ss += __shfl_xor(ss, 32);
                if (fq == 0) atomicAdd(ssq_out + row, ss); }
    }
};
}

struct Params {
    const float* x; const float* norm_mix; const float* norm_ffn; const float* norm_final; const float* rel_bias;
    const float* nsa_w_in; const float* pos_k; const float* pos_v; const float* ck_w1; const float* ck_b1; const float* ck_w2;
    const float* cv_w1; const float* cv_b1; const float* cv_w2; const float* nsa_w_out;
    const float* pool_w_in; const float* pool_w_grp; const float* pool_scale; const float* pool_w_out; const float* ffn_w_gu; const float* ffn_w_down;
    float* out; unsigned char* ws;
};

constexpr int NTHR = 512, NWAVES = 8;
constexpr int LDS_BYTES = 163840;

__device__ __forceinline__ int nsa_map(int n0) {
    if (n0 < 3072) return n0;
    if (n0 < 3456) return C_KC + (n0 - 3072);
    if (n0 < 3712) return C_VC + (n0 - 3456);
    if (n0 < 4096) return C_KS + (n0 - 3712);
    if (n0 < 4352) return C_VS + (n0 - 4096);
    if (n0 < 4736) return C_KW + (n0 - 4352);
    if (n0 < 4992) return C_VW + (n0 - 4736);
    return C_GATE + (n0 - 4992);
}
__device__ __forceinline__ int gu_map(int n0) { return n0 < DFF ? (n0 >> 7) * 256 + (n0 & 127) : ((n0 - DFF) >> 7) * 256 + 128 + ((n0 - DFF) & 127); }

template <int MAP>
__device__ __forceinline__ void transpose_items(const float* W, int K, int N, bf16_t* WT, int ldd, int row_off, const float* fold, LAS float* scr, int gw, int ngw, int lane) {
    const int nblk = N / 32, nitems = (K / 64) * nblk;
    for (int item = gw; item < nitems; item += ngw) {
        const int kb = item / nblk, nb = item % nblk, k0 = 64 * kb, n0 = 32 * nb;
        const int d0 = row_off + (MAP == 1 ? nsa_map(n0) : (MAP == 2 ? gu_map(n0) : n0));
        float wv[32];
#pragma unroll
        for (int i = 0; i < 32; ++i) wv[i] = W[(size_t)(k0 + 2 * i + (lane >> 5)) * N + n0 + (lane & 31)];
#pragma unroll
        for (int i = 0; i < 32; ++i) { const int kk = 2 * i + (lane >> 5); float v = wv[i]; if (fold) v *= fold[k0 + kk]; scr[kk * 33 + (lane & 31)] = v; }
        asm volatile("s_waitcnt lgkmcnt(0)" ::: "memory");
        const int c = lane & 7;
#pragma unroll
        for (int j = 0; j < 4; ++j) { const int n = (lane >> 3) + 8 * j; const LAS float* s = scr + (8 * c) * 33 + n;
            u32x4 o; o.x = cvt_pk_bf16(s[0 * 33], s[1 * 33]); o.y = cvt_pk_bf16(s[2 * 33], s[3 * 33]); o.z = cvt_pk_bf16(s[4 * 33], s[5 * 33]); o.w = cvt_pk_bf16(s[6 * 33], s[7 * 33]);
            *(u32x4*)(WT + (size_t)(d0 + n) * ldd + k0 + 8 * c) = o; }
        asm volatile("s_waitcnt lgkmcnt(0)" ::: "memory");
    }
}

__device__ __forceinline__ void phase_prologue(const Params& p, LAS unsigned char* lds) {
    const int tid = threadIdx.x, lane = tid & 63, wave = tid >> 6;
    const int gw = blockIdx.x * NWAVES + wave, ngw = gridDim.x * NWAVES;
    LAS float* scr = (LAS float*)(lds + wave * 8704);
    unsigned char* ws = p.ws;
    if (blockIdx.x == 0 && tid < 16) ((unsigned*)(ws + WS_KMAX))[tid] = 0u;
    { float* ssq = (float*)(ws + WS_SSQ); for (int i = blockIdx.x * NTHR + tid; i < 4 * MT; i += gridDim.x * NTHR) ssq[MT + i] = 0.f; }
    transpose_items<1>(p.nsa_w_in, DM, 5088, (bf16_t*)(ws + WS_W_IN), DM, 0, p.norm_mix, scr, gw, ngw, lane);
    transpose_items<0>(p.nsa_w_out, DM, DM, (bf16_t*)(ws + WS_W_OUT), DM, 0, nullptr, scr, gw, ngw, lane);
    transpose_items<2>(p.ffn_w_gu, DM, 2 * DFF, (bf16_t*)(ws + WS_W_GU0), DM, 0, p.norm_ffn, scr, gw, ngw, lane);
    transpose_items<2>(p.ffn_w_gu + (size_t)DM * 2 * DFF, DM, 2 * DFF, (bf16_t*)(ws + WS_W_GU1), DM, 0, p.norm_ffn + DM, scr, gw, ngw, lane);
    transpose_items<0>(p.ffn_w_down, DFF, DM, (bf16_t*)(ws + WS_W_DN0), DFF, 0, nullptr, scr, gw, ngw, lane);
    transpose_items<0>(p.ffn_w_down + (size_t)DFF * DM, DFF, DM, (bf16_t*)(ws + WS_W_DN1), DFF, 0, nullptr, scr, gw, ngw, lane);
    transpose_items<0>(p.pool_w_in, DM, DM, (bf16_t*)(ws + WS_P_IN), DM, 0, p.norm_mix + DM, scr, gw, ngw, lane);
#pragma unroll 1
    for (int gi = 0; gi < 4; ++gi) transpose_items<0>(p.pool_w_grp + (size_t)gi * 512 * 512, 512, 512, (bf16_t*)(ws + WS_P_GRP), 512, gi * 512, nullptr, scr, gw, ngw, lane);
    transpose_items<0>(p.pool_w_out, DM, DM, (bf16_t*)(ws + WS_P_OUT), DM, 0, nullptr, scr, gw, ngw, lane);
    transpose_items<0>(p.ck_w1, 32 * DK, 256, (bf16_t*)(ws + WS_CK1), 32 * DK, 0, nullptr, scr, gw, ngw, lane);
    transpose_items<0>(p.cv_w1, 32 * DV, 256, (bf16_t*)(ws + WS_CV1), 32 * DV, 0, nullptr, scr, gw, ngw, lane);
    transpose_items<0>(p.ck_w2, 256, DK, (bf16_t*)(ws + WS_CK2), 256, 0, nullptr, scr, gw, ngw, lane);
    transpose_items<0>(p.cv_w2, 256, DV, (bf16_t*)(ws + WS_CV2), 256, 0, nullptr, scr, gw, ngw, lane);
    float* ssq0 = (float*)(ws + WS_SSQ); bf16_t* xb = (bf16_t*)(ws + WS_XB);
    for (int row = gw; row < MT; row += ngw) {
        const f32x4* xr = (const f32x4*)(p.x + (size_t)row * DM) + lane; u32x2* o = (u32x2*)(xb + (size_t)row * DM) + lane;
        float s = 0.f;
#pragma unroll
        for (int j = 0; j < 8; ++j) { const f32x4 v = xr[64 * j]; s += (v[0] * v[0] + v[1] * v[1]) + (v[2] * v[2] + v[3] * v[3]); u32x2 w; w.x = cvt_pk_bf16(v[0], v[1]); w.y = cvt_pk_bf16(v[2], v[3]); o[64 * j] = w; }
        s = wave_sum(s);
        if (lane == 0) ssq0[row] = s;
    }
}

__device__ __forceinline__ float gelu_tanh(float x) { const float u = 0.7978845608028654f * (x + 0.044715f * x * x * x); return 0.5f * x * (1.0f + tanhf(u)); }

template <int DH>
__device__ __forceinline__ void compress_unit(const Params& p, LAS unsigned char* lds, int b, int n0, int colbase, const float* pos, const bf16_t* w1t, const float* b1, const bf16_t* w2t, bf16_t* outp) {
    constexpr int KC = 32 * DH;
    const int tid = threadIdx.x, lane = tid & 63, wave = __builtin_amdgcn_readfirstlane(tid >> 6), c = lane & 15, kq = lane >> 4;
    const bf16_t* proj = (const bf16_t*)(p.ws + WS_BIG);
    LAS unsigned char* As = lds; LAS unsigned char* Bs = lds + 5120; LAS unsigned char* Hs = lds + 32768;
    const int arow = tid >> 2, ach = tid & 3;
    const int ag = arow >> 4, an = n0 + (arow & 15);
    u32x4 areg = {0, 0, 0, 0}, breg[2];
#define CMP_LOAD(k0_) do { const int k0v = (k0_); \
        if (tid < 256) { const int kk = k0v + ach * 8, l = kk / DH, d = kk % DH; int tok = 16 * an + l; tok = tok < SEQ ? tok : SEQ - 1; \
            const u32x4 raw = *(const u32x4*)(proj + (size_t)(b * SEQ + tok) * NPROJ + colbase + ag * DH + d); \
            const f32x4 p0 = *(const f32x4*)(pos + l * DH + d), p1 = *(const f32x4*)(pos + l * DH + d + 4); \
            areg.x = cvt_pk_bf16(bf_lo(raw.x) + p0[0], bf_hi(raw.x) + p0[1]); areg.y = cvt_pk_bf16(bf_lo(raw.y) + p0[2], bf_hi(raw.y) + p0[3]); \
            areg.z = cvt_pk_bf16(bf_lo(raw.z) + p1[0], bf_hi(raw.z) + p1[1]); areg.w = cvt_pk_bf16(bf_lo(raw.w) + p1[2], bf_hi(raw.w) + p1[3]); } \
        _Pragma("unroll") for (int i_ = 0; i_ < 2; ++i_) { const int idx = tid + 512 * i_; breg[i_] = *(const u32x4*)(w1t + (size_t)(idx >> 2) * KC + k0v + (idx & 3) * 8); } } while (0)
    f32x4 acc[4][2];
#pragma unroll
    for (int m = 0; m < 4; ++m) { acc[m][0] = (f32x4){0.f, 0.f, 0.f, 0.f}; acc[m][1] = (f32x4){0.f, 0.f, 0.f, 0.f}; }
    CMP_LOAD(0);
    for (int k0 = 0; k0 < KC; k0 += 32) {
        __syncthreads();
        if (tid < 256) *(LAS u32x4*)(As + arow * 80 + ach * 16) = areg;
#pragma unroll
        for (int i = 0; i < 2; ++i) { const int idx = tid + 512 * i; *(LAS u32x4*)(Bs + (idx >> 2) * 80 + (idx & 3) * 16) = breg[i]; }
        __syncthreads();
        if (k0 + 32 < KC) CMP_LOAD(k0 + 32);
        bf16x8 af[4], bfr[2];
#pragma unroll
        for (int m = 0; m < 4; ++m) af[m] = *(const LAS bf16x8*)(As + (16 * m + c) * 80 + kq * 16);
#pragma unroll
        for (int n = 0; n < 2; ++n) bfr[n] = *(const LAS bf16x8*)(Bs + (32 * wave + 16 * n + c) * 80 + kq * 16);
#pragma unroll
        for (int m = 0; m < 4; ++m)
#pragma unroll
            for (int n = 0; n < 2; ++n) acc[m][n] = __builtin_amdgcn_mfma_f32_16x16x32_bf16(af[m], bfr[n], acc[m][n], 0, 0, 0);
    }
#pragma unroll
    for (int n = 0; n < 2; ++n) { const int col = 32 * wave + 16 * n + c; const float bb = b1[col];
#pragma unroll
        for (int m = 0; m < 4; ++m)
#pragma unroll
            for (int i = 0; i < 4; ++i) { const float h = gelu_tanh(acc[m][n][i] + bb); *(LAS bf16_t*)(Hs + (16 * m + 4 * kq + i) * 528 + col * 2) = (bf16_t)(cvt_pk_bf16(h, 0.f) & 0xffffu); } }
    __syncthreads();
    constexpr int NT2 = 4 * (DH / 16);
    for (int idx = wave; idx < NT2; idx += 8) {
        const int m2 = idx & 3, n2 = idx >> 2;
        f32x4 a2 = {0.f, 0.f, 0.f, 0.f};
#pragma unroll
        for (int ks = 0; ks < 8; ++ks) { const bf16x8 a = *(const LAS bf16x8*)(Hs + (16 * m2 + c) * 528 + (32 * ks + 8 * kq) * 2);
            const bf16x8 bb = *(const bf16x8*)(w2t + (size_t)(16 * n2 + c) * 256 + 32 * ks + 8 * kq);
            a2 = __builtin_amdgcn_mfma_f32_16x16x32_bf16(a, bb, a2, 0, 0, 0); }
#pragma unroll
        for (int i = 0; i < 4; ++i) outp[((size_t)(b * NG + m2) * NCMP + n0 + 4 * kq + i) * DH + 16 * n2 + c] = (bf16_t)(cvt_pk_bf16(a2[i], 0.f) & 0xffffu);
    }
    __syncthreads();
}

__device__ __forceinline__ void phase_compress(const Params& p, LAS unsigned char* lds) {
    unsigned char* ws = p.ws;
    for (int u = blockIdx.x; u < 256; u += gridDim.x) {
        const int which = u >> 7, b = (u >> 6) & 1, n0 = (u & 63) * 16;
        if (which == 0) compress_unit<DK>(p, lds, b, n0, C_KC, p.pos_k, (const bf16_t*)(ws + WS_CK1), p.ck_b1, (const bf16_t*)(ws + WS_CK2), (bf16_t*)(ws + WS_KCMP));
        else compress_unit<DV>(p, lds, b, n0, C_VC, p.pos_v, (const bf16_t*)(ws + WS_CV1), p.cv_b1, (const bf16_t*)(ws + WS_CV2), (bf16_t*)(ws + WS_VCMP));
    }
    { const bf16_t* proj = (const bf16_t*)(ws + WS_BIG); unsigned* kmaxp = (unsigned*)(ws + WS_KMAX); const int lane = threadIdx.x & 63;
      for (int it = blockIdx.x * NTHR + threadIdx.x; it < MT * 8; it += gridDim.x * NTHR) { const int row = it >> 3, sg = it & 7, br = sg >> 2, g = sg & 3;
        const u32x4* kp = (const u32x4*)(proj + (size_t)row * NPROJ + (br ? C_KW : C_KS) + g * DK); float n2 = 0.f;
#pragma unroll
        for (int ch = 0; ch < 12; ++ch) { const u32x4 w = kp[ch];
            n2 += bf_lo(w.x) * bf_lo(w.x) + bf_hi(w.x) * bf_hi(w.x) + bf_lo(w.y) * bf_lo(w.y) + bf_hi(w.y) * bf_hi(w.y) + bf_lo(w.z) * bf_lo(w.z) + bf_hi(w.z) * bf_hi(w.z) + bf_lo(w.w) * bf_lo(w.w) + bf_hi(w.w) * bf_hi(w.w); }
        n2 = fmaxf(n2, __shfl_xor(n2, 8)); n2 = fmaxf(n2, __shfl_xor(n2, 16)); n2 = fmaxf(n2, __shfl_xor(n2, 32));
        if (lane < 8) atomicMax(kmaxp + br * 8 + (row >> 14) * 4 + g, __float_as_uint(sqrtf(n2))); } }
}

constexpr int KT_STRIDE = 208, SLOT_K = 64 * KT_STRIDE;
constexpr int VT_STRIDE = 144, SLOT_V = 64 * VT_STRIDE;
constexpr int SLOT_BYTES = SLOT_K + SLOT_V, RING = 5, PD = RING - 1;
constexpr int RING_WS = 6;
constexpr int L_RING = 0, L_IMP = RING * SLOT_BYTES, L_BIAS = LDS_BYTES - 4 * 8 * 132 * 4, L_SELM = L_BIAS - 2048;
static_assert(L_IMP + 32 * 256 * 4 <= L_BIAS && RING_WS * SLOT_BYTES <= L_SELM, "attention LDS map");

struct PairState { f32x4 o[4]; float m, l; bf16x8 q[3]; };
struct TileSrc { const bf16_t* K; const bf16_t* V; int kld, vld; };
struct DmaPlan { int off[3]; };

__device__ __forceinline__ void glds16(const void* gsrc, unsigned lds_dst) { unsigned keep;
    asm volatile("s_mov_b32 %0, m0\n\ts_mov_b32 m0, %2\n\ts_nop 0\n\tglobal_load_lds_dwordx4 %1, off\n\ts_mov_b32 m0, %0" : "=&s"(keep) : "v"(gsrc), "s"(lds_dst) : "memory"); }
#define ATT_WAIT_BAR(N) asm volatile("s_waitcnt vmcnt(" #N ") lgkmcnt(0)\n\ts_barrier" ::: "memory")
__device__ __forceinline__ void att_wait_bar(int rem) { if (rem <= 0) ATT_WAIT_BAR(0); else if (rem == 1) ATT_WAIT_BAR(3); else if (rem == 2) ATT_WAIT_BAR(6); else ATT_WAIT_BAR(9); }
__device__ __forceinline__ bool piece_is_k(int s) { return s < 13 || s >= 22; }
__device__ __forceinline__ int piece_grp(int s) { return s < 13 ? s : (s >= 22 ? s - 22 : s - 13); }
__device__ __forceinline__ void make_plan(DmaPlan& pl, const TileSrc& src, int wave, int lane) {
#pragma unroll
    for (int j = 0; j < 3; ++j) { const int sidx = wave + 8 * j, ci = 64 * piece_grp(sidx) + lane;
        if (piece_is_k(sidx)) { const int key = ci / 13, ch = ci % 13; pl.off[j] = key * src.kld + (ch < 12 ? ch : 11) * 8; }
        else { const int key = ci / 9, ch = ci % 9; pl.off[j] = key * src.vld + (ch < 8 ? ch : 7) * 8; } }
}
__device__ __forceinline__ void issue_tile(const DmaPlan& pl, const TileSrc& src, int key0, unsigned slot_addr, int wave) {
#pragma unroll
    for (int j = 0; j < 3; ++j) { const int sidx = wave + 8 * j; const bool isk = piece_is_k(sidx);
        const bf16_t* gp = (isk ? src.K + (size_t)key0 * src.kld : src.V + (size_t)key0 * src.vld) + pl.off[j];
        glds16(gp, slot_addr + (isk ? 0u : (unsigned)SLOT_K) + 1024u * (unsigned)piece_grp(sidx)); }
}
typedef short s16x4 __attribute__((ext_vector_type(4)));
__device__ __forceinline__ s16x4 vtr(const LAS unsigned char* p) { return __builtin_bit_cast(s16x4, __builtin_amdgcn_ds_read_tr16_b64_v4i16((LAS s16x4*)p)); }

__device__ __forceinline__ float sum8_dpp(float x) {
    x += __builtin_bit_cast(float, __builtin_amdgcn_update_dpp(0, __builtin_bit_cast(int, x), 0xB1, 0xF, 0xF, true));
    x += __builtin_bit_cast(float, __builtin_amdgcn_update_dpp(0, __builtin_bit_cast(int, x), 0x4E, 0xF, 0xF, true));
    x += __builtin_bit_cast(float, __builtin_amdgcn_update_dpp(0, __builtin_bit_cast(int, x), 0x141, 0xF, 0xF, true));
    return x;
}
template <int MODE, bool FAR>
__device__ __forceinline__ void pair_tile(PairState& st, const LAS unsigned char* Kt, const LAS unsigned char* Vt, int tadj, int kstride, int maxdist, bool rowsel,
                                          const LAS float* biasrow, float bias_far, LAS float* improw, int jj0, int lane) {
    const int c = lane & 15, kq = lane >> 4;
    f32x4 s[4];
    float bv[4][4];
    if (!FAR) {
#pragma unroll
        for (int kt = 0; kt < 4; ++kt)
#pragma unroll
            for (int i = 0; i < 4; ++i) { const int d = tadj - (16 * kt + 4 * kq + i) * kstride; const int bi = d < 0 ? 0 : (d > 128 ? 128 : d); bv[kt][i] = biasrow[bi]; }
    }
    const float init = (FAR ? bias_far : 0.f) - st.m;
    const f32x4 initv = {init, init, init, init};
#pragma unroll
    for (int kt = 0; kt < 4; ++kt) {
#pragma unroll
        for (int ds = 0; ds < 3; ++ds) { const bf16x8 a = *(const LAS bf16x8*)(Kt + (16 * kt + c) * KT_STRIDE + (32 * ds + 8 * kq) * 2);
            s[kt] = __builtin_amdgcn_mfma_f32_16x16x32_bf16(a, st.q[ds], ds == 0 ? initv : s[kt], 0, 0, 0); } }
    if (!FAR) {
#pragma unroll
        for (int kt = 0; kt < 4; ++kt)
#pragma unroll
            for (int i = 0; i < 4; ++i) { const int d = tadj - (16 * kt + 4 * kq + i) * kstride; const bool valid = ((unsigned)d < (unsigned)maxdist) && rowsel;
                s[kt][i] = valid ? s[kt][i] + bv[kt][i] : NEGF; }
    }
    float psum = 0.f;
#pragma unroll
    for (int kt = 0; kt < 4; ++kt)
#pragma unroll
        for (int i = 0; i < 4; ++i) { const float pv = __builtin_amdgcn_exp2f(s[kt][i]); s[kt][i] = pv; psum += pv; }
    if (MODE != 1) st.l += psum;
    if (MODE == 0) return;
#pragma unroll
    for (int s2 = 0; s2 < 2; ++s2) {
        u32x4 pw; pw.x = cvt_pk_bf16(s[2 * s2][0], s[2 * s2][1]); pw.y = cvt_pk_bf16(s[2 * s2][2], s[2 * s2][3]); pw.z = cvt_pk_bf16(s[2 * s2 + 1][0], s[2 * s2 + 1][1]); pw.w = cvt_pk_bf16(s[2 * s2 + 1][2], s[2 * s2 + 1][3]);
        const bf16x8 pb = __builtin_bit_cast(bf16x8, pw);
#pragma unroll
        for (int dt = 0; dt < 4; ++dt) { const LAS unsigned char* vp = Vt + (32 * s2 + 4 * kq + (c >> 2)) * VT_STRIDE + (16 * dt + 4 * (c & 3)) * 2;
            const s16x4 lo = vtr(vp), hi = vtr(vp + 16 * VT_STRIDE); const bf16x8 a = {lo[0], lo[1], lo[2], lo[3], hi[0], hi[1], hi[2], hi[3]};
            st.o[dt] = __builtin_amdgcn_mfma_f32_16x16x32_bf16(a, pb, st.o[dt], 0, 0, 0); }
    }
    if (MODE == 1) {
#pragma unroll
        for (int kt = 0; kt < 4; ++kt) {
            float u0 = 2.0f * (s[kt][0] + s[kt][1] + s[kt][2]) + s[kt][3], u1 = s[kt][3];
            u0 = sum8_dpp(u0); u1 = sum8_dpp(u1);
            if ((lane & 7) == 0) { const int jj = jj0 + 4 * kt + kq;
                __hip_atomic_fetch_add(improw + jj, u0, __ATOMIC_RELAXED, __HIP_MEMORY_SCOPE_WORKGROUP);
                if (jj + 1 < 256) __hip_atomic_fetch_add(improw + jj + 1, u1, __ATOMIC_RELAXED, __HIP_MEMORY_SCOPE_WORKGROUP); }
        }
    }
}
#define PAIR_TILE(MODE, far, ...) do { if (far) pair_tile<MODE, true>(__VA_ARGS__); else pair_tile<MODE, false>(__VA_ARGS__); } while (0)

__device__ __forceinline__ int t5_bucket(int n) {
    if (n < 16) return n;
    int bk = 16;
    bk += (n >= 19); bk += (n >= 21); bk += (n >= 24); bk += (n >= 27); bk += (n >= 31); bk += (n >= 35); bk += (n >= 40); bk += (n >= 46);
    bk += (n >= 52); bk += (n >= 59); bk += (n >= 67); bk += (n >= 77); bk += (n >= 87); bk += (n >= 99); bk += (n >= 113);
    return bk;
}
__device__ __forceinline__ void build_bias(const Params& p, LAS unsigned char* lds) {
    LAS float* bt = (LAS float*)(lds + L_BIAS);
    for (int i = threadIdx.x; i < 32 * 129; i += NTHR) { const int h = i / 129, d = i % 129; bt[h * 132 + d] = p.rel_bias[t5_bucket(d) * 32 + h] * 1.4426950408889634f; }
    __syncthreads();
    if (threadIdx.x < 32) { float mx = bt[threadIdx.x * 132]; for (int d = 1; d < 129; ++d) mx = fmaxf(mx, bt[threadIdx.x * 132 + d]); bt[threadIdx.x * 132 + 129] = mx; }
    __syncthreads();
}

__device__ __forceinline__ void load_q(PairState& st, const bf16_t* proj, int b, int g, int tq0, int lane, float kmx, float bmax) {
    const int c = lane & 15, kq = lane >> 4; const size_t row = (size_t)b * SEQ + tq0 + (c >> 3);
#pragma unroll
    for (int ds = 0; ds < 3; ++ds) st.q[ds] = *(const bf16x8*)(proj + row * NPROJ + (g * 8 + (c & 7)) * DK + 32 * ds + 8 * kq);
    asm volatile("" : "+v"(st.q[0]), "+v"(st.q[1]), "+v"(st.q[2]));
    float qq = 0.f;
#pragma unroll
    for (int ds = 0; ds < 3; ++ds) { const u32x4 w = __builtin_bit_cast(u32x4, st.q[ds]);
        qq += bf_lo(w.x) * bf_lo(w.x) + bf_hi(w.x) * bf_hi(w.x) + bf_lo(w.y) * bf_lo(w.y) + bf_hi(w.y) * bf_hi(w.y) + bf_lo(w.z) * bf_lo(w.z) + bf_hi(w.z) * bf_hi(w.z) + bf_lo(w.w) * bf_lo(w.w) + bf_hi(w.w) * bf_hi(w.w); }
    qq += __shfl_xor(qq, 16); qq += __shfl_xor(qq, 32);
    st.m = sqrtf(qq) * kmx + bmax + 0.25f;
}
__device__ __forceinline__ void reset_state(PairState& st) {
#pragma unroll
    for (int dt = 0; dt < 4; ++dt) st.o[dt] = (f32x4){0.f, 0.f, 0.f, 0.f};
    st.l = 0.f;
}
template <bool ACCUM>
__device__ __forceinline__ void write_out(const PairState& st, float inv, const bf16_t* proj, bf16_t* obuf, int b, int g, int tq0, int br, int lane) {
    const int c = lane & 15, kq = lane >> 4; const size_t row = (size_t)b * SEQ + tq0 + (c >> 3);
    const float gl = bf_lo((unsigned)proj[row * NPROJ + C_GATE + br * 32 + g * 8 + (c & 7)]);
    const float sc = inv * __builtin_amdgcn_rcpf(1.0f + __expf(-gl));
    bf16_t* op = obuf + row * DM + (g * 8 + (c & 7)) * DV + 4 * kq;
#pragma unroll
    for (int dt = 0; dt < 4; ++dt) { f32x4 v = st.o[dt] * sc;
        if (ACCUM) { const u32x2 old = *(const u32x2*)(op + 16 * dt); v[0] += bf_lo(old.x); v[1] += bf_hi(old.x); v[2] += bf_lo(old.y); v[3] += bf_hi(old.y); }
        u32x2 w; w.x = cvt_pk_bf16(v[0], v[1]); w.y = cvt_pk_bf16(v[2], v[3]); *(u32x2*)(op + 16 * dt) = w; }
}

constexpr size_t WS_UCTR = WS_XBAR + 14336;
#define UNIT_LOOP_BEGIN(ctrptr, NU) \
    { LAS unsigned* ubox_ = (LAS unsigned*)(lds + 146440); unsigned nxt_ = 0u; \
      if (threadIdx.x == 0) ubox_[0] = atomicAdd((ctrptr), 1u); \
      __syncthreads(); \
      for (;;) { const unsigned ul = ubox_[0]; if (ul >= (unsigned)(NU)) break; \
          __syncthreads(); \
          if (threadIdx.x == 0) nxt_ = atomicAdd((ctrptr), 1u);
#define UNIT_LOOP_END() \
          if (threadIdx.x == 0) ubox_[0] = nxt_; \
          __syncthreads(); } }

__device__ __forceinline__ void phase_cmp(const Params& p, LAS unsigned char* lds) {
    const int tid = threadIdx.x, lane = tid & 63, wave = __builtin_amdgcn_readfirstlane(tid >> 6), c = lane & 15;
    const bf16_t* proj = (const bf16_t*)(p.ws + WS_BIG); bf16_t* obuf = (bf16_t*)(p.ws + WS_O); unsigned* selm = (unsigned*)(p.ws + WS_SELM);
    build_bias(p, lds);
    { LAS float* bt = (LAS float*)(lds + L_BIAS); const u32x4* kc = (const u32x4*)(p.ws + WS_KCMP) + (size_t)wave * NCMP * 12; float n2m = 0.f;
      for (int r = lane; r < NCMP; r += 64) { float n2 = 0.f;
#pragma unroll
        for (int ch = 0; ch < 12; ++ch) { const u32x4 w = kc[r * 12 + ch];
            n2 += bf_lo(w.x) * bf_lo(w.x) + bf_hi(w.x) * bf_hi(w.x) + bf_lo(w.y) * bf_lo(w.y) + bf_hi(w.y) * bf_hi(w.y) + bf_lo(w.z) * bf_lo(w.z) + bf_hi(w.z) * bf_hi(w.z) + bf_lo(w.w) * bf_lo(w.w) + bf_hi(w.w) * bf_hi(w.w); }
        n2m = fmaxf(n2m, n2); }
#pragma unroll
      for (int o = 1; o < 64; o <<= 1) n2m = fmaxf(n2m, __shfl_xor(n2m, o));
      if (lane == 0) bt[wave * 132 + 130] = sqrtf(n2m);
      __syncthreads(); }
    LAS float* imp = (LAS float*)(lds + L_IMP);
    UNIT_LOOP_BEGIN((unsigned*)(p.ws + WS_UCTR) + (blockIdx.x & 7), 512)
        const int bg = blockIdx.x & 7, b = bg >> 2, g = bg & 3, t0 = (511 - (int)ul) * 32;
        TileSrc src; src.K = (const bf16_t*)(p.ws + WS_KCMP) + (size_t)bg * NCMP * DK; src.V = (const bf16_t*)(p.ws + WS_VCMP) + (size_t)bg * NCMP * DV; src.kld = DK; src.vld = DV;
        const int nt = t0 / 1024 + 1;
        const LAS float* biasrow = (const LAS float*)(lds + L_BIAS) + (g * 8 + (c & 7)) * 132; const float bias_far = biasrow[128];
        PairState st[2];
#pragma unroll
        for (int pi = 0; pi < 2; ++pi) { reset_state(st[pi]); load_q(st[pi], proj, b, g, t0 + 4 * wave + 2 * pi, lane, ((const LAS float*)(lds + L_BIAS))[bg * 132 + 130], biasrow[129]); }
#pragma unroll
        for (int i = 0; i < 16; ++i) imp[(4 * wave) * 256 + i * 64 + lane] = 0.f;
        DmaPlan pl; make_plan(pl, src, wave, lane);
        const unsigned ring = (unsigned)(size_t)(lds + L_RING);
#pragma unroll 1
        for (int pass = 0; pass < 2; ++pass) {
            if (pass == 1) {
#pragma unroll
                for (int pi = 0; pi < 2; ++pi) { float lt = st[pi].l; lt += __shfl_xor(lt, 16); lt += __shfl_xor(lt, 32); if (lt > 0.f) st[pi].m += __builtin_amdgcn_logf(lt); }
            }
            for (int d = 0; d < PD && d < nt; ++d) issue_tile(pl, src, 64 * d, ring + d * SLOT_BYTES, wave);
            int slot = 0, islot = PD;
#pragma unroll 1
            for (int i = 0; i < nt; ++i) {
                { int rem = nt - 1 - i; rem = rem < PD - 1 ? rem : PD - 1; att_wait_bar(rem); }
                if (i + PD < nt) issue_tile(pl, src, 64 * (i + PD), ring + islot * SLOT_BYTES, wave);
                const LAS unsigned char* Kt = lds + L_RING + slot * SLOT_BYTES; const LAS unsigned char* Vt = Kt + SLOT_K;
#pragma unroll
                for (int pi = 0; pi < 2; ++pi) { const int tq0 = t0 + 4 * wave + 2 * pi; const int P0 = 16 * 64 * i + 31;
                    if (tq0 + 1 < P0) continue;
                    const bool far = (tq0 - (P0 + 63 * 16)) >= 113;
                    const int tadj = tq0 + (c >> 3) - P0;
                    if (pass == 0) PAIR_TILE(0, far, st[pi], Kt, Vt, tadj, 16, 1 << 30, true, biasrow, bias_far, nullptr, 0, lane);
                    else PAIR_TILE(1, far, st[pi], Kt, Vt, tadj, 16, 1 << 30, true, biasrow, bias_far, imp + (4 * wave + 2 * pi + (c >> 3)) * 256, 16 * i, lane); }
                slot = slot + 1 == RING ? 0 : slot + 1; islot = islot + 1 == RING ? 0 : islot + 1;
            }
            ATT_WAIT_BAR(0);
        }
#pragma unroll
        for (int pi = 0; pi < 2; ++pi) write_out<false>(st[pi], 1.0f, proj, obuf, b, g, t0 + 4 * wave + 2 * pi, 0, lane);
        asm volatile("s_waitcnt lgkmcnt(0)" ::: "memory");
#pragma unroll 1
        for (int qq = 0; qq < 4; ++qq) {
            const int t = t0 + 4 * wave + qq, cur = t >> 6;
            unsigned key[4]; bool sel[4];
#pragma unroll
            for (int i = 0; i < 4; ++i) { const int j = lane + 64 * i; const float v = imp[(4 * wave + qq) * 256 + j];
                sel[i] = (j == 0) || (j == cur) || (j == cur - 1);
                const bool cand = (j >= 1) && (j <= cur - 2);
                key[i] = cand ? (__float_as_uint(v) + 1u) : 0u; }
            const int need = 16 - (1 + (cur >= 1) + (cur >= 2));
            unsigned T = 0u;
#pragma unroll 1
            for (int bit = 31; bit >= 0; --bit) { const unsigned cand = T | (1u << bit);
                const int cnt = __popcll(__ballot(key[0] >= cand)) + __popcll(__ballot(key[1] >= cand)) + __popcll(__ballot(key[2] >= cand)) + __popcll(__ballot(key[3] >= cand));
                if (cnt >= need) T = cand; }
            if (T == 0u) T = 1u;
            int above = 0;
#pragma unroll
            for (int i = 0; i < 4; ++i) above += __popcll(__ballot(key[i] > T));
            int room = need - above;
#pragma unroll
            for (int i = 0; i < 4; ++i) { const unsigned long long eq = __ballot(key[i] == T); const int rank = __popcll(eq & ((1ull << lane) - 1ull));
                sel[i] = sel[i] || (key[i] > T) || (key[i] == T && rank < room); room -= __popcll(eq); }
            unsigned* mrow = selm + ((size_t)bg * SEQ + t) * 8;
#pragma unroll
            for (int i = 0; i < 4; ++i) { const unsigned long long bal = __ballot(sel[i]); if (lane == 0) { mrow[2 * i] = (unsigned)bal; mrow[2 * i + 1] = (unsigned)(bal >> 32); } }
        }
    UNIT_LOOP_END()
}

__device__ __forceinline__ void build_order(const LAS unsigned* lsel, LAS unsigned char* ord, LAS int* cnt, int cb, int nq, int lane) {
    int base = 0;
#pragma unroll 1
    for (int r = 0; 64 * r <= cb; ++r) { const int j = lane + 64 * r; unsigned m = 0u;
        for (int q = 0; q < nq; ++q) m |= lsel[q * 8 + (j >> 5)];
        const bool need = (j <= cb) && ((m >> (j & 31)) & 1u);
        const unsigned long long bal = __ballot(need);
        if (need) ord[base + __popcll(bal & ((1ull << lane) - 1ull))] = (unsigned char)j;
        base += __popcll(bal); }
    if (lane == 0) *cnt = base;
}

template <bool WIN, int NP>
__device__ __forceinline__ void phase_ws(const Params& p, LAS unsigned char* lds) {
    constexpr int QW = 2 * NP, QU = 8 * QW, NUNIT = MT * NG / QU;
    const int tid = threadIdx.x, lane = tid & 63, wave = __builtin_amdgcn_readfirstlane(tid >> 6), c = lane & 15;
    const bf16_t* proj = (const bf16_t*)(p.ws + WS_BIG); bf16_t* obuf = (bf16_t*)(p.ws + WS_O); const unsigned* selm = (const unsigned*)(p.ws + WS_SELM);
    build_bias(p, lds);
    LAS unsigned* lsel = (LAS unsigned*)(lds + L_SELM);
    UNIT_LOOP_BEGIN((unsigned*)(p.ws + WS_UCTR) + (WIN ? 8 : 16) + (blockIdx.x & 7), NUNIT / 8)
        const int bg = blockIdx.x & 7, b = bg >> 2, g = bg & 3, t0 = (SEQ / QU - 1 - (int)ul) * QU;
        TileSrc src; src.kld = NPROJ; src.vld = NPROJ;
        src.K = proj + (size_t)b * SEQ * NPROJ + (WIN ? C_KW : C_KS) + g * DK; src.V = proj + (size_t)b * SEQ * NPROJ + (WIN ? C_VW : C_VS) + g * DV;
        const int cb = t0 >> 6;
        const int kstart = WIN ? (cb >= 8 ? (cb - 8) * 64 : 0) : 0;
        const int nt = cb + 1 - kstart / 64;
        const LAS float* biasrow = (const LAS float*)(lds + L_BIAS) + (g * 8 + (c & 7)) * 132; const float bias_far = biasrow[128];
        const float kmx = __uint_as_float(((const unsigned*)(p.ws + WS_KMAX))[(WIN ? 8 : 0) + bg]);
        LAS unsigned char* ord = (LAS unsigned char*)(lds + L_SELM + 1024);
        int npos = nt;
        if (!WIN) { if (tid < QU * 8) lsel[tid] = selm[((size_t)bg * SEQ + t0) * 8 + tid];
            __syncthreads();
            if (wave == 0) build_order(lsel, ord, (LAS int*)(lds + L_SELM + 1024 + 256), cb, QU, lane);
            __syncthreads();
            npos = *(LAS int*)(lds + L_SELM + 1024 + 256); }
        PairState st[NP];
#pragma unroll
        for (int pi = 0; pi < NP; ++pi) { reset_state(st[pi]); load_q(st[pi], proj, b, g, t0 + QW * wave + 2 * pi, lane, kmx, biasrow[129]); }
        DmaPlan pl; make_plan(pl, src, wave, lane);
        const unsigned ring = (unsigned)(size_t)(lds + L_RING);
#define WS_TILE(pos) (WIN ? (pos) : (int)ord[pos])
        for (int d = 0; d < 4 && d < npos; ++d) issue_tile(pl, src, kstart + 64 * WS_TILE(d), ring + d * SLOT_BYTES, wave);
        int slot = 0, islot = 4;
#pragma unroll 1
        for (int i0 = 0; i0 < npos; i0 += 2) {
            { const int issued = npos < i0 + 4 ? npos : i0 + 4, done = npos < i0 + 2 ? npos : i0 + 2; att_wait_bar(issued - done); }
#pragma unroll 1
            for (int e = 0; e < 2; ++e) { if (i0 + e >= npos) break; const int i = WS_TILE(i0 + e);
                const LAS unsigned char* Kt = lds + L_RING + slot * SLOT_BYTES; const LAS unsigned char* Vt = Kt + SLOT_K;
                slot = slot + 1 == RING_WS ? 0 : slot + 1;
                const int P0 = kstart + 64 * i;
#pragma unroll
                for (int pi = 0; pi < NP; ++pi) { const int tq0 = t0 + QW * wave + 2 * pi;
                    bool rowsel = true; bool allsel = true;
                    if (!WIN) { const unsigned w = lsel[(QW * wave + 2 * pi + (c >> 3)) * 8 + (i >> 5)]; rowsel = (w >> (i & 31)) & 1u;
                        const unsigned long long bal = __ballot(rowsel); if (bal == 0ull) continue; allsel = (bal == ~0ull); }
                    else { if (tq0 + 1 < P0 || tq0 - (P0 + 63) >= 512) continue; }
                    const bool far = allsel && (tq0 - (P0 + 63) >= 113) && (!WIN || (tq0 + 1 - P0 < 512));
                    PAIR_TILE(2, far, st[pi], Kt, Vt, tq0 + (c >> 3) - P0, 1, WIN ? 512 : (1 << 30), rowsel, biasrow, bias_far, nullptr, 0, lane); } }
#pragma unroll
            for (int e = 0; e < 2; ++e) { if (i0 + 4 + e < npos) issue_tile(pl, src, kstart + 64 * WS_TILE(i0 + 4 + e), ring + islot * SLOT_BYTES, wave); islot = islot + 1 == RING_WS ? 0 : islot + 1; }
        }
#undef WS_TILE
        ATT_WAIT_BAR(0);
#pragma unroll
        for (int pi = 0; pi < NP; ++pi) { float lt = st[pi].l; lt += __shfl_xor(lt, 16); lt += __shfl_xor(lt, 32);
            write_out<true>(st[pi], lt > 0.f ? 1.0f / lt : 0.f, proj, obuf, b, g, t0 + QW * wave + 2 * pi, WIN ? 2 : 1, lane); }
    UNIT_LOOP_END()
}

template <int W>
__device__ __forceinline__ void pool_item(const bf16_t* ub, bf16_t* pooled, int row, int t, int ch) {
    u32x4 v[W];
#pragma unroll
    for (int k = 0; k < W; ++k) v[k] = *(const u32x4*)(ub + (size_t)(k <= t ? row - k : row) * DM + ch * 8);
    const int cnt = (t + 1 < W) ? t + 1 : W;
    float acc[8] = {0.f, 0.f, 0.f, 0.f, 0.f, 0.f, 0.f, 0.f};
#pragma unroll
    for (int k = 0; k < W; ++k) { const float m = k < cnt ? 1.0f : 0.0f;
        acc[0] += m * bf_lo(v[k].x); acc[1] += m * bf_hi(v[k].x); acc[2] += m * bf_lo(v[k].y); acc[3] += m * bf_hi(v[k].y); acc[4] += m * bf_lo(v[k].z); acc[5] += m * bf_hi(v[k].z); acc[6] += m * bf_lo(v[k].w); acc[7] += m * bf_hi(v[k].w); }
    const float ic = 1.0f / (float)cnt; const u32x4 self = v[0];
    u32x4 o; o.x = cvt_pk_bf16(acc[0] * ic - bf_lo(self.x), acc[1] * ic - bf_hi(self.x)); o.y = cvt_pk_bf16(acc[2] * ic - bf_lo(self.y), acc[3] * ic - bf_hi(self.y));
    o.z = cvt_pk_bf16(acc[4] * ic - bf_lo(self.z), acc[5] * ic - bf_hi(self.z)); o.w = cvt_pk_bf16(acc[6] * ic - bf_lo(self.w), acc[7] * ic - bf_hi(self.w));
    *(u32x4*)(pooled + (size_t)row * DM + ch * 8) = o;
}
__device__ __forceinline__ void phase_pool(const Params& p) {
    const bf16_t* ub = (const bf16_t*)(p.ws + WS_BIG); bf16_t* pooled = (bf16_t*)(p.ws + WS_BIG + 128 * MiB);
    const int nthr = gridDim.x * NTHR;
    for (int it = blockIdx.x * NTHR + threadIdx.x; it < MT * 256; it += nthr) {
        const int row = it >> 8, ch = it & 255, t = row & (SEQ - 1); const int gi = ch >> 6;
        if (gi == 0) pool_item<2>(ub, pooled, row, t, ch); else if (gi == 1) pool_item<4>(ub, pooled, row, t, ch);
        else if (gi == 2) pool_item<8>(ub, pooled, row, t, ch); else pool_item<16>(ub, pooled, row, t, ch);
    }
}
__device__ __forceinline__ void phase_final(const Params& p) {
    const int lane = threadIdx.x & 63, wave = threadIdx.x >> 6; const int gw = blockIdx.x * NWAVES + wave, ngw = gridDim.x * NWAVES;
    const float* ssq = (const float*)(p.ws + WS_SSQ) + 4 * (size_t)MT;
    for (int row = gw; row < MT; row += ngw) { const float rs = rsqrtf(ssq[row] * (1.0f / DM) + EPS);
        f32x4* xr = (f32x4*)(p.out + (size_t)row * DM) + lane; const f32x4* gr = (const f32x4*)p.norm_final + lane;
#pragma unroll
        for (int j = 0; j < 8; ++j) xr[64 * j] = xr[64 * j] * rs * gr[64 * j]; }
}

#define XB_TMO      128
#define XB_XCNT(j)  (256  + 64 * (j))
#define XB_XSUB(j)  (1280 + 64 * (j))
#define XB_XGEN(j)  (2304 + 64 * (j))
#define XB_TOP      3328
#define XB_TOPGEN   3392
#define XCD_BAR_WORDS 3456
#define XB_SPIN_CAP (1u << 18)

__device__ __forceinline__ unsigned xb_ld(unsigned* p)              { return __hip_atomic_load(p, __ATOMIC_RELAXED, __HIP_MEMORY_SCOPE_AGENT); }
__device__ __forceinline__ unsigned xb_add(unsigned* p, unsigned v) { return __hip_atomic_fetch_add(p, v, __ATOMIC_RELAXED, __HIP_MEMORY_SCOPE_AGENT); }
__device__ __forceinline__ unsigned xb_xcc_id() { return (unsigned)__builtin_amdgcn_s_getreg((3 << 11) | 20) & 0xFu; }
#define XB_SPIN(cond, bar) do { unsigned _sp = 0; while (cond) { __builtin_amdgcn_s_sleep(1); \
    if ((++_sp & 255u) == 0u) { if (xb_ld(&(bar)[XB_TMO])) break; if (_sp > XB_SPIN_CAP) { atomicAdd(&(bar)[XB_TMO], 1u); break; } } } } while (0)

struct XcdBarrier {
    unsigned* bar; unsigned x;
    volatile LAS unsigned* st;
};

__device__ __forceinline__ XcdBarrier xcd_barrier_post(unsigned* bar, volatile LAS unsigned* st) {
    XcdBarrier b; b.bar = bar; b.x = xb_xcc_id(); b.st = st;
    if (threadIdx.x == 0) (void)xb_add(&bar[XB_XCNT(b.x)], 1u);
    return b;
}
__device__ __forceinline__ void xcd_barrier_complete(unsigned* bar, unsigned x, unsigned& nloc, unsigned& nx) {
    const unsigned G = gridDim.x * gridDim.y * gridDim.z;
    unsigned sum, cnt, mine, sp = 0u;
    for (;;) {
        sum = 0u; cnt = 0u; mine = 0u;
#pragma unroll
        for (unsigned j = 0; j < 16; ++j) { const unsigned c = xb_ld(&bar[XB_XCNT(j)]); sum += c; cnt += (c > 0u) ? 1u : 0u; mine = (j == x) ? c : mine; }
        if (sum == G) break;
        __builtin_amdgcn_s_sleep(1);
        if ((++sp & 255u) == 0u) { if (xb_ld(&bar[XB_TMO])) break; if (sp > XB_SPIN_CAP) { atomicAdd(&bar[XB_TMO], 1u); break; } }
    }
    nloc = mine > 0u ? mine : 1u; nx = cnt > 0u ? cnt : 1u;
}

__device__ __forceinline__ void xcd_barrier(const XcdBarrier& b) {
    asm volatile("s_waitcnt vmcnt(0)" ::: "memory");
    __syncthreads();
    if (threadIdx.x == 0) {
        unsigned* bar = b.bar;
        __builtin_amdgcn_s_waitcnt(0);
        unsigned nloc = b.st[0], nx = b.st[1];
        if (nloc == 0u) { xcd_barrier_complete(bar, b.x, nloc, nx); b.st[0] = nloc; b.st[1] = nx; }
        const unsigned old = xb_add(&bar[XB_XSUB(b.x)], 1u);
        const unsigned gen = old / nloc;
        if (old + 1u == (gen + 1u) * nloc) {
            __builtin_amdgcn_fence(__ATOMIC_RELEASE, "agent");
            asm volatile("s_waitcnt vmcnt(0)" ::: "memory");
            const unsigned og = xb_add(&bar[XB_TOP], 1u);
            const unsigned tg = og / nx;
            if (og + 1u == (tg + 1u) * nx) xb_add(&bar[XB_TOPGEN], 1u);
            else XB_SPIN(xb_ld(&bar[XB_TOPGEN]) == tg, bar);
            __builtin_amdgcn_fence(__ATOMIC_ACQUIRE, "agent");
            xb_add(&bar[XB_XGEN(b.x)], 1u);
            asm volatile("s_waitcnt vmcnt(0)" ::: "memory");
        } else {
            XB_SPIN(xb_ld(&bar[XB_XGEN(b.x)]) == gen, bar);
            __builtin_amdgcn_fence(__ATOMIC_ACQUIRE, "agent");
            asm volatile("s_waitcnt vmcnt(0)" ::: "memory");
        }
    }
    __syncthreads();
}

#define GSYNC_() do { asm volatile("s_waitcnt vmcnt(0) lgkmcnt(0)" ::: "memory"); __builtin_amdgcn_fence(__ATOMIC_RELEASE, "agent"); grid.sync(); __builtin_amdgcn_fence(__ATOMIC_ACQUIRE, "agent"); } while (0)
#define GSYNC() xcd_barrier(xbar)
__global__ void __launch_bounds__(NTHR, 2) fwd_megakernel(Params p) {
    extern __shared__ __attribute__((aligned(16))) unsigned char lds_raw[];
    LAS unsigned char* lds = (LAS unsigned char*)lds_raw;
    cg::grid_group grid = cg::this_grid();
    volatile LAS unsigned* xst = (volatile LAS unsigned*)(lds + 146432);
    if (threadIdx.x < 2) xst[threadIdx.x] = 0u;
    __syncthreads();
    const XcdBarrier xbar = xcd_barrier_post((unsigned*)(p.ws + WS_XBAR), xst);
    unsigned char* ws = p.ws;
    float* ssq = (float*)(ws + WS_SSQ);
    bf16_t* xb = (bf16_t*)(ws + WS_XB); bf16_t* obuf = (bf16_t*)(ws + WS_O); bf16_t* big = (bf16_t*)(ws + WS_BIG);
    const int G = gridDim.x, cidx = blockIdx.x;
    pg8::StaticOrder S;

    phase_prologue(p, lds);
    if (p.ws == nullptr) GSYNC_();
    GSYNC();
    { pg8::Gemm g{xb, (const bf16_t*)(ws + WS_W_IN), DM, DM, MT, NPROJ, DM, 0}; S.init(MT, NPROJ, G, cidx); pg8::EpiProj E{big, ssq}; pg8::gemm_phase(lds, g, S, E); }
    GSYNC();
    phase_compress(p, lds);
    GSYNC();
    phase_cmp(p, lds);
    GSYNC();
    phase_ws<true, 2>(p, lds);
    GSYNC();
    phase_ws<false, 2>(p, lds);
    GSYNC();
    { pg8::Gemm g{obuf, (const bf16_t*)(ws + WS_W_OUT), DM, DM, MT, DM, DM, 0}; S.init(MT, DM, G, cidx); pg8::EpiRes E{p.x, p.out, xb, ssq + MT}; pg8::gemm_phase(lds, g, S, E); }
    GSYNC();
    { pg8::Gemm g{xb, (const bf16_t*)(ws + WS_W_GU0), DM, DM, MT, 2 * DFF, DM, 0}; S.init(MT, 2 * DFF, G, cidx); pg8::EpiSwiglu E{big, ssq + MT}; pg8::gemm_phase(lds, g, S, E); }
    GSYNC();
    { pg8::Gemm g{big, (const bf16_t*)(ws + WS_W_DN0), DFF, DFF, MT, DM, DFF, 0}; S.init(MT, DM, G, cidx); pg8::EpiRes E{p.out, p.out, xb, ssq + 2 * MT}; pg8::gemm_phase(lds, g, S, E); }
    GSYNC();
    { pg8::Gemm g{xb, (const bf16_t*)(ws + WS_P_IN), DM, DM, MT, DM, DM, 0}; S.init(MT, DM, G, cidx); pg8::EpiRowScale E{big, ssq + 2 * MT}; pg8::gemm_phase(lds, g, S, E); }
    GSYNC();
    phase_pool(p);
    GSYNC();
    { pg8::Gemm g{(const bf16_t*)(ws + WS_BIG + 128 * MiB), (const bf16_t*)(ws + WS_P_GRP), DM, 512, MT, DM, 512, 1024}; S.init(MT, DM, G, cidx); pg8::EpiColScale E{obuf, p.pool_scale}; pg8::gemm_phase(lds, g, S, E); }
    GSYNC();
    { pg8::Gemm g{obuf, (const bf16_t*)(ws + WS_P_OUT), DM, DM, MT, DM, DM, 0}; S.init(MT, DM, G, cidx); pg8::EpiRes E{p.out, p.out, xb, ssq + 3 * MT}; pg8::gemm_phase(lds, g, S, E); }
    GSYNC();
    { pg8::Gemm g{xb, (const bf16_t*)(ws + WS_W_GU1), DM, DM, MT, 2 * DFF, DM, 0}; S.init(MT, 2 * DFF, G, cidx); pg8::EpiSwiglu E{big, ssq + 3 * MT}; pg8::gemm_phase(lds, g, S, E); }
    GSYNC();
    { pg8::Gemm g{big, (const bf16_t*)(ws + WS_W_DN1), DFF, DFF, MT, DM, DFF, 0}; S.init(MT, DM, G, cidx); pg8::EpiRes E{p.out, p.out, xb, ssq + 4 * MT}; pg8::gemm_phase(lds, g, S, E); }
    GSYNC();
    phase_final(p);
}

extern "C" void kernel_launch(void* const* d_in, const int* in_sizes, int n_in, void* d_out, int out_size, void* d_ws, size_t ws_size, hipStream_t stream) {
    static int grid_blocks = 0;
    if (grid_blocks == 0) {
        if (n_in != 21 || ws_size < WS_END) { fprintf(stderr, "kernel_launch: unexpected inputs (n_in %d, ws %zu)\n", n_in, ws_size); grid_blocks = -1; return; }
        int dev = 0, cus = 0, per_cu = 0;
        hipGetDevice(&dev); hipDeviceGetAttribute(&cus, hipDeviceAttributeMultiprocessorCount, dev);
        if (hipFuncSetAttribute((const void*)fwd_megakernel, hipFuncAttributeMaxDynamicSharedMemorySize, LDS_BYTES) != hipSuccess) { fprintf(stderr, "kernel_launch: hipFuncSetAttribute failed\n"); grid_blocks = -1; return; }
        if (hipOccupancyMaxActiveBlocksPerMultiprocessor(&per_cu, (const void*)fwd_megakernel, NTHR, LDS_BYTES) != hipSuccess || per_cu < 1) { fprintf(stderr, "kernel_launch: occupancy query failed (%d)\n", per_cu); (void)hipGetLastError(); per_cu = 1; }
        grid_blocks = cus * 1;
    }
    if (grid_blocks < 0) return;
    Params p{};
    p.x = (const float*)d_in[0]; p.norm_mix = (const float*)d_in[1]; p.norm_ffn = (const float*)d_in[2]; p.norm_final = (const float*)d_in[3]; p.rel_bias = (const float*)d_in[4];
    p.nsa_w_in = (const float*)d_in[5]; p.pos_k = (const float*)d_in[6]; p.pos_v = (const float*)d_in[7]; p.ck_w1 = (const float*)d_in[8]; p.ck_b1 = (const float*)d_in[9]; p.ck_w2 = (const float*)d_in[10];
    p.cv_w1 = (const float*)d_in[11]; p.cv_b1 = (const float*)d_in[12]; p.cv_w2 = (const float*)d_in[13]; p.nsa_w_out = (const float*)d_in[14];
    p.pool_w_in = (const float*)d_in[15]; p.pool_w_grp = (const float*)d_in[16]; p.pool_scale = (const float*)d_in[17]; p.pool_w_out = (const float*)d_in[18]; p.ffn_w_gu = (const float*)d_in[19]; p.ffn_w_down = (const float*)d_in[20];
    p.out = (float*)d_out; p.ws = (unsigned char*)d_ws;
    if (hipMemsetAsync((char*)d_ws + WS_XBAR, 0, 16384, stream) != hipSuccess) { fprintf(stderr, "kernel_launch: hipMemsetAsync failed\n"); return; }
    void* args[] = {&p};
    hipError_t e = hipLaunchCooperativeKernel((const void*)fwd_megakernel, dim3(grid_blocks), dim3(NTHR), args, LDS_BYTES, stream);
    if (e != hipSuccess) fprintf(stderr, "cooperative launch failed: %s (grid %d)\n", hipGetErrorString(e), grid_blocks);
}
```

```cpp
#include <hip/hip_runtime.h>
#include <hip/hip_cooperative_groups.h>
#include <cstdio>
#include <cstdint>
namespace cg = cooperative_groups;

#define LAS __attribute__((address_space(3)))
typedef unsigned short bf16_t;
typedef short bf16x8 __attribute__((ext_vector_type(8)));
typedef float f32x4 __attribute__((ext_vector_type(4)));
typedef float f32x2 __attribute__((ext_vector_type(2)));
typedef unsigned u32x4 __attribute__((ext_vector_type(4)));
typedef unsigned u32x2 __attribute__((ext_vector_type(2)));

constexpr int BATCH = 2, SEQ = 16384, DM = 2048, MT = BATCH * SEQ;
constexpr int NG = 4, HG = 8, DK = 96, DV = 64;
constexpr int NPROJ = 5120;
constexpr int C_VC = 3072, C_VS = 3328, C_VW = 3584, C_KC = 3840, C_KS = 4224, C_KW = 4608, C_GATE = 4992;
constexpr int DFF = 5632;
constexpr int NCMP = 1024;
constexpr float EPS = 1e-6f;
constexpr float NEGF = -1e30f;

constexpr size_t MiB = 1u << 20;
constexpr size_t WS_SSQ = 0;
constexpr size_t WS_XBAR = 768 * 1024;
constexpr size_t WS_KMAX = 900 * 1024;
constexpr size_t WS_W_IN = 1 * MiB;
constexpr size_t WS_W_OUT = 21 * MiB;
constexpr size_t WS_W_GU0 = 29 * MiB, WS_W_GU1 = 73 * MiB;
constexpr size_t WS_W_DN0 = 117 * MiB, WS_W_DN1 = 139 * MiB;
constexpr size_t WS_P_IN = 161 * MiB, WS_P_GRP = 169 * MiB, WS_P_OUT = 171 * MiB;
constexpr size_t WS_CK1 = 179 * MiB, WS_CV1 = 181 * MiB, WS_CK2 = 182 * MiB, WS_CV2 = 182 * MiB + 65536;
constexpr size_t WS_KCMP = 183 * MiB, WS_VCMP = 185 * MiB, WS_SELM = 186 * MiB;
constexpr size_t WS_XB = 190 * MiB;
constexpr size_t WS_O = 318 * MiB;
constexpr size_t WS_BIG = 446 * MiB;
constexpr size_t WS_END = 798 * MiB;

typedef __bf16 bf16x2_t __attribute__((ext_vector_type(2)));
__device__ __forceinline__ unsigned cvt_pk_bf16(float lo, float hi) { const f32x2 v = {lo, hi}; const bf16x2_t b = __builtin_convertvector(v, bf16x2_t); return __builtin_bit_cast(unsigned, b); }
__device__ __forceinline__ float bf_lo(unsigned u) { return __uint_as_float(u << 16); }
__device__ __forceinline__ float bf_hi(unsigned u) { return __uint_as_float(u & 0xffff0000u); }
__device__ __forceinline__ float wave_sum(float v) {
#pragma unroll
    for (int o = 1; o < 64; o <<= 1) v += __shfl_xor(v, o);
    return v;
}

namespace pg8 {
constexpr int BM = 256, BK = 64, HALF = 128, HTB = HALF * BK * 2, STAGE_BYTES = 8 * HTB, NXCD = 8, WGM = 8;
__host__ __device__ __forceinline__ int lds_byte(int r, int c) { const int st = (r >> 4) * 2 + (c >> 5), rr = r & 15, cc = c & 31, ob = rr * 64 + cc * 2; return st * 1024 + (ob ^ (((ob >> 9) & 1) << 5)); }
__host__ __device__ __forceinline__ void stage_rc(int b, int& R, int& C) { const int st = b / 1024, sb = b % 1024, swz = sb ^ (((sb >> 9) & 1) << 5); R = (st >> 1) * 16 + swz / 64; C = (st & 1) * 32 + (swz % 64) / 2; }
__host__ __device__ __forceinline__ int perm32(int rho) { const int n = rho >> 4, i = rho & 15; return 8 * (i >> 2) + 4 * n + (i & 3); }

struct Unit { int pm, pn; };
struct Gemm { const bf16_t* A; const bf16_t* Bt; int lda, ldb, M, N, K; int acolb; };

struct StaticOrder {
    int nM, nN, nwg, G, c;
    __device__ void init(int M, int N, int G_, int c_) { nM = M / BM; nN = N / BM; nwg = nM * nN; G = G_; c = c_; }
    __device__ bool next(int i, Unit& u) const {
        const long L = (long)i * G + c; if (L >= nwg) return false;
        int wgid = (int)L; { const int q = nwg / NXCD, r = nwg % NXCD, xcd = wgid % NXCD, off = wgid / NXCD; wgid = (xcd < r ? xcd * (q + 1) : r * (q + 1) + (xcd - r) * q) + off; }
        const int nig = WGM * nN, gid = wgid / nig, fm = gid * WGM, gsz = (nM - fm) < WGM ? (nM - fm) : WGM;
        u.pm = fm + ((wgid % nig) % gsz); u.pn = (wgid % nig) / gsz; return true;
    }
};

template <class Epi>
__device__ __forceinline__ void gemm_phase(LAS unsigned char* lds, const Gemm g, const StaticOrder& S, const Epi& E) {
    const int tid = threadIdx.x, wid = __builtin_amdgcn_readfirstlane(tid >> 6), lane = tid & 63, wr = wid >> 2, wc = wid & 3, fr = lane & 15, fq = lane >> 4;
    const int K = g.K, nt = K / BK;
    unsigned voffA[2], voffB[2];
#pragma unroll
    for (int i = 0; i < 2; ++i) { int R, C; stage_rc(tid * 16 + i * 8192, R, C); const int Rb = (R & ~31) + perm32(R & 31);
        voffA[i] = (unsigned)(R * g.lda + C) * 2u; voffB[i] = (unsigned)(Rb * g.ldb + C) * 2u; }
    const size_t kstep = (size_t)(BK * 2);
    const size_t hstepA = (size_t)HALF * g.lda * 2, hstepB = (size_t)HALF * g.ldb * 2;
    const size_t tstepA = 2 * hstepA, tstepB = 2 * hstepB;
    const unsigned ldsw = (unsigned)wid * 1024u;
    const int aoff = lds_byte(wr * 64 + fr, fq * 8), boff = lds_byte(wc * 32 + fr, fq * 8);
#define PG8_SA(b, h) (((b) * 2 + (h)) * HTB)
#define PG8_SB(b, h) ((4 + (b) * 2 + (h)) * HTB)
#define PG8_STAGE(bufoff, gbase, voff) do { _Pragma("unroll") for (int _i = 0; _i < 2; ++_i) \
        __builtin_amdgcn_global_load_lds((const unsigned*)((const char*)(gbase) + (voff)[_i]), (LAS unsigned*)(lds + (bufoff) + ldsw + _i * 8192), 16, 0, 0); } while (0)
#define PG8_LDA(dst, b, h) do { _Pragma("unroll") for (int m = 0; m < 4; ++m) _Pragma("unroll") for (int k = 0; k < 2; ++k) dst[m][k] = *(const LAS bf16x8*)(lds + PG8_SA(b, h) + aoff + m * 2048 + k * 1024); } while (0)
#define PG8_LDB(dst, b, h) do { _Pragma("unroll") for (int n = 0; n < 2; ++n) _Pragma("unroll") for (int k = 0; k < 2; ++k) dst[n][k] = *(const LAS bf16x8*)(lds + PG8_SB(b, h) + boff + n * 2048 + k * 1024); } while (0)
#define PG8_MMA(ai, bj, At, Bt) do { __builtin_amdgcn_s_setprio(1); _Pragma("unroll") for (int m = 0; m < 4; ++m) _Pragma("unroll") for (int n = 0; n < 2; ++n) _Pragma("unroll") for (int k = 0; k < 2; ++k) \
        acc[ai][bj][m][n] = __builtin_amdgcn_mfma_f32_16x16x32_bf16(Bt[n][k], At[m][k], acc[ai][bj][m][n], 0, 0, 0); __builtin_amdgcn_s_setprio(0); } while (0)
#define PG8_WAIT_V(n) asm volatile("s_waitcnt vmcnt(" #n ")" ::: "memory")
#define PG8_WAIT_L(n) asm volatile("s_waitcnt lgkmcnt(" #n ")" ::: "memory")
#define PG8_BAR __builtin_amdgcn_s_barrier()
#define PG8_SCHED __builtin_amdgcn_sched_barrier(0)
#define PG8_APTR(u) ((const char*)g.A + (size_t)(u).pm * tstepA + (size_t)((u).pn >> 1) * (size_t)g.acolb)
#define PG8_BPTR(u) ((const char*)g.Bt + (size_t)(u).pn * tstepB)
    Unit cur, nxt; int ui = 0;
    if (!S.next(0, cur)) return;
    f32x4 acc[2][2][4][2];
#pragma unroll
    for (int a = 0; a < 2; ++a)
#pragma unroll
        for (int b = 0; b < 2; ++b)
#pragma unroll
            for (int m = 0; m < 4; ++m)
#pragma unroll
                for (int n = 0; n < 2; ++n) acc[a][b][m][n] = (f32x4){0.f, 0.f, 0.f, 0.f};
    bf16x8 At[4][2], B0[2][2], B1[2][2];
    const char* cA = PG8_APTR(cur); const char* cB = PG8_BPTR(cur);
    PG8_STAGE(PG8_SB(0, 0), cB, voffB); PG8_STAGE(PG8_SB(0, 1), cB + hstepB, voffB); PG8_STAGE(PG8_SA(0, 0), cA, voffA); PG8_STAGE(PG8_SA(0, 1), cA + hstepA, voffA);
    if (wr == 1) PG8_BAR;
    PG8_WAIT_V(2); PG8_BAR;
    PG8_STAGE(PG8_SB(1, 0), cB + kstep, voffB); PG8_STAGE(PG8_SA(1, 0), cA + kstep, voffA); PG8_STAGE(PG8_SB(1, 1), cB + hstepB + kstep, voffB);
    PG8_WAIT_V(6); PG8_BAR;
    for (;;) {
        const bool has_next = S.next(ui + 1, nxt);
        const char* nA = has_next ? PG8_APTR(nxt) : cA; const char* nB = has_next ? PG8_BPTR(nxt) : cB;
        for (int t = 0; t < nt; t += 2) {
            const bool last = (t == nt - 2);
            const char* a1 = cA + (size_t)(t + 1) * kstep;
            const char* a2 = last ? nA : cA + (size_t)(t + 2) * kstep; const char* b2 = last ? nB : cB + (size_t)(t + 2) * kstep;
            const char* a3 = a2 + kstep; const char* b3 = b2 + kstep;
            PG8_LDB(B0, 0, 0); PG8_LDB(B1, 0, 1); PG8_SCHED; PG8_LDA(At, 0, 0); PG8_STAGE(PG8_SA(1, 1), a1 + hstepA, voffA);
            PG8_WAIT_V(8); PG8_WAIT_L(0); PG8_BAR; PG8_MMA(0, 0, At, B0); PG8_MMA(0, 1, At, B1); PG8_BAR; PG8_SCHED;
            PG8_LDA(At, 0, 1); PG8_STAGE(PG8_SB(0, 0), b2, voffB); PG8_STAGE(PG8_SB(0, 1), b2 + hstepB, voffB); PG8_STAGE(PG8_SA(0, 0), a2, voffA);
            PG8_WAIT_V(8); PG8_WAIT_L(0); PG8_BAR; PG8_MMA(1, 0, At, B0); PG8_MMA(1, 1, At, B1); PG8_BAR; PG8_SCHED;
            PG8_LDB(B0, 1, 0); PG8_LDB(B1, 1, 1); PG8_SCHED; PG8_LDA(At, 1, 0); PG8_STAGE(PG8_SA(0, 1), a2 + hstepA, voffA);
            PG8_WAIT_V(8); PG8_WAIT_L(0); PG8_BAR; PG8_MMA(0, 0, At, B0); PG8_MMA(0, 1, At, B1); PG8_BAR; PG8_SCHED;
            PG8_LDA(At, 1, 1); PG8_STAGE(PG8_SB(1, 0), b3, voffB); PG8_STAGE(PG8_SB(1, 1), b3 + hstepB, voffB); PG8_STAGE(PG8_SA(1, 0), a3, voffA);
            PG8_WAIT_V(8); PG8_WAIT_L(0); PG8_BAR; PG8_MMA(1, 0, At, B0); PG8_MMA(1, 1, At, B1); PG8_BAR; PG8_SCHED;
        }
        if (wr == 0) PG8_BAR;
        E(acc, cur, wr, wc, fr, fq);
        if (!has_next) break;
#pragma unroll
        for (int a = 0; a < 2; ++a)
#pragma unroll
            for (int b = 0; b < 2; ++b)
#pragma unroll
                for (int m = 0; m < 4; ++m)
#pragma unroll
                    for (int n = 0; n < 2; ++n) acc[a][b][m][n] = (f32x4){0.f, 0.f, 0.f, 0.f};
        cur = nxt; cA = nA; cB = nB; ++ui;
        if (wr == 1) PG8_BAR;
    }
    PG8_WAIT_V(0);
    PG8_BAR;
#undef PG8_SA
#undef PG8_SB
#undef PG8_STAGE
#undef PG8_LDA
#undef PG8_LDB
#undef PG8_MMA
#undef PG8_WAIT_V
#undef PG8_WAIT_L
#undef PG8_BAR
#undef PG8_SCHED
#undef PG8_APTR
#undef PG8_BPTR
}

#define EPI_ROW(u, ai, m) ((u).pm * BM + (ai) * HALF + wr * 64 + (m) * 16 + fr)
__device__ __forceinline__ u32x4 pack8(f32x4 v0, f32x4 v1) { u32x4 w; w.x = cvt_pk_bf16(v0[0], v0[1]); w.y = cvt_pk_bf16(v0[2], v0[3]); w.z = cvt_pk_bf16(v1[0], v1[1]); w.w = cvt_pk_bf16(v1[2], v1[3]); return w; }

struct EpiProj {
    bf16_t* O; const float* ssq;
    __device__ __forceinline__ void operator()(const f32x4 (&acc)[2][2][4][2], const Unit& u, int wr, int wc, int fr, int fq) const {
        const float qs = (u.pn < 12) ? 0.10206207261596577f * 1.4426950408889634f : 1.0f;
#pragma unroll
        for (int ai = 0; ai < 2; ++ai)
#pragma unroll
            for (int m = 0; m < 4; ++m) { const int row = EPI_ROW(u, ai, m); const float rs = rsqrtf(ssq[row] * (1.0f / DM) + EPS) * qs;
#pragma unroll
                for (int bj = 0; bj < 2; ++bj) { const int c0 = u.pn * BM + bj * HALF + wc * 32 + 8 * fq;
                    *(u32x4*)(O + (size_t)row * NPROJ + c0) = pack8(acc[ai][bj][m][0] * rs, acc[ai][bj][m][1] * rs); } }
    }
};
struct EpiRowScale {
    bf16_t* O; const float* ssq;
    __device__ __forceinline__ void operator()(const f32x4 (&acc)[2][2][4][2], const Unit& u, int wr, int wc, int fr, int fq) const {
#pragma unroll
        for (int ai = 0; ai < 2; ++ai)
#pragma unroll
            for (int m = 0; m < 4; ++m) { const int row = EPI_ROW(u, ai, m); const float rs = rsqrtf(ssq[row] * (1.0f / DM) + EPS);
#pragma unroll
                for (int bj = 0; bj < 2; ++bj) { const int c0 = u.pn * BM + bj * HALF + wc * 32 + 8 * fq;
                    *(u32x4*)(O + (size_t)row * DM + c0) = pack8(acc[ai][bj][m][0] * rs, acc[ai][bj][m][1] * rs); } }
    }
};
struct EpiColScale {
    bf16_t* O; const float* scale;
    __device__ __forceinline__ void operator()(const f32x4 (&acc)[2][2][4][2], const Unit& u, int wr, int wc, int fr, int fq) const {
#pragma unroll
        for (int bj = 0; bj < 2; ++bj) { const int c0 = u.pn * BM + bj * HALF + wc * 32 + 8 * fq;
            const f32x4 s0 = *(const f32x4*)(scale + c0), s1 = *(const f32x4*)(scale + c0 + 4);
#pragma unroll
            for (int ai = 0; ai < 2; ++ai)
#pragma unroll
                for (int m = 0; m < 4; ++m) { const int row = EPI_ROW(u, ai, m);
                    *(u32x4*)(O + (size_t)row * DM + c0) = pack8(acc[ai][bj][m][0] * s0, acc[ai][bj][m][1] * s1); } }
    }
};
struct EpiSwiglu {
    bf16_t* O; const float* ssq;
    __device__ __forceinline__ void operator()(const f32x4 (&acc)[2][2][4][2], const Unit& u, int wr, int wc, int fr, int fq) const {
        const int c0 = u.pn * HALF + wc * 32 + 8 * fq;
#pragma unroll
        for (int ai = 0; ai < 2; ++ai)
#pragma unroll
            for (int m = 0; m < 4; ++m) { const int row = EPI_ROW(u, ai, m); const float rs = rsqrtf(ssq[row] * (1.0f / DM) + EPS);
                f32x4 r[2];
#pragma unroll
                for (int n = 0; n < 2; ++n)
#pragma unroll
                    for (int j = 0; j < 4; ++j) { const float gt = acc[ai][0][m][n][j] * rs, up = acc[ai][1][m][n][j] * rs; r[n][j] = gt * up * __builtin_amdgcn_rcpf(1.0f + __expf(-gt)); }
                *(u32x4*)(O + (size_t)row * DFF + c0) = pack8(r[0], r[1]); }
    }
};
struct EpiRes {
    const float* src; float* dst; bf16_t* xb; float* ssq_out;
    __device__ __forceinline__ void operator()(const f32x4 (&acc)[2][2][4][2], const Unit& u, int wr, int wc, int fr, int fq) const {
#pragma unroll
        for (int ai = 0; ai < 2; ++ai)
#pragma unroll
            for (int m = 0; m < 4; ++m) { const int row = EPI_ROW(u, ai, m); float ss = 0.f;
#pragma unroll
                for (int bj = 0; bj < 2; ++bj) { const size_t off = (size_t)row * DM + u.pn * BM + bj * HALF + wc * 32 + 8 * fq;
                    const f32x4 x0 = *(const f32x4*)(src + off) + acc[ai][bj][m][0], x1 = *(const f32x4*)(src + off + 4) + acc[ai][bj][m][1];
                    *(f32x4*)(dst + off) = x0; *(f32x4*)(dst + off + 4) = x1; *(u32x4*)(xb + off) = pack8(x0, x1);
                    ss += (x0[0] * x0[0] + x0[1] * x0[1]) + (x0[2] * x0[2] + x0[3] * x0[3]) + (x1[0] * x1[0] + x1[1] * x1[1]) + (x1[2] * x1[2] + x1[3] * x1[3]); }
                ss += __shfl_xor(ss, 16); ss += __shfl_xor(ss, 32);
                if (fq == 0) atomicAdd(ssq_out + row, ss); }
    }
};
}

struct Params {
    const float* x; const float* norm_mix; const float* norm_ffn; const float* norm_final; const float* rel_bias;
    const float* nsa_w_in; const float* pos_k; const float* pos_v; const float* ck_w1; const float* ck_b1; const float* ck_w2;
    const float* cv_w1; const float* cv_b1; const float* cv_w2; const float* nsa_w_out;
    const float* pool_w_in; const float* pool_w_grp; const float* pool_scale; const float* pool_w_out; const float* ffn_w_gu; const float* ffn_w_down;
    float* out; unsigned char* ws;
};

constexpr int NTHR = 512, NWAVES = 8;
constexpr int LDS_BYTES = 163840;

__device__ __forceinline__ int nsa_map(int n0) {
    if (n0 < 3072) return n0;
    if (n0 < 3456) return C_KC + (n0 - 3072);
    if (n0 < 3712) return C_VC + (n0 - 3456);
    if (n0 < 4096) return C_KS + (n0 - 3712);
    if (n0 < 4352) return C_VS + (n0 - 4096);
    if (n0 < 4736) return C_KW + (n0 - 4352);
    if (n0 < 4992) return C_VW + (n0 - 4736);
    return C_GATE + (n0 - 4992);
}
__device__ __forceinline__ int gu_map(int n0) { return n0 < DFF ? (n0 >> 7) * 256 + (n0 & 127) : ((n0 - DFF) >> 7) * 256 + 128 + ((n0 - DFF) & 127); }

template <int MAP>
__device__ __forceinline__ void transpose_items(const float* W, int K, int N, bf16_t* WT, int ldd, int row_off, const float* fold, LAS float* scr, int gw, int ngw, int lane) {
    const int nblk = N / 32, nitems = (K / 64) * nblk;
    for (int item = gw; item < nitems; item += ngw) {
        const int kb = item / nblk, nb = item % nblk, k0 = 64 * kb, n0 = 32 * nb;
        const int d0 = row_off + (MAP == 1 ? nsa_map(n0) : (MAP == 2 ? gu_map(n0) : n0));
        float wv[32];
#pragma unroll
        for (int i = 0; i < 32; ++i) wv[i] = W[(size_t)(k0 + 2 * i + (lane >> 5)) * N + n0 + (lane & 31)];
#pragma unroll
        for (int i = 0; i < 32; ++i) { const int kk = 2 * i + (lane >> 5); float v = wv[i]; if (fold) v *= fold[k0 + kk]; scr[kk * 33 + (lane & 31)] = v; }
        asm volatile("s_waitcnt lgkmcnt(0)" ::: "memory");
        const int c = lane & 7;
#pragma unroll
        for (int j = 0; j < 4; ++j) { const int n = (lane >> 3) + 8 * j; const LAS float* s = scr + (8 * c) * 33 + n;
            u32x4 o; o.x = cvt_pk_bf16(s[0 * 33], s[1 * 33]); o.y = cvt_pk_bf16(s[2 * 33], s[3 * 33]); o.z = cvt_pk_bf16(s[4 * 33], s[5 * 33]); o.w = cvt_pk_bf16(s[6 * 33], s[7 * 33]);
            *(u32x4*)(WT + (size_t)(d0 + n) * ldd + k0 + 8 * c) = o; }
        asm volatile("s_waitcnt lgkmcnt(0)" ::: "memory");
    }
}

__device__ __forceinline__ void phase_prologue(const Params& p, LAS unsigned char* lds) {
    const int tid = threadIdx.x, lane = tid & 63, wave = tid >> 6;
    const int gw = blockIdx.x * NWAVES + wave, ngw = gridDim.x * NWAVES;
    LAS float* scr = (LAS float*)(lds + wave * 8704);
    unsigned char* ws = p.ws;
    if (blockIdx.x == 0 && tid < 16) ((unsigned*)(ws + WS_KMAX))[tid] = 0u;
    { float* ssq = (float*)(ws + WS_SSQ); for (int i = blockIdx.x * NTHR + tid; i < 4 * MT; i += gridDim.x * NTHR) ssq[MT + i] = 0.f; }
    transpose_items<1>(p.nsa_w_in, DM, 5088, (bf16_t*)(ws + WS_W_IN), DM, 0, p.norm_mix, scr, gw, ngw, lane);
    transpose_items<0>(p.nsa_w_out, DM, DM, (bf16_t*)(ws + WS_W_OUT), DM, 0, nullptr, scr, gw, ngw, lane);
    transpose_items<2>(p.ffn_w_gu, DM, 2 * DFF, (bf16_t*)(ws + WS_W_GU0), DM, 0, p.norm_ffn, scr, gw, ngw, lane);
    transpose_items<2>(p.ffn_w_gu + (size_t)DM * 2 * DFF, DM, 2 * DFF, (bf16_t*)(ws + WS_W_GU1), DM, 0, p.norm_ffn + DM, scr, gw, ngw, lane);
    transpose_items<0>(p.ffn_w_down, DFF, DM, (bf16_t*)(ws + WS_W_DN0), DFF, 0, nullptr, scr, gw, ngw, lane);
    transpose_items<0>(p.ffn_w_down + (size_t)DFF * DM, DFF, DM, (bf16_t*)(ws + WS_W_DN1), DFF, 0, nullptr, scr, gw, ngw, lane);
    transpose_items<0>(p.pool_w_in, DM, DM, (bf16_t*)(ws + WS_P_IN), DM, 0, p.norm_mix + DM, scr, gw, ngw, lane);
#pragma unroll 1
    for (int gi = 0; gi < 4; ++gi) transpose_items<0>(p.pool_w_grp + (size_t)gi * 512 * 512, 512, 512, (bf16_t*)(ws + WS_P_GRP), 512, gi * 512, nullptr, scr, gw, ngw, lane);
    transpose_items<0>(p.pool_w_out, DM, DM, (bf16_t*)(ws + WS_P_OUT), DM, 0, nullptr, scr, gw, ngw, lane);
    transpose_items<0>(p.ck_w1, 32 * DK, 256, (bf16_t*)(ws + WS_CK1), 32 * DK, 0, nullptr, scr, gw, ngw, lane);
    transpose_items<0>(p.cv_w1, 32 * DV, 256, (bf16_t*)(ws + WS_CV1), 32 * DV, 0, nullptr, scr, gw, ngw, lane);
    transpose_items<0>(p.ck_w2, 256, DK, (bf16_t*)(ws + WS_CK2), 256, 0, nullptr, scr, gw, ngw, lane);
    transpose_items<0>(p.cv_w2, 256, DV, (bf16_t*)(ws + WS_CV2), 256, 0, nullptr, scr, gw, ngw, lane);
    float* ssq0 = (float*)(ws + WS_SSQ); bf16_t* xb = (bf16_t*)(ws + WS_XB);
    for (int row = gw; row < MT; row += ngw) {
        const f32x4* xr = (const f32x4*)(p.x + (size_t)row * DM) + lane; u32x2* o = (u32x2*)(xb + (size_t)row * DM) + lane;
        float s = 0.f;
#pragma unroll
        for (int j = 0; j < 8; ++j) { const f32x4 v = xr[64 * j]; s += (v[0] * v[0] + v[1] * v[1]) + (v[2] * v[2] + v[3] * v[3]); u32x2 w; w.x = cvt_pk_bf16(v[0], v[1]); w.y = cvt_pk_bf16(v[2], v[3]); o[64 * j] = w; }
        s = wave_sum(s);
        if (lane == 0) ssq0[row] = s;
    }
}

__device__ __forceinline__ float gelu_tanh(float x) { const float u = 0.7978845608028654f * (x + 0.044715f * x * x * x); return 0.5f * x * (1.0f + tanhf(u)); }

template <int DH>
__device__ __forceinline__ void compress_unit(const Params& p, LAS unsigned char* lds, int b, int n0, int colbase, const float* pos, const bf16_t* w1t, const float* b1, const bf16_t* w2t, bf16_t* outp) {
    constexpr int KC = 32 * DH;
    const int tid = threadIdx.x, lane = tid & 63, wave = __builtin_amdgcn_readfirstlane(tid >> 6), c = lane & 15, kq = lane >> 4;
    const bf16_t* proj = (const bf16_t*)(p.ws + WS_BIG);
    LAS unsigned char* As = lds; LAS unsigned char* Bs = lds + 5120; LAS unsigned char* Hs = lds + 32768;
    const int arow = tid >> 2, ach = tid & 3;
    const int ag = arow >> 4, an = n0 + (arow & 15);
    u32x4 areg = {0, 0, 0, 0}, breg[2];
#define CMP_LOAD(k0_) do { const int k0v = (k0_); \
        if (tid < 256) { const int kk = k0v + ach * 8, l = kk / DH, d = kk % DH; int tok = 16 * an + l; tok = tok < SEQ ? tok : SEQ - 1; \
            const u32x4 raw = *(const u32x4*)(proj + (size_t)(b * SEQ + tok) * NPROJ + colbase + ag * DH + d); \
            const f32x4 p0 = *(const f32x4*)(pos + l * DH + d), p1 = *(const f32x4*)(pos + l * DH + d + 4); \
            areg.x = cvt_pk_bf16(bf_lo(raw.x) + p0[0], bf_hi(raw.x) + p0[1]); areg.y = cvt_pk_bf16(bf_lo(raw.y) + p0[2], bf_hi(raw.y) + p0[3]); \
            areg.z = cvt_pk_bf16(bf_lo(raw.z) + p1[0], bf_hi(raw.z) + p1[1]); areg.w = cvt_pk_bf16(bf_lo(raw.w) + p1[2], bf_hi(raw.w) + p1[3]); } \
        _Pragma("unroll") for (int i_ = 0; i_ < 2; ++i_) { const int idx = tid + 512 * i_; breg[i_] = *(const u32x4*)(w1t + (size_t)(idx >> 2) * KC + k0v + (idx & 3) * 8); } } while (0)
    f32x4 acc[4][2];
#pragma unroll
    for (int m = 0; m < 4; ++m) { acc[m][0] = (f32x4){0.f, 0.f, 0.f, 0.f}; acc[m][1] = (f32x4){0.f, 0.f, 0.f, 0.f}; }
    CMP_LOAD(0);
    for (int k0 = 0; k0 < KC; k0 += 32) {
        __syncthreads();
        if (tid < 256) *(LAS u32x4*)(As + arow * 80 + ach * 16) = areg;
#pragma unroll
        for (int i = 0; i < 2; ++i) { const int idx = tid + 512 * i; *(LAS u32x4*)(Bs + (idx >> 2) * 80 + (idx & 3) * 16) = breg[i]; }
        __syncthreads();
        if (k0 + 32 < KC) CMP_LOAD(k0 + 32);
        bf16x8 af[4], bfr[2];
#pragma unroll
        for (int m = 0; m < 4; ++m) af[m] = *(const LAS bf16x8*)(As + (16 * m + c) * 80 + kq * 16);
#pragma unroll
        for (int n = 0; n < 2; ++n) bfr[n] = *(const LAS bf16x8*)(Bs + (32 * wave + 16 * n + c) * 80 + kq * 16);
#pragma unroll
        for (int m = 0; m < 4; ++m)
#pragma unroll
            for (int n = 0; n < 2; ++n) acc[m][n] = __builtin_amdgcn_mfma_f32_16x16x32_bf16(af[m], bfr[n], acc[m][n], 0, 0, 0);
    }
#pragma unroll
    for (int n = 0; n < 2; ++n) { const int col = 32 * wave + 16 * n + c; const float bb = b1[col];
#pragma unroll
        for (int m = 0; m < 4; ++m)
#pragma unroll
            for (int i = 0; i < 4; ++i) { const float h = gelu_tanh(acc[m][n][i] + bb); *(LAS bf16_t*)(Hs + (16 * m + 4 * kq + i) * 528 + col * 2) = (bf16_t)(cvt_pk_bf16(h, 0.f) & 0xffffu); } }
    __syncthreads();
    constexpr int NT2 = 4 * (DH / 16);
    for (int idx = wave; idx < NT2; idx += 8) {
        const int m2 = idx & 3, n2 = idx >> 2;
        f32x4 a2 = {0.f, 0.f, 0.f, 0.f};
#pragma unroll
        for (int ks = 0; ks < 8; ++ks) { const bf16x8 a = *(const LAS bf16x8*)(Hs + (16 * m2 + c) * 528 + (32 * ks + 8 * kq) * 2);
            const bf16x8 bb = *(const bf16x8*)(w2t + (size_t)(16 * n2 + c) * 256 + 32 * ks + 8 * kq);
            a2 = __builtin_amdgcn_mfma_f32_16x16x32_bf16(a, bb, a2, 0, 0, 0); }
#pragma unroll
        for (int i = 0; i < 4; ++i) outp[((size_t)(b * NG + m2) * NCMP + n0 + 4 * kq + i) * DH + 16 * n2 + c] = (bf16_t)(cvt_pk_bf16(a2[i], 0.f) & 0xffffu);
    }
    __syncthreads();
}

__device__ __forceinline__ void phase_compress(const Params& p, LAS unsigned char* lds) {
    unsigned char* ws = p.ws;
    for (int u = blockIdx.x; u < 256; u += gridDim.x) {
        const int which = u >> 7, b = (u >> 6) & 1, n0 = (u & 63) * 16;
        if (which == 0) compress_unit<DK>(p, lds, b, n0, C_KC, p.pos_k, (const bf16_t*)(ws + WS_CK1), p.ck_b1, (const bf16_t*)(ws + WS_CK2), (bf16_t*)(ws + WS_KCMP));
        else compress_unit<DV>(p, lds, b, n0, C_VC, p.pos_v, (const bf16_t*)(ws + WS_CV1), p.cv_b1, (const bf16_t*)(ws + WS_CV2), (bf16_t*)(ws + WS_VCMP));
    }
    { const bf16_t* proj = (const bf16_t*)(ws + WS_BIG); unsigned* kmaxp = (unsigned*)(ws + WS_KMAX); const int lane = threadIdx.x & 63;
      for (int it = blockIdx.x * NTHR + threadIdx.x; it < MT * 8; it += gridDim.x * NTHR) { const int row = it >> 3, sg = it & 7, br = sg >> 2, g = sg & 3;
        const u32x4* kp = (const u32x4*)(proj + (size_t)row * NPROJ + (br ? C_KW : C_KS) + g * DK); float n2 = 0.f;
#pragma unroll
        for (int ch = 0; ch < 12; ++ch) { const u32x4 w = kp[ch];
            n2 += bf_lo(w.x) * bf_lo(w.x) + bf_hi(w.x) * bf_hi(w.x) + bf_lo(w.y) * bf_lo(w.y) + bf_hi(w.y) * bf_hi(w.y) + bf_lo(w.z) * bf_lo(w.z) + bf_hi(w.z) * bf_hi(w.z) + bf_lo(w.w) * bf_lo(w.w) + bf_hi(w.w) * bf_hi(w.w); }
        n2 = fmaxf(n2, __shfl_xor(n2, 8)); n2 = fmaxf(n2, __shfl_xor(n2, 16)); n2 = fmaxf(n2, __shfl_xor(n2, 32));
        if (lane < 8) atomicMax(kmaxp + br * 8 + (row >> 14) * 4 + g, __float_as_uint(sqrtf(n2))); } }
}

constexpr int KT_STRIDE = 208, SLOT_K = 64 * KT_STRIDE;
constexpr int VT_STRIDE = 144, SLOT_V = 64 * VT_STRIDE;
constexpr int SLOT_BYTES = SLOT_K + SLOT_V, RING = 5, PD = RING - 1;
constexpr int RING_WS = 6;
constexpr int L_RING = 0, L_IMP = RING * SLOT_BYTES, L_BIAS = LDS_BYTES - 4 * 8 * 132 * 4, L_SELM = L_BIAS - 2048;
static_assert(L_IMP + 32 * 256 * 4 <= L_BIAS && RING_WS * SLOT_BYTES <= L_SELM, "attention LDS map");

struct PairState { f32x4 o[4]; float m, l; bf16x8 q[3]; };
struct TileSrc { const bf16_t* K; const bf16_t* V; int kld, vld; };
struct DmaPlan { int off[3]; };

__device__ __forceinline__ void glds16(const void* gsrc, unsigned lds_dst) { unsigned keep;
    asm volatile("s_mov_b32 %0, m0\n\ts_mov_b32 m0, %2\n\ts_nop 0\n\tglobal_load_lds_dwordx4 %1, off\n\ts_mov_b32 m0, %0" : "=&s"(keep) : "v"(gsrc), "s"(lds_dst) : "memory"); }
#define ATT_WAIT_BAR(N) asm volatile("s_waitcnt vmcnt(" #N ") lgkmcnt(0)\n\ts_barrier" ::: "memory")
__device__ __forceinline__ void att_wait_bar(int rem) { if (rem <= 0) ATT_WAIT_BAR(0); else if (rem == 1) ATT_WAIT_BAR(3); else if (rem == 2) ATT_WAIT_BAR(6); else ATT_WAIT_BAR(9); }
__device__ __forceinline__ bool piece_is_k(int s) { return s < 13 || s >= 22; }
__device__ __forceinline__ int piece_grp(int s) { return s < 13 ? s : (s >= 22 ? s - 22 : s - 13); }
__device__ __forceinline__ void make_plan(DmaPlan& pl, const TileSrc& src, int wave, int lane) {
#pragma unroll
    for (int j = 0; j < 3; ++j) { const int sidx = wave + 8 * j, ci = 64 * piece_grp(sidx) + lane;
        if (piece_is_k(sidx)) { const int key = ci / 13, ch = ci % 13; pl.off[j] = key * src.kld + (ch < 12 ? ch : 11) * 8; }
        else { const int key = ci / 9, ch = ci % 9; pl.off[j] = key * src.vld + (ch < 8 ? ch : 7) * 8; } }
}
__device__ __forceinline__ void issue_tile(const DmaPlan& pl, const TileSrc& src, int key0, unsigned slot_addr, int wave) {
#pragma unroll
    for (int j = 0; j < 3; ++j) { const int sidx = wave + 8 * j; const bool isk = piece_is_k(sidx);
        const bf16_t* gp = (isk ? src.K + (size_t)key0 * src.kld : src.V + (size_t)key0 * src.vld) + pl.off[j];
        glds16(gp, slot_addr + (isk ? 0u : (unsigned)SLOT_K) + 1024u * (unsigned)piece_grp(sidx)); }
}
typedef short s16x4 __attribute__((ext_vector_type(4)));
__device__ __forceinline__ s16x4 vtr(const LAS unsigned char* p) { return __builtin_bit_cast(s16x4, __builtin_amdgcn_ds_read_tr16_b64_v4i16((LAS s16x4*)p)); }

__device__ __forceinline__ float sum8_dpp(float x) {
    x += __builtin_bit_cast(float, __builtin_amdgcn_update_dpp(0, __builtin_bit_cast(int, x), 0xB1, 0xF, 0xF, true));
    x += __builtin_bit_cast(float, __builtin_amdgcn_update_dpp(0, __builtin_bit_cast(int, x), 0x4E, 0xF, 0xF, true));
    x += __builtin_bit_cast(float, __builtin_amdgcn_update_dpp(0, __builtin_bit_cast(int, x), 0x141, 0xF, 0xF, true));
    return x;
}
template <int MODE, bool FAR>
__device__ __forceinline__ void pair_tile(PairState& st, const LAS unsigned char* Kt, const LAS unsigned char* Vt, int tadj, int kstride, int maxdist, bool rowsel,
                                          const LAS float* biasrow, float bias_far, LAS float* improw, int jj0, int lane) {
    const int c = lane & 15, kq = lane >> 4;
    f32x4 s[4];
    float bv[4][4];
    if (!FAR) {
#pragma unroll
        for (int kt = 0; kt < 4; ++kt)
#pragma unroll
            for (int i = 0; i < 4; ++i) { const int d = tadj - (16 * kt + 4 * kq + i) * kstride; const int bi = d < 0 ? 0 : (d > 128 ? 128 : d); bv[kt][i] = biasrow[bi]; }
    }
    const float init = FAR ? (rowsel ? bias_far - st.m : NEGF) : -st.m;
    const f32x4 initv = {init, init, init, init};
#pragma unroll
    for (int kt = 0; kt < 4; ++kt) {
#pragma unroll
        for (int ds = 0; ds < 3; ++ds) { const bf16x8 a = *(const LAS bf16x8*)(Kt + (16 * kt + c) * KT_STRIDE + (32 * ds + 8 * kq) * 2);
            s[kt] = __builtin_amdgcn_mfma_f32_16x16x32_bf16(a, st.q[ds], ds == 0 ? initv : s[kt], 0, 0, 0); } }
    if (!FAR) {
#pragma unroll
        for (int kt = 0; kt < 4; ++kt)
#pragma unroll
            for (int i = 0; i < 4; ++i) { const int d = tadj - (16 * kt + 4 * kq + i) * kstride; const bool valid = ((unsigned)d < (unsigned)maxdist) && rowsel;
                s[kt][i] = valid ? s[kt][i] + bv[kt][i] : NEGF; }
    }
    float psum = 0.f;
#pragma unroll
    for (int kt = 0; kt < 4; ++kt)
#pragma unroll
        for (int i = 0; i < 4; ++i) { const float pv = __builtin_amdgcn_exp2f(s[kt][i]); s[kt][i] = pv; psum += pv; }
    if (MODE != 1) st.l += psum;
    if (MODE == 0) return;
#pragma unroll
    for (int s2 = 0; s2 < 2; ++s2) {
        u32x4 pw; pw.x = cvt_pk_bf16(s[2 * s2][0], s[2 * s2][1]); pw.y = cvt_pk_bf16(s[2 * s2][2], s[2 * s2][3]); pw.z = cvt_pk_bf16(s[2 * s2 + 1][0], s[2 * s2 + 1][1]); pw.w = cvt_pk_bf16(s[2 * s2 + 1][2], s[2 * s2 + 1][3]);
        const bf16x8 pb = __builtin_bit_cast(bf16x8, pw);
#pragma unroll
        for (int dt = 0; dt < 4; ++dt) { const LAS unsigned char* vp = Vt + (32 * s2 + 4 * kq + (c >> 2)) * VT_STRIDE + (16 * dt + 4 * (c & 3)) * 2;
            const s16x4 lo = vtr(vp), hi = vtr(vp + 16 * VT_STRIDE); const bf16x8 a = {lo[0], lo[1], lo[2], lo[3], hi[0], hi[1], hi[2], hi[3]};
            st.o[dt] = __builtin_amdgcn_mfma_f32_16x16x32_bf16(a, pb, st.o[dt], 0, 0, 0); }
    }
    if (MODE == 1) {
#pragma unroll
        for (int kt = 0; kt < 4; ++kt) {
            float u0 = 2.0f * (s[kt][0] + s[kt][1] + s[kt][2]) + s[kt][3], u1 = s[kt][3];
            u0 = sum8_dpp(u0); u1 = sum8_dpp(u1);
            if ((lane & 7) == 0) { const int jj = jj0 + 4 * kt + kq;
                __hip_atomic_fetch_add(improw + jj, u0, __ATOMIC_RELAXED, __HIP_MEMORY_SCOPE_WORKGROUP);
                if (jj + 1 < 256) __hip_atomic_fetch_add(improw + jj + 1, u1, __ATOMIC_RELAXED, __HIP_MEMORY_SCOPE_WORKGROUP); }
        }
    }
}
#define PAIR_TILE(MODE, far, ...) do { if (far) pair_tile<MODE, true>(__VA_ARGS__); else pair_tile<MODE, false>(__VA_ARGS__); } while (0)

__device__ __forceinline__ int t5_bucket(int n) {
    if (n < 16) return n;
    int bk = 16;
    bk += (n >= 19); bk += (n >= 21); bk += (n >= 24); bk += (n >= 27); bk += (n >= 31); bk += (n >= 35); bk += (n >= 40); bk += (n >= 46);
    bk += (n >= 52); bk += (n >= 59); bk += (n >= 67); bk += (n >= 77); bk += (n >= 87); bk += (n >= 99); bk += (n >= 113);
    return bk;
}
__device__ __forceinline__ void build_bias(const Params& p, LAS unsigned char* lds) {
    LAS float* bt = (LAS float*)(lds + L_BIAS);
    for (int i = threadIdx.x; i < 32 * 129; i += NTHR) { const int h = i / 129, d = i % 129; bt[h * 132 + d] = p.rel_bias[t5_bucket(d) * 32 + h] * 1.4426950408889634f; }
    __syncthreads();
    if (threadIdx.x < 32) { float mx = bt[threadIdx.x * 132]; for (int d = 1; d < 129; ++d) mx = fmaxf(mx, bt[threadIdx.x * 132 + d]); bt[threadIdx.x * 132 + 129] = mx; }
    __syncthreads();
}

__device__ __forceinline__ void load_q(PairState& st, const bf16_t* proj, int b, int g, int tq0, int lane, float kmx, float bmax) {
    const int c = lane & 15, kq = lane >> 4; const size_t row = (size_t)b * SEQ + tq0 + (c >> 3);
#pragma unroll
    for (int ds = 0; ds < 3; ++ds) st.q[ds] = *(const bf16x8*)(proj + row * NPROJ + (g * 8 + (c & 7)) * DK + 32 * ds + 8 * kq);
    asm volatile("" : "+v"(st.q[0]), "+v"(st.q[1]), "+v"(st.q[2]));
    float qq = 0.f;
#pragma unroll
    for (int ds = 0; ds < 3; ++ds) { const u32x4 w = __builtin_bit_cast(u32x4, st.q[ds]);
        qq += bf_lo(w.x) * bf_lo(w.x) + bf_hi(w.x) * bf_hi(w.x) + bf_lo(w.y) * bf_lo(w.y) + bf_hi(w.y) * bf_hi(w.y) + bf_lo(w.z) * bf_lo(w.z) + bf_hi(w.z) * bf_hi(w.z) + bf_lo(w.w) * bf_lo(w.w) + bf_hi(w.w) * bf_hi(w.w); }
    qq += __shfl_xor(qq, 16); qq += __shfl_xor(qq, 32);
    st.m = sqrtf(qq) * kmx + bmax + 0.25f;
}
__device__ __forceinline__ void reset_state(PairState& st) {
#pragma unroll
    for (int dt = 0; dt < 4; ++dt) st.o[dt] = (f32x4){0.f, 0.f, 0.f, 0.f};
    st.l = 0.f;
}
template <bool ACCUM>
__device__ __forceinline__ void write_out(const PairState& st, float inv, const bf16_t* proj, bf16_t* obuf, int b, int g, int tq0, int br, int lane) {
    const int c = lane & 15, kq = lane >> 4; const size_t row = (size_t)b * SEQ + tq0 + (c >> 3);
    const float gl = bf_lo((unsigned)proj[row * NPROJ + C_GATE + br * 32 + g * 8 + (c & 7)]);
    const float sc = inv * __builtin_amdgcn_rcpf(1.0f + __expf(-gl));
    bf16_t* op = obuf + row * DM + (g * 8 + (c & 7)) * DV + 4 * kq;
#pragma unroll
    for (int dt = 0; dt < 4; ++dt) { f32x4 v = st.o[dt] * sc;
        if (ACCUM) { const u32x2 old = *(const u32x2*)(op + 16 * dt); v[0] += bf_lo(old.x); v[1] += bf_hi(old.x); v[2] += bf_lo(old.y); v[3] += bf_hi(old.y); }
        u32x2 w; w.x = cvt_pk_bf16(v[0], v[1]); w.y = cvt_pk_bf16(v[2], v[3]); *(u32x2*)(op + 16 * dt) = w; }
}

constexpr size_t WS_UCTR = WS_XBAR + 14336;
#define UNIT_LOOP_BEGIN(ctrptr, NU) \
    { LAS unsigned* ubox_ = (LAS unsigned*)(lds + 146440); unsigned nxt_ = 0u; \
      if (threadIdx.x == 0) ubox_[0] = atomicAdd((ctrptr), 1u); \
      __syncthreads(); \
      for (;;) { const unsigned ul = ubox_[0]; if (ul >= (unsigned)(NU)) break; \
          __syncthreads(); \
          if (threadIdx.x == 0) nxt_ = atomicAdd((ctrptr), 1u);
#define UNIT_LOOP_END() \
          if (threadIdx.x == 0) ubox_[0] = nxt_; \
          __syncthreads(); } }

__device__ __forceinline__ void phase_cmp(const Params& p, LAS unsigned char* lds) {
    const int tid = threadIdx.x, lane = tid & 63, wave = __builtin_amdgcn_readfirstlane(tid >> 6), c = lane & 15;
    const bf16_t* proj = (const bf16_t*)(p.ws + WS_BIG); bf16_t* obuf = (bf16_t*)(p.ws + WS_O); unsigned* selm = (unsigned*)(p.ws + WS_SELM);
    build_bias(p, lds);
    { LAS float* bt = (LAS float*)(lds + L_BIAS); const u32x4* kc = (const u32x4*)(p.ws + WS_KCMP) + (size_t)wave * NCMP * 12; float n2m = 0.f;
      for (int r = lane; r < NCMP; r += 64) { float n2 = 0.f;
#pragma unroll
        for (int ch = 0; ch < 12; ++ch) { const u32x4 w = kc[r * 12 + ch];
            n2 += bf_lo(w.x) * bf_lo(w.x) + bf_hi(w.x) * bf_hi(w.x) + bf_lo(w.y) * bf_lo(w.y) + bf_hi(w.y) * bf_hi(w.y) + bf_lo(w.z) * bf_lo(w.z) + bf_hi(w.z) * bf_hi(w.z) + bf_lo(w.w) * bf_lo(w.w) + bf_hi(w.w) * bf_hi(w.w); }
        n2m = fmaxf(n2m, n2); }
#pragma unroll
      for (int o = 1; o < 64; o <<= 1) n2m = fmaxf(n2m, __shfl_xor(n2m, o));
      if (lane == 0) bt[wave * 132 + 130] = sqrtf(n2m);
      __syncthreads(); }
    LAS float* imp = (LAS float*)(lds + L_IMP);
    UNIT_LOOP_BEGIN((unsigned*)(p.ws + WS_UCTR) + (blockIdx.x & 7), 512)
        const int bg = blockIdx.x & 7, b = bg >> 2, g = bg & 3, t0 = (511 - (int)ul) * 32;
        TileSrc src; src.K = (const bf16_t*)(p.ws + WS_KCMP) + (size_t)bg * NCMP * DK; src.V = (const bf16_t*)(p.ws + WS_VCMP) + (size_t)bg * NCMP * DV; src.kld = DK; src.vld = DV;
        const int nt = t0 / 1024 + 1;
        const LAS float* biasrow = (const LAS float*)(lds + L_BIAS) + (g * 8 + (c & 7)) * 132; const float bias_far = biasrow[128];
        PairState st[2];
#pragma unroll
        for (int pi = 0; pi < 2; ++pi) { reset_state(st[pi]); load_q(st[pi], proj, b, g, t0 + 4 * wave + 2 * pi, lane, ((const LAS float*)(lds + L_BIAS))[bg * 132 + 130], biasrow[129]); }
#pragma unroll
        for (int i = 0; i < 16; ++i) imp[(4 * wave) * 256 + i * 64 + lane] = 0.f;
        DmaPlan pl; make_plan(pl, src, wave, lane);
        const unsigned ring = (unsigned)(size_t)(lds + L_RING);
#pragma unroll 1
        for (int pass = 0; pass < 2; ++pass) {
            if (pass == 1) {
#pragma unroll
                for (int pi = 0; pi < 2; ++pi) { float lt = st[pi].l; lt += __shfl_xor(lt, 16); lt += __shfl_xor(lt, 32); if (lt > 0.f) st[pi].m += __builtin_amdgcn_logf(lt); }
            }
            for (int d = 0; d < PD && d < nt; ++d) issue_tile(pl, src, 64 * d, ring + d * SLOT_BYTES, wave);
            int slot = 0, islot = PD;
#pragma unroll 1
            for (int i = 0; i < nt; ++i) {
                { int rem = nt - 1 - i; rem = rem < PD - 1 ? rem : PD - 1; att_wait_bar(rem); }
                if (i + PD < nt) issue_tile(pl, src, 64 * (i + PD), ring + islot * SLOT_BYTES, wave);
                const LAS unsigned char* Kt = lds + L_RING + slot * SLOT_BYTES; const LAS unsigned char* Vt = Kt + SLOT_K;
#pragma unroll
                for (int pi = 0; pi < 2; ++pi) { const int tq0 = t0 + 4 * wave + 2 * pi; const int P0 = 16 * 64 * i + 31;
                    if (tq0 + 1 < P0) continue;
                    const bool far = (tq0 - (P0 + 63 * 16)) >= 113;
                    const int tadj = tq0 + (c >> 3) - P0;
                    if (pass == 0) PAIR_TILE(0, far, st[pi], Kt, Vt, tadj, 16, 1 << 30, true, biasrow, bias_far, nullptr, 0, lane);
                    else PAIR_TILE(1, far, st[pi], Kt, Vt, tadj, 16, 1 << 30, true, biasrow, bias_far, imp + (4 * wave + 2 * pi + (c >> 3)) * 256, 16 * i, lane); }
                slot = slot + 1 == RING ? 0 : slot + 1; islot = islot + 1 == RING ? 0 : islot + 1;
            }
            ATT_WAIT_BAR(0);
        }
#pragma unroll
        for (int pi = 0; pi < 2; ++pi) write_out<false>(st[pi], 1.0f, proj, obuf, b, g, t0 + 4 * wave + 2 * pi, 0, lane);
        asm volatile("s_waitcnt lgkmcnt(0)" ::: "memory");
#pragma unroll 1
        for (int qq = 0; qq < 4; ++qq) {
            const int t = t0 + 4 * wave + qq, cur = t >> 6;
            unsigned key[4]; bool sel[4];
#pragma unroll
            for (int i = 0; i < 4; ++i) { const int j = lane + 64 * i; const float v = imp[(4 * wave + qq) * 256 + j];
                sel[i] = (j == 0) || (j == cur) || (j == cur - 1);
                const bool cand = (j >= 1) && (j <= cur - 2);
                key[i] = cand ? (__float_as_uint(v) + 1u) : 0u; }
            const int need = 16 - (1 + (cur >= 1) + (cur >= 2));
            unsigned T = 0u;
#pragma unroll 1
            for (int bit = 31; bit >= 0; --bit) { const unsigned cand = T | (1u << bit);
                const int cnt = __popcll(__ballot(key[0] >= cand)) + __popcll(__ballot(key[1] >= cand)) + __popcll(__ballot(key[2] >= cand)) + __popcll(__ballot(key[3] >= cand));
                if (cnt >= need) T = cand; }
            if (T == 0u) T = 1u;
            int above = 0;
#pragma unroll
            for (int i = 0; i < 4; ++i) above += __popcll(__ballot(key[i] > T));
            int room = need - above;
#pragma unroll
            for (int i = 0; i < 4; ++i) { const unsigned long long eq = __ballot(key[i] == T); const int rank = __popcll(eq & ((1ull << lane) - 1ull));
                sel[i] = sel[i] || (key[i] > T) || (key[i] == T && rank < room); room -= __popcll(eq); }
            unsigned* mrow = selm + ((size_t)bg * SEQ + t) * 8;
#pragma unroll
            for (int i = 0; i < 4; ++i) { const unsigned long long bal = __ballot(sel[i]); if (lane == 0) { mrow[2 * i] = (unsigned)bal; mrow[2 * i + 1] = (unsigned)(bal >> 32); } }
        }
    UNIT_LOOP_END()
}

__device__ __forceinline__ void build_order(const LAS unsigned* lsel, LAS unsigned char* ord, LAS int* cnt, int cb, int nq, int lane) {
    int base = 0;
#pragma unroll 1
    for (int r = 0; 64 * r <= cb; ++r) { const int j = lane + 64 * r; unsigned m = 0u;
        for (int q = 0; q < nq; ++q) m |= lsel[q * 8 + (j >> 5)];
        const bool need = (j <= cb) && ((m >> (j & 31)) & 1u);
        const unsigned long long bal = __ballot(need);
        if (need) ord[base + __popcll(bal & ((1ull << lane) - 1ull))] = (unsigned char)j;
        base += __popcll(bal); }
    if (lane == 0) *cnt = base;
}

template <bool WIN, int NP>
__device__ __forceinline__ void phase_ws(const Params& p, LAS unsigned char* lds) {
    constexpr int QW = 2 * NP, QU = 8 * QW, NUNIT = MT * NG / QU;
    const int tid = threadIdx.x, lane = tid & 63, wave = __builtin_amdgcn_readfirstlane(tid >> 6), c = lane & 15;
    const bf16_t* proj = (const bf16_t*)(p.ws + WS_BIG); bf16_t* obuf = (bf16_t*)(p.ws + WS_O); const unsigned* selm = (const unsigned*)(p.ws + WS_SELM);
    build_bias(p, lds);
    LAS unsigned* lsel = (LAS unsigned*)(lds + L_SELM);
    UNIT_LOOP_BEGIN((unsigned*)(p.ws + WS_UCTR) + (WIN ? 8 : 16) + (blockIdx.x & 7), NUNIT / 8)
        const int bg = blockIdx.x & 7, b = bg >> 2, g = bg & 3, t0 = (SEQ / QU - 1 - (int)ul) * QU;
        TileSrc src; src.kld = NPROJ; src.vld = NPROJ;
        src.K = proj + (size_t)b * SEQ * NPROJ + (WIN ? C_KW : C_KS) + g * DK; src.V = proj + (size_t)b * SEQ * NPROJ + (WIN ? C_VW : C_VS) + g * DV;
        const int cb = t0 >> 6;
        const int kstart = WIN ? (cb >= 8 ? (cb - 8) * 64 : 0) : 0;
        const int nt = cb + 1 - kstart / 64;
        const LAS float* biasrow = (const LAS float*)(lds + L_BIAS) + (g * 8 + (c & 7)) * 132; const float bias_far = biasrow[128];
        const float kmx = __uint_as_float(((const unsigned*)(p.ws + WS_KMAX))[(WIN ? 8 : 0) + bg]);
        LAS unsigned char* ord = (LAS unsigned char*)(lds + L_SELM + 1024);
        int npos = nt;
        if (!WIN) { if (tid < QU * 8) lsel[tid] = selm[((size_t)bg * SEQ + t0) * 8 + tid];
            __syncthreads();
            if (wave == 0) build_order(lsel, ord, (LAS int*)(lds + L_SELM + 1024 + 256), cb, QU, lane);
            __syncthreads();
            npos = *(LAS int*)(lds + L_SELM + 1024 + 256); }
        PairState st[NP];
#pragma unroll
        for (int pi = 0; pi < NP; ++pi) { reset_state(st[pi]); load_q(st[pi], proj, b, g, t0 + QW * wave + 2 * pi, lane, kmx, biasrow[129]); }
        DmaPlan pl; make_plan(pl, src, wave, lane);
        const unsigned ring = (unsigned)(size_t)(lds + L_RING);
#define WS_TILE(pos) (WIN ? (pos) : (int)ord[pos])
        for (int d = 0; d < 4 && d < npos; ++d) issue_tile(pl, src, kstart + 64 * WS_TILE(d), ring + d * SLOT_BYTES, wave);
        int slot = 0, islot = 4;
#pragma unroll 1
        for (int i0 = 0; i0 < npos; i0 += 2) {
            { const int issued = npos < i0 + 4 ? npos : i0 + 4, done = npos < i0 + 2 ? npos : i0 + 2; att_wait_bar(issued - done); }
#pragma unroll 1
            for (int e = 0; e < 2; ++e) { if (i0 + e >= npos) break; const int i = WS_TILE(i0 + e);
                const LAS unsigned char* Kt = lds + L_RING + slot * SLOT_BYTES; const LAS unsigned char* Vt = Kt + SLOT_K;
                slot = slot + 1 == RING_WS ? 0 : slot + 1;
                const int P0 = kstart + 64 * i;
#pragma unroll
                for (int pi = 0; pi < NP; ++pi) { const int tq0 = t0 + QW * wave + 2 * pi;
                    bool rowsel = true; bool allsel = true;
                    if (!WIN) { const unsigned w = lsel[(QW * wave + 2 * pi + (c >> 3)) * 8 + (i >> 5)]; rowsel = (w >> (i & 31)) & 1u;
                        const unsigned long long bal = __ballot(rowsel); if (bal == 0ull) continue; allsel = (bal == ~0ull); }
                    else { if (tq0 + 1 < P0 || tq0 - (P0 + 63) >= 512) continue; }
                    const bool far = (tq0 - (P0 + 63) >= 113) && (!WIN || (tq0 + 1 - P0 < 512));
                    PAIR_TILE(2, far, st[pi], Kt, Vt, tq0 + (c >> 3) - P0, 1, WIN ? 512 : (1 << 30), rowsel, biasrow, bias_far, nullptr, 0, lane); } }
#pragma unroll
            for (int e = 0; e < 2; ++e) { if (i0 + 4 + e < npos) issue_tile(pl, src, kstart + 64 * WS_TILE(i0 + 4 + e), ring + islot * SLOT_BYTES, wave); islot = islot + 1 == RING_WS ? 0 : islot + 1; }
        }
#undef WS_TILE
        ATT_WAIT_BAR(0);
#pragma unroll
        for (int pi = 0; pi < NP; ++pi) { float lt = st[pi].l; lt += __shfl_xor(lt, 16); lt += __shfl_xor(lt, 32);
            write_out<true>(st[pi], lt > 0.f ? 1.0f / lt : 0.f, proj, obuf, b, g, t0 + QW * wave + 2 * pi, WIN ? 2 : 1, lane); }
    UNIT_LOOP_END()
}

template <int W>
__device__ __forceinline__ void pool_item(const bf16_t* ub, bf16_t* pooled, int row, int t, int ch) {
    u32x4 v[W];
#pragma unroll
    for (int k = 0; k < W; ++k) v[k] = *(const u32x4*)(ub + (size_t)(k <= t ? row - k : row) * DM + ch * 8);
    const int cnt = (t + 1 < W) ? t + 1 : W;
    float acc[8] = {0.f, 0.f, 0.f, 0.f, 0.f, 0.f, 0.f, 0.f};
#pragma unroll
    for (int k = 0; k < W; ++k) { const float m = k < cnt ? 1.0f : 0.0f;
        acc[0] += m * bf_lo(v[k].x); acc[1] += m * bf_hi(v[k].x); acc[2] += m * bf_lo(v[k].y); acc[3] += m * bf_hi(v[k].y); acc[4] += m * bf_lo(v[k].z); acc[5] += m * bf_hi(v[k].z); acc[6] += m * bf_lo(v[k].w); acc[7] += m * bf_hi(v[k].w); }
    const float ic = 1.0f / (float)cnt; const u32x4 self = v[0];
    u32x4 o; o.x = cvt_pk_bf16(acc[0] * ic - bf_lo(self.x), acc[1] * ic - bf_hi(self.x)); o.y = cvt_pk_bf16(acc[2] * ic - bf_lo(self.y), acc[3] * ic - bf_hi(self.y));
    o.z = cvt_pk_bf16(acc[4] * ic - bf_lo(self.z), acc[5] * ic - bf_hi(self.z)); o.w = cvt_pk_bf16(acc[6] * ic - bf_lo(self.w), acc[7] * ic - bf_hi(self.w));
    *(u32x4*)(pooled + (size_t)row * DM + ch * 8) = o;
}
__device__ __forceinline__ void phase_pool(const Params& p) {
    const bf16_t* ub = (const bf16_t*)(p.ws + WS_BIG); bf16_t* pooled = (bf16_t*)(p.ws + WS_BIG + 128 * MiB);
    const int nthr = gridDim.x * NTHR;
    for (int it = blockIdx.x * NTHR + threadIdx.x; it < MT * 256; it += nthr) {
        const int row = it >> 8, ch = it & 255, t = row & (SEQ - 1); const int gi = ch >> 6;
        if (gi == 0) pool_item<2>(ub, pooled, row, t, ch); else if (gi == 1) pool_item<4>(ub, pooled, row, t, ch);
        else if (gi == 2) pool_item<8>(ub, pooled, row, t, ch); else pool_item<16>(ub, pooled, row, t, ch);
    }
}
__device__ __forceinline__ void phase_final(const Params& p) {
    const int lane = threadIdx.x & 63, wave = threadIdx.x >> 6; const int gw = blockIdx.x * NWAVES + wave, ngw = gridDim.x * NWAVES;
    const float* ssq = (const float*)(p.ws + WS_SSQ) + 4 * (size_t)MT;
    for (int row = gw; row < MT; row += ngw) { const float rs = rsqrtf(ssq[row] * (1.0f / DM) + EPS);
        f32x4* xr = (f32x4*)(p.out + (size_t)row * DM) + lane; const f32x4* gr = (const f32x4*)p.norm_final + lane;
#pragma unroll
        for (int j = 0; j < 8; ++j) xr[64 * j] = xr[64 * j] * rs * gr[64 * j]; }
}

#define XB_TMO      128
#define XB_XCNT(j)  (256  + 64 * (j))
#define XB_XSUB(j)  (1280 + 64 * (j))
#define XB_XGEN(j)  (2304 + 64 * (j))
#define XB_TOP      3328
#define XB_TOPGEN   3392
#define XCD_BAR_WORDS 3456
#define XB_SPIN_CAP (1u << 18)

__device__ __forceinline__ unsigned xb_ld(unsigned* p)              { return __hip_atomic_load(p, __ATOMIC_RELAXED, __HIP_MEMORY_SCOPE_AGENT); }
__device__ __forceinline__ unsigned xb_add(unsigned* p, unsigned v) { return __hip_atomic_fetch_add(p, v, __ATOMIC_RELAXED, __HIP_MEMORY_SCOPE_AGENT); }
__device__ __forceinline__ unsigned xb_xcc_id() { return (unsigned)__builtin_amdgcn_s_getreg((3 << 11) | 20) & 0xFu; }
#define XB_SPIN(cond, bar) do { unsigned _sp = 0; while (cond) { __builtin_amdgcn_s_sleep(1); \
    if ((++_sp & 255u) == 0u) { if (xb_ld(&(bar)[XB_TMO])) break; if (_sp > XB_SPIN_CAP) { atomicAdd(&(bar)[XB_TMO], 1u); break; } } } } while (0)

struct XcdBarrier {
    unsigned* bar; unsigned x;
    volatile LAS unsigned* st;
};

__device__ __forceinline__ XcdBarrier xcd_barrier_post(unsigned* bar, volatile LAS unsigned* st) {
    XcdBarrier b; b.bar = bar; b.x = xb_xcc_id(); b.st = st;
    if (threadIdx.x == 0) (void)xb_add(&bar[XB_XCNT(b.x)], 1u);
    return b;
}
__device__ __forceinline__ void xcd_barrier_complete(unsigned* bar, unsigned x, unsigned& nloc, unsigned& nx) {
    const unsigned G = gridDim.x * gridDim.y * gridDim.z;
    unsigned sum, cnt, mine, sp = 0u;
    for (;;) {
        sum = 0u; cnt = 0u; mine = 0u;
#pragma unroll
        for (unsigned j = 0; j < 16; ++j) { const unsigned c = xb_ld(&bar[XB_XCNT(j)]); sum += c; cnt += (c > 0u) ? 1u : 0u; mine = (j == x) ? c : mine; }
        if (sum == G) break;
        __builtin_amdgcn_s_sleep(1);
        if ((++sp & 255u) == 0u) { if (xb_ld(&bar[XB_TMO])) break; if (sp > XB_SPIN_CAP) { atomicAdd(&bar[XB_TMO], 1u); break; } }
    }
    nloc = mine > 0u ? mine : 1u; nx = cnt > 0u ? cnt : 1u;
}

__device__ __forceinline__ void xcd_barrier(const XcdBarrier& b) {
    asm volatile("s_waitcnt vmcnt(0)" ::: "memory");
    __syncthreads();
    if (threadIdx.x == 0) {
        unsigned* bar = b.bar;
        __builtin_amdgcn_s_waitcnt(0);
        unsigned nloc = b.st[0], nx = b.st[1];
        if (nloc == 0u) { xcd_barrier_complete(bar, b.x, nloc, nx); b.st[0] = nloc; b.st[1] = nx; }
        const unsigned old = xb_add(&bar[XB_XSUB(b.x)], 1u);
        const unsigned gen = old / nloc;
        if (old + 1u == (gen + 1u) * nloc) {
            __builtin_amdgcn_fence(__ATOMIC_RELEASE, "agent");
            asm volatile("s_waitcnt vmcnt(0)" ::: "memory");
            const unsigned og = xb_add(&bar[XB_TOP], 1u);
            const unsigned tg = og / nx;
            if (og + 1u == (tg + 1u) * nx) xb_add(&bar[XB_TOPGEN], 1u);
            else XB_SPIN(xb_ld(&bar[XB_TOPGEN]) == tg, bar);
            __builtin_amdgcn_fence(__ATOMIC_ACQUIRE, "agent");
            xb_add(&bar[XB_XGEN(b.x)], 1u);
            asm volatile("s_waitcnt vmcnt(0)" ::: "memory");
        } else {
            XB_SPIN(xb_ld(&bar[XB_XGEN(b.x)]) == gen, bar);
            __builtin_amdgcn_fence(__ATOMIC_ACQUIRE, "agent");
            asm volatile("s_waitcnt vmcnt(0)" ::: "memory");
        }
    }
    __syncthreads();
}

#define GSYNC_() do { asm volatile("s_waitcnt vmcnt(0) lgkmcnt(0)" ::: "memory"); __builtin_amdgcn_fence(__ATOMIC_RELEASE, "agent"); grid.sync(); __builtin_amdgcn_fence(__ATOMIC_ACQUIRE, "agent"); } while (0)
#define GSYNC() xcd_barrier(xbar)
__global__ void __launch_bounds__(NTHR, 2) fwd_megakernel(Params p) {
    extern __shared__ __attribute__((aligned(16))) unsigned char lds_raw[];
    LAS unsigned char* lds = (LAS unsigned char*)lds_raw;
    cg::grid_group grid = cg::this_grid();
    volatile LAS unsigned* xst = (volatile LAS unsigned*)(lds + 146432);
    if (threadIdx.x < 2) xst[threadIdx.x] = 0u;
    __syncthreads();
    const XcdBarrier xbar = xcd_barrier_post((unsigned*)(p.ws + WS_XBAR), xst);
    unsigned char* ws = p.ws;
    float* ssq = (float*)(ws + WS_SSQ);
    bf16_t* xb = (bf16_t*)(ws + WS_XB); bf16_t* obuf = (bf16_t*)(ws + WS_O); bf16_t* big = (bf16_t*)(ws + WS_BIG);
    const int G = gridDim.x, cidx = blockIdx.x;
    pg8::StaticOrder S;

    phase_prologue(p, lds);
    if (p.ws == nullptr) GSYNC_();
    GSYNC();
    { pg8::Gemm g{xb, (const bf16_t*)(ws + WS_W_IN), DM, DM, MT, NPROJ, DM, 0}; S.init(MT, NPROJ, G, cidx); pg8::EpiProj E{big, ssq}; pg8::gemm_phase(lds, g, S, E); }
    GSYNC();
    phase_compress(p, lds);
    GSYNC();
    phase_cmp(p, lds);
    GSYNC();
    phase_ws<true, 2>(p, lds);
    GSYNC();
    phase_ws<false, 2>(p, lds);
    GSYNC();
    { pg8::Gemm g{obuf, (const bf16_t*)(ws + WS_W_OUT), DM, DM, MT, DM, DM, 0}; S.init(MT, DM, G, cidx); pg8::EpiRes E{p.x, p.out, xb, ssq + MT}; pg8::gemm_phase(lds, g, S, E); }
    GSYNC();
    { pg8::Gemm g{xb, (const bf16_t*)(ws + WS_W_GU0), DM, DM, MT, 2 * DFF, DM, 0}; S.init(MT, 2 * DFF, G, cidx); pg8::EpiSwiglu E{big, ssq + MT}; pg8::gemm_phase(lds, g, S, E); }
    GSYNC();
    { pg8::Gemm g{big, (const bf16_t*)(ws + WS_W_DN0), DFF, DFF, MT, DM, DFF, 0}; S.init(MT, DM, G, cidx); pg8::EpiRes E{p.out, p.out, xb, ssq + 2 * MT}; pg8::gemm_phase(lds, g, S, E); }
    GSYNC();
    { pg8::Gemm g{xb, (const bf16_t*)(ws + WS_P_IN), DM, DM, MT, DM, DM, 0}; S.init(MT, DM, G, cidx); pg8::EpiRowScale E{big, ssq + 2 * MT}; pg8::gemm_phase(lds, g, S, E); }
    GSYNC();
    phase_pool(p);
    GSYNC();
    { pg8::Gemm g{(const bf16_t*)(ws + WS_BIG + 128 * MiB), (const bf16_t*)(ws + WS_P_GRP), DM, 512, MT, DM, 512, 1024}; S.init(MT, DM, G, cidx); pg8::EpiColScale E{obuf, p.pool_scale}; pg8::gemm_phase(lds, g, S, E); }
    GSYNC();
    { pg8::Gemm g{obuf, (const bf16_t*)(ws + WS_P_OUT), DM, DM, MT, DM, DM, 0}; S.init(MT, DM, G, cidx); pg8::EpiRes E{p.out, p.out, xb, ssq + 3 * MT}; pg8::gemm_phase(lds, g, S, E); }
    GSYNC();
    { pg8::Gemm g{xb, (const bf16_t*)(ws + WS_W_GU1), DM, DM, MT, 2 * DFF, DM, 0}; S.init(MT, 2 * DFF, G, cidx); pg8::EpiSwiglu E{big, ssq + 3 * MT}; pg8::gemm_phase(lds, g, S, E); }
    GSYNC();
    { pg8::Gemm g{big, (const bf16_t*)(ws + WS_W_DN1), DFF, DFF, MT, DM, DFF, 0}; S.init(MT, DM, G, cidx); pg8::EpiRes E{p.out, p.out, xb, ssq + 4 * MT}; pg8::gemm_phase(lds, g, S, E); }
    GSYNC();
    phase_final(p);
}

extern "C" void kernel_launch(void* const* d_in, const int* in_sizes, int n_in, void* d_out, int out_size, void* d_ws, size_t ws_size, hipStream_t stream) {
    static int grid_blocks = 0;
    if (grid_blocks == 0) {
        if (n_in != 21 || ws_size < WS_END) { fprintf(stderr, "kernel_launch: unexpected inputs (n_in %d, ws %zu)\n", n_in, ws_size); grid_blocks = -1; return; }
        int dev = 0, cus = 0, per_cu = 0;
        hipGetDevice(&dev); hipDeviceGetAttribute(&cus, hipDeviceAttributeMultiprocessorCount, dev);
        if (hipFuncSetAttribute((const void*)fwd_megakernel, hipFuncAttributeMaxDynamicSharedMemorySize, LDS_BYTES) != hipSuccess) { fprintf(stderr, "kernel_launch: hipFuncSetAttribute failed\n"); grid_blocks = -1; return; }
        if (hipOccupancyMaxActiveBlocksPerMultiprocessor(&per_cu, (const void*)fwd_megakernel, NTHR, LDS_BYTES) != hipSuccess || per_cu < 1) { fprintf(stderr, "kernel_launch: occupancy query failed (%d)\n", per_cu); (void)hipGetLastError(); per_cu = 1; }
        grid_blocks = cus * 1;
    }
    if (grid_blocks < 0) return;
    Params p{};
    p.x = (const float*)d_in[0]; p.norm_mix = (const float*)d_in[1]; p.norm_ffn = (const float*)d_in[2]; p.norm_final = (const float*)d_in[3]; p.rel_bias = (const float*)d_in[4];
    p.nsa_w_in = (const float*)d_in[5]; p.pos_k = (const float*)d_in[6]; p.pos_v = (const float*)d_in[7]; p.ck_w1 = (const float*)d_in[8]; p.ck_b1 = (const float*)d_in[9]; p.ck_w2 = (const float*)d_in[10];
    p.cv_w1 = (const float*)d_in[11]; p.cv_b1 = (const float*)d_in[12]; p.cv_w2 = (const float*)d_in[13]; p.nsa_w_out = (const float*)d_in[14];
    p.pool_w_in = (const float*)d_in[15]; p.pool_w_grp = (const float*)d_in[16]; p.pool_scale = (const float*)d_in[17]; p.pool_w_out = (const float*)d_in[18]; p.ffn_w_gu = (const float*)d_in[19]; p.ffn_w_down = (const float*)d_in[20];
    p.out = (float*)d_out; p.ws = (unsigned char*)d_ws;
    if (hipMemsetAsync((char*)d_ws + WS_XBAR, 0, 16384, stream) != hipSuccess) { fprintf(stderr, "kernel_launch: hipMemsetAsync failed\n"); return; }
    void* args[] = {&p};
    hipError_t e = hipLaunchCooperativeKernel((const void*)fwd_megakernel, dim3(grid_blocks), dim3(NTHR), args, LDS_BYTES, stream);
    if (e != hipSuccess) fprintf(stderr, "cooperative launch failed: %s (grid %d)\n", hipGetErrorString(e), grid_blocks);
}
```

```cpp
#include <hip/hip_runtime.h>
#include <hip/hip_cooperative_groups.h>
#include <cstdio>
#include <cstdint>
namespace cg = cooperative_groups;

#define LAS __attribute__((address_space(3)))
typedef unsigned short bf16_t;
typedef short bf16x8 __attribute__((ext_vector_type(8)));
typedef float f32x4 __attribute__((ext_vector_type(4)));
typedef float f32x2 __attribute__((ext_vector_type(2)));
typedef unsigned u32x4 __attribute__((ext_vector_type(4)));
typedef unsigned u32x2 __attribute__((ext_vector_type(2)));

constexpr int BATCH = 2, SEQ = 16384, DM = 2048, MT = BATCH * SEQ;
constexpr int NG = 4, HG = 8, DK = 96, DV = 64;
constexpr int NPROJ = 5120;
constexpr int C_VC = 3072, C_VS = 3328, C_VW = 3584, C_KC = 3840, C_KS = 4224, C_KW = 4608, C_GATE = 4992;
constexpr int DFF = 5632;
constexpr int NCMP = 1024;
constexpr float EPS = 1e-6f;
constexpr float NEGF = -1e30f;

constexpr size_t MiB = 1u << 20;
constexpr size_t WS_SSQ = 0;
constexpr size_t WS_XBAR = 768 * 1024;
constexpr size_t WS_KMAX = 900 * 1024;
constexpr size_t WS_W_IN = 1 * MiB;
constexpr size_t WS_W_OUT = 21 * MiB;
constexpr size_t WS_W_GU0 = 29 * MiB, WS_W_GU1 = 73 * MiB;
constexpr size_t WS_W_DN0 = 117 * MiB, WS_W_DN1 = 139 * MiB;
constexpr size_t WS_P_IN = 161 * MiB, WS_P_GRP = 169 * MiB, WS_P_OUT = 171 * MiB;
constexpr size_t WS_CK1 = 179 * MiB, WS_CV1 = 181 * MiB, WS_CK2 = 182 * MiB, WS_CV2 = 182 * MiB + 65536;
constexpr size_t WS_KCMP = 183 * MiB, WS_VCMP = 185 * MiB, WS_SELM = 186 * MiB;
constexpr size_t WS_XB = 190 * MiB;
constexpr size_t WS_O = 318 * MiB;
constexpr size_t WS_BIG = 446 * MiB;
constexpr size_t WS_END = 798 * MiB;

typedef __bf16 bf16x2_t __attribute__((ext_vector_type(2)));
__device__ __forceinline__ unsigned cvt_pk_bf16(float lo, float hi) { const f32x2 v = {lo, hi}; const bf16x2_t b = __builtin_convertvector(v, bf16x2_t); return __builtin_bit_cast(unsigned, b); }
__device__ __forceinline__ float bf_lo(unsigned u) { return __uint_as_float(u << 16); }
__device__ __forceinline__ float bf_hi(unsigned u) { return __uint_as_float(u & 0xffff0000u); }
__device__ __forceinline__ float wave_sum(float v) {
#pragma unroll
    for (int o = 1; o < 64; o <<= 1) v += __shfl_xor(v, o);
    return v;
}

namespace pg8 {
constexpr int BM = 256, BK = 64, HALF = 128, HTB = HALF * BK * 2, STAGE_BYTES = 8 * HTB, NXCD = 8, WGM = 8;
__host__ __device__ __forceinline__ int lds_byte(int r, int c) { const int st = (r >> 4) * 2 + (c >> 5), rr = r & 15, cc = c & 31, ob = rr * 64 + cc * 2; return st * 1024 + (ob ^ (((ob >> 9) & 1) << 5)); }
__host__ __device__ __forceinline__ void stage_rc(int b, int& R, int& C) { const int st = b / 1024, sb = b % 1024, swz = sb ^ (((sb >> 9) & 1) << 5); R = (st >> 1) * 16 + swz / 64; C = (st & 1) * 32 + (swz % 64) / 2; }
__host__ __device__ __forceinline__ int perm32(int rho) { const int n = rho >> 4, i = rho & 15; return 8 * (i >> 2) + 4 * n + (i & 3); }

struct Unit { int pm, pn; };
struct Gemm { const bf16_t* A; const bf16_t* Bt; int lda, ldb, M, N, K; int acolb; };

struct StaticOrder {
    int nM, nN, nwg, G, c;
    __device__ void init(int M, int N, int G_, int c_) { nM = M / BM; nN = N / BM; nwg = nM * nN; G = G_; c = c_; }
    __device__ bool next(int i, Unit& u) const {
        const long L = (long)i * G + c; if (L >= nwg) return false;
        int wgid = (int)L; { const int q = nwg / NXCD, r = nwg % NXCD, xcd = wgid % NXCD, off = wgid / NXCD; wgid = (xcd < r ? xcd * (q + 1) : r * (q + 1) + (xcd - r) * q) + off; }
        const int nig = WGM * nN, gid = wgid / nig, fm = gid * WGM, gsz = (nM - fm) < WGM ? (nM - fm) : WGM;
        u.pm = fm + ((wgid % nig) % gsz); u.pn = (wgid % nig) / gsz; return true;
    }
};

template <class Epi>
__device__ __forceinline__ void gemm_phase(LAS unsigned char* lds, const Gemm g, const StaticOrder& S, const Epi& E) {
    const int tid = threadIdx.x, wid = __builtin_amdgcn_readfirstlane(tid >> 6), lane = tid & 63, wr = wid >> 2, wc = wid & 3, fr = lane & 15, fq = lane >> 4;
    const int K = g.K, nt = K / BK;
    unsigned voffA[2], voffB[2];
#pragma unroll
    for (int i = 0; i < 2; ++i) { int R, C; stage_rc(tid * 16 + i * 8192, R, C); const int Rb = (R & ~31) + perm32(R & 31);
        voffA[i] = (unsigned)(R * g.lda + C) * 2u; voffB[i] = (unsigned)(Rb * g.ldb + C) * 2u; }
    const size_t kstep = (size_t)(BK * 2);
    const size_t hstepA = (size_t)HALF * g.lda * 2, hstepB = (size_t)HALF * g.ldb * 2;
    const size_t tstepA = 2 * hstepA, tstepB = 2 * hstepB;
    const unsigned ldsw = (unsigned)wid * 1024u;
    const int aoff = lds_byte(wr * 64 + fr, fq * 8), boff = lds_byte(wc * 32 + fr, fq * 8);
#define PG8_SA(b, h) (((b) * 2 + (h)) * HTB)
#define PG8_SB(b, h) ((4 + (b) * 2 + (h)) * HTB)
#define PG8_STAGE(bufoff, gbase, voff) do { _Pragma("unroll") for (int _i = 0; _i < 2; ++_i) \
        __builtin_amdgcn_global_load_lds((const unsigned*)((const char*)(gbase) + (voff)[_i]), (LAS unsigned*)(lds + (bufoff) + ldsw + _i * 8192), 16, 0, 0); } while (0)
#define PG8_LDA(dst, b, h) do { _Pragma("unroll") for (int m = 0; m < 4; ++m) _Pragma("unroll") for (int k = 0; k < 2; ++k) dst[m][k] = *(const LAS bf16x8*)(lds + PG8_SA(b, h) + aoff + m * 2048 + k * 1024); } while (0)
#define PG8_LDB(dst, b, h) do { _Pragma("unroll") for (int n = 0; n < 2; ++n) _Pragma("unroll") for (int k = 0; k < 2; ++k) dst[n][k] = *(const LAS bf16x8*)(lds + PG8_SB(b, h) + boff + n * 2048 + k * 1024); } while (0)
#define PG8_MMA(ai, bj, At, Bt) do { __builtin_amdgcn_s_setprio(1); _Pragma("unroll") for (int m = 0; m < 4; ++m) _Pragma("unroll") for (int n = 0; n < 2; ++n) _Pragma("unroll") for (int k = 0; k < 2; ++k) \
        acc[ai][bj][m][n] = __builtin_amdgcn_mfma_f32_16x16x32_bf16(Bt[n][k], At[m][k], acc[ai][bj][m][n], 0, 0, 0); __builtin_amdgcn_s_setprio(0); } while (0)
#define PG8_WAIT_V(n) asm volatile("s_waitcnt vmcnt(" #n ")" ::: "memory")
#define PG8_WAIT_L(n) asm volatile("s_waitcnt lgkmcnt(" #n ")" ::: "memory")
#define PG8_BAR __builtin_amdgcn_s_barrier()
#define PG8_SCHED __builtin_amdgcn_sched_barrier(0)
#define PG8_APTR(u) ((const char*)g.A + (size_t)(u).pm * tstepA + (size_t)((u).pn >> 1) * (size_t)g.acolb)
#define PG8_BPTR(u) ((const char*)g.Bt + (size_t)(u).pn * tstepB)
    Unit cur, nxt; int ui = 0;
    if (!S.next(0, cur)) return;
    f32x4 acc[2][2][4][2];
#pragma unroll
    for (int a = 0; a < 2; ++a)
#pragma unroll
        for (int b = 0; b < 2; ++b)
#pragma unroll
            for (int m = 0; m < 4; ++m)
#pragma unroll
                for (int n = 0; n < 2; ++n) acc[a][b][m][n] = (f32x4){0.f, 0.f, 0.f, 0.f};
    bf16x8 At[4][2], B0[2][2], B1[2][2];
    const char* cA = PG8_APTR(cur); const char* cB = PG8_BPTR(cur);
    PG8_STAGE(PG8_SB(0, 0), cB, voffB); PG8_STAGE(PG8_SB(0, 1), cB + hstepB, voffB); PG8_STAGE(PG8_SA(0, 0), cA, voffA); PG8_STAGE(PG8_SA(0, 1), cA + hstepA, voffA);
    if (wr == 1) PG8_BAR;
    PG8_WAIT_V(2); PG8_BAR;
    PG8_STAGE(PG8_SB(1, 0), cB + kstep, voffB); PG8_STAGE(PG8_SA(1, 0), cA + kstep, voffA); PG8_STAGE(PG8_SB(1, 1), cB + hstepB + kstep, voffB);
    PG8_WAIT_V(6); PG8_BAR;
    for (;;) {
        const bool has_next = S.next(ui + 1, nxt);
        const char* nA = has_next ? PG8_APTR(nxt) : cA; const char* nB = has_next ? PG8_BPTR(nxt) : cB;
        for (int t = 0; t < nt; t += 2) {
            const bool last = (t == nt - 2);
            const char* a1 = cA + (size_t)(t + 1) * kstep;
            const char* a2 = last ? nA : cA + (size_t)(t + 2) * kstep; const char* b2 = last ? nB : cB + (size_t)(t + 2) * kstep;
            const char* a3 = a2 + kstep; const char* b3 = b2 + kstep;
            PG8_LDB(B0, 0, 0); PG8_LDB(B1, 0, 1); PG8_SCHED; PG8_LDA(At, 0, 0); PG8_STAGE(PG8_SA(1, 1), a1 + hstepA, voffA);
            PG8_WAIT_V(8); PG8_WAIT_L(0); PG8_BAR; PG8_MMA(0, 0, At, B0); PG8_MMA(0, 1, At, B1); PG8_BAR; PG8_SCHED;
            PG8_LDA(At, 0, 1); PG8_STAGE(PG8_SB(0, 0), b2, voffB); PG8_STAGE(PG8_SB(0, 1), b2 + hstepB, voffB); PG8_STAGE(PG8_SA(0, 0), a2, voffA);
            PG8_WAIT_V(8); PG8_WAIT_L(0); PG8_BAR; PG8_MMA(1, 0, At, B0); PG8_MMA(1, 1, At, B1); PG8_BAR; PG8_SCHED;
            PG8_LDB(B0, 1, 0); PG8_LDB(B1, 1, 1); PG8_SCHED; PG8_LDA(At, 1, 0); PG8_STAGE(PG8_SA(0, 1), a2 + hstepA, voffA);
            PG8_WAIT_V(8); PG8_WAIT_L(0); PG8_BAR; PG8_MMA(0, 0, At, B0); PG8_MMA(0, 1, At, B1); PG8_BAR; PG8_SCHED;
            PG8_LDA(At, 1, 1); PG8_STAGE(PG8_SB(1, 0), b3, voffB); PG8_STAGE(PG8_SB(1, 1), b3 + hstepB, voffB); PG8_STAGE(PG8_SA(1, 0), a3, voffA);
            PG8_WAIT_V(8); PG8_WAIT_L(0); PG8_BAR; PG8_MMA(1, 0, At, B0); PG8_MMA(1, 1, At, B1); PG8_BAR; PG8_SCHED;
        }
        if (wr == 0) PG8_BAR;
        E(acc, cur, wr, wc, fr, fq);
        if (!has_next) break;
#pragma unroll
        for (int a = 0; a < 2; ++a)
#pragma unroll
            for (int b = 0; b < 2; ++b)
#pragma unroll
                for (int m = 0; m < 4; ++m)
#pragma unroll
                    for (int n = 0; n < 2; ++n) acc[a][b][m][n] = (f32x4){0.f, 0.f, 0.f, 0.f};
        cur = nxt; cA = nA; cB = nB; ++ui;
        if (wr == 1) PG8_BAR;
    }
    PG8_WAIT_V(0);
    PG8_BAR;
#undef PG8_SA
#undef PG8_SB
#undef PG8_STAGE
#undef PG8_LDA
#undef PG8_LDB
#undef PG8_MMA
#undef PG8_WAIT_V
#undef PG8_WAIT_L
#undef PG8_BAR
#undef PG8_SCHED
#undef PG8_APTR
#undef PG8_BPTR
}

#define EPI_ROW(u, ai, m) ((u).pm * BM + (ai) * HALF + wr * 64 + (m) * 16 + fr)
__device__ __forceinline__ u32x4 pack8(f32x4 v0, f32x4 v1) { u32x4 w; w.x = cvt_pk_bf16(v0[0], v0[1]); w.y = cvt_pk_bf16(v0[2], v0[3]); w.z = cvt_pk_bf16(v1[0], v1[1]); w.w = cvt_pk_bf16(v1[2], v1[3]); return w; }

struct EpiProj {
    bf16_t* O; const float* ssq;
    __device__ __forceinline__ void operator()(const f32x4 (&acc)[2][2][4][2], const Unit& u, int wr, int wc, int fr, int fq) const {
        const float qs = (u.pn < 12) ? 0.10206207261596577f * 1.4426950408889634f : 1.0f;
#pragma unroll
        for (int ai = 0; ai < 2; ++ai)
#pragma unroll
            for (int m = 0; m < 4; ++m) { const int row = EPI_ROW(u, ai, m); const float rs = rsqrtf(ssq[row] * (1.0f / DM) + EPS) * qs;
#pragma unroll
                for (int bj = 0; bj < 2; ++bj) { const int c0 = u.pn * BM + bj * HALF + wc * 32 + 8 * fq;
                    *(u32x4*)(O + (size_t)row * NPROJ + c0) = pack8(acc[ai][bj][m][0] * rs, acc[ai][bj][m][1] * rs); } }
    }
};
struct EpiRowScale {
    bf16_t* O; const float* ssq;
    __device__ __forceinline__ void operator()(const f32x4 (&acc)[2][2][4][2], const Unit& u, int wr, int wc, int fr, int fq) const {
#pragma unroll
        for (int ai = 0; ai < 2; ++ai)
#pragma unroll
            for (int m = 0; m < 4; ++m) { const int row = EPI_ROW(u, ai, m); const float rs = rsqrtf(ssq[row] * (1.0f / DM) + EPS);
#pragma unroll
                for (int bj = 0; bj < 2; ++bj) { const int c0 = u.pn * BM + bj * HALF + wc * 32 + 8 * fq;
                    *(u32x4*)(O + (size_t)row * DM + c0) = pack8(acc[ai][bj][m][0] * rs, acc[ai][bj][m][1] * rs); } }
    }
};
struct EpiColScale {
    bf16_t* O; const float* scale;
    __device__ __forceinline__ void operator()(const f32x4 (&acc)[2][2][4][2], const Unit& u, int wr, int wc, int fr, int fq) const {
#pragma unroll
        for (int bj = 0; bj < 2; ++bj) { const int c0 = u.pn * BM + bj * HALF + wc * 32 + 8 * fq;
            const f32x4 s0 = *(const f32x4*)(scale + c0), s1 = *(const f32x4*)(scale + c0 + 4);
#pragma unroll
            for (int ai = 0; ai < 2; ++ai)
#pragma unroll
                for (int m = 0; m < 4; ++m) { const int row = EPI_ROW(u, ai, m);
                    *(u32x4*)(O + (size_t)row * DM + c0) = pack8(acc[ai][bj][m][0] * s0, acc[ai][bj][m][1] * s1); } }
    }
};
struct EpiSwiglu {
    bf16_t* O; const float* ssq;
    __device__ __forceinline__ void operator()(const f32x4 (&acc)[2][2][4][2], const Unit& u, int wr, int wc, int fr, int fq) const {
        const int c0 = u.pn * HALF + wc * 32 + 8 * fq;
#pragma unroll
        for (int ai = 0; ai < 2; ++ai)
#pragma unroll
            for (int m = 0; m < 4; ++m) { const int row = EPI_ROW(u, ai, m); const float rs = rsqrtf(ssq[row] * (1.0f / DM) + EPS);
                f32x4 r[2];
#pragma unroll
                for (int n = 0; n < 2; ++n)
#pragma unroll
                    for (int j = 0; j < 4; ++j) { const float gt = acc[ai][0][m][n][j] * rs, up = acc[ai][1][m][n][j] * rs; r[n][j] = gt * up * __builtin_amdgcn_rcpf(1.0f + __expf(-gt)); }
                *(u32x4*)(O + (size_t)row * DFF + c0) = pack8(r[0], r[1]); }
    }
};
struct EpiRes {
    const float* src; float* dst; bf16_t* xb; float* ssq_out;
    __device__ __forceinline__ void operator()(const f32x4 (&acc)[2][2][4][2], const Unit& u, int wr, int wc, int fr, int fq) const {
#pragma unroll
        for (int ai = 0; ai < 2; ++ai)
#pragma unroll
            for (int m = 0; m < 4; ++m) { const int row = EPI_ROW(u, ai, m); float ss = 0.f;
#pragma unroll
                for (int bj = 0; bj < 2; ++bj) { const size_t off = (size_t)row * DM + u.pn * BM + bj * HALF + wc * 32 + 8 * fq;
                    const f32x4 x0 = *(const f32x4*)(src + off) + acc[ai][bj][m][0], x1 = *(const f32x4*)(src + off + 4) + acc[ai][bj][m][1];
                    *(f32x4*)(dst + off) = x0; *(f32x4*)(dst + off + 4) = x1; *(u32x4*)(xb + off) = pack8(x0, x1);
                    ss += (x0[0] * x0[0] + x0[1] * x0[1]) + (x0[2] * x0[2] + x0[3] * x0[3]) + (x1[0] * x1[0] + x1[1] * x1[1]) + (x1[2] * x1[2] + x1[3] * x1[3]); }
                ss += __shfl_xor(ss, 16); ss += __shfl_xor(ss, 32);
                if (fq == 0) atomicAdd(ssq_out + row, ss); }
    }
};
}

struct Params {
    const float* x; const float* norm_mix; const float* norm_ffn; const float* norm_final; const float* rel_bias;
    const float* nsa_w_in; const float* pos_k; const float* pos_v; const float* ck_w1; const float* ck_b1; const float* ck_w2;
    const float* cv_w1; const float* cv_b1; const float* cv_w2; const float* nsa_w_out;
    const float* pool_w_in; const float* pool_w_grp; const float* pool_scale; const float* pool_w_out; const float* ffn_w_gu; const float* ffn_w_down;
    float* out; unsigned char* ws;
};

constexpr int NTHR = 512, NWAVES = 8;
constexpr int LDS_BYTES = 163840;

__device__ __forceinline__ int nsa_map(int n0) {
    if (n0 < 3072) return n0;
    if (n0 < 3456) return C_KC + (n0 - 3072);
    if (n0 < 3712) return C_VC + (n0 - 3456);
    if (n0 < 4096) return C_KS + (n0 - 3712);
    if (n0 < 4352) return C_VS + (n0 - 4096);
    if (n0 < 4736) return C_KW + (n0 - 4352);
    if (n0 < 4992) return C_VW + (n0 - 4736);
    return C_GATE + (n0 - 4992);
}
__device__ __forceinline__ int gu_map(int n0) { return n0 < DFF ? (n0 >> 7) * 256 + (n0 & 127) : ((n0 - DFF) >> 7) * 256 + 128 + ((n0 - DFF) & 127); }

template <int MAP>
__device__ __forceinline__ void transpose_items(const float* W, int K, int N, bf16_t* WT, int ldd, int row_off, const float* fold, LAS float* scr, int gw, int ngw, int lane) {
    const int nblk = N / 32, nitems = (K / 64) * nblk;
    for (int item = gw; item < nitems; item += ngw) {
        const int kb = item / nblk, nb = item % nblk, k0 = 64 * kb, n0 = 32 * nb;
        const int d0 = row_off + (MAP == 1 ? nsa_map(n0) : (MAP == 2 ? gu_map(n0) : n0));
        float wv[32];
#pragma unroll
        for (int i = 0; i < 32; ++i) wv[i] = W[(size_t)(k0 + 2 * i + (lane >> 5)) * N + n0 + (lane & 31)];
#pragma unroll
        for (int i = 0; i < 32; ++i) { const int kk = 2 * i + (lane >> 5); float v = wv[i]; if (fold) v *= fold[k0 + kk]; scr[kk * 33 + (lane & 31)] = v; }
        asm volatile("s_waitcnt lgkmcnt(0)" ::: "memory");
        const int c = lane & 7;
#pragma unroll
        for (int j = 0; j < 4; ++j) { const int n = (lane >> 3) + 8 * j; const LAS float* s = scr + (8 * c) * 33 + n;
            u32x4 o; o.x = cvt_pk_bf16(s[0 * 33], s[1 * 33]); o.y = cvt_pk_bf16(s[2 * 33], s[3 * 33]); o.z = cvt_pk_bf16(s[4 * 33], s[5 * 33]); o.w = cvt_pk_bf16(s[6 * 33], s[7 * 33]);
            *(u32x4*)(WT + (size_t)(d0 + n) * ldd + k0 + 8 * c) = o; }
        asm volatile("s_waitcnt lgkmcnt(0)" ::: "memory");
    }
}

__device__ __forceinline__ void phase_prologue(const Params& p, LAS unsigned char* lds) {
    const int tid = threadIdx.x, lane = tid & 63, wave = tid >> 6;
    const int gw = blockIdx.x * NWAVES + wave, ngw = gridDim.x * NWAVES;
    LAS float* scr = (LAS float*)(lds + wave * 8704);
    unsigned char* ws = p.ws;
    if (blockIdx.x == 0 && tid < 16) ((unsigned*)(ws + WS_KMAX))[tid] = 0u;
    { float* ssq = (float*)(ws + WS_SSQ); for (int i = blockIdx.x * NTHR + tid; i < 4 * MT; i += gridDim.x * NTHR) ssq[MT + i] = 0.f; }
    transpose_items<1>(p.nsa_w_in, DM, 5088, (bf16_t*)(ws + WS_W_IN), DM, 0, p.norm_mix, scr, gw, ngw, lane);
    transpose_items<0>(p.nsa_w_out, DM, DM, (bf16_t*)(ws + WS_W_OUT), DM, 0, nullptr, scr, gw, ngw, lane);
    transpose_items<2>(p.ffn_w_gu, DM, 2 * DFF, (bf16_t*)(ws + WS_W_GU0), DM, 0, p.norm_ffn, scr, gw, ngw, lane);
    transpose_items<2>(p.ffn_w_gu + (size_t)DM * 2 * DFF, DM, 2 * DFF, (bf16_t*)(ws + WS_W_GU1), DM, 0, p.norm_ffn + DM, scr, gw, ngw, lane);
    transpose_items<0>(p.ffn_w_down, DFF, DM, (bf16_t*)(ws + WS_W_DN0), DFF, 0, nullptr, scr, gw, ngw, lane);
    transpose_items<0>(p.ffn_w_down + (size_t)DFF * DM, DFF, DM, (bf16_t*)(ws + WS_W_DN1), DFF, 0, nullptr, scr, gw, ngw, lane);
    transpose_items<0>(p.pool_w_in, DM, DM, (bf16_t*)(ws + WS_P_IN), DM, 0, p.norm_mix + DM, scr, gw, ngw, lane);
#pragma unroll 1
    for (int gi = 0; gi < 4; ++gi) transpose_items<0>(p.pool_w_grp + (size_t)gi * 512 * 512, 512, 512, (bf16_t*)(ws + WS_P_GRP), 512, gi * 512, nullptr, scr, gw, ngw, lane);
    transpose_items<0>(p.pool_w_out, DM, DM, (bf16_t*)(ws + WS_P_OUT), DM, 0, nullptr, scr, gw, ngw, lane);
    transpose_items<0>(p.ck_w1, 32 * DK, 256, (bf16_t*)(ws + WS_CK1), 32 * DK, 0, nullptr, scr, gw, ngw, lane);
    transpose_items<0>(p.cv_w1, 32 * DV, 256, (bf16_t*)(ws + WS_CV1), 32 * DV, 0, nullptr, scr, gw, ngw, lane);
    transpose_items<0>(p.ck_w2, 256, DK, (bf16_t*)(ws + WS_CK2), 256, 0, nullptr, scr, gw, ngw, lane);
    transpose_items<0>(p.cv_w2, 256, DV, (bf16_t*)(ws + WS_CV2), 256, 0, nullptr, scr, gw, ngw, lane);
    float* ssq0 = (float*)(ws + WS_SSQ); bf16_t* xb = (bf16_t*)(ws + WS_XB);
    for (int row = gw; row < MT; row += ngw) {
        const f32x4* xr = (const f32x4*)(p.x + (size_t)row * DM) + lane; u32x2* o = (u32x2*)(xb + (size_t)row * DM) + lane;
        float s = 0.f;
#pragma unroll
        for (int j = 0; j < 8; ++j) { const f32x4 v = xr[64 * j]; s += (v[0] * v[0] + v[1] * v[1]) + (v[2] * v[2] + v[3] * v[3]); u32x2 w; w.x = cvt_pk_bf16(v[0], v[1]); w.y = cvt_pk_bf16(v[2], v[3]); o[64 * j] = w; }
        s = wave_sum(s);
        if (lane == 0) ssq0[row] = s;
    }
}

__device__ __forceinline__ float gelu_tanh(float x) { const float u = 0.7978845608028654f * (x + 0.044715f * x * x * x); return 0.5f * x * (1.0f + tanhf(u)); }

template <int DH>
__device__ __forceinline__ void compress_unit(const Params& p, LAS unsigned char* lds, int b, int n0, int colbase, const float* pos, const bf16_t* w1t, const float* b1, const bf16_t* w2t, bf16_t* outp) {
    constexpr int KC = 32 * DH;
    const int tid = threadIdx.x, lane = tid & 63, wave = __builtin_amdgcn_readfirstlane(tid >> 6), c = lane & 15, kq = lane >> 4;
    const bf16_t* proj = (const bf16_t*)(p.ws + WS_BIG);
    LAS unsigned char* As = lds; LAS unsigned char* Bs = lds + 5120; LAS unsigned char* Hs = lds + 32768;
    const int arow = tid >> 2, ach = tid & 3;
    const int ag = arow >> 4, an = n0 + (arow & 15);
    u32x4 areg = {0, 0, 0, 0}, breg[2];
#define CMP_LOAD(k0_) do { const int k0v = (k0_); \
        if (tid < 256) { const int kk = k0v + ach * 8, l = kk / DH, d = kk % DH; int tok = 16 * an + l; tok = tok < SEQ ? tok : SEQ - 1; \
            const u32x4 raw = *(const u32x4*)(proj + (size_t)(b * SEQ + tok) * NPROJ + colbase + ag * DH + d); \
            const f32x4 p0 = *(const f32x4*)(pos + l * DH + d), p1 = *(const f32x4*)(pos + l * DH + d + 4); \
            areg.x = cvt_pk_bf16(bf_lo(raw.x) + p0[0], bf_hi(raw.x) + p0[1]); areg.y = cvt_pk_bf16(bf_lo(raw.y) + p0[2], bf_hi(raw.y) + p0[3]); \
            areg.z = cvt_pk_bf16(bf_lo(raw.z) + p1[0], bf_hi(raw.z) + p1[1]); areg.w = cvt_pk_bf16(bf_lo(raw.w) + p1[2], bf_hi(raw.w) + p1[3]); } \
        _Pragma("unroll") for (int i_ = 0; i_ < 2; ++i_) { const int idx = tid + 512 * i_; breg[i_] = *(const u32x4*)(w1t + (size_t)(idx >> 2) * KC + k0v + (idx & 3) * 8); } } while (0)
    f32x4 acc[4][2];
#pragma unroll
    for (int m = 0; m < 4; ++m) { acc[m][0] = (f32x4){0.f, 0.f, 0.f, 0.f}; acc[m][1] = (f32x4){0.f, 0.f, 0.f, 0.f}; }
    CMP_LOAD(0);
    for (int k0 = 0; k0 < KC; k0 += 32) {
        __syncthreads();
        if (tid < 256) *(LAS u32x4*)(As + arow * 80 + ach * 16) = areg;
#pragma unroll
        for (int i = 0; i < 2; ++i) { const int idx = tid + 512 * i; *(LAS u32x4*)(Bs + (idx >> 2) * 80 + (idx & 3) * 16) = breg[i]; }
        __syncthreads();
        if (k0 + 32 < KC) CMP_LOAD(k0 + 32);
        bf16x8 af[4], bfr[2];
#pragma unroll
        for (int m = 0; m < 4; ++m) af[m] = *(const LAS bf16x8*)(As + (16 * m + c) * 80 + kq * 16);
#pragma unroll
        for (int n = 0; n < 2; ++n) bfr[n] = *(const LAS bf16x8*)(Bs + (32 * wave + 16 * n + c) * 80 + kq * 16);
#pragma unroll
        for (int m = 0; m < 4; ++m)
#pragma unroll
            for (int n = 0; n < 2; ++n) acc[m][n] = __builtin_amdgcn_mfma_f32_16x16x32_bf16(af[m], bfr[n], acc[m][n], 0, 0, 0);
    }
#pragma unroll
    for (int n = 0; n < 2; ++n) { const int col = 32 * wave + 16 * n + c; const float bb = b1[col];
#pragma unroll
        for (int m = 0; m < 4; ++m)
#pragma unroll
            for (int i = 0; i < 4; ++i) { const float h = gelu_tanh(acc[m][n][i] + bb); *(LAS bf16_t*)(Hs + (16 * m + 4 * kq + i) * 528 + col * 2) = (bf16_t)(cvt_pk_bf16(h, 0.f) & 0xffffu); } }
    __syncthreads();
    constexpr int NT2 = 4 * (DH / 16);
    for (int idx = wave; idx < NT2; idx += 8) {
        const int m2 = idx & 3, n2 = idx >> 2;
        f32x4 a2 = {0.f, 0.f, 0.f, 0.f};
#pragma unroll
        for (int ks = 0; ks < 8; ++ks) { const bf16x8 a = *(const LAS bf16x8*)(Hs + (16 * m2 + c) * 528 + (32 * ks + 8 * kq) * 2);
            const bf16x8 bb = *(const bf16x8*)(w2t + (size_t)(16 * n2 + c) * 256 + 32 * ks + 8 * kq);
            a2 = __builtin_amdgcn_mfma_f32_16x16x32_bf16(a, bb, a2, 0, 0, 0); }
#pragma unroll
        for (int i = 0; i < 4; ++i) outp[((size_t)(b * NG + m2) * NCMP + n0 + 4 * kq + i) * DH + 16 * n2 + c] = (bf16_t)(cvt_pk_bf16(a2[i], 0.f) & 0xffffu);
    }
    __syncthreads();
}

__device__ __forceinline__ void phase_compress(const Params& p, LAS unsigned char* lds) {
    unsigned char* ws = p.ws;
    for (int u = blockIdx.x; u < 256; u += gridDim.x) {
        const int which = u >> 7, b = (u >> 6) & 1, n0 = (u & 63) * 16;
        if (which == 0) compress_unit<DK>(p, lds, b, n0, C_KC, p.pos_k, (const bf16_t*)(ws + WS_CK1), p.ck_b1, (const bf16_t*)(ws + WS_CK2), (bf16_t*)(ws + WS_KCMP));
        else compress_unit<DV>(p, lds, b, n0, C_VC, p.pos_v, (const bf16_t*)(ws + WS_CV1), p.cv_b1, (const bf16_t*)(ws + WS_CV2), (bf16_t*)(ws + WS_VCMP));
    }
    { const bf16_t* proj = (const bf16_t*)(ws + WS_BIG); unsigned* kmaxp = (unsigned*)(ws + WS_KMAX); const int lane = threadIdx.x & 63;
      for (int it = blockIdx.x * NTHR + threadIdx.x; it < MT * 8; it += gridDim.x * NTHR) { const int row = it >> 3, sg = it & 7, br = sg >> 2, g = sg & 3;
        const u32x4* kp = (const u32x4*)(proj + (size_t)row * NPROJ + (br ? C_KW : C_KS) + g * DK); float n2 = 0.f;
#pragma unroll
        for (int ch = 0; ch < 12; ++ch) { const u32x4 w = kp[ch];
            n2 += bf_lo(w.x) * bf_lo(w.x) + bf_hi(w.x) * bf_hi(w.x) + bf_lo(w.y) * bf_lo(w.y) + bf_hi(w.y) * bf_hi(w.y) + bf_lo(w.z) * bf_lo(w.z) + bf_hi(w.z) * bf_hi(w.z) + bf_lo(w.w) * bf_lo(w.w) + bf_hi(w.w) * bf_hi(w.w); }
        n2 = fmaxf(n2, __shfl_xor(n2, 8)); n2 = fmaxf(n2, __shfl_xor(n2, 16)); n2 = fmaxf(n2, __shfl_xor(n2, 32));
        if (lane < 8) atomicMax(kmaxp + br * 8 + (row >> 14) * 4 + g, __float_as_uint(sqrtf(n2))); } }
}

constexpr int KT_STRIDE = 208, SLOT_K = 64 * KT_STRIDE;
constexpr int VT_STRIDE = 144, SLOT_V = 64 * VT_STRIDE;
constexpr int SLOT_BYTES = SLOT_K + SLOT_V, RING = 5, PD = RING - 1;
constexpr int RING_WS = 6;
constexpr int L_RING = 0, L_IMP = RING * SLOT_BYTES, L_BIAS = LDS_BYTES - 4 * 8 * 132 * 4, L_SELM = L_BIAS - 2048;
static_assert(L_IMP + 32 * 256 * 4 <= L_BIAS && RING_WS * SLOT_BYTES <= L_SELM, "attention LDS map");

struct PairState { f32x4 o[4]; float m, l; bf16x8 q[3]; };
struct TileSrc { const bf16_t* K; const bf16_t* V; int kld, vld; };
struct DmaPlan { int off[3]; };

__device__ __forceinline__ void glds16(const void* gsrc, unsigned lds_dst) { unsigned keep;
    asm volatile("s_mov_b32 %0, m0\n\ts_mov_b32 m0, %2\n\ts_nop 0\n\tglobal_load_lds_dwordx4 %1, off\n\ts_mov_b32 m0, %0" : "=&s"(keep) : "v"(gsrc), "s"(lds_dst) : "memory"); }
#define ATT_WAIT_BAR(N) asm volatile("s_waitcnt vmcnt(" #N ") lgkmcnt(0)\n\ts_barrier" ::: "memory")
__device__ __forceinline__ void att_wait_bar(int rem) { if (rem <= 0) ATT_WAIT_BAR(0); else if (rem == 1) ATT_WAIT_BAR(3); else if (rem == 2) ATT_WAIT_BAR(6); else ATT_WAIT_BAR(9); }
__device__ __forceinline__ bool piece_is_k(int s) { return s < 13 || s >= 22; }
__device__ __forceinline__ int piece_grp(int s) { return s < 13 ? s : (s >= 22 ? s - 22 : s - 13); }
__device__ __forceinline__ void make_plan(DmaPlan& pl, const TileSrc& src, int wave, int lane) {
#pragma unroll
    for (int j = 0; j < 3; ++j) { const int sidx = wave + 8 * j, ci = 64 * piece_grp(sidx) + lane;
        if (piece_is_k(sidx)) { const int key = ci / 13, ch = ci % 13; pl.off[j] = key * src.kld + (ch < 12 ? ch : 11) * 8; }
        else { const int key = ci / 9, ch = ci % 9; pl.off[j] = key * src.vld + (ch < 8 ? ch : 7) * 8; } }
}
__device__ __forceinline__ void issue_tile(const DmaPlan& pl, const TileSrc& src, int key0, unsigned slot_addr, int wave) {
#pragma unroll
    for (int j = 0; j < 3; ++j) { const int sidx = wave + 8 * j; const bool isk = piece_is_k(sidx);
        const bf16_t* gp = (isk ? src.K + (size_t)key0 * src.kld : src.V + (size_t)key0 * src.vld) + pl.off[j];
        glds16(gp, slot_addr + (isk ? 0u : (unsigned)SLOT_K) + 1024u * (unsigned)piece_grp(sidx)); }
}
typedef short s16x4 __attribute__((ext_vector_type(4)));
__device__ __forceinline__ s16x4 vtr(const LAS unsigned char* p) { return __builtin_bit_cast(s16x4, __builtin_amdgcn_ds_read_tr16_b64_v4i16((LAS s16x4*)p)); }

__device__ __forceinline__ float sum8_dpp(float x) {
    x += __builtin_bit_cast(float, __builtin_amdgcn_update_dpp(0, __builtin_bit_cast(int, x), 0xB1, 0xF, 0xF, true));
    x += __builtin_bit_cast(float, __builtin_amdgcn_update_dpp(0, __builtin_bit_cast(int, x), 0x4E, 0xF, 0xF, true));
    x += __builtin_bit_cast(float, __builtin_amdgcn_update_dpp(0, __builtin_bit_cast(int, x), 0x141, 0xF, 0xF, true));
    return x;
}
template <int MODE, bool FAR>
__device__ __forceinline__ void pair_tile(PairState& st, const LAS unsigned char* Kt, const LAS unsigned char* Vt, int tadj, int kstride, int maxdist, bool rowsel,
                                          const LAS float* biasrow, float bias_far, LAS float* improw, int jj0, int lane) {
    const int c = lane & 15, kq = lane >> 4;
    f32x4 s[4];
    float bv[4][4];
    if (!FAR) {
#pragma unroll
        for (int kt = 0; kt < 4; ++kt)
#pragma unroll
            for (int i = 0; i < 4; ++i) { const int d = tadj - (16 * kt + 4 * kq + i) * kstride; const int bi = d < 0 ? 0 : (d > 128 ? 128 : d); bv[kt][i] = biasrow[bi]; }
    }
    const float init = FAR ? (rowsel ? bias_far - st.m : NEGF) : -st.m;
    const f32x4 initv = {init, init, init, init};
#pragma unroll
    for (int kt = 0; kt < 4; ++kt) {
#pragma unroll
        for (int ds = 0; ds < 3; ++ds) { const bf16x8 a = *(const LAS bf16x8*)(Kt + (16 * kt + c) * KT_STRIDE + (32 * ds + 8 * kq) * 2);
            s[kt] = __builtin_amdgcn_mfma_f32_16x16x32_bf16(a, st.q[ds], ds == 0 ? initv : s[kt], 0, 0, 0); } }
    if (!FAR) {
#pragma unroll
        for (int kt = 0; kt < 4; ++kt)
#pragma unroll
            for (int i = 0; i < 4; ++i) { const int d = tadj - (16 * kt + 4 * kq + i) * kstride; const bool valid = ((unsigned)d < (unsigned)maxdist) && rowsel;
                s[kt][i] = valid ? s[kt][i] + bv[kt][i] : NEGF; }
    }
    float psum = 0.f;
#pragma unroll
    for (int kt = 0; kt < 4; ++kt)
#pragma unroll
        for (int i = 0; i < 4; ++i) { const float pv = __builtin_amdgcn_exp2f(s[kt][i]); s[kt][i] = pv; psum += pv; }
    if (MODE != 1) st.l += psum;
    if (MODE == 0) return;
#pragma unroll
    for (int s2 = 0; s2 < 2; ++s2) {
        u32x4 pw; pw.x = cvt_pk_bf16(s[2 * s2][0], s[2 * s2][1]); pw.y = cvt_pk_bf16(s[2 * s2][2], s[2 * s2][3]); pw.z = cvt_pk_bf16(s[2 * s2 + 1][0], s[2 * s2 + 1][1]); pw.w = cvt_pk_bf16(s[2 * s2 + 1][2], s[2 * s2 + 1][3]);
        const bf16x8 pb = __builtin_bit_cast(bf16x8, pw);
#pragma unroll
        for (int dt = 0; dt < 4; ++dt) { const LAS unsigned char* vp = Vt + (32 * s2 + 4 * kq + (c >> 2)) * VT_STRIDE + (16 * dt + 4 * (c & 3)) * 2;
            const s16x4 lo = vtr(vp), hi = vtr(vp + 16 * VT_STRIDE); const bf16x8 a = {lo[0], lo[1], lo[2], lo[3], hi[0], hi[1], hi[2], hi[3]};
            st.o[dt] = __builtin_amdgcn_mfma_f32_16x16x32_bf16(a, pb, st.o[dt], 0, 0, 0); }
    }
    if (MODE == 1) {
#pragma unroll
        for (int kt = 0; kt < 4; ++kt) {
            float u0 = 2.0f * (s[kt][0] + s[kt][1] + s[kt][2]) + s[kt][3], u1 = s[kt][3];
            u0 = sum8_dpp(u0); u1 = sum8_dpp(u1);
            if ((lane & 7) == 0) { const int jj = jj0 + 4 * kt + kq;
                __hip_atomic_fetch_add(improw + jj, u0, __ATOMIC_RELAXED, __HIP_MEMORY_SCOPE_WORKGROUP);
                if (jj + 1 < 256) __hip_atomic_fetch_add(improw + jj + 1, u1, __ATOMIC_RELAXED, __HIP_MEMORY_SCOPE_WORKGROUP); }
        }
    }
}
#define PAIR_TILE(MODE, far, ...) do { if (far) pair_tile<MODE, true>(__VA_ARGS__); else pair_tile<MODE, false>(__VA_ARGS__); } while (0)

__device__ __forceinline__ int t5_bucket(int n) {
    if (n < 16) return n;
    int bk = 16;
    bk += (n >= 19); bk += (n >= 21); bk += (n >= 24); bk += (n >= 27); bk += (n >= 31); bk += (n >= 35); bk += (n >= 40); bk += (n >= 46);
    bk += (n >= 52); bk += (n >= 59); bk += (n >= 67); bk += (n >= 77); bk += (n >= 87); bk += (n >= 99); bk += (n >= 113);
    return bk;
}
__device__ __forceinline__ void build_bias(const Params& p, LAS unsigned char* lds) {
    LAS float* bt = (LAS float*)(lds + L_BIAS);
    for (int i = threadIdx.x; i < 32 * 129; i += NTHR) { const int h = i / 129, d = i % 129; bt[h * 132 + d] = p.rel_bias[t5_bucket(d) * 32 + h] * 1.4426950408889634f; }
    __syncthreads();
    if (threadIdx.x < 32) { float mx = bt[threadIdx.x * 132]; for (int d = 1; d < 129; ++d) mx = fmaxf(mx, bt[threadIdx.x * 132 + d]); bt[threadIdx.x * 132 + 129] = mx; }
    __syncthreads();
}

__device__ __forceinline__ void load_q(PairState& st, const bf16_t* proj, int b, int g, int tq0, int lane, float kmx, float bmax) {
    const int c = lane & 15, kq = lane >> 4; const size_t row = (size_t)b * SEQ + tq0 + (c >> 3);
#pragma unroll
    for (int ds = 0; ds < 3; ++ds) st.q[ds] = *(const bf16x8*)(proj + row * NPROJ + (g * 8 + (c & 7)) * DK + 32 * ds + 8 * kq);
    asm volatile("" : "+v"(st.q[0]), "+v"(st.q[1]), "+v"(st.q[2]));
    float qq = 0.f;
#pragma unroll
    for (int ds = 0; ds < 3; ++ds) { const u32x4 w = __builtin_bit_cast(u32x4, st.q[ds]);
        qq += bf_lo(w.x) * bf_lo(w.x) + bf_hi(w.x) * bf_hi(w.x) + bf_lo(w.y) * bf_lo(w.y) + bf_hi(w.y) * bf_hi(w.y) + bf_lo(w.z) * bf_lo(w.z) + bf_hi(w.z) * bf_hi(w.z) + bf_lo(w.w) * bf_lo(w.w) + bf_hi(w.w) * bf_hi(w.w); }
    qq += __shfl_xor(qq, 16); qq += __shfl_xor(qq, 32);
    st.m = sqrtf(qq) * kmx + bmax + 0.25f;
}
__device__ __forceinline__ void reset_state(PairState& st) {
#pragma unroll
    for (int dt = 0; dt < 4; ++dt) st.o[dt] = (f32x4){0.f, 0.f, 0.f, 0.f};
    st.l = 0.f;
}
template <bool ACCUM>
__device__ __forceinline__ void write_out(const PairState& st, float inv, const bf16_t* proj, bf16_t* obuf, int b, int g, int tq0, int br, int lane) {
    const int c = lane & 15, kq = lane >> 4; const size_t row = (size_t)b * SEQ + tq0 + (c >> 3);
    const float gl = bf_lo((unsigned)proj[row * NPROJ + C_GATE + br * 32 + g * 8 + (c & 7)]);
    const float sc = inv * __builtin_amdgcn_rcpf(1.0f + __expf(-gl));
    bf16_t* op = obuf + row * DM + (g * 8 + (c & 7)) * DV + 4 * kq;
#pragma unroll
    for (int dt = 0; dt < 4; ++dt) { f32x4 v = st.o[dt] * sc;
        if (ACCUM) { const u32x2 old = *(const u32x2*)(op + 16 * dt); v[0] += bf_lo(old.x); v[1] += bf_hi(old.x); v[2] += bf_lo(old.y); v[3] += bf_hi(old.y); }
        u32x2 w; w.x = cvt_pk_bf16(v[0], v[1]); w.y = cvt_pk_bf16(v[2], v[3]); *(u32x2*)(op + 16 * dt) = w; }
}

constexpr size_t WS_UCTR = WS_XBAR + 14336;
#define UNIT_LOOP_BEGIN(ctrptr, NU) \
    { LAS unsigned* ubox_ = (LAS unsigned*)(lds + 146440); unsigned nxt_ = 0u; \
      if (threadIdx.x == 0) ubox_[0] = atomicAdd((ctrptr), 1u); \
      __syncthreads(); \
      for (;;) { const unsigned ul = ubox_[0]; if (ul >= (unsigned)(NU)) break; \
          __syncthreads();
#define UNIT_PREFETCH(ctrptr) do { if (threadIdx.x == 0) nxt_ = atomicAdd((ctrptr), 1u); } while (0)
#define UNIT_LOOP_END() \
          if (threadIdx.x == 0) ubox_[0] = nxt_; \
          __syncthreads(); } }

__device__ __forceinline__ void phase_cmp(const Params& p, LAS unsigned char* lds) {
    const int tid = threadIdx.x, lane = tid & 63, wave = __builtin_amdgcn_readfirstlane(tid >> 6), c = lane & 15;
    const bf16_t* proj = (const bf16_t*)(p.ws + WS_BIG); bf16_t* obuf = (bf16_t*)(p.ws + WS_O); unsigned* selm = (unsigned*)(p.ws + WS_SELM);
    build_bias(p, lds);
    { LAS float* bt = (LAS float*)(lds + L_BIAS); const u32x4* kc = (const u32x4*)(p.ws + WS_KCMP) + (size_t)wave * NCMP * 12; float n2m = 0.f;
      for (int r = lane; r < NCMP; r += 64) { float n2 = 0.f;
#pragma unroll
        for (int ch = 0; ch < 12; ++ch) { const u32x4 w = kc[r * 12 + ch];
            n2 += bf_lo(w.x) * bf_lo(w.x) + bf_hi(w.x) * bf_hi(w.x) + bf_lo(w.y) * bf_lo(w.y) + bf_hi(w.y) * bf_hi(w.y) + bf_lo(w.z) * bf_lo(w.z) + bf_hi(w.z) * bf_hi(w.z) + bf_lo(w.w) * bf_lo(w.w) + bf_hi(w.w) * bf_hi(w.w); }
        n2m = fmaxf(n2m, n2); }
#pragma unroll
      for (int o = 1; o < 64; o <<= 1) n2m = fmaxf(n2m, __shfl_xor(n2m, o));
      if (lane == 0) bt[wave * 132 + 130] = sqrtf(n2m);
      __syncthreads(); }
    LAS float* imp = (LAS float*)(lds + L_IMP);
    UNIT_LOOP_BEGIN((unsigned*)(p.ws + WS_UCTR) + (blockIdx.x & 7), 512)
        const int bg = blockIdx.x & 7, b = bg >> 2, g = bg & 3, t0 = (511 - (int)ul) * 32;
        TileSrc src; src.K = (const bf16_t*)(p.ws + WS_KCMP) + (size_t)bg * NCMP * DK; src.V = (const bf16_t*)(p.ws + WS_VCMP) + (size_t)bg * NCMP * DV; src.kld = DK; src.vld = DV;
        const int nt = t0 / 1024 + 1;
        const LAS float* biasrow = (const LAS float*)(lds + L_BIAS) + (g * 8 + (c & 7)) * 132; const float bias_far = biasrow[128];
        PairState st[2];
#pragma unroll
        for (int pi = 0; pi < 2; ++pi) { reset_state(st[pi]); load_q(st[pi], proj, b, g, t0 + 4 * wave + 2 * pi, lane, ((const LAS float*)(lds + L_BIAS))[bg * 132 + 130], biasrow[129]); }
#pragma unroll
        for (int i = 0; i < 16; ++i) imp[(4 * wave) * 256 + i * 64 + lane] = 0.f;
        DmaPlan pl; make_plan(pl, src, wave, lane);
        const unsigned ring = (unsigned)(size_t)(lds + L_RING);
#pragma unroll 1
        for (int pass = 0; pass < 2; ++pass) {
            if (pass == 1) {
#pragma unroll
                for (int pi = 0; pi < 2; ++pi) { float lt = st[pi].l; lt += __shfl_xor(lt, 16); lt += __shfl_xor(lt, 32); if (lt > 0.f) st[pi].m += __builtin_amdgcn_logf(lt); }
            }
            for (int d = 0; d < PD && d < nt; ++d) issue_tile(pl, src, 64 * d, ring + d * SLOT_BYTES, wave);
            if (pass == 0) UNIT_PREFETCH((unsigned*)(p.ws + WS_UCTR) + (blockIdx.x & 7));
            int slot = 0, islot = PD;
#pragma unroll 1
            for (int i = 0; i < nt; ++i) {
                { int rem = nt - 1 - i; rem = rem < PD - 1 ? rem : PD - 1; att_wait_bar(rem); }
                if (i + PD < nt) issue_tile(pl, src, 64 * (i + PD), ring + islot * SLOT_BYTES, wave);
                const LAS unsigned char* Kt = lds + L_RING + slot * SLOT_BYTES; const LAS unsigned char* Vt = Kt + SLOT_K;
#pragma unroll
                for (int pi = 0; pi < 2; ++pi) { const int tq0 = t0 + 4 * wave + 2 * pi; const int P0 = 16 * 64 * i + 31;
                    if (tq0 + 1 < P0) continue;
                    const bool far = (tq0 - (P0 + 63 * 16)) >= 113;
                    const int tadj = tq0 + (c >> 3) - P0;
                    if (pass == 0) PAIR_TILE(0, far, st[pi], Kt, Vt, tadj, 16, 1 << 30, true, biasrow, bias_far, nullptr, 0, lane);
                    else PAIR_TILE(1, far, st[pi], Kt, Vt, tadj, 16, 1 << 30, true, biasrow, bias_far, imp + (4 * wave + 2 * pi + (c >> 3)) * 256, 16 * i, lane); }
                slot = slot + 1 == RING ? 0 : slot + 1; islot = islot + 1 == RING ? 0 : islot + 1;
            }
            ATT_WAIT_BAR(0);
        }
#pragma unroll
        for (int pi = 0; pi < 2; ++pi) write_out<false>(st[pi], 1.0f, proj, obuf, b, g, t0 + 4 * wave + 2 * pi, 0, lane);
        asm volatile("s_waitcnt lgkmcnt(0)" ::: "memory");
#pragma unroll 1
        for (int qq = 0; qq < 4; ++qq) {
            const int t = t0 + 4 * wave + qq, cur = t >> 6;
            unsigned key[4]; bool sel[4];
#pragma unroll
            for (int i = 0; i < 4; ++i) { const int j = lane + 64 * i; const float v = imp[(4 * wave + qq) * 256 + j];
                sel[i] = (j == 0) || (j == cur) || (j == cur - 1);
                const bool cand = (j >= 1) && (j <= cur - 2);
                key[i] = cand ? (__float_as_uint(v) + 1u) : 0u; }
            const int need = 16 - (1 + (cur >= 1) + (cur >= 2));
            unsigned T = 0u;
#pragma unroll 1
            for (int bit = 31; bit >= 0; --bit) { const unsigned cand = T | (1u << bit);
                const int cnt = __popcll(__ballot(key[0] >= cand)) + __popcll(__ballot(key[1] >= cand)) + __popcll(__ballot(key[2] >= cand)) + __popcll(__ballot(key[3] >= cand));
                if (cnt >= need) T = cand; }
            if (T == 0u) T = 1u;
            int above = 0;
#pragma unroll
            for (int i = 0; i < 4; ++i) above += __popcll(__ballot(key[i] > T));
            int room = need - above;
#pragma unroll
            for (int i = 0; i < 4; ++i) { const unsigned long long eq = __ballot(key[i] == T); const int rank = __popcll(eq & ((1ull << lane) - 1ull));
                sel[i] = sel[i] || (key[i] > T) || (key[i] == T && rank < room); room -= __popcll(eq); }
            unsigned* mrow = selm + ((size_t)bg * SEQ + t) * 8;
#pragma unroll
            for (int i = 0; i < 4; ++i) { const unsigned long long bal = __ballot(sel[i]); if (lane == 0) { mrow[2 * i] = (unsigned)bal; mrow[2 * i + 1] = (unsigned)(bal >> 32); } }
        }
    UNIT_LOOP_END()
}

__device__ __forceinline__ void build_order(const LAS unsigned* lsel, LAS unsigned char* ord, LAS int* cnt, int cb, int nq, int lane) {
    int base = 0;
#pragma unroll 1
    for (int r = 0; 64 * r <= cb; ++r) { const int j = lane + 64 * r; unsigned m = 0u;
        for (int q = 0; q < nq; ++q) m |= lsel[q * 8 + (j >> 5)];
        const bool need = (j <= cb) && ((m >> (j & 31)) & 1u);
        const unsigned long long bal = __ballot(need);
        if (need) ord[base + __popcll(bal & ((1ull << lane) - 1ull))] = (unsigned char)j;
        base += __popcll(bal); }
    if (lane == 0) *cnt = base;
}

template <bool WIN, int NP>
__device__ __forceinline__ void phase_ws(const Params& p, LAS unsigned char* lds) {
    constexpr int QW = 2 * NP, QU = 8 * QW, NUNIT = MT * NG / QU;
    const int tid = threadIdx.x, lane = tid & 63, wave = __builtin_amdgcn_readfirstlane(tid >> 6), c = lane & 15;
    const bf16_t* proj = (const bf16_t*)(p.ws + WS_BIG); bf16_t* obuf = (bf16_t*)(p.ws + WS_O); const unsigned* selm = (const unsigned*)(p.ws + WS_SELM);
    build_bias(p, lds);
    LAS unsigned* lsel = (LAS unsigned*)(lds + L_SELM);
    UNIT_LOOP_BEGIN((unsigned*)(p.ws + WS_UCTR) + (WIN ? 8 : 16) + (blockIdx.x & 7), NUNIT / 8)
        const int bg = blockIdx.x & 7, b = bg >> 2, g = bg & 3, t0 = (SEQ / QU - 1 - (int)ul) * QU;
        TileSrc src; src.kld = NPROJ; src.vld = NPROJ;
        src.K = proj + (size_t)b * SEQ * NPROJ + (WIN ? C_KW : C_KS) + g * DK; src.V = proj + (size_t)b * SEQ * NPROJ + (WIN ? C_VW : C_VS) + g * DV;
        const int cb = t0 >> 6;
        const int kstart = WIN ? (cb >= 8 ? (cb - 8) * 64 : 0) : 0;
        const int nt = cb + 1 - kstart / 64;
        const LAS float* biasrow = (const LAS float*)(lds + L_BIAS) + (g * 8 + (c & 7)) * 132; const float bias_far = biasrow[128];
        const float kmx = __uint_as_float(((const unsigned*)(p.ws + WS_KMAX))[(WIN ? 8 : 0) + bg]);
        LAS unsigned char* ord = (LAS unsigned char*)(lds + L_SELM + 1024);
        int npos = nt;
        if (!WIN) { if (tid < QU * 8) lsel[tid] = selm[((size_t)bg * SEQ + t0) * 8 + tid];
            __syncthreads();
            if (wave == 0) build_order(lsel, ord, (LAS int*)(lds + L_SELM + 1024 + 256), cb, QU, lane);
            __syncthreads();
            npos = *(LAS int*)(lds + L_SELM + 1024 + 256); }
        PairState st[NP];
#pragma unroll
        for (int pi = 0; pi < NP; ++pi) { reset_state(st[pi]); load_q(st[pi], proj, b, g, t0 + QW * wave + 2 * pi, lane, kmx, biasrow[129]); }
        DmaPlan pl; make_plan(pl, src, wave, lane);
        const unsigned ring = (unsigned)(size_t)(lds + L_RING);
#define WS_TILE(pos) (WIN ? (pos) : (int)ord[pos])
        for (int d = 0; d < 4 && d < npos; ++d) issue_tile(pl, src, kstart + 64 * WS_TILE(d), ring + d * SLOT_BYTES, wave);
        UNIT_PREFETCH((unsigned*)(p.ws + WS_UCTR) + (WIN ? 8 : 16) + (blockIdx.x & 7));
        int slot = 0, islot = 4;
#pragma unroll 1
        for (int i0 = 0; i0 < npos; i0 += 2) {
            { const int issued = npos < i0 + 4 ? npos : i0 + 4, done = npos < i0 + 2 ? npos : i0 + 2; att_wait_bar(issued - done); }
#pragma unroll 1
            for (int e = 0; e < 2; ++e) { if (i0 + e >= npos) break; const int i = WS_TILE(i0 + e);
                const LAS unsigned char* Kt = lds + L_RING + slot * SLOT_BYTES; const LAS unsigned char* Vt = Kt + SLOT_K;
                slot = slot + 1 == RING_WS ? 0 : slot + 1;
                const int P0 = kstart + 64 * i;
#pragma unroll
                for (int pi = 0; pi < NP; ++pi) { const int tq0 = t0 + QW * wave + 2 * pi;
                    bool rowsel = true; bool allsel = true;
                    if (!WIN) { const unsigned w = lsel[(QW * wave + 2 * pi + (c >> 3)) * 8 + (i >> 5)]; rowsel = (w >> (i & 31)) & 1u;
                        const unsigned long long bal = __ballot(rowsel); if (bal == 0ull) continue; allsel = (bal == ~0ull); }
                    else { if (tq0 + 1 < P0 || tq0 - (P0 + 63) >= 512) continue; }
                    const bool far = (tq0 - (P0 + 63) >= 113) && (!WIN || (tq0 + 1 - P0 < 512));
                    PAIR_TILE(2, far, st[pi], Kt, Vt, tq0 + (c >> 3) - P0, 1, WIN ? 512 : (1 << 30), rowsel, biasrow, bias_far, nullptr, 0, lane); } }
#pragma unroll
            for (int e = 0; e < 2; ++e) { if (i0 + 4 + e < npos) issue_tile(pl, src, kstart + 64 * WS_TILE(i0 + 4 + e), ring + islot * SLOT_BYTES, wave); islot = islot + 1 == RING_WS ? 0 : islot + 1; }
        }
#undef WS_TILE
        ATT_WAIT_BAR(0);
#pragma unroll
        for (int pi = 0; pi < NP; ++pi) { float lt = st[pi].l; lt += __shfl_xor(lt, 16); lt += __shfl_xor(lt, 32);
            write_out<true>(st[pi], lt > 0.f ? 1.0f / lt : 0.f, proj, obuf, b, g, t0 + QW * wave + 2 * pi, WIN ? 2 : 1, lane); }
    UNIT_LOOP_END()
}

template <int W>
__device__ __forceinline__ void pool_item(const bf16_t* ub, bf16_t* pooled, int row, int t, int ch) {
    u32x4 v[W];
#pragma unroll
    for (int k = 0; k < W; ++k) v[k] = *(const u32x4*)(ub + (size_t)(k <= t ? row - k : row) * DM + ch * 8);
    const int cnt = (t + 1 < W) ? t + 1 : W;
    float acc[8] = {0.f, 0.f, 0.f, 0.f, 0.f, 0.f, 0.f, 0.f};
#pragma unroll
    for (int k = 0; k < W; ++k) { const float m = k < cnt ? 1.0f : 0.0f;
        acc[0] += m * bf_lo(v[k].x); acc[1] += m * bf_hi(v[k].x); acc[2] += m * bf_lo(v[k].y); acc[3] += m * bf_hi(v[k].y); acc[4] += m * bf_lo(v[k].z); acc[5] += m * bf_hi(v[k].z); acc[6] += m * bf_lo(v[k].w); acc[7] += m * bf_hi(v[k].w); }
    const float ic = 1.0f / (float)cnt; const u32x4 self = v[0];
    u32x4 o; o.x = cvt_pk_bf16(acc[0] * ic - bf_lo(self.x), acc[1] * ic - bf_hi(self.x)); o.y = cvt_pk_bf16(acc[2] * ic - bf_lo(self.y), acc[3] * ic - bf_hi(self.y));
    o.z = cvt_pk_bf16(acc[4] * ic - bf_lo(self.z), acc[5] * ic - bf_hi(self.z)); o.w = cvt_pk_bf16(acc[6] * ic - bf_lo(self.w), acc[7] * ic - bf_hi(self.w));
    *(u32x4*)(pooled + (size_t)row * DM + ch * 8) = o;
}
__device__ __forceinline__ void phase_pool(const Params& p) {
    const bf16_t* ub = (const bf16_t*)(p.ws + WS_BIG); bf16_t* pooled = (bf16_t*)(p.ws + WS_BIG + 128 * MiB);
    const int nthr = gridDim.x * NTHR;
    for (int it = blockIdx.x * NTHR + threadIdx.x; it < MT * 256; it += nthr) {
        const int row = it >> 8, ch = it & 255, t = row & (SEQ - 1); const int gi = ch >> 6;
        if (gi == 0) pool_item<2>(ub, pooled, row, t, ch); else if (gi == 1) pool_item<4>(ub, pooled, row, t, ch);
        else if (gi == 2) pool_item<8>(ub, pooled, row, t, ch); else pool_item<16>(ub, pooled, row, t, ch);
    }
}
__device__ __forceinline__ void phase_final(const Params& p) {
    const int lane = threadIdx.x & 63, wave = threadIdx.x >> 6; const int gw = blockIdx.x * NWAVES + wave, ngw = gridDim.x * NWAVES;
    const float* ssq = (const float*)(p.ws + WS_SSQ) + 4 * (size_t)MT;
    for (int row = gw; row < MT; row += ngw) { const float rs = rsqrtf(ssq[row] * (1.0f / DM) + EPS);
        f32x4* xr = (f32x4*)(p.out + (size_t)row * DM) + lane; const f32x4* gr = (const f32x4*)p.norm_final + lane;
#pragma unroll
        for (int j = 0; j < 8; ++j) xr[64 * j] = xr[64 * j] * rs * gr[64 * j]; }
}

#define XB_TMO      128
#define XB_XCNT(j)  (256  + 64 * (j))
#define XB_XSUB(j)  (1280 + 64 * (j))
#define XB_XGEN(j)  (2304 + 64 * (j))
#define XB_TOP      3328
#define XB_TOPGEN   3392
#define XCD_BAR_WORDS 3456
#define XB_SPIN_CAP (1u << 18)

__device__ __forceinline__ unsigned xb_ld(unsigned* p)              { return __hip_atomic_load(p, __ATOMIC_RELAXED, __HIP_MEMORY_SCOPE_AGENT); }
__device__ __forceinline__ unsigned xb_add(unsigned* p, unsigned v) { return __hip_atomic_fetch_add(p, v, __ATOMIC_RELAXED, __HIP_MEMORY_SCOPE_AGENT); }
__device__ __forceinline__ unsigned xb_xcc_id() { return (unsigned)__builtin_amdgcn_s_getreg((3 << 11) | 20) & 0xFu; }
#define XB_SPIN(cond, bar) do { unsigned _sp = 0; while (cond) { __builtin_amdgcn_s_sleep(1); \
    if ((++_sp & 255u) == 0u) { if (xb_ld(&(bar)[XB_TMO])) break; if (_sp > XB_SPIN_CAP) { atomicAdd(&(bar)[XB_TMO], 1u); break; } } } } while (0)

struct XcdBarrier {
    unsigned* bar; unsigned x;
    volatile LAS unsigned* st;
};

__device__ __forceinline__ XcdBarrier xcd_barrier_post(unsigned* bar, volatile LAS unsigned* st) {
    XcdBarrier b; b.bar = bar; b.x = xb_xcc_id(); b.st = st;
    if (threadIdx.x == 0) (void)xb_add(&bar[XB_XCNT(b.x)], 1u);
    return b;
}
__device__ __forceinline__ void xcd_barrier_complete(unsigned* bar, unsigned x, unsigned& nloc, unsigned& nx) {
    const unsigned G = gridDim.x * gridDim.y * gridDim.z;
    unsigned sum, cnt, mine, sp = 0u;
    for (;;) {
        sum = 0u; cnt = 0u; mine = 0u;
#pragma unroll
        for (unsigned j = 0; j < 16; ++j) { const unsigned c = xb_ld(&bar[XB_XCNT(j)]); sum += c; cnt += (c > 0u) ? 1u : 0u; mine = (j == x) ? c : mine; }
        if (sum == G) break;
        __builtin_amdgcn_s_sleep(1);
        if ((++sp & 255u) == 0u) { if (xb_ld(&bar[XB_TMO])) break; if (sp > XB_SPIN_CAP) { atomicAdd(&bar[XB_TMO], 1u); break; } }
    }
    nloc = mine > 0u ? mine : 1u; nx = cnt > 0u ? cnt : 1u;
}

__device__ __forceinline__ void xcd_barrier(const XcdBarrier& b) {
    asm volatile("s_waitcnt vmcnt(0)" ::: "memory");
    __syncthreads();
    if (threadIdx.x == 0) {
        unsigned* bar = b.bar;
        __builtin_amdgcn_s_waitcnt(0);
        unsigned nloc = b.st[0], nx = b.st[1];
        if (nloc == 0u) { xcd_barrier_complete(bar, b.x, nloc, nx); b.st[0] = nloc; b.st[1] = nx; }
        const unsigned old = xb_add(&bar[XB_XSUB(b.x)], 1u);
        const unsigned gen = old / nloc;
        if (old + 1u == (gen + 1u) * nloc) {
            __builtin_amdgcn_fence(__ATOMIC_RELEASE, "agent");
            asm volatile("s_waitcnt vmcnt(0)" ::: "memory");
            const unsigned og = xb_add(&bar[XB_TOP], 1u);
            const unsigned tg = og / nx;
            if (og + 1u == (tg + 1u) * nx) xb_add(&bar[XB_TOPGEN], 1u);
            else XB_SPIN(xb_ld(&bar[XB_TOPGEN]) == tg, bar);
            __builtin_amdgcn_fence(__ATOMIC_ACQUIRE, "agent");
            xb_add(&bar[XB_XGEN(b.x)], 1u);
            asm volatile("s_waitcnt vmcnt(0)" ::: "memory");
        } else {
            XB_SPIN(xb_ld(&bar[XB_XGEN(b.x)]) == gen, bar);
            __builtin_amdgcn_fence(__ATOMIC_ACQUIRE, "agent");
            asm volatile("s_waitcnt vmcnt(0)" ::: "memory");
        }
    }
    __syncthreads();
}

#define GSYNC_() do { asm volatile("s_waitcnt vmcnt(0) lgkmcnt(0)" ::: "memory"); __builtin_amdgcn_fence(__ATOMIC_RELEASE, "agent"); grid.sync(); __builtin_amdgcn_fence(__ATOMIC_ACQUIRE, "agent"); } while (0)
#define GSYNC() xcd_barrier(xbar)
__global__ void __launch_bounds__(NTHR, 2) fwd_megakernel(Params p) {
    extern __shared__ __attribute__((aligned(16))) unsigned char lds_raw[];
    LAS unsigned char* lds = (LAS unsigned char*)lds_raw;
    cg::grid_group grid = cg::this_grid();
    volatile LAS unsigned* xst = (volatile LAS unsigned*)(lds + 146432);
    if (threadIdx.x < 2) xst[threadIdx.x] = 0u;
    __syncthreads();
    const XcdBarrier xbar = xcd_barrier_post((unsigned*)(p.ws + WS_XBAR), xst);
    unsigned char* ws = p.ws;
    float* ssq = (float*)(ws + WS_SSQ);
    bf16_t* xb = (bf16_t*)(ws + WS_XB); bf16_t* obuf = (bf16_t*)(ws + WS_O); bf16_t* big = (bf16_t*)(ws + WS_BIG);
    const int G = gridDim.x, cidx = blockIdx.x;
    pg8::StaticOrder S;

    phase_prologue(p, lds);
    if (p.ws == nullptr) GSYNC_();
    GSYNC();
    { pg8::Gemm g{xb, (const bf16_t*)(ws + WS_W_IN), DM, DM, MT, NPROJ, DM, 0}; S.init(MT, NPROJ, G, cidx); pg8::EpiProj E{big, ssq}; pg8::gemm_phase(lds, g, S, E); }
    GSYNC();
    phase_compress(p, lds);
    GSYNC();
    phase_cmp(p, lds);
    GSYNC();
    phase_ws<true, 2>(p, lds);
    GSYNC();
    phase_ws<false, 2>(p, lds);
    GSYNC();
    { pg8::Gemm g{obuf, (const bf16_t*)(ws + WS_W_OUT), DM, DM, MT, DM, DM, 0}; S.init(MT, DM, G, cidx); pg8::EpiRes E{p.x, p.out, xb, ssq + MT}; pg8::gemm_phase(lds, g, S, E); }
    GSYNC();
    { pg8::Gemm g{xb, (const bf16_t*)(ws + WS_W_GU0), DM, DM, MT, 2 * DFF, DM, 0}; S.init(MT, 2 * DFF, G, cidx); pg8::EpiSwiglu E{big, ssq + MT}; pg8::gemm_phase(lds, g, S, E); }
    GSYNC();
    { pg8::Gemm g{big, (const bf16_t*)(ws + WS_W_DN0), DFF, DFF, MT, DM, DFF, 0}; S.init(MT, DM, G, cidx); pg8::EpiRes E{p.out, p.out, xb, ssq + 2 * MT}; pg8::gemm_phase(lds, g, S, E); }
    GSYNC();
    { pg8::Gemm g{xb, (const bf16_t*)(ws + WS_P_IN), DM, DM, MT, DM, DM, 0}; S.init(MT, DM, G, cidx); pg8::EpiRowScale E{big, ssq + 2 * MT}; pg8::gemm_phase(lds, g, S, E); }
    GSYNC();
    phase_pool(p);
    GSYNC();
    { pg8::Gemm g{(const bf16_t*)(ws + WS_BIG + 128 * MiB), (const bf16_t*)(ws + WS_P_GRP), DM, 512, MT, DM, 512, 1024}; S.init(MT, DM, G, cidx); pg8::EpiColScale E{obuf, p.pool_scale}; pg8::gemm_phase(lds, g, S, E); }
    GSYNC();
    { pg8::Gemm g{obuf, (const bf16_t*)(ws + WS_P_OUT), DM, DM, MT, DM, DM, 0}; S.init(MT, DM, G, cidx); pg8::EpiRes E{p.out, p.out, xb, ssq + 3 * MT}; pg8::gemm_phase(lds, g, S, E); }
    GSYNC();
    { pg8::Gemm g{xb, (const bf16_t*)(ws + WS_W_GU1), DM, DM, MT, 2 * DFF, DM, 0}; S.init(MT, 2 * DFF, G, cidx); pg8::EpiSwiglu E{big, ssq + 3 * MT}; pg8::gemm_phase(lds, g, S, E); }
    GSYNC();
    { pg8::Gemm g{big, (const bf16_t*)(ws + WS_W_DN1), DFF, DFF, MT, DM, DFF, 0}; S.init(MT, DM, G, cidx); pg8::EpiRes E{p.out, p.out, xb, ssq + 4 * MT}; pg8::gemm_phase(lds, g, S, E); }
    GSYNC();
    phase_final(p);
}

extern "C" void kernel_launch(void* const* d_in, const int* in_sizes, int n_in, void* d_out, int out_size, void* d_ws, size_t ws_size, hipStream_t stream) {
    static int grid_blocks = 0;
    if (grid_blocks == 0) {
        if (n_in != 21 || ws_size < WS_END) { fprintf(stderr, "kernel_launch: unexpected inputs (n_in %d, ws %zu)\n", n_in, ws_size); grid_blocks = -1; return; }
        int dev = 0, cus = 0, per_cu = 0;
        hipGetDevice(&dev); hipDeviceGetAttribute(&cus, hipDeviceAttributeMultiprocessorCount, dev);
        if (hipFuncSetAttribute((const void*)fwd_megakernel, hipFuncAttributeMaxDynamicSharedMemorySize, LDS_BYTES) != hipSuccess) { fprintf(stderr, "kernel_launch: hipFuncSetAttribute failed\n"); grid_blocks = -1; return; }
        if (hipOccupancyMaxActiveBlocksPerMultiprocessor(&per_cu, (const void*)fwd_megakernel, NTHR, LDS_BYTES) != hipSuccess || per_cu < 1) { fprintf(stderr, "kernel_launch: occupancy query failed (%d)\n", per_cu); (void)hipGetLastError(); per_cu = 1; }
        grid_blocks = cus * 1;
    }
    if (grid_blocks < 0) return;
    Params p{};
    p.x = (const float*)d_in[0]; p.norm_mix = (const float*)d_in[1]; p.norm_ffn = (const float*)d_in[2]; p.norm_final = (const float*)d_in[3]; p.rel_bias = (const float*)d_in[4];
    p.nsa_w_in = (const float*)d_in[5]; p.pos_k = (const float*)d_in[6]; p.pos_v = (const float*)d_in[7]; p.ck_w1 = (const float*)d_in[8]; p.ck_b1 = (const float*)d_in[9]; p.ck_w2 = (const float*)d_in[10];
    p.cv_w1 = (const float*)d_in[11]; p.cv_b1 = (const float*)d_in[12]; p.cv_w2 = (const float*)d_in[13]; p.nsa_w_out = (const float*)d_in[14];
    p.pool_w_in = (const float*)d_in[15]; p.pool_w_grp = (const float*)d_in[16]; p.pool_scale = (const float*)d_in[17]; p.pool_w_out = (const float*)d_in[18]; p.ffn_w_gu = (const float*)d_in[19]; p.ffn_w_down = (const float*)d_in[20];
    p.out = (float*)d_out; p.ws = (unsigned char*)d_ws;
    if (hipMemsetAsync((char*)d_ws + WS_XBAR, 0, 16384, stream) != hipSuccess) { fprintf(stderr, "kernel_launch: hipMemsetAsync failed\n"); return; }
    void* args[] = {&p};
    hipError_t e = hipLaunchCooperativeKernel((const void*)fwd_megakernel, dim3(grid_blocks), dim3(NTHR), args, LDS_BYTES, stream);
    if (e != hipSuccess) fprintf(stderr, "cooperative launch failed: %s (grid %d)\n", hipGetErrorString(e), grid_blocks);
}
```

```cpp
#include <hip/hip_runtime.h>
#include <hip/hip_cooperative_groups.h>
#include <cstdio>
#include <cstdint>
namespace cg = cooperative_groups;

#define LAS __attribute__((address_space(3)))
typedef unsigned short bf16_t;
typedef short bf16x8 __attribute__((ext_vector_type(8)));
typedef float f32x4 __attribute__((ext_vector_type(4)));
typedef float f32x2 __attribute__((ext_vector_type(2)));
typedef unsigned u32x4 __attribute__((ext_vector_type(4)));
typedef unsigned u32x2 __attribute__((ext_vector_type(2)));

constexpr int BATCH = 2, SEQ = 16384, DM = 2048, MT = BATCH * SEQ;
constexpr int NG = 4, HG = 8, DK = 96, DV = 64;
constexpr int NPROJ = 5120;
constexpr int C_VC = 3072, C_VS = 3328, C_VW = 3584, C_KC = 3840, C_KS = 4224, C_KW = 4608, C_GATE = 4992;
constexpr int DFF = 5632;
constexpr int NCMP = 1024;
constexpr float EPS = 1e-6f;
constexpr float NEGF = -1e30f;

constexpr size_t MiB = 1u << 20;
constexpr size_t WS_SSQ = 0;
constexpr size_t WS_XBAR = 768 * 1024;
constexpr size_t WS_KMAX = 900 * 1024;
constexpr size_t WS_W_IN = 1 * MiB;
constexpr size_t WS_W_OUT = 21 * MiB;
constexpr size_t WS_W_GU0 = 29 * MiB, WS_W_GU1 = 73 * MiB;
constexpr size_t WS_W_DN0 = 117 * MiB, WS_W_DN1 = 139 * MiB;
constexpr size_t WS_P_IN = 161 * MiB, WS_P_GRP = 169 * MiB, WS_P_OUT = 171 * MiB;
constexpr size_t WS_CK1 = 179 * MiB, WS_CV1 = 181 * MiB, WS_CK2 = 182 * MiB, WS_CV2 = 182 * MiB + 65536;
constexpr size_t WS_KCMP = 183 * MiB, WS_VCMP = 185 * MiB, WS_SELM = 186 * MiB;
constexpr size_t WS_XB = 190 * MiB;
constexpr size_t WS_O = 318 * MiB;
constexpr size_t WS_BIG = 446 * MiB;
constexpr size_t WS_END = 798 * MiB;

typedef __bf16 bf16x2_t __attribute__((ext_vector_type(2)));
__device__ __forceinline__ unsigned cvt_pk_bf16(float lo, float hi) { const f32x2 v = {lo, hi}; const bf16x2_t b = __builtin_convertvector(v, bf16x2_t); return __builtin_bit_cast(unsigned, b); }
__device__ __forceinline__ float bf_lo(unsigned u) { return __uint_as_float(u << 16); }
__device__ __forceinline__ float bf_hi(unsigned u) { return __uint_as_float(u & 0xffff0000u); }
__device__ __forceinline__ float wave_sum(float v) {
#pragma unroll
    for (int o = 1; o < 64; o <<= 1) v += __shfl_xor(v, o);
    return v;
}

namespace pg8 {
constexpr int BM = 256, BK = 64, HALF = 128, HTB = HALF * BK * 2, STAGE_BYTES = 8 * HTB, NXCD = 8, WGM = 8;
__host__ __device__ __forceinline__ int lds_byte(int r, int c) { const int st = (r >> 4) * 2 + (c >> 5), rr = r & 15, cc = c & 31, ob = rr * 64 + cc * 2; return st * 1024 + (ob ^ (((ob >> 9) & 1) << 5)); }
__host__ __device__ __forceinline__ void stage_rc(int b, int& R, int& C) { const int st = b / 1024, sb = b % 1024, swz = sb ^ (((sb >> 9) & 1) << 5); R = (st >> 1) * 16 + swz / 64; C = (st & 1) * 32 + (swz % 64) / 2; }
__host__ __device__ __forceinline__ int perm32(int rho) { const int n = rho >> 4, i = rho & 15; return 8 * (i >> 2) + 4 * n + (i & 3); }

struct Unit { int pm, pn; };
struct Gemm { const bf16_t* A; const bf16_t* Bt; int lda, ldb, M, N, K; int acolb; };

struct StaticOrder {
    int nM, nN, nwg, G, c;
    __device__ void init(int M, int N, int G_, int c_) { nM = M / BM; nN = N / BM; nwg = nM * nN; G = G_; c = c_; }
    __device__ bool next(int i, Unit& u) const {
        const long L = (long)i * G + c; if (L >= nwg) return false;
        int wgid = (int)L; { const int q = nwg / NXCD, r = nwg % NXCD, xcd = wgid % NXCD, off = wgid / NXCD; wgid = (xcd < r ? xcd * (q + 1) : r * (q + 1) + (xcd - r) * q) + off; }
        const int nig = WGM * nN, gid = wgid / nig, fm = gid * WGM, gsz = (nM - fm) < WGM ? (nM - fm) : WGM;
        u.pm = fm + ((wgid % nig) % gsz); u.pn = (wgid % nig) / gsz; return true;
    }
};

template <class Epi>
__device__ __forceinline__ void gemm_phase(LAS unsigned char* lds, const Gemm g, const StaticOrder& S, const Epi& E) {
    const int tid = threadIdx.x, wid = __builtin_amdgcn_readfirstlane(tid >> 6), lane = tid & 63, wr = wid >> 2, wc = wid & 3, fr = lane & 15, fq = lane >> 4;
    const int K = g.K, nt = K / BK;
    unsigned voffA[2], voffB[2];
#pragma unroll
    for (int i = 0; i < 2; ++i) { int R, C; stage_rc(tid * 16 + i * 8192, R, C); const int Rb = (R & ~31) + perm32(R & 31);
        voffA[i] = (unsigned)(R * g.lda + C) * 2u; voffB[i] = (unsigned)(Rb * g.ldb + C) * 2u; }
    const size_t kstep = (size_t)(BK * 2);
    const size_t hstepA = (size_t)HALF * g.lda * 2, hstepB = (size_t)HALF * g.ldb * 2;
    const size_t tstepA = 2 * hstepA, tstepB = 2 * hstepB;
    const unsigned ldsw = (unsigned)wid * 1024u;
    const int aoff = lds_byte(wr * 64 + fr, fq * 8), boff = lds_byte(wc * 32 + fr, fq * 8);
#define PG8_SA(b, h) (((b) * 2 + (h)) * HTB)
#define PG8_SB(b, h) ((4 + (b) * 2 + (h)) * HTB)
#define PG8_STAGE(bufoff, gbase, voff) do { _Pragma("unroll") for (int _i = 0; _i < 2; ++_i) \
        __builtin_amdgcn_global_load_lds((const unsigned*)((const char*)(gbase) + (voff)[_i]), (LAS unsigned*)(lds + (bufoff) + ldsw + _i * 8192), 16, 0, 0); } while (0)
#define PG8_LDA(dst, b, h) do { _Pragma("unroll") for (int m = 0; m < 4; ++m) _Pragma("unroll") for (int k = 0; k < 2; ++k) dst[m][k] = *(const LAS bf16x8*)(lds + PG8_SA(b, h) + aoff + m * 2048 + k * 1024); } while (0)
#define PG8_LDB(dst, b, h) do { _Pragma("unroll") for (int n = 0; n < 2; ++n) _Pragma("unroll") for (int k = 0; k < 2; ++k) dst[n][k] = *(const LAS bf16x8*)(lds + PG8_SB(b, h) + boff + n * 2048 + k * 1024); } while (0)
#define PG8_MMA(ai, bj, At, Bt) do { __builtin_amdgcn_s_setprio(1); _Pragma("unroll") for (int m = 0; m < 4; ++m) _Pragma("unroll") for (int n = 0; n < 2; ++n) _Pragma("unroll") for (int k = 0; k < 2; ++k) \
        acc[ai][bj][m][n] = __builtin_amdgcn_mfma_f32_16x16x32_bf16(Bt[n][k], At[m][k], acc[ai][bj][m][n], 0, 0, 0); __builtin_amdgcn_s_setprio(0); } while (0)
#define PG8_WAIT_V(n) asm volatile("s_waitcnt vmcnt(" #n ")" ::: "memory")
#define PG8_WAIT_L(n) asm volatile("s_waitcnt lgkmcnt(" #n ")" ::: "memory")
#define PG8_BAR __builtin_amdgcn_s_barrier()
#define PG8_SCHED __builtin_amdgcn_sched_barrier(0)
#define PG8_APTR(u) ((const char*)g.A + (size_t)(u).pm * tstepA + (size_t)((u).pn >> 1) * (size_t)g.acolb)
#define PG8_BPTR(u) ((const char*)g.Bt + (size_t)(u).pn * tstepB)
    Unit cur, nxt; int ui = 0;
    if (!S.next(0, cur)) return;
    f32x4 acc[2][2][4][2];
#pragma unroll
    for (int a = 0; a < 2; ++a)
#pragma unroll
        for (int b = 0; b < 2; ++b)
#pragma unroll
            for (int m = 0; m < 4; ++m)
#pragma unroll
                for (int n = 0; n < 2; ++n) acc[a][b][m][n] = (f32x4){0.f, 0.f, 0.f, 0.f};
    bf16x8 At[4][2], B0[2][2], B1[2][2];
    const char* cA = PG8_APTR(cur); const char* cB = PG8_BPTR(cur);
    PG8_STAGE(PG8_SB(0, 0), cB, voffB); PG8_STAGE(PG8_SB(0, 1), cB + hstepB, voffB); PG8_STAGE(PG8_SA(0, 0), cA, voffA); PG8_STAGE(PG8_SA(0, 1), cA + hstepA, voffA);
    if (wr == 1) PG8_BAR;
    PG8_WAIT_V(2); PG8_BAR;
    PG8_STAGE(PG8_SB(1, 0), cB + kstep, voffB); PG8_STAGE(PG8_SA(1, 0), cA + kstep, voffA); PG8_STAGE(PG8_SB(1, 1), cB + hstepB + kstep, voffB);
    PG8_WAIT_V(6); PG8_BAR;
    for (;;) {
        const bool has_next = S.next(ui + 1, nxt);
        const char* nA = has_next ? PG8_APTR(nxt) : cA; const char* nB = has_next ? PG8_BPTR(nxt) : cB;
        for (int t = 0; t < nt; t += 2) {
            const bool last = (t == nt - 2);
            const char* a1 = cA + (size_t)(t + 1) * kstep;
            const char* a2 = last ? nA : cA + (size_t)(t + 2) * kstep; const char* b2 = last ? nB : cB + (size_t)(t + 2) * kstep;
            const char* a3 = a2 + kstep; const char* b3 = b2 + kstep;
            PG8_LDB(B0, 0, 0); PG8_LDB(B1, 0, 1); PG8_SCHED; PG8_LDA(At, 0, 0); PG8_STAGE(PG8_SA(1, 1), a1 + hstepA, voffA);
            PG8_WAIT_V(8); PG8_WAIT_L(0); PG8_BAR; PG8_MMA(0, 0, At, B0); PG8_MMA(0, 1, At, B1); PG8_BAR; PG8_SCHED;
            PG8_LDA(At, 0, 1); PG8_STAGE(PG8_SB(0, 0), b2, voffB); PG8_STAGE(PG8_SB(0, 1), b2 + hstepB, voffB); PG8_STAGE(PG8_SA(0, 0), a2, voffA);
            PG8_WAIT_V(8); PG8_WAIT_L(0); PG8_BAR; PG8_MMA(1, 0, At, B0); PG8_MMA(1, 1, At, B1); PG8_BAR; PG8_SCHED;
            PG8_LDB(B0, 1, 0); PG8_LDB(B1, 1, 1); PG8_SCHED; PG8_LDA(At, 1, 0); PG8_STAGE(PG8_SA(0, 1), a2 + hstepA, voffA);
            PG8_WAIT_V(8); PG8_WAIT_L(0); PG8_BAR; PG8_MMA(0, 0, At, B0); PG8_MMA(0, 1, At, B1); PG8_BAR; PG8_SCHED;
            PG8_LDA(At, 1, 1); PG8_STAGE(PG8_SB(1, 0), b3, voffB); PG8_STAGE(PG8_SB(1, 1), b3 + hstepB, voffB); PG8_STAGE(PG8_SA(1, 0), a3, voffA);
            PG8_WAIT_V(8); PG8_WAIT_L(0); PG8_BAR; PG8_MMA(1, 0, At, B0); PG8_MMA(1, 1, At, B1); PG8_BAR; PG8_SCHED;
        }
        if (wr == 0) PG8_BAR;
        E(acc, cur, wr, wc, fr, fq);
        if (!has_next) break;
#pragma unroll
        for (int a = 0; a < 2; ++a)
#pragma unroll
            for (int b = 0; b < 2; ++b)
#pragma unroll
                for (int m = 0; m < 4; ++m)
#pragma unroll
                    for (int n = 0; n < 2; ++n) acc[a][b][m][n] = (f32x4){0.f, 0.f, 0.f, 0.f};
        cur = nxt; cA = nA; cB = nB; ++ui;
        if (wr == 1) PG8_BAR;
    }
    PG8_WAIT_V(0);
    PG8_BAR;
#undef PG8_SA
#undef PG8_SB
#undef PG8_STAGE
#undef PG8_LDA
#undef PG8_LDB
#undef PG8_MMA
#undef PG8_WAIT_V
#undef PG8_WAIT_L
#undef PG8_BAR
#undef PG8_SCHED
#undef PG8_APTR
#undef PG8_BPTR
}

#define EPI_ROW(u, ai, m) ((u).pm * BM + (ai) * HALF + wr * 64 + (m) * 16 + fr)
__device__ __forceinline__ u32x4 pack8(f32x4 v0, f32x4 v1) { u32x4 w; w.x = cvt_pk_bf16(v0[0], v0[1]); w.y = cvt_pk_bf16(v0[2], v0[3]); w.z = cvt_pk_bf16(v1[0], v1[1]); w.w = cvt_pk_bf16(v1[2], v1[3]); return w; }

struct EpiProj {
    bf16_t* O; const float* ssq;
    __device__ __forceinline__ void operator()(const f32x4 (&acc)[2][2][4][2], const Unit& u, int wr, int wc, int fr, int fq) const {
        const float qs = (u.pn < 12) ? 0.10206207261596577f * 1.4426950408889634f : 1.0f;
#pragma unroll
        for (int ai = 0; ai < 2; ++ai)
#pragma unroll
            for (int m = 0; m < 4; ++m) { const int row = EPI_ROW(u, ai, m); const float rs = rsqrtf(ssq[row] * (1.0f / DM) + EPS) * qs;
#pragma unroll
                for (int bj = 0; bj < 2; ++bj) { const int c0 = u.pn * BM + bj * HALF + wc * 32 + 8 * fq;
                    *(u32x4*)(O + (size_t)row * NPROJ + c0) = pack8(acc[ai][bj][m][0] * rs, acc[ai][bj][m][1] * rs); } }
    }
};
struct EpiRowScale {
    bf16_t* O; const float* ssq;
    __device__ __forceinline__ void operator()(const f32x4 (&acc)[2][2][4][2], const Unit& u, int wr, int wc, int fr, int fq) const {
#pragma unroll
        for (int ai = 0; ai < 2; ++ai)
#pragma unroll
            for (int m = 0; m < 4; ++m) { const int row = EPI_ROW(u, ai, m); const float rs = rsqrtf(ssq[row] * (1.0f / DM) + EPS);
#pragma unroll
                for (int bj = 0; bj < 2; ++bj) { const int c0 = u.pn * BM + bj * HALF + wc * 32 + 8 * fq;
                    *(u32x4*)(O + (size_t)row * DM + c0) = pack8(acc[ai][bj][m][0] * rs, acc[ai][bj][m][1] * rs); } }
    }
};
struct EpiColScale {
    bf16_t* O; const float* scale;
    __device__ __forceinline__ void operator()(const f32x4 (&acc)[2][2][4][2], const Unit& u, int wr, int wc, int fr, int fq) const {
#pragma unroll
        for (int bj = 0; bj < 2; ++bj) { const int c0 = u.pn * BM + bj * HALF + wc * 32 + 8 * fq;
            const f32x4 s0 = *(const f32x4*)(scale + c0), s1 = *(const f32x4*)(scale + c0 + 4);
#pragma unroll
            for (int ai = 0; ai < 2; ++ai)
#pragma unroll
                for (int m = 0; m < 4; ++m) { const int row = EPI_ROW(u, ai, m);
                    *(u32x4*)(O + (size_t)row * DM + c0) = pack8(acc[ai][bj][m][0] * s0, acc[ai][bj][m][1] * s1); } }
    }
};
struct EpiSwiglu {
    bf16_t* O; const float* ssq;
    __device__ __forceinline__ void operator()(const f32x4 (&acc)[2][2][4][2], const Unit& u, int wr, int wc, int fr, int fq) const {
        const int c0 = u.pn * HALF + wc * 32 + 8 * fq;
#pragma unroll
        for (int ai = 0; ai < 2; ++ai)
#pragma unroll
            for (int m = 0; m < 4; ++m) { const int row = EPI_ROW(u, ai, m); const float rs = rsqrtf(ssq[row] * (1.0f / DM) + EPS);
                f32x4 r[2];
#pragma unroll
                for (int n = 0; n < 2; ++n)
#pragma unroll
                    for (int j = 0; j < 4; ++j) { const float gt = acc[ai][0][m][n][j] * rs, up = acc[ai][1][m][n][j] * rs; r[n][j] = gt * up * __builtin_amdgcn_rcpf(1.0f + __expf(-gt)); }
                *(u32x4*)(O + (size_t)row * DFF + c0) = pack8(r[0], r[1]); }
    }
};
struct EpiRes {
    const float* src; float* dst; bf16_t* xb; float* ssq_out;
    __device__ __forceinline__ void operator()(const f32x4 (&acc)[2][2][4][2], const Unit& u, int wr, int wc, int fr, int fq) const {
#pragma unroll
        for (int ai = 0; ai < 2; ++ai)
#pragma unroll
            for (int m = 0; m < 4; ++m) { const int row = EPI_ROW(u, ai, m); float ss = 0.f;
#pragma unroll
                for (int bj = 0; bj < 2; ++bj) { const size_t off = (size_t)row * DM + u.pn * BM + bj * HALF + wc * 32 + 8 * fq;
                    const f32x4 x0 = *(const f32x4*)(src + off) + acc[ai][bj][m][0], x1 = *(const f32x4*)(src + off + 4) + acc[ai][bj][m][1];
                    *(f32x4*)(dst + off) = x0; *(f32x4*)(dst + off + 4) = x1; if (xb) *(u32x4*)(xb + off) = pack8(x0, x1);
                    ss += (x0[0] * x0[0] + x0[1] * x0[1]) + (x0[2] * x0[2] + x0[3] * x0[3]) + (x1[0] * x1[0] + x1[1] * x1[1]) + (x1[2] * x1[2] + x1[3] * x1[3]); }
                ss += __shfl_xor(ss, 16); ss += __shfl_xor(ss, 32);
                if (fq == 0) atomicAdd(ssq_out + row, ss); }
    }
};
}

struct Params {
    const float* x; const float* norm_mix; const float* norm_ffn; const float* norm_final; const float* rel_bias;
    const float* nsa_w_in; const float* pos_k; const float* pos_v; const float* ck_w1; const float* ck_b1; const float* ck_w2;
    const float* cv_w1; const float* cv_b1; const float* cv_w2; const float* nsa_w_out;
    const float* pool_w_in; const float* pool_w_grp; const float* pool_scale; const float* pool_w_out; const float* ffn_w_gu; const float* ffn_w_down;
    float* out; unsigned char* ws;
};

constexpr int NTHR = 512, NWAVES = 8;
constexpr int LDS_BYTES = 163840;

__device__ __forceinline__ int nsa_map(int n0) {
    if (n0 < 3072) return n0;
    if (n0 < 3456) return C_KC + (n0 - 3072);
    if (n0 < 3712) return C_VC + (n0 - 3456);
    if (n0 < 4096) return C_KS + (n0 - 3712);
    if (n0 < 4352) return C_VS + (n0 - 4096);
    if (n0 < 4736) return C_KW + (n0 - 4352);
    if (n0 < 4992) return C_VW + (n0 - 4736);
    return C_GATE + (n0 - 4992);
}
__device__ __forceinline__ int gu_map(int n0) { return n0 < DFF ? (n0 >> 7) * 256 + (n0 & 127) : ((n0 - DFF) >> 7) * 256 + 128 + ((n0 - DFF) & 127); }

template <int MAP>
__device__ __forceinline__ void transpose_items(const float* W, int K, int N, bf16_t* WT, int ldd, int row_off, const float* fold, LAS float* scr, int gw, int ngw, int lane) {
    const int nblk = N / 32, nitems = (K / 64) * nblk;
    for (int item = gw; item < nitems; item += ngw) {
        const int kb = item / nblk, nb = item % nblk, k0 = 64 * kb, n0 = 32 * nb;
        const int d0 = row_off + (MAP == 1 ? nsa_map(n0) : (MAP == 2 ? gu_map(n0) : n0));
        float wv[32];
#pragma unroll
        for (int i = 0; i < 32; ++i) wv[i] = W[(size_t)(k0 + 2 * i + (lane >> 5)) * N + n0 + (lane & 31)];
#pragma unroll
        for (int i = 0; i < 32; ++i) { const int kk = 2 * i + (lane >> 5); float v = wv[i]; if (fold) v *= fold[k0 + kk]; scr[kk * 33 + (lane & 31)] = v; }
        asm volatile("s_waitcnt lgkmcnt(0)" ::: "memory");
        const int c = lane & 7;
#pragma unroll
        for (int j = 0; j < 4; ++j) { const int n = (lane >> 3) + 8 * j; const LAS float* s = scr + (8 * c) * 33 + n;
            u32x4 o; o.x = cvt_pk_bf16(s[0 * 33], s[1 * 33]); o.y = cvt_pk_bf16(s[2 * 33], s[3 * 33]); o.z = cvt_pk_bf16(s[4 * 33], s[5 * 33]); o.w = cvt_pk_bf16(s[6 * 33], s[7 * 33]);
            *(u32x4*)(WT + (size_t)(d0 + n) * ldd + k0 + 8 * c) = o; }
        asm volatile("s_waitcnt lgkmcnt(0)" ::: "memory");
    }
}

__device__ __forceinline__ void phase_prologue(const Params& p, LAS unsigned char* lds) {
    const int tid = threadIdx.x, lane = tid & 63, wave = tid >> 6;
    const int gw = blockIdx.x * NWAVES + wave, ngw = gridDim.x * NWAVES;
    LAS float* scr = (LAS float*)(lds + wave * 8704);
    unsigned char* ws = p.ws;
    if (blockIdx.x == 0 && tid < 16) ((unsigned*)(ws + WS_KMAX))[tid] = 0u;
    { float* ssq = (float*)(ws + WS_SSQ); for (int i = blockIdx.x * NTHR + tid; i < 4 * MT; i += gridDim.x * NTHR) ssq[MT + i] = 0.f; }
    transpose_items<1>(p.nsa_w_in, DM, 5088, (bf16_t*)(ws + WS_W_IN), DM, 0, p.norm_mix, scr, gw, ngw, lane);
    transpose_items<0>(p.nsa_w_out, DM, DM, (bf16_t*)(ws + WS_W_OUT), DM, 0, nullptr, scr, gw, ngw, lane);
    transpose_items<2>(p.ffn_w_gu, DM, 2 * DFF, (bf16_t*)(ws + WS_W_GU0), DM, 0, p.norm_ffn, scr, gw, ngw, lane);
    transpose_items<2>(p.ffn_w_gu + (size_t)DM * 2 * DFF, DM, 2 * DFF, (bf16_t*)(ws + WS_W_GU1), DM, 0, p.norm_ffn + DM, scr, gw, ngw, lane);
    transpose_items<0>(p.ffn_w_down, DFF, DM, (bf16_t*)(ws + WS_W_DN0), DFF, 0, nullptr, scr, gw, ngw, lane);
    transpose_items<0>(p.ffn_w_down + (size_t)DFF * DM, DFF, DM, (bf16_t*)(ws + WS_W_DN1), DFF, 0, nullptr, scr, gw, ngw, lane);
    transpose_items<0>(p.pool_w_in, DM, DM, (bf16_t*)(ws + WS_P_IN), DM, 0, p.norm_mix + DM, scr, gw, ngw, lane);
#pragma unroll 1
    for (int gi = 0; gi < 4; ++gi) transpose_items<0>(p.pool_w_grp + (size_t)gi * 512 * 512, 512, 512, (bf16_t*)(ws + WS_P_GRP), 512, gi * 512, nullptr, scr, gw, ngw, lane);
    transpose_items<0>(p.pool_w_out, DM, DM, (bf16_t*)(ws + WS_P_OUT), DM, 0, nullptr, scr, gw, ngw, lane);
    transpose_items<0>(p.ck_w1, 32 * DK, 256, (bf16_t*)(ws + WS_CK1), 32 * DK, 0, nullptr, scr, gw, ngw, lane);
    transpose_items<0>(p.cv_w1, 32 * DV, 256, (bf16_t*)(ws + WS_CV1), 32 * DV, 0, nullptr, scr, gw, ngw, lane);
    transpose_items<0>(p.ck_w2, 256, DK, (bf16_t*)(ws + WS_CK2), 256, 0, nullptr, scr, gw, ngw, lane);
    transpose_items<0>(p.cv_w2, 256, DV, (bf16_t*)(ws + WS_CV2), 256, 0, nullptr, scr, gw, ngw, lane);
    float* ssq0 = (float*)(ws + WS_SSQ); bf16_t* xb = (bf16_t*)(ws + WS_XB);
    for (int row = gw; row < MT; row += ngw) {
        const f32x4* xr = (const f32x4*)(p.x + (size_t)row * DM) + lane; u32x2* o = (u32x2*)(xb + (size_t)row * DM) + lane;
        float s = 0.f;
#pragma unroll
        for (int j = 0; j < 8; ++j) { const f32x4 v = xr[64 * j]; s += (v[0] * v[0] + v[1] * v[1]) + (v[2] * v[2] + v[3] * v[3]); u32x2 w; w.x = cvt_pk_bf16(v[0], v[1]); w.y = cvt_pk_bf16(v[2], v[3]); o[64 * j] = w; }
        s = wave_sum(s);
        if (lane == 0) ssq0[row] = s;
    }
}

__device__ __forceinline__ float gelu_tanh(float x) { const float u = 0.7978845608028654f * (x + 0.044715f * x * x * x); return 0.5f * x * (1.0f + tanhf(u)); }

template <int DH>
__device__ __forceinline__ void compress_unit(const Params& p, LAS unsigned char* lds, int b, int n0, int colbase, const float* pos, const bf16_t* w1t, const float* b1, const bf16_t* w2t, bf16_t* outp) {
    constexpr int KC = 32 * DH;
    const int tid = threadIdx.x, lane = tid & 63, wave = __builtin_amdgcn_readfirstlane(tid >> 6), c = lane & 15, kq = lane >> 4;
    const bf16_t* proj = (const bf16_t*)(p.ws + WS_BIG);
    LAS unsigned char* As = lds; LAS unsigned char* Bs = lds + 5120; LAS unsigned char* Hs = lds + 32768;
    const int arow = tid >> 2, ach = tid & 3;
    const int ag = arow >> 4, an = n0 + (arow & 15);
    u32x4 areg = {0, 0, 0, 0}, breg[2];
#define CMP_LOAD(k0_) do { const int k0v = (k0_); \
        if (tid < 256) { const int kk = k0v + ach * 8, l = kk / DH, d = kk % DH; int tok = 16 * an + l; tok = tok < SEQ ? tok : SEQ - 1; \
            const u32x4 raw = *(const u32x4*)(proj + (size_t)(b * SEQ + tok) * NPROJ + colbase + ag * DH + d); \
            const f32x4 p0 = *(const f32x4*)(pos + l * DH + d), p1 = *(const f32x4*)(pos + l * DH + d + 4); \
            areg.x = cvt_pk_bf16(bf_lo(raw.x) + p0[0], bf_hi(raw.x) + p0[1]); areg.y = cvt_pk_bf16(bf_lo(raw.y) + p0[2], bf_hi(raw.y) + p0[3]); \
            areg.z = cvt_pk_bf16(bf_lo(raw.z) + p1[0], bf_hi(raw.z) + p1[1]); areg.w = cvt_pk_bf16(bf_lo(raw.w) + p1[2], bf_hi(raw.w) + p1[3]); } \
        _Pragma("unroll") for (int i_ = 0; i_ < 2; ++i_) { const int idx = tid + 512 * i_; breg[i_] = *(const u32x4*)(w1t + (size_t)(idx >> 2) * KC + k0v + (idx & 3) * 8); } } while (0)
    f32x4 acc[4][2];
#pragma unroll
    for (int m = 0; m < 4; ++m) { acc[m][0] = (f32x4){0.f, 0.f, 0.f, 0.f}; acc[m][1] = (f32x4){0.f, 0.f, 0.f, 0.f}; }
    CMP_LOAD(0);
    for (int k0 = 0; k0 < KC; k0 += 32) {
        __syncthreads();
        if (tid < 256) *(LAS u32x4*)(As + arow * 80 + ach * 16) = areg;
#pragma unroll
        for (int i = 0; i < 2; ++i) { const int idx = tid + 512 * i; *(LAS u32x4*)(Bs + (idx >> 2) * 80 + (idx & 3) * 16) = breg[i]; }
        __syncthreads();
        if (k0 + 32 < KC) CMP_LOAD(k0 + 32);
        bf16x8 af[4], bfr[2];
#pragma unroll
        for (int m = 0; m < 4; ++m) af[m] = *(const LAS bf16x8*)(As + (16 * m + c) * 80 + kq * 16);
#pragma unroll
        for (int n = 0; n < 2; ++n) bfr[n] = *(const LAS bf16x8*)(Bs + (32 * wave + 16 * n + c) * 80 + kq * 16);
#pragma unroll
        for (int m = 0; m < 4; ++m)
#pragma unroll
            for (int n = 0; n < 2; ++n) acc[m][n] = __builtin_amdgcn_mfma_f32_16x16x32_bf16(af[m], bfr[n], acc[m][n], 0, 0, 0);
    }
#pragma unroll
    for (int n = 0; n < 2; ++n) { const int col = 32 * wave + 16 * n + c; const float bb = b1[col];
#pragma unroll
        for (int m = 0; m < 4; ++m)
#pragma unroll
            for (int i = 0; i < 4; ++i) { const float h = gelu_tanh(acc[m][n][i] + bb); *(LAS bf16_t*)(Hs + (16 * m + 4 * kq + i) * 528 + col * 2) = (bf16_t)(cvt_pk_bf16(h, 0.f) & 0xffffu); } }
    __syncthreads();
    constexpr int NT2 = 4 * (DH / 16);
    for (int idx = wave; idx < NT2; idx += 8) {
        const int m2 = idx & 3, n2 = idx >> 2;
        f32x4 a2 = {0.f, 0.f, 0.f, 0.f};
#pragma unroll
        for (int ks = 0; ks < 8; ++ks) { const bf16x8 a = *(const LAS bf16x8*)(Hs + (16 * m2 + c) * 528 + (32 * ks + 8 * kq) * 2);
            const bf16x8 bb = *(const bf16x8*)(w2t + (size_t)(16 * n2 + c) * 256 + 32 * ks + 8 * kq);
            a2 = __builtin_amdgcn_mfma_f32_16x16x32_bf16(a, bb, a2, 0, 0, 0); }
#pragma unroll
        for (int i = 0; i < 4; ++i) outp[((size_t)(b * NG + m2) * NCMP + n0 + 4 * kq + i) * DH + 16 * n2 + c] = (bf16_t)(cvt_pk_bf16(a2[i], 0.f) & 0xffffu);
    }
    __syncthreads();
}

__device__ __forceinline__ void phase_compress(const Params& p, LAS unsigned char* lds) {
    unsigned char* ws = p.ws;
    for (int u = blockIdx.x; u < 256; u += gridDim.x) {
        const int which = u >> 7, b = (u >> 6) & 1, n0 = (u & 63) * 16;
        if (which == 0) compress_unit<DK>(p, lds, b, n0, C_KC, p.pos_k, (const bf16_t*)(ws + WS_CK1), p.ck_b1, (const bf16_t*)(ws + WS_CK2), (bf16_t*)(ws + WS_KCMP));
        else compress_unit<DV>(p, lds, b, n0, C_VC, p.pos_v, (const bf16_t*)(ws + WS_CV1), p.cv_b1, (const bf16_t*)(ws + WS_CV2), (bf16_t*)(ws + WS_VCMP));
    }
    { const bf16_t* proj = (const bf16_t*)(ws + WS_BIG); unsigned* kmaxp = (unsigned*)(ws + WS_KMAX); const int lane = threadIdx.x & 63;
      for (int it = blockIdx.x * NTHR + threadIdx.x; it < MT * 8; it += gridDim.x * NTHR) { const int row = it >> 3, sg = it & 7, br = sg >> 2, g = sg & 3;
        const u32x4* kp = (const u32x4*)(proj + (size_t)row * NPROJ + (br ? C_KW : C_KS) + g * DK); float n2 = 0.f;
#pragma unroll
        for (int ch = 0; ch < 12; ++ch) { const u32x4 w = kp[ch];
            n2 += bf_lo(w.x) * bf_lo(w.x) + bf_hi(w.x) * bf_hi(w.x) + bf_lo(w.y) * bf_lo(w.y) + bf_hi(w.y) * bf_hi(w.y) + bf_lo(w.z) * bf_lo(w.z) + bf_hi(w.z) * bf_hi(w.z) + bf_lo(w.w) * bf_lo(w.w) + bf_hi(w.w) * bf_hi(w.w); }
        n2 = fmaxf(n2, __shfl_xor(n2, 8)); n2 = fmaxf(n2, __shfl_xor(n2, 16)); n2 = fmaxf(n2, __shfl_xor(n2, 32));
        if (lane < 8) atomicMax(kmaxp + br * 8 + (row >> 14) * 4 + g, __float_as_uint(sqrtf(n2))); } }
}

constexpr int KT_STRIDE = 208, SLOT_K = 64 * KT_STRIDE;
constexpr int VT_STRIDE = 144, SLOT_V = 64 * VT_STRIDE;
constexpr int SLOT_BYTES = SLOT_K + SLOT_V, RING = 5, PD = RING - 1;
constexpr int RING_WS = 6;
constexpr int L_RING = 0, L_IMP = RING * SLOT_BYTES, L_BIAS = LDS_BYTES - 4 * 8 * 132 * 4, L_SELM = L_BIAS - 2048;
static_assert(L_IMP + 32 * 256 * 4 <= L_BIAS && RING_WS * SLOT_BYTES <= L_SELM, "attention LDS map");

struct PairState { f32x4 o[4]; float m, l; bf16x8 q[3]; };
struct TileSrc { const bf16_t* K; const bf16_t* V; int kld, vld; };
struct DmaPlan { int off[3]; };

__device__ __forceinline__ void glds16(const void* gsrc, unsigned lds_dst) { unsigned keep;
    asm volatile("s_mov_b32 %0, m0\n\ts_mov_b32 m0, %2\n\ts_nop 0\n\tglobal_load_lds_dwordx4 %1, off\n\ts_mov_b32 m0, %0" : "=&s"(keep) : "v"(gsrc), "s"(lds_dst) : "memory"); }
#define ATT_WAIT_BAR(N) asm volatile("s_waitcnt vmcnt(" #N ") lgkmcnt(0)\n\ts_barrier" ::: "memory")
__device__ __forceinline__ void att_wait_bar(int rem) { if (rem <= 0) ATT_WAIT_BAR(0); else if (rem == 1) ATT_WAIT_BAR(3); else if (rem == 2) ATT_WAIT_BAR(6); else ATT_WAIT_BAR(9); }
__device__ __forceinline__ bool piece_is_k(int s) { return s < 13 || s >= 22; }
__device__ __forceinline__ int piece_grp(int s) { return s < 13 ? s : (s >= 22 ? s - 22 : s - 13); }
__device__ __forceinline__ void make_plan(DmaPlan& pl, const TileSrc& src, int wave, int lane) {
#pragma unroll
    for (int j = 0; j < 3; ++j) { const int sidx = wave + 8 * j, ci = 64 * piece_grp(sidx) + lane;
        if (piece_is_k(sidx)) { const int key = ci / 13, ch = ci % 13; pl.off[j] = key * src.kld + (ch < 12 ? ch : 11) * 8; }
        else { const int key = ci / 9, ch = ci % 9; pl.off[j] = key * src.vld + (ch < 8 ? ch : 7) * 8; } }
}
__device__ __forceinline__ void issue_tile(const DmaPlan& pl, const TileSrc& src, int key0, unsigned slot_addr, int wave) {
#pragma unroll
    for (int j = 0; j < 3; ++j) { const int sidx = wave + 8 * j; const bool isk = piece_is_k(sidx);
        const bf16_t* gp = (isk ? src.K + (size_t)key0 * src.kld : src.V + (size_t)key0 * src.vld) + pl.off[j];
        glds16(gp, slot_addr + (isk ? 0u : (unsigned)SLOT_K) + 1024u * (unsigned)piece_grp(sidx)); }
}
typedef short s16x4 __attribute__((ext_vector_type(4)));
__device__ __forceinline__ s16x4 vtr(const LAS unsigned char* p) { return __builtin_bit_cast(s16x4, __builtin_amdgcn_ds_read_tr16_b64_v4i16((LAS s16x4*)p)); }

__device__ __forceinline__ float sum8_dpp(float x) {
    x += __builtin_bit_cast(float, __builtin_amdgcn_update_dpp(0, __builtin_bit_cast(int, x), 0xB1, 0xF, 0xF, true));
    x += __builtin_bit_cast(float, __builtin_amdgcn_update_dpp(0, __builtin_bit_cast(int, x), 0x4E, 0xF, 0xF, true));
    x += __builtin_bit_cast(float, __builtin_amdgcn_update_dpp(0, __builtin_bit_cast(int, x), 0x141, 0xF, 0xF, true));
    return x;
}
template <int MODE, bool FAR>
__device__ __forceinline__ void pair_tile(PairState& st, const LAS unsigned char* Kt, const LAS unsigned char* Vt, int tadj, int kstride, int maxdist, bool rowsel,
                                          const LAS float* biasrow, float bias_far, LAS float* improw, int jj0, int lane) {
    const int c = lane & 15, kq = lane >> 4;
    f32x4 s[4];
    float bv[4][4];
    if (!FAR) {
#pragma unroll
        for (int kt = 0; kt < 4; ++kt)
#pragma unroll
            for (int i = 0; i < 4; ++i) { const int d = tadj - (16 * kt + 4 * kq + i) * kstride; const int bi = d < 0 ? 0 : (d > 128 ? 128 : d); bv[kt][i] = biasrow[bi]; }
    }
    const float init = FAR ? (rowsel ? bias_far - st.m : NEGF) : -st.m;
    const f32x4 initv = {init, init, init, init};
#pragma unroll
    for (int kt = 0; kt < 4; ++kt) {
#pragma unroll
        for (int ds = 0; ds < 3; ++ds) { const bf16x8 a = *(const LAS bf16x8*)(Kt + (16 * kt + c) * KT_STRIDE + (32 * ds + 8 * kq) * 2);
            s[kt] = __builtin_amdgcn_mfma_f32_16x16x32_bf16(a, st.q[ds], ds == 0 ? initv : s[kt], 0, 0, 0); } }
    if (!FAR) {
#pragma unroll
        for (int kt = 0; kt < 4; ++kt)
#pragma unroll
            for (int i = 0; i < 4; ++i) { const int d = tadj - (16 * kt + 4 * kq + i) * kstride; const bool valid = ((unsigned)d < (unsigned)maxdist) && rowsel;
                s[kt][i] = valid ? s[kt][i] + bv[kt][i] : NEGF; }
    }
    float psum = 0.f;
#pragma unroll
    for (int kt = 0; kt < 4; ++kt)
#pragma unroll
        for (int i = 0; i < 4; ++i) { const float pv = __builtin_amdgcn_exp2f(s[kt][i]); s[kt][i] = pv; psum += pv; }
    if (MODE != 1) st.l += psum;
    if (MODE == 0) return;
#pragma unroll
    for (int s2 = 0; s2 < 2; ++s2) {
        u32x4 pw; pw.x = cvt_pk_bf16(s[2 * s2][0], s[2 * s2][1]); pw.y = cvt_pk_bf16(s[2 * s2][2], s[2 * s2][3]); pw.z = cvt_pk_bf16(s[2 * s2 + 1][0], s[2 * s2 + 1][1]); pw.w = cvt_pk_bf16(s[2 * s2 + 1][2], s[2 * s2 + 1][3]);
        const bf16x8 pb = __builtin_bit_cast(bf16x8, pw);
#pragma unroll
        for (int dt = 0; dt < 4; ++dt) { const LAS unsigned char* vp = Vt + (32 * s2 + 4 * kq + (c >> 2)) * VT_STRIDE + (16 * dt + 4 * (c & 3)) * 2;
            const s16x4 lo = vtr(vp), hi = vtr(vp + 16 * VT_STRIDE); const bf16x8 a = {lo[0], lo[1], lo[2], lo[3], hi[0], hi[1], hi[2], hi[3]};
            st.o[dt] = __builtin_amdgcn_mfma_f32_16x16x32_bf16(a, pb, st.o[dt], 0, 0, 0); }
    }
    if (MODE == 1) {
#pragma unroll
        for (int kt = 0; kt < 4; ++kt) {
            float u0 = 2.0f * (s[kt][0] + s[kt][1] + s[kt][2]) + s[kt][3], u1 = s[kt][3];
            u0 = sum8_dpp(u0); u1 = sum8_dpp(u1);
            if ((lane & 7) == 0) { const int jj = jj0 + 4 * kt + kq;
                __hip_atomic_fetch_add(improw + jj, u0, __ATOMIC_RELAXED, __HIP_MEMORY_SCOPE_WORKGROUP);
                if (jj + 1 < 256) __hip_atomic_fetch_add(improw + jj + 1, u1, __ATOMIC_RELAXED, __HIP_MEMORY_SCOPE_WORKGROUP); }
        }
    }
}
#define PAIR_TILE(MODE, far, ...) do { if (far) pair_tile<MODE, true>(__VA_ARGS__); else pair_tile<MODE, false>(__VA_ARGS__); } while (0)

__device__ __forceinline__ int t5_bucket(int n) {
    if (n < 16) return n;
    int bk = 16;
    bk += (n >= 19); bk += (n >= 21); bk += (n >= 24); bk += (n >= 27); bk += (n >= 31); bk += (n >= 35); bk += (n >= 40); bk += (n >= 46);
    bk += (n >= 52); bk += (n >= 59); bk += (n >= 67); bk += (n >= 77); bk += (n >= 87); bk += (n >= 99); bk += (n >= 113);
    return bk;
}
__device__ __forceinline__ void build_bias(const Params& p, LAS unsigned char* lds) {
    LAS float* bt = (LAS float*)(lds + L_BIAS);
    for (int i = threadIdx.x; i < 32 * 129; i += NTHR) { const int h = i / 129, d = i % 129; bt[h * 132 + d] = p.rel_bias[t5_bucket(d) * 32 + h] * 1.4426950408889634f; }
    __syncthreads();
    if (threadIdx.x < 32) { float mx = bt[threadIdx.x * 132]; for (int d = 1; d < 129; ++d) mx = fmaxf(mx, bt[threadIdx.x * 132 + d]); bt[threadIdx.x * 132 + 129] = mx; }
    __syncthreads();
}

__device__ __forceinline__ void load_q(PairState& st, const bf16_t* proj, int b, int g, int tq0, int lane, float kmx, float bmax) {
    const int c = lane & 15, kq = lane >> 4; const size_t row = (size_t)b * SEQ + tq0 + (c >> 3);
#pragma unroll
    for (int ds = 0; ds < 3; ++ds) st.q[ds] = *(const bf16x8*)(proj + row * NPROJ + (g * 8 + (c & 7)) * DK + 32 * ds + 8 * kq);
    asm volatile("" : "+v"(st.q[0]), "+v"(st.q[1]), "+v"(st.q[2]));
    float qq = 0.f;
#pragma unroll
    for (int ds = 0; ds < 3; ++ds) { const u32x4 w = __builtin_bit_cast(u32x4, st.q[ds]);
        qq += bf_lo(w.x) * bf_lo(w.x) + bf_hi(w.x) * bf_hi(w.x) + bf_lo(w.y) * bf_lo(w.y) + bf_hi(w.y) * bf_hi(w.y) + bf_lo(w.z) * bf_lo(w.z) + bf_hi(w.z) * bf_hi(w.z) + bf_lo(w.w) * bf_lo(w.w) + bf_hi(w.w) * bf_hi(w.w); }
    qq += __shfl_xor(qq, 16); qq += __shfl_xor(qq, 32);
    st.m = sqrtf(qq) * kmx + bmax + 0.25f;
}
__device__ __forceinline__ void reset_state(PairState& st) {
#pragma unroll
    for (int dt = 0; dt < 4; ++dt) st.o[dt] = (f32x4){0.f, 0.f, 0.f, 0.f};
    st.l = 0.f;
}
template <bool ACCUM>
__device__ __forceinline__ void write_out(const PairState& st, float inv, const bf16_t* proj, bf16_t* obuf, int b, int g, int tq0, int br, int lane) {
    const int c = lane & 15, kq = lane >> 4; const size_t row = (size_t)b * SEQ + tq0 + (c >> 3);
    const float gl = bf_lo((unsigned)proj[row * NPROJ + C_GATE + br * 32 + g * 8 + (c & 7)]);
    const float sc = inv * __builtin_amdgcn_rcpf(1.0f + __expf(-gl));
    bf16_t* op = obuf + row * DM + (g * 8 + (c & 7)) * DV + 4 * kq;
#pragma unroll
    for (int dt = 0; dt < 4; ++dt) { f32x4 v = st.o[dt] * sc;
        if (ACCUM) { const u32x2 old = *(const u32x2*)(op + 16 * dt); v[0] += bf_lo(old.x); v[1] += bf_hi(old.x); v[2] += bf_lo(old.y); v[3] += bf_hi(old.y); }
        u32x2 w; w.x = cvt_pk_bf16(v[0], v[1]); w.y = cvt_pk_bf16(v[2], v[3]); *(u32x2*)(op + 16 * dt) = w; }
}

constexpr size_t WS_UCTR = WS_XBAR + 14336;
#define UNIT_LOOP_BEGIN(ctrptr, NU) \
    { LAS unsigned* ubox_ = (LAS unsigned*)(lds + 146440); unsigned nxt_ = 0u; \
      if (threadIdx.x == 0) ubox_[0] = atomicAdd((ctrptr), 1u); \
      __syncthreads(); \
      for (;;) { const unsigned ul = ubox_[0]; if (ul >= (unsigned)(NU)) break; \
          __syncthreads();
#define UNIT_PREFETCH(ctrptr) do { if (threadIdx.x == 0) nxt_ = atomicAdd((ctrptr), 1u); } while (0)
#define UNIT_LOOP_END() \
          if (threadIdx.x == 0) ubox_[0] = nxt_; \
          __syncthreads(); } }

__device__ __forceinline__ void phase_cmp(const Params& p, LAS unsigned char* lds) {
    const int tid = threadIdx.x, lane = tid & 63, wave = __builtin_amdgcn_readfirstlane(tid >> 6), c = lane & 15;
    const bf16_t* proj = (const bf16_t*)(p.ws + WS_BIG); bf16_t* obuf = (bf16_t*)(p.ws + WS_O); unsigned* selm = (unsigned*)(p.ws + WS_SELM);
    build_bias(p, lds);
    { LAS float* bt = (LAS float*)(lds + L_BIAS); const u32x4* kc = (const u32x4*)(p.ws + WS_KCMP) + (size_t)wave * NCMP * 12; float n2m = 0.f;
#pragma unroll 4
      for (int r = lane; r < NCMP; r += 64) { float n2 = 0.f;
#pragma unroll
        for (int ch = 0; ch < 12; ++ch) { const u32x4 w = kc[r * 12 + ch];
            n2 += bf_lo(w.x) * bf_lo(w.x) + bf_hi(w.x) * bf_hi(w.x) + bf_lo(w.y) * bf_lo(w.y) + bf_hi(w.y) * bf_hi(w.y) + bf_lo(w.z) * bf_lo(w.z) + bf_hi(w.z) * bf_hi(w.z) + bf_lo(w.w) * bf_lo(w.w) + bf_hi(w.w) * bf_hi(w.w); }
        n2m = fmaxf(n2m, n2); }
#pragma unroll
      for (int o = 1; o < 64; o <<= 1) n2m = fmaxf(n2m, __shfl_xor(n2m, o));
      if (lane == 0) bt[wave * 132 + 130] = sqrtf(n2m);
      __syncthreads(); }
    LAS float* imp = (LAS float*)(lds + L_IMP);
    UNIT_LOOP_BEGIN((unsigned*)(p.ws + WS_UCTR) + (blockIdx.x & 7), 512)
        const int bg = blockIdx.x & 7, b = bg >> 2, g = bg & 3, t0 = (511 - (int)ul) * 32;
        TileSrc src; src.K = (const bf16_t*)(p.ws + WS_KCMP) + (size_t)bg * NCMP * DK; src.V = (const bf16_t*)(p.ws + WS_VCMP) + (size_t)bg * NCMP * DV; src.kld = DK; src.vld = DV;
        const int nt = t0 / 1024 + 1;
        const LAS float* biasrow = (const LAS float*)(lds + L_BIAS) + (g * 8 + (c & 7)) * 132; const float bias_far = biasrow[128];
        PairState st[2];
#pragma unroll
        for (int pi = 0; pi < 2; ++pi) { reset_state(st[pi]); load_q(st[pi], proj, b, g, t0 + 4 * wave + 2 * pi, lane, ((const LAS float*)(lds + L_BIAS))[bg * 132 + 130], biasrow[129]); }
#pragma unroll
        for (int i = 0; i < 16; ++i) imp[(4 * wave) * 256 + i * 64 + lane] = 0.f;
        DmaPlan pl; make_plan(pl, src, wave, lane);
        const unsigned ring = (unsigned)(size_t)(lds + L_RING);
#pragma unroll 1
        for (int pass = 0; pass < 2; ++pass) {
            if (pass == 1) {
#pragma unroll
                for (int pi = 0; pi < 2; ++pi) { float lt = st[pi].l; lt += __shfl_xor(lt, 16); lt += __shfl_xor(lt, 32); if (lt > 0.f) st[pi].m += __builtin_amdgcn_logf(lt); }
            }
            for (int d = 0; d < PD && d < nt; ++d) issue_tile(pl, src, 64 * d, ring + d * SLOT_BYTES, wave);
            if (pass == 0) UNIT_PREFETCH((unsigned*)(p.ws + WS_UCTR) + (blockIdx.x & 7));
            int slot = 0, islot = PD;
#pragma unroll 1
            for (int i = 0; i < nt; ++i) {
                { int rem = nt - 1 - i; rem = rem < PD - 1 ? rem : PD - 1; att_wait_bar(rem); }
                if (i + PD < nt) issue_tile(pl, src, 64 * (i + PD), ring + islot * SLOT_BYTES, wave);
                const LAS unsigned char* Kt = lds + L_RING + slot * SLOT_BYTES; const LAS unsigned char* Vt = Kt + SLOT_K;
#pragma unroll
                for (int pi = 0; pi < 2; ++pi) { const int tq0 = t0 + 4 * wave + 2 * pi; const int P0 = 16 * 64 * i + 31;
                    if (tq0 + 1 < P0) continue;
                    const bool far = (tq0 - (P0 + 63 * 16)) >= 113;
                    const int tadj = tq0 + (c >> 3) - P0;
                    if (pass == 0) PAIR_TILE(0, far, st[pi], Kt, Vt, tadj, 16, 1 << 30, true, biasrow, bias_far, nullptr, 0, lane);
                    else PAIR_TILE(1, far, st[pi], Kt, Vt, tadj, 16, 1 << 30, true, biasrow, bias_far, imp + (4 * wave + 2 * pi + (c >> 3)) * 256, 16 * i, lane); }
                slot = slot + 1 == RING ? 0 : slot + 1; islot = islot + 1 == RING ? 0 : islot + 1;
            }
            ATT_WAIT_BAR(0);
        }
#pragma unroll
        for (int pi = 0; pi < 2; ++pi) write_out<false>(st[pi], 1.0f, proj, obuf, b, g, t0 + 4 * wave + 2 * pi, 0, lane);
        asm volatile("s_waitcnt lgkmcnt(0)" ::: "memory");
        {
            unsigned key[4][4]; unsigned T[4]; int need[4];
            const int cur = (t0 + 4 * wave) >> 6;
#pragma unroll
            for (int qq = 0; qq < 4; ++qq) { T[qq] = 0u; need[qq] = 16 - (1 + (cur >= 1) + (cur >= 2));
#pragma unroll
                for (int i = 0; i < 4; ++i) { const int j = lane + 64 * i; const float v = imp[(4 * wave + qq) * 256 + j];
                    const bool cand = (j >= 1) && (j <= cur - 2);
                    key[qq][i] = cand ? (__float_as_uint(v) + 1u) : 0u; } }
#pragma unroll 1
            for (int bit = 31; bit >= 0; --bit) {
#pragma unroll
                for (int qq = 0; qq < 4; ++qq) { const unsigned cand = T[qq] | (1u << bit);
                    const int cnt = __popcll(__ballot(key[qq][0] >= cand)) + __popcll(__ballot(key[qq][1] >= cand)) + __popcll(__ballot(key[qq][2] >= cand)) + __popcll(__ballot(key[qq][3] >= cand));
                    if (cnt >= need[qq]) T[qq] = cand; } }
#pragma unroll
            for (int qq = 0; qq < 4; ++qq) { const int t = t0 + 4 * wave + qq;
                unsigned Tq = T[qq]; if (Tq == 0u) Tq = 1u;
                int above = 0;
#pragma unroll
                for (int i = 0; i < 4; ++i) above += __popcll(__ballot(key[qq][i] > Tq));
                int room = need[qq] - above;
                unsigned* mrow = selm + ((size_t)bg * SEQ + t) * 8;
#pragma unroll
                for (int i = 0; i < 4; ++i) { const int j = lane + 64 * i; const unsigned long long eq = __ballot(key[qq][i] == Tq); const int rank = __popcll(eq & ((1ull << lane) - 1ull));
                    const bool sl = (j == 0) || (j == cur) || (j == cur - 1) || (key[qq][i] > Tq) || (key[qq][i] == Tq && rank < room); room -= __popcll(eq);
                    const unsigned long long bal = __ballot(sl); if (lane == 0) { mrow[2 * i] = (unsigned)bal; mrow[2 * i + 1] = (unsigned)(bal >> 32); } } }
        }
    UNIT_LOOP_END()
}

__device__ __forceinline__ void build_order(const LAS unsigned* lsel, LAS unsigned char* ord, LAS int* cnt, int cb, int nq, int lane) {
    int base = 0;
#pragma unroll 1
    for (int r = 0; 64 * r <= cb; ++r) { const int j = lane + 64 * r; unsigned m = 0u;
        for (int q = 0; q < nq; ++q) m |= lsel[q * 8 + (j >> 5)];
        const bool need = (j <= cb) && ((m >> (j & 31)) & 1u);
        const unsigned long long bal = __ballot(need);
        if (need) ord[base + __popcll(bal & ((1ull << lane) - 1ull))] = (unsigned char)j;
        base += __popcll(bal); }
    if (lane == 0) *cnt = base;
}

template <bool WIN, int NP>
__device__ __forceinline__ void phase_ws(const Params& p, LAS unsigned char* lds) {
    constexpr int QW = 2 * NP, QU = 8 * QW, NUNIT = MT * NG / QU;
    const int tid = threadIdx.x, lane = tid & 63, wave = __builtin_amdgcn_readfirstlane(tid >> 6), c = lane & 15;
    const bf16_t* proj = (const bf16_t*)(p.ws + WS_BIG); bf16_t* obuf = (bf16_t*)(p.ws + WS_O); const unsigned* selm = (const unsigned*)(p.ws + WS_SELM);
    build_bias(p, lds);
    LAS unsigned* lsel = (LAS unsigned*)(lds + L_SELM);
    UNIT_LOOP_BEGIN((unsigned*)(p.ws + WS_UCTR) + (WIN ? 8 : 16) + (blockIdx.x & 7), NUNIT / 8)
        const int bg = blockIdx.x & 7, b = bg >> 2, g = bg & 3, t0 = (SEQ / QU - 1 - (int)ul) * QU;
        TileSrc src; src.kld = NPROJ; src.vld = NPROJ;
        src.K = proj + (size_t)b * SEQ * NPROJ + (WIN ? C_KW : C_KS) + g * DK; src.V = proj + (size_t)b * SEQ * NPROJ + (WIN ? C_VW : C_VS) + g * DV;
        const int cb = t0 >> 6;
        const int kstart = WIN ? (cb >= 8 ? (cb - 8) * 64 : 0) : 0;
        const int nt = cb + 1 - kstart / 64;
        const LAS float* biasrow = (const LAS float*)(lds + L_BIAS) + (g * 8 + (c & 7)) * 132; const float bias_far = biasrow[128];
        const float kmx = __uint_as_float(((const unsigned*)(p.ws + WS_KMAX))[(WIN ? 8 : 0) + bg]);
        LAS unsigned char* ord = (LAS unsigned char*)(lds + L_SELM + 1024);
        int npos = nt;
        if (!WIN) { if (tid < QU * 8) lsel[tid] = selm[((size_t)bg * SEQ + t0) * 8 + tid];
            __syncthreads();
            if (wave == 0) build_order(lsel, ord, (LAS int*)(lds + L_SELM + 1024 + 256), cb, QU, lane);
            __syncthreads();
            npos = *(LAS int*)(lds + L_SELM + 1024 + 256); }
        PairState st[NP];
#pragma unroll
        for (int pi = 0; pi < NP; ++pi) { reset_state(st[pi]); load_q(st[pi], proj, b, g, t0 + QW * wave + 2 * pi, lane, kmx, biasrow[129]); }
        DmaPlan pl; make_plan(pl, src, wave, lane);
        const unsigned ring = (unsigned)(size_t)(lds + L_RING);
#define WS_TILE(pos) (WIN ? (pos) : (int)ord[pos])
        for (int d = 0; d < 4 && d < npos; ++d) issue_tile(pl, src, kstart + 64 * WS_TILE(d), ring + d * SLOT_BYTES, wave);
        UNIT_PREFETCH((unsigned*)(p.ws + WS_UCTR) + (WIN ? 8 : 16) + (blockIdx.x & 7));
        int slot = 0, islot = 4;
#pragma unroll 1
        for (int i0 = 0; i0 < npos; i0 += 2) {
            { const int issued = npos < i0 + 4 ? npos : i0 + 4, done = npos < i0 + 2 ? npos : i0 + 2; att_wait_bar(issued - done); }
#pragma unroll 1
            for (int e = 0; e < 2; ++e) { if (i0 + e >= npos) break; const int i = WS_TILE(i0 + e);
                const LAS unsigned char* Kt = lds + L_RING + slot * SLOT_BYTES; const LAS unsigned char* Vt = Kt + SLOT_K;
                slot = slot + 1 == RING_WS ? 0 : slot + 1;
                const int P0 = kstart + 64 * i;
#pragma unroll
                for (int pi = 0; pi < NP; ++pi) { const int tq0 = t0 + QW * wave + 2 * pi;
                    bool rowsel = true; bool allsel = true;
                    if (!WIN) { const unsigned w = lsel[(QW * wave + 2 * pi + (c >> 3)) * 8 + (i >> 5)]; rowsel = (w >> (i & 31)) & 1u;
                        const unsigned long long bal = __ballot(rowsel); if (bal == 0ull) continue; allsel = (bal == ~0ull); }
                    else { if (tq0 + 1 < P0 || tq0 - (P0 + 63) >= 512) continue; }
                    const bool far = (tq0 - (P0 + 63) >= 113) && (!WIN || (tq0 + 1 - P0 < 512));
                    PAIR_TILE(2, far, st[pi], Kt, Vt, tq0 + (c >> 3) - P0, 1, WIN ? 512 : (1 << 30), rowsel, biasrow, bias_far, nullptr, 0, lane); } }
#pragma unroll
            for (int e = 0; e < 2; ++e) { if (i0 + 4 + e < npos) issue_tile(pl, src, kstart + 64 * WS_TILE(i0 + 4 + e), ring + islot * SLOT_BYTES, wave); islot = islot + 1 == RING_WS ? 0 : islot + 1; }
        }
#undef WS_TILE
        ATT_WAIT_BAR(0);
#pragma unroll
        for (int pi = 0; pi < NP; ++pi) { float lt = st[pi].l; lt += __shfl_xor(lt, 16); lt += __shfl_xor(lt, 32);
            write_out<true>(st[pi], lt > 0.f ? 1.0f / lt : 0.f, proj, obuf, b, g, t0 + QW * wave + 2 * pi, WIN ? 2 : 1, lane); }
    UNIT_LOOP_END()
}

template <int W>
__device__ __forceinline__ void pool_item(const bf16_t* ub, bf16_t* pooled, int row, int t, int ch) {
    u32x4 v[W];
#pragma unroll
    for (int k = 0; k < W; ++k) v[k] = *(const u32x4*)(ub + (size_t)(k <= t ? row - k : row) * DM + ch * 8);
    const int cnt = (t + 1 < W) ? t + 1 : W;
    float acc[8] = {0.f, 0.f, 0.f, 0.f, 0.f, 0.f, 0.f, 0.f};
#pragma unroll
    for (int k = 0; k < W; ++k) { const float m = k < cnt ? 1.0f : 0.0f;
        acc[0] += m * bf_lo(v[k].x); acc[1] += m * bf_hi(v[k].x); acc[2] += m * bf_lo(v[k].y); acc[3] += m * bf_hi(v[k].y); acc[4] += m * bf_lo(v[k].z); acc[5] += m * bf_hi(v[k].z); acc[6] += m * bf_lo(v[k].w); acc[7] += m * bf_hi(v[k].w); }
    const float ic = 1.0f / (float)cnt; const u32x4 self = v[0];
    u32x4 o; o.x = cvt_pk_bf16(acc[0] * ic - bf_lo(self.x), acc[1] * ic - bf_hi(self.x)); o.y = cvt_pk_bf16(acc[2] * ic - bf_lo(self.y), acc[3] * ic - bf_hi(self.y));
    o.z = cvt_pk_bf16(acc[4] * ic - bf_lo(self.z), acc[5] * ic - bf_hi(self.z)); o.w = cvt_pk_bf16(acc[6] * ic - bf_lo(self.w), acc[7] * ic - bf_hi(self.w));
    *(u32x4*)(pooled + (size_t)row * DM + ch * 8) = o;
}
__device__ __forceinline__ void phase_pool(const Params& p) {
    const bf16_t* ub = (const bf16_t*)(p.ws + WS_BIG); bf16_t* pooled = (bf16_t*)(p.ws + WS_BIG + 128 * MiB);
    const int nthr = gridDim.x * NTHR;
    for (int it = blockIdx.x * NTHR + threadIdx.x; it < MT * 256; it += nthr) {
        const int row = it >> 8, ch = it & 255, t = row & (SEQ - 1); const int gi = ch >> 6;
        if (gi == 0) pool_item<2>(ub, pooled, row, t, ch); else if (gi == 1) pool_item<4>(ub, pooled, row, t, ch);
        else if (gi == 2) pool_item<8>(ub, pooled, row, t, ch); else pool_item<16>(ub, pooled, row, t, ch);
    }
}
__device__ __forceinline__ void phase_final(const Params& p) {
    const int lane = threadIdx.x & 63, wave = threadIdx.x >> 6; const int gw = blockIdx.x * NWAVES + wave, ngw = gridDim.x * NWAVES;
    const float* ssq = (const float*)(p.ws + WS_SSQ) + 4 * (size_t)MT;
    for (int row = gw; row < MT; row += ngw) { const float rs = rsqrtf(ssq[row] * (1.0f / DM) + EPS);
        f32x4* xr = (f32x4*)(p.out + (size_t)row * DM) + lane; const f32x4* gr = (const f32x4*)p.norm_final + lane;
#pragma unroll
        for (int j = 0; j < 8; ++j) xr[64 * j] = xr[64 * j] * rs * gr[64 * j]; }
}

#define XB_TMO      128
#define XB_XCNT(j)  (256  + 64 * (j))
#define XB_XSUB(j)  (1280 + 64 * (j))
#define XB_XGEN(j)  (2304 + 64 * (j))
#define XB_TOP      3328
#define XB_TOPGEN   3392
#define XCD_BAR_WORDS 3456
#define XB_SPIN_CAP (1u << 18)

__device__ __forceinline__ unsigned xb_ld(unsigned* p)              { return __hip_atomic_load(p, __ATOMIC_RELAXED, __HIP_MEMORY_SCOPE_AGENT); }
__device__ __forceinline__ unsigned xb_add(unsigned* p, unsigned v) { return __hip_atomic_fetch_add(p, v, __ATOMIC_RELAXED, __HIP_MEMORY_SCOPE_AGENT); }
__device__ __forceinline__ unsigned xb_xcc_id() { return (unsigned)__builtin_amdgcn_s_getreg((3 << 11) | 20) & 0xFu; }
#define XB_SPIN(cond, bar) do { unsigned _sp = 0; while (cond) { __builtin_amdgcn_s_sleep(1); \
    if ((++_sp & 255u) == 0u) { if (xb_ld(&(bar)[XB_TMO])) break; if (_sp > XB_SPIN_CAP) { atomicAdd(&(bar)[XB_TMO], 1u); break; } } } } while (0)

struct XcdBarrier {
    unsigned* bar; unsigned x;
    volatile LAS unsigned* st;
};

__device__ __forceinline__ XcdBarrier xcd_barrier_post(unsigned* bar, volatile LAS unsigned* st) {
    XcdBarrier b; b.bar = bar; b.x = xb_xcc_id(); b.st = st;
    if (threadIdx.x == 0) (void)xb_add(&bar[XB_XCNT(b.x)], 1u);
    return b;
}
__device__ __forceinline__ void xcd_barrier_complete(unsigned* bar, unsigned x, unsigned& nloc, unsigned& nx) {
    const unsigned G = gridDim.x * gridDim.y * gridDim.z;
    unsigned sum, cnt, mine, sp = 0u;
    for (;;) {
        sum = 0u; cnt = 0u; mine = 0u;
#pragma unroll
        for (unsigned j = 0; j < 16; ++j) { const unsigned c = xb_ld(&bar[XB_XCNT(j)]); sum += c; cnt += (c > 0u) ? 1u : 0u; mine = (j == x) ? c : mine; }
        if (sum == G) break;
        __builtin_amdgcn_s_sleep(1);
        if ((++sp & 255u) == 0u) { if (xb_ld(&bar[XB_TMO])) break; if (sp > XB_SPIN_CAP) { atomicAdd(&bar[XB_TMO], 1u); break; } }
    }
    nloc = mine > 0u ? mine : 1u; nx = cnt > 0u ? cnt : 1u;
}

__device__ __forceinline__ void xcd_barrier(const XcdBarrier& b) {
    asm volatile("s_waitcnt vmcnt(0)" ::: "memory");
    __syncthreads();
    if (threadIdx.x == 0) {
        unsigned* bar = b.bar;
        __builtin_amdgcn_s_waitcnt(0);
        unsigned nloc = b.st[0], nx = b.st[1];
        if (nloc == 0u) { xcd_barrier_complete(bar, b.x, nloc, nx); b.st[0] = nloc; b.st[1] = nx; }
        const unsigned old = xb_add(&bar[XB_XSUB(b.x)], 1u);
        const unsigned gen = old / nloc;
        if (old + 1u == (gen + 1u) * nloc) {
            __builtin_amdgcn_fence(__ATOMIC_RELEASE, "agent");
            asm volatile("s_waitcnt vmcnt(0)" ::: "memory");
            const unsigned og = xb_add(&bar[XB_TOP], 1u);
            const unsigned tg = og / nx;
            if (og + 1u == (tg + 1u) * nx) xb_add(&bar[XB_TOPGEN], 1u);
            else XB_SPIN(xb_ld(&bar[XB_TOPGEN]) == tg, bar);
            __builtin_amdgcn_fence(__ATOMIC_ACQUIRE, "agent");
            xb_add(&bar[XB_XGEN(b.x)], 1u);
            asm volatile("s_waitcnt vmcnt(0)" ::: "memory");
        } else {
            XB_SPIN(xb_ld(&bar[XB_XGEN(b.x)]) == gen, bar);
            __builtin_amdgcn_fence(__ATOMIC_ACQUIRE, "agent");
            asm volatile("s_waitcnt vmcnt(0)" ::: "memory");
        }
    }
    __syncthreads();
}

#define GSYNC_() do { asm volatile("s_waitcnt vmcnt(0) lgkmcnt(0)" ::: "memory"); __builtin_amdgcn_fence(__ATOMIC_RELEASE, "agent"); grid.sync(); __builtin_amdgcn_fence(__ATOMIC_ACQUIRE, "agent"); } while (0)
#define GSYNC() xcd_barrier(xbar)
__global__ void __launch_bounds__(NTHR, 2) fwd_megakernel(Params p) {
    extern __shared__ __attribute__((aligned(16))) unsigned char lds_raw[];
    LAS unsigned char* lds = (LAS unsigned char*)lds_raw;
    cg::grid_group grid = cg::this_grid();
    volatile LAS unsigned* xst = (volatile LAS unsigned*)(lds + 146432);
    if (threadIdx.x < 2) xst[threadIdx.x] = 0u;
    __syncthreads();
    const XcdBarrier xbar = xcd_barrier_post((unsigned*)(p.ws + WS_XBAR), xst);
    unsigned char* ws = p.ws;
    float* ssq = (float*)(ws + WS_SSQ);
    bf16_t* xb = (bf16_t*)(ws + WS_XB); bf16_t* obuf = (bf16_t*)(ws + WS_O); bf16_t* big = (bf16_t*)(ws + WS_BIG);
    const int G = gridDim.x, cidx = blockIdx.x;
    pg8::StaticOrder S;

    phase_prologue(p, lds);
    if (p.ws == nullptr) GSYNC_();
    GSYNC();
    { pg8::Gemm g{xb, (const bf16_t*)(ws + WS_W_IN), DM, DM, MT, NPROJ, DM, 0}; S.init(MT, NPROJ, G, cidx); pg8::EpiProj E{big, ssq}; pg8::gemm_phase(lds, g, S, E); }
    GSYNC();
    phase_compress(p, lds);
    GSYNC();
    phase_cmp(p, lds);
    GSYNC();
    phase_ws<true, 2>(p, lds);
    GSYNC();
    phase_ws<false, 2>(p, lds);
    GSYNC();
    { pg8::Gemm g{obuf, (const bf16_t*)(ws + WS_W_OUT), DM, DM, MT, DM, DM, 0}; S.init(MT, DM, G, cidx); pg8::EpiRes E{p.x, p.out, xb, ssq + MT}; pg8::gemm_phase(lds, g, S, E); }
    GSYNC();
    { pg8::Gemm g{xb, (const bf16_t*)(ws + WS_W_GU0), DM, DM, MT, 2 * DFF, DM, 0}; S.init(MT, 2 * DFF, G, cidx); pg8::EpiSwiglu E{big, ssq + MT}; pg8::gemm_phase(lds, g, S, E); }
    GSYNC();
    { pg8::Gemm g{big, (const bf16_t*)(ws + WS_W_DN0), DFF, DFF, MT, DM, DFF, 0}; S.init(MT, DM, G, cidx); pg8::EpiRes E{p.out, p.out, xb, ssq + 2 * MT}; pg8::gemm_phase(lds, g, S, E); }
    GSYNC();
    { pg8::Gemm g{xb, (const bf16_t*)(ws + WS_P_IN), DM, DM, MT, DM, DM, 0}; S.init(MT, DM, G, cidx); pg8::EpiRowScale E{big, ssq + 2 * MT}; pg8::gemm_phase(lds, g, S, E); }
    GSYNC();
    phase_pool(p);
    GSYNC();
    { pg8::Gemm g{(const bf16_t*)(ws + WS_BIG + 128 * MiB), (const bf16_t*)(ws + WS_P_GRP), DM, 512, MT, DM, 512, 1024}; S.init(MT, DM, G, cidx); pg8::EpiColScale E{obuf, p.pool_scale}; pg8::gemm_phase(lds, g, S, E); }
    GSYNC();
    { pg8::Gemm g{obuf, (const bf16_t*)(ws + WS_P_OUT), DM, DM, MT, DM, DM, 0}; S.init(MT, DM, G, cidx); pg8::EpiRes E{p.out, p.out, xb, ssq + 3 * MT}; pg8::gemm_phase(lds, g, S, E); }
    GSYNC();
    { pg8::Gemm g{xb, (const bf16_t*)(ws + WS_W_GU1), DM, DM, MT, 2 * DFF, DM, 0}; S.init(MT, 2 * DFF, G, cidx); pg8::EpiSwiglu E{big, ssq + 3 * MT}; pg8::gemm_phase(lds, g, S, E); }
    GSYNC();
    { pg8::Gemm g{big, (const bf16_t*)(ws + WS_W_DN1), DFF, DFF, MT, DM, DFF, 0}; S.init(MT, DM, G, cidx); pg8::EpiRes E{p.out, p.out, nullptr, ssq + 4 * MT};     pg8::gemm_phase(lds, g, S, E); }
    GSYNC();
    phase_final(p);
}

extern "C" void kernel_launch(void* const* d_in, const int* in_sizes, int n_in, void* d_out, int out_size, void* d_ws, size_t ws_size, hipStream_t stream) {
    static int grid_blocks = 0;
    if (grid_blocks == 0) {
        if (n_in != 21 || ws_size < WS_END) { fprintf(stderr, "kernel_launch: unexpected inputs (n_in %d, ws %zu)\n", n_in, ws_size); grid_blocks = -1; return; }
        int dev = 0, cus = 0, per_cu = 0;
        hipGetDevice(&dev); hipDeviceGetAttribute(&cus, hipDeviceAttributeMultiprocessorCount, dev);
        if (hipFuncSetAttribute((const void*)fwd_megakernel, hipFuncAttributeMaxDynamicSharedMemorySize, LDS_BYTES) != hipSuccess) { fprintf(stderr, "kernel_launch: hipFuncSetAttribute failed\n"); grid_blocks = -1; return; }
        if (hipOccupancyMaxActiveBlocksPerMultiprocessor(&per_cu, (const void*)fwd_megakernel, NTHR, LDS_BYTES) != hipSuccess || per_cu < 1) { fprintf(stderr, "kernel_launch: occupancy query failed (%d)\n", per_cu); (void)hipGetLastError(); per_cu = 1; }
        grid_blocks = cus * 1;
    }
    if (grid_blocks < 0) return;
    Params p{};
    p.x = (const float*)d_in[0]; p.norm_mix = (const float*)d_in[1]; p.norm_ffn = (const float*)d_in[2]; p.norm_final = (const float*)d_in[3]; p.rel_bias = (const float*)d_in[4];
    p.nsa_w_in = (const float*)d_in[5]; p.pos_k = (const float*)d_in[6]; p.pos_v = (const float*)d_in[7]; p.ck_w1 = (const float*)d_in[8]; p.ck_b1 = (const float*)d_in[9]; p.ck_w2 = (const float*)d_in[10];
    p.cv_w1 = (const float*)d_in[11]; p.cv_b1 = (const float*)d_in[12]; p.cv_w2 = (const float*)d_in[13]; p.nsa_w_out = (const float*)d_in[14];
    p.pool_w_in = (const float*)d_in[15]; p.pool_w_grp = (const float*)d_in[16]; p.pool_scale = (const float*)d_in[17]; p.pool_w_out = (const float*)d_in[18]; p.ffn_w_gu = (const float*)d_in[19]; p.ffn_w_down = (const float*)d_in[20];
    p.out = (float*)d_out; p.ws = (unsigned char*)d_ws;
    if (hipMemsetAsync((char*)d_ws + WS_XBAR, 0, 16384, stream) != hipSuccess) { fprintf(stderr, "kernel_launch: hipMemsetAsync failed\n"); return; }
    void* args[] = {&p};
    hipError_t e = hipLaunchCooperativeKernel((const void*)fwd_megakernel, dim3(grid_blocks), dim3(NTHR), args, LDS_BYTES, stream);
    if (e != hipSuccess) fprintf(stderr, "cooperative launch failed: %s (grid %d)\n", hipGetErrorString(e), grid_blocks);
}
```

```cpp
#include <hip/hip_runtime.h>
#include <hip/hip_cooperative_groups.h>
#include <cstdio>
#include <cstdint>
namespace cg = cooperative_groups;

#define LAS __attribute__((address_space(3)))
typedef unsigned short bf16_t;
typedef short bf16x8 __attribute__((ext_vector_type(8)));
typedef float f32x4 __attribute__((ext_vector_type(4)));
typedef float f32x2 __attribute__((ext_vector_type(2)));
typedef unsigned u32x4 __attribute__((ext_vector_type(4)));
typedef unsigned u32x2 __attribute__((ext_vector_type(2)));

constexpr int BATCH = 2, SEQ = 16384, DM = 2048, MT = BATCH * SEQ;
constexpr int NG = 4, HG = 8, DK = 96, DV = 64;
constexpr int NPROJ = 5120;
constexpr int C_VC = 3072, C_VS = 3328, C_VW = 3584, C_KC = 3840, C_KS = 4224, C_KW = 4608, C_GATE = 4992;
constexpr int DFF = 5632;
constexpr int NCMP = 1024;
constexpr float EPS = 1e-6f;
constexpr float NEGF = -1e30f;

constexpr size_t MiB = 1u << 20;
constexpr size_t WS_SSQ = 0;
constexpr size_t WS_XBAR = 768 * 1024;
constexpr size_t WS_KMAX = 900 * 1024;
constexpr size_t WS_W_IN = 1 * MiB;
constexpr size_t WS_W_OUT = 21 * MiB;
constexpr size_t WS_W_GU0 = 29 * MiB, WS_W_GU1 = 73 * MiB;
constexpr size_t WS_W_DN0 = 117 * MiB, WS_W_DN1 = 139 * MiB;
constexpr size_t WS_P_IN = 161 * MiB, WS_P_GRP = 169 * MiB, WS_P_OUT = 171 * MiB;
constexpr size_t WS_CK1 = 179 * MiB, WS_CV1 = 181 * MiB, WS_CK2 = 182 * MiB, WS_CV2 = 182 * MiB + 65536;
constexpr size_t WS_KCMP = 183 * MiB, WS_VCMP = 185 * MiB, WS_SELM = 186 * MiB;
constexpr size_t WS_XB = 190 * MiB;
constexpr size_t WS_O = 318 * MiB;
constexpr size_t WS_BIG = 446 * MiB;
constexpr size_t WS_END = 798 * MiB;

typedef __bf16 bf16x2_t __attribute__((ext_vector_type(2)));
__device__ __forceinline__ unsigned cvt_pk_bf16(float lo, float hi) { const f32x2 v = {lo, hi}; const bf16x2_t b = __builtin_convertvector(v, bf16x2_t); return __builtin_bit_cast(unsigned, b); }
__device__ __forceinline__ float bf_lo(unsigned u) { return __uint_as_float(u << 16); }
__device__ __forceinline__ float bf_hi(unsigned u) { return __uint_as_float(u & 0xffff0000u); }
__device__ __forceinline__ float wave_sum(float v) {
#pragma unroll
    for (int o = 1; o < 64; o <<= 1) v += __shfl_xor(v, o);
    return v;
}

namespace pg8 {
constexpr int BM = 256, BK = 64, HALF = 128, HTB = HALF * BK * 2, STAGE_BYTES = 8 * HTB, NXCD = 8, WGM = 8;
__host__ __device__ __forceinline__ int lds_byte(int r, int c) { const int st = (r >> 4) * 2 + (c >> 5), rr = r & 15, cc = c & 31, ob = rr * 64 + cc * 2; return st * 1024 + (ob ^ (((ob >> 9) & 1) << 5)); }
__host__ __device__ __forceinline__ void stage_rc(int b, int& R, int& C) { const int st = b / 1024, sb = b % 1024, swz = sb ^ (((sb >> 9) & 1) << 5); R = (st >> 1) * 16 + swz / 64; C = (st & 1) * 32 + (swz % 64) / 2; }
__host__ __device__ __forceinline__ int perm32(int rho) { const int n = rho >> 4, i = rho & 15; return 8 * (i >> 2) + 4 * n + (i & 3); }

struct Unit { int pm, pn; };
struct Gemm { const bf16_t* A; const bf16_t* Bt; int lda, ldb, M, N, K; int acolb; };

struct StaticOrder {
    int nM, nN, nwg, G, c;
    __device__ void init(int M, int N, int G_, int c_) { nM = M / BM; nN = N / BM; nwg = nM * nN; G = G_; c = c_; }
    __device__ bool next(int i, Unit& u) const {
        const long L = (long)i * G + c; if (L >= nwg) return false;
        int wgid = (int)L; { const int q = nwg / NXCD, r = nwg % NXCD, xcd = wgid % NXCD, off = wgid / NXCD; wgid = (xcd < r ? xcd * (q + 1) : r * (q + 1) + (xcd - r) * q) + off; }
        const int nig = WGM * nN, gid = wgid / nig, fm = gid * WGM, gsz = (nM - fm) < WGM ? (nM - fm) : WGM;
        u.pm = fm + ((wgid % nig) % gsz); u.pn = (wgid % nig) / gsz; return true;
    }
};

template <class Epi>
__device__ __forceinline__ void gemm_phase(LAS unsigned char* lds, const Gemm g, const StaticOrder& S, const Epi& E) {
    const int tid = threadIdx.x, wid = __builtin_amdgcn_readfirstlane(tid >> 6), lane = tid & 63, wr = wid >> 2, wc = wid & 3, fr = lane & 15, fq = lane >> 4;
    const int K = g.K, nt = K / BK;
    unsigned voffA[2], voffB[2];
#pragma unroll
    for (int i = 0; i < 2; ++i) { int R, C; stage_rc(tid * 16 + i * 8192, R, C); const int Rb = (R & ~31) + perm32(R & 31);
        voffA[i] = (unsigned)(R * g.lda + C) * 2u; voffB[i] = (unsigned)(Rb * g.ldb + C) * 2u; }
    const size_t kstep = (size_t)(BK * 2);
    const size_t hstepA = (size_t)HALF * g.lda * 2, hstepB = (size_t)HALF * g.ldb * 2;
    const size_t tstepA = 2 * hstepA, tstepB = 2 * hstepB;
    const unsigned ldsw = (unsigned)wid * 1024u;
    const int aoff = lds_byte(wr * 64 + fr, fq * 8), boff = lds_byte(wc * 32 + fr, fq * 8);
#define PG8_SA(b, h) (((b) * 2 + (h)) * HTB)
#define PG8_SB(b, h) ((4 + (b) * 2 + (h)) * HTB)
#define PG8_STAGE(bufoff, gbase, voff) do { _Pragma("unroll") for (int _i = 0; _i < 2; ++_i) \
        __builtin_amdgcn_global_load_lds((const unsigned*)((const char*)(gbase) + (voff)[_i]), (LAS unsigned*)(lds + (bufoff) + ldsw + _i * 8192), 16, 0, 0); } while (0)
#define PG8_LDA(dst, b, h) do { _Pragma("unroll") for (int m = 0; m < 4; ++m) _Pragma("unroll") for (int k = 0; k < 2; ++k) dst[m][k] = *(const LAS bf16x8*)(lds + PG8_SA(b, h) + aoff + m * 2048 + k * 1024); } while (0)
#define PG8_LDB(dst, b, h) do { _Pragma("unroll") for (int n = 0; n < 2; ++n) _Pragma("unroll") for (int k = 0; k < 2; ++k) dst[n][k] = *(const LAS bf16x8*)(lds + PG8_SB(b, h) + boff + n * 2048 + k * 1024); } while (0)
#define PG8_MMA(ai, bj, At, Bt) do { __builtin_amdgcn_s_setprio(1); _Pragma("unroll") for (int m = 0; m < 4; ++m) _Pragma("unroll") for (int n = 0; n < 2; ++n) _Pragma("unroll") for (int k = 0; k < 2; ++k) \
        acc[ai][bj][m][n] = __builtin_amdgcn_mfma_f32_16x16x32_bf16(Bt[n][k], At[m][k], acc[ai][bj][m][n], 0, 0, 0); __builtin_amdgcn_s_setprio(0); } while (0)
#define PG8_WAIT_V(n) asm volatile("s_waitcnt vmcnt(" #n ")" ::: "memory")
#define PG8_WAIT_L(n) asm volatile("s_waitcnt lgkmcnt(" #n ")" ::: "memory")
#define PG8_BAR __builtin_amdgcn_s_barrier()
#define PG8_SCHED __builtin_amdgcn_sched_barrier(0)
#define PG8_APTR(u) ((const char*)g.A + (size_t)(u).pm * tstepA + (size_t)((u).pn >> 1) * (size_t)g.acolb)
#define PG8_BPTR(u) ((const char*)g.Bt + (size_t)(u).pn * tstepB)
    Unit cur, nxt; int ui = 0;
    if (!S.next(0, cur)) return;
    f32x4 acc[2][2][4][2];
#pragma unroll
    for (int a = 0; a < 2; ++a)
#pragma unroll
        for (int b = 0; b < 2; ++b)
#pragma unroll
            for (int m = 0; m < 4; ++m)
#pragma unroll
                for (int n = 0; n < 2; ++n) acc[a][b][m][n] = (f32x4){0.f, 0.f, 0.f, 0.f};
    bf16x8 At[4][2], B0[2][2], B1[2][2];
    const char* cA = PG8_APTR(cur); const char* cB = PG8_BPTR(cur);
    PG8_STAGE(PG8_SB(0, 0), cB, voffB); PG8_STAGE(PG8_SB(0, 1), cB + hstepB, voffB); PG8_STAGE(PG8_SA(0, 0), cA, voffA); PG8_STAGE(PG8_SA(0, 1), cA + hstepA, voffA);
    if (wr == 1) PG8_BAR;
    PG8_WAIT_V(2); PG8_BAR;
    PG8_STAGE(PG8_SB(1, 0), cB + kstep, voffB); PG8_STAGE(PG8_SA(1, 0), cA + kstep, voffA); PG8_STAGE(PG8_SB(1, 1), cB + hstepB + kstep, voffB);
    PG8_WAIT_V(6); PG8_BAR;
    for (;;) {
        const bool has_next = S.next(ui + 1, nxt);
        const char* nA = has_next ? PG8_APTR(nxt) : cA; const char* nB = has_next ? PG8_BPTR(nxt) : cB;
        for (int t = 0; t < nt; t += 2) {
            const bool last = (t == nt - 2);
            const char* a1 = cA + (size_t)(t + 1) * kstep;
            const char* a2 = last ? nA : cA + (size_t)(t + 2) * kstep; const char* b2 = last ? nB : cB + (size_t)(t + 2) * kstep;
            const char* a3 = a2 + kstep; const char* b3 = b2 + kstep;
            PG8_LDB(B0, 0, 0); PG8_LDB(B1, 0, 1); PG8_SCHED; PG8_LDA(At, 0, 0); PG8_STAGE(PG8_SA(1, 1), a1 + hstepA, voffA);
            PG8_WAIT_V(8); PG8_WAIT_L(0); PG8_BAR; PG8_MMA(0, 0, At, B0); PG8_MMA(0, 1, At, B1); PG8_BAR; PG8_SCHED;
            PG8_LDA(At, 0, 1); PG8_STAGE(PG8_SB(0, 0), b2, voffB); PG8_STAGE(PG8_SB(0, 1), b2 + hstepB, voffB); PG8_STAGE(PG8_SA(0, 0), a2, voffA);
            PG8_WAIT_V(8); PG8_WAIT_L(0); PG8_BAR; PG8_MMA(1, 0, At, B0); PG8_MMA(1, 1, At, B1); PG8_BAR; PG8_SCHED;
            PG8_LDB(B0, 1, 0); PG8_LDB(B1, 1, 1); PG8_SCHED; PG8_LDA(At, 1, 0); PG8_STAGE(PG8_SA(0, 1), a2 + hstepA, voffA);
            PG8_WAIT_V(8); PG8_WAIT_L(0); PG8_BAR; PG8_MMA(0, 0, At, B0); PG8_MMA(0, 1, At, B1); PG8_BAR; PG8_SCHED;
            PG8_LDA(At, 1, 1); PG8_STAGE(PG8_SB(1, 0), b3, voffB); PG8_STAGE(PG8_SB(1, 1), b3 + hstepB, voffB); PG8_STAGE(PG8_SA(1, 0), a3, voffA);
            PG8_WAIT_V(8); PG8_WAIT_L(0); PG8_BAR; PG8_MMA(1, 0, At, B0); PG8_MMA(1, 1, At, B1); PG8_BAR; PG8_SCHED;
        }
        if (wr == 0) PG8_BAR;
        E(acc, cur, wr, wc, fr, fq);
        if (!has_next) break;
#pragma unroll
        for (int a = 0; a < 2; ++a)
#pragma unroll
            for (int b = 0; b < 2; ++b)
#pragma unroll
                for (int m = 0; m < 4; ++m)
#pragma unroll
                    for (int n = 0; n < 2; ++n) acc[a][b][m][n] = (f32x4){0.f, 0.f, 0.f, 0.f};
        cur = nxt; cA = nA; cB = nB; ++ui;
        if (wr == 1) PG8_BAR;
    }
    PG8_WAIT_V(0);
    PG8_BAR;
#undef PG8_SA
#undef PG8_SB
#undef PG8_STAGE
#undef PG8_LDA
#undef PG8_LDB
#undef PG8_MMA
#undef PG8_WAIT_V
#undef PG8_WAIT_L
#undef PG8_BAR
#undef PG8_SCHED
#undef PG8_APTR
#undef PG8_BPTR
}

#define EPI_ROW(u, ai, m) ((u).pm * BM + (ai) * HALF + wr * 64 + (m) * 16 + fr)
__device__ __forceinline__ u32x4 pack8(f32x4 v0, f32x4 v1) { u32x4 w; w.x = cvt_pk_bf16(v0[0], v0[1]); w.y = cvt_pk_bf16(v0[2], v0[3]); w.z = cvt_pk_bf16(v1[0], v1[1]); w.w = cvt_pk_bf16(v1[2], v1[3]); return w; }

struct EpiProj {
    bf16_t* O; const float* ssq;
    __device__ __forceinline__ void operator()(const f32x4 (&acc)[2][2][4][2], const Unit& u, int wr, int wc, int fr, int fq) const {
        const float qs = (u.pn < 12) ? 0.10206207261596577f * 1.4426950408889634f : 1.0f;
#pragma unroll
        for (int ai = 0; ai < 2; ++ai)
#pragma unroll
            for (int m = 0; m < 4; ++m) { const int row = EPI_ROW(u, ai, m); const float rs = rsqrtf(ssq[row] * (1.0f / DM) + EPS) * qs;
#pragma unroll
                for (int bj = 0; bj < 2; ++bj) { const int c0 = u.pn * BM + bj * HALF + wc * 32 + 8 * fq;
                    *(u32x4*)(O + (size_t)row * NPROJ + c0) = pack8(acc[ai][bj][m][0] * rs, acc[ai][bj][m][1] * rs); } }
    }
};
struct EpiRowScale {
    bf16_t* O; const float* ssq;
    __device__ __forceinline__ void operator()(const f32x4 (&acc)[2][2][4][2], const Unit& u, int wr, int wc, int fr, int fq) const {
#pragma unroll
        for (int ai = 0; ai < 2; ++ai)
#pragma unroll
            for (int m = 0; m < 4; ++m) { const int row = EPI_ROW(u, ai, m); const float rs = rsqrtf(ssq[row] * (1.0f / DM) + EPS);
#pragma unroll
                for (int bj = 0; bj < 2; ++bj) { const int c0 = u.pn * BM + bj * HALF + wc * 32 + 8 * fq;
                    *(u32x4*)(O + (size_t)row * DM + c0) = pack8(acc[ai][bj][m][0] * rs, acc[ai][bj][m][1] * rs); } }
    }
};
struct EpiColScale {
    bf16_t* O; const float* scale;
    __device__ __forceinline__ void operator()(const f32x4 (&acc)[2][2][4][2], const Unit& u, int wr, int wc, int fr, int fq) const {
#pragma unroll
        for (int bj = 0; bj < 2; ++bj) { const int c0 = u.pn * BM + bj * HALF + wc * 32 + 8 * fq;
            const f32x4 s0 = *(const f32x4*)(scale + c0), s1 = *(const f32x4*)(scale + c0 + 4);
#pragma unroll
            for (int ai = 0; ai < 2; ++ai)
#pragma unroll
                for (int m = 0; m < 4; ++m) { const int row = EPI_ROW(u, ai, m);
                    *(u32x4*)(O + (size_t)row * DM + c0) = pack8(acc[ai][bj][m][0] * s0, acc[ai][bj][m][1] * s1); } }
    }
};
struct EpiSwiglu {
    bf16_t* O; const float* ssq;
    __device__ __forceinline__ void operator()(const f32x4 (&acc)[2][2][4][2], const Unit& u, int wr, int wc, int fr, int fq) const {
        const int c0 = u.pn * HALF + wc * 32 + 8 * fq;
#pragma unroll
        for (int ai = 0; ai < 2; ++ai)
#pragma unroll
            for (int m = 0; m < 4; ++m) { const int row = EPI_ROW(u, ai, m); const float rs = rsqrtf(ssq[row] * (1.0f / DM) + EPS);
                f32x4 r[2];
#pragma unroll
                for (int n = 0; n < 2; ++n)
#pragma unroll
                    for (int j = 0; j < 4; ++j) { const float gt = acc[ai][0][m][n][j] * rs, up = acc[ai][1][m][n][j] * rs; r[n][j] = gt * up * __builtin_amdgcn_rcpf(1.0f + __expf(-gt)); }
                *(u32x4*)(O + (size_t)row * DFF + c0) = pack8(r[0], r[1]); }
    }
};
struct EpiRes {
    const float* src; float* dst; bf16_t* xb; float* ssq_out;
    __device__ __forceinline__ void operator()(const f32x4 (&acc)[2][2][4][2], const Unit& u, int wr, int wc, int fr, int fq) const {
#pragma unroll
        for (int ai = 0; ai < 2; ++ai)
#pragma unroll
            for (int m = 0; m < 4; ++m) { const int row = EPI_ROW(u, ai, m); float ss = 0.f;
#pragma unroll
                for (int bj = 0; bj < 2; ++bj) { const size_t off = (size_t)row * DM + u.pn * BM + bj * HALF + wc * 32 + 8 * fq;
                    const f32x4 x0 = *(const f32x4*)(src + off) + acc[ai][bj][m][0], x1 = *(const f32x4*)(src + off + 4) + acc[ai][bj][m][1];
                    *(f32x4*)(dst + off) = x0; *(f32x4*)(dst + off + 4) = x1; if (xb) *(u32x4*)(xb + off) = pack8(x0, x1);
                    ss += (x0[0] * x0[0] + x0[1] * x0[1]) + (x0[2] * x0[2] + x0[3] * x0[3]) + (x1[0] * x1[0] + x1[1] * x1[1]) + (x1[2] * x1[2] + x1[3] * x1[3]); }
                ss += __shfl_xor(ss, 16); ss += __shfl_xor(ss, 32);
                if (fq == 0) atomicAdd(ssq_out + row, ss); }
    }
};
}

struct Params {
    const float* x; const float* norm_mix; const float* norm_ffn; const float* norm_final; const float* rel_bias;
    const float* nsa_w_in; const float* pos_k; const float* pos_v; const float* ck_w1; const float* ck_b1; const float* ck_w2;
    const float* cv_w1; const float* cv_b1; const float* cv_w2; const float* nsa_w_out;
    const float* pool_w_in; const float* pool_w_grp; const float* pool_scale; const float* pool_w_out; const float* ffn_w_gu; const float* ffn_w_down;
    float* out; unsigned char* ws;
};

constexpr int NTHR = 512, NWAVES = 8;
constexpr int LDS_BYTES = 163840;

__device__ __forceinline__ int nsa_map(int n0) {
    if (n0 < 3072) return n0;
    if (n0 < 3456) return C_KC + (n0 - 3072);
    if (n0 < 3712) return C_VC + (n0 - 3456);
    if (n0 < 4096) return C_KS + (n0 - 3712);
    if (n0 < 4352) return C_VS + (n0 - 4096);
    if (n0 < 4736) return C_KW + (n0 - 4352);
    if (n0 < 4992) return C_VW + (n0 - 4736);
    return C_GATE + (n0 - 4992);
}
__device__ __forceinline__ int gu_map(int n0) { return n0 < DFF ? (n0 >> 7) * 256 + (n0 & 127) : ((n0 - DFF) >> 7) * 256 + 128 + ((n0 - DFF) & 127); }

template <int MAP>
__device__ __forceinline__ void transpose_items(const float* W, int K, int N, bf16_t* WT, int ldd, int row_off, const float* fold, LAS float* scr, int gw, int ngw, int lane) {
    const int nblk = N / 32, nitems = (K / 64) * nblk;
    for (int item = gw; item < nitems; item += ngw) {
        const int kb = item / nblk, nb = item % nblk, k0 = 64 * kb, n0 = 32 * nb;
        const int d0 = row_off + (MAP == 1 ? nsa_map(n0) : (MAP == 2 ? gu_map(n0) : n0));
        float wv[32];
#pragma unroll
        for (int i = 0; i < 32; ++i) wv[i] = W[(size_t)(k0 + 2 * i + (lane >> 5)) * N + n0 + (lane & 31)];
#pragma unroll
        for (int i = 0; i < 32; ++i) { const int kk = 2 * i + (lane >> 5); float v = wv[i]; if (fold) v *= fold[k0 + kk]; scr[kk * 33 + (lane & 31)] = v; }
        asm volatile("s_waitcnt lgkmcnt(0)" ::: "memory");
        const int c = lane & 7;
#pragma unroll
        for (int j = 0; j < 4; ++j) { const int n = (lane >> 3) + 8 * j; const LAS float* s = scr + (8 * c) * 33 + n;
            u32x4 o; o.x = cvt_pk_bf16(s[0 * 33], s[1 * 33]); o.y = cvt_pk_bf16(s[2 * 33], s[3 * 33]); o.z = cvt_pk_bf16(s[4 * 33], s[5 * 33]); o.w = cvt_pk_bf16(s[6 * 33], s[7 * 33]);
            *(u32x4*)(WT + (size_t)(d0 + n) * ldd + k0 + 8 * c) = o; }
        asm volatile("s_waitcnt lgkmcnt(0)" ::: "memory");
    }
}

__device__ __forceinline__ void phase_prologue(const Params& p, LAS unsigned char* lds) {
    const int tid = threadIdx.x, lane = tid & 63, wave = tid >> 6;
    const int gw = blockIdx.x * NWAVES + wave, ngw = gridDim.x * NWAVES;
    LAS float* scr = (LAS float*)(lds + wave * 8704);
    unsigned char* ws = p.ws;
    if (blockIdx.x == 0 && tid < 16) ((unsigned*)(ws + WS_KMAX))[tid] = 0u;
    { float* ssq = (float*)(ws + WS_SSQ); for (int i = blockIdx.x * NTHR + tid; i < 4 * MT; i += gridDim.x * NTHR) ssq[MT + i] = 0.f; }
    transpose_items<1>(p.nsa_w_in, DM, 5088, (bf16_t*)(ws + WS_W_IN), DM, 0, p.norm_mix, scr, gw, ngw, lane);
    transpose_items<0>(p.nsa_w_out, DM, DM, (bf16_t*)(ws + WS_W_OUT), DM, 0, nullptr, scr, gw, ngw, lane);
    transpose_items<2>(p.ffn_w_gu, DM, 2 * DFF, (bf16_t*)(ws + WS_W_GU0), DM, 0, p.norm_ffn, scr, gw, ngw, lane);
    transpose_items<2>(p.ffn_w_gu + (size_t)DM * 2 * DFF, DM, 2 * DFF, (bf16_t*)(ws + WS_W_GU1), DM, 0, p.norm_ffn + DM, scr, gw, ngw, lane);
    transpose_items<0>(p.ffn_w_down, DFF, DM, (bf16_t*)(ws + WS_W_DN0), DFF, 0, nullptr, scr, gw, ngw, lane);
    transpose_items<0>(p.ffn_w_down + (size_t)DFF * DM, DFF, DM, (bf16_t*)(ws + WS_W_DN1), DFF, 0, nullptr, scr, gw, ngw, lane);
    transpose_items<0>(p.pool_w_in, DM, DM, (bf16_t*)(ws + WS_P_IN), DM, 0, p.norm_mix + DM, scr, gw, ngw, lane);
#pragma unroll 1
    for (int gi = 0; gi < 4; ++gi) transpose_items<0>(p.pool_w_grp + (size_t)gi * 512 * 512, 512, 512, (bf16_t*)(ws + WS_P_GRP), 512, gi * 512, nullptr, scr, gw, ngw, lane);
    transpose_items<0>(p.pool_w_out, DM, DM, (bf16_t*)(ws + WS_P_OUT), DM, 0, nullptr, scr, gw, ngw, lane);
    transpose_items<0>(p.ck_w1, 32 * DK, 256, (bf16_t*)(ws + WS_CK1), 32 * DK, 0, nullptr, scr, gw, ngw, lane);
    transpose_items<0>(p.cv_w1, 32 * DV, 256, (bf16_t*)(ws + WS_CV1), 32 * DV, 0, nullptr, scr, gw, ngw, lane);
    transpose_items<0>(p.ck_w2, 256, DK, (bf16_t*)(ws + WS_CK2), 256, 0, nullptr, scr, gw, ngw, lane);
    transpose_items<0>(p.cv_w2, 256, DV, (bf16_t*)(ws + WS_CV2), 256, 0, nullptr, scr, gw, ngw, lane);
    float* ssq0 = (float*)(ws + WS_SSQ); bf16_t* xb = (bf16_t*)(ws + WS_XB);
    for (int row = gw; row < MT; row += ngw) {
        const f32x4* xr = (const f32x4*)(p.x + (size_t)row * DM) + lane; u32x2* o = (u32x2*)(xb + (size_t)row * DM) + lane;
        float s = 0.f;
#pragma unroll
        for (int j = 0; j < 8; ++j) { const f32x4 v = xr[64 * j]; s += (v[0] * v[0] + v[1] * v[1]) + (v[2] * v[2] + v[3] * v[3]); u32x2 w; w.x = cvt_pk_bf16(v[0], v[1]); w.y = cvt_pk_bf16(v[2], v[3]); o[64 * j] = w; }
        s = wave_sum(s);
        if (lane == 0) ssq0[row] = s;
    }
}

__device__ __forceinline__ float gelu_tanh(float x) { const float u = 0.7978845608028654f * (x + 0.044715f * x * x * x); return 0.5f * x * (1.0f + tanhf(u)); }

template <int DH>
__device__ __forceinline__ void compress_unit(const Params& p, LAS unsigned char* lds, int b, int n0, int colbase, const float* pos, const bf16_t* w1t, const float* b1, const bf16_t* w2t, bf16_t* outp) {
    constexpr int KC = 32 * DH;
    const int tid = threadIdx.x, lane = tid & 63, wave = __builtin_amdgcn_readfirstlane(tid >> 6), c = lane & 15, kq = lane >> 4;
    const bf16_t* proj = (const bf16_t*)(p.ws + WS_BIG);
    LAS unsigned char* As = lds; LAS unsigned char* Bs = lds + 5120; LAS unsigned char* Hs = lds + 32768;
    const int arow = tid >> 2, ach = tid & 3;
    const int ag = arow >> 4, an = n0 + (arow & 15);
    u32x4 areg = {0, 0, 0, 0}, breg[2];
#define CMP_LOAD(k0_) do { const int k0v = (k0_); \
        if (tid < 256) { const int kk = k0v + ach * 8, l = kk / DH, d = kk % DH; int tok = 16 * an + l; tok = tok < SEQ ? tok : SEQ - 1; \
            const u32x4 raw = *(const u32x4*)(proj + (size_t)(b * SEQ + tok) * NPROJ + colbase + ag * DH + d); \
            const f32x4 p0 = *(const f32x4*)(pos + l * DH + d), p1 = *(const f32x4*)(pos + l * DH + d + 4); \
            areg.x = cvt_pk_bf16(bf_lo(raw.x) + p0[0], bf_hi(raw.x) + p0[1]); areg.y = cvt_pk_bf16(bf_lo(raw.y) + p0[2], bf_hi(raw.y) + p0[3]); \
            areg.z = cvt_pk_bf16(bf_lo(raw.z) + p1[0], bf_hi(raw.z) + p1[1]); areg.w = cvt_pk_bf16(bf_lo(raw.w) + p1[2], bf_hi(raw.w) + p1[3]); } \
        _Pragma("unroll") for (int i_ = 0; i_ < 2; ++i_) { const int idx = tid + 512 * i_; breg[i_] = *(const u32x4*)(w1t + (size_t)(idx >> 2) * KC + k0v + (idx & 3) * 8); } } while (0)
    f32x4 acc[4][2];
#pragma unroll
    for (int m = 0; m < 4; ++m) { acc[m][0] = (f32x4){0.f, 0.f, 0.f, 0.f}; acc[m][1] = (f32x4){0.f, 0.f, 0.f, 0.f}; }
    CMP_LOAD(0);
    for (int k0 = 0; k0 < KC; k0 += 32) {
        __syncthreads();
        if (tid < 256) *(LAS u32x4*)(As + arow * 80 + ach * 16) = areg;
#pragma unroll
        for (int i = 0; i < 2; ++i) { const int idx = tid + 512 * i; *(LAS u32x4*)(Bs + (idx >> 2) * 80 + (idx & 3) * 16) = breg[i]; }
        __syncthreads();
        if (k0 + 32 < KC) CMP_LOAD(k0 + 32);
        bf16x8 af[4], bfr[2];
#pragma unroll
        for (int m = 0; m < 4; ++m) af[m] = *(const LAS bf16x8*)(As + (16 * m + c) * 80 + kq * 16);
#pragma unroll
        for (int n = 0; n < 2; ++n) bfr[n] = *(const LAS bf16x8*)(Bs + (32 * wave + 16 * n + c) * 80 + kq * 16);
#pragma unroll
        for (int m = 0; m < 4; ++m)
#pragma unroll
            for (int n = 0; n < 2; ++n) acc[m][n] = __builtin_amdgcn_mfma_f32_16x16x32_bf16(af[m], bfr[n], acc[m][n], 0, 0, 0);
    }
#pragma unroll
    for (int n = 0; n < 2; ++n) { const int col = 32 * wave + 16 * n + c; const float bb = b1[col];
#pragma unroll
        for (int m = 0; m < 4; ++m)
#pragma unroll
            for (int i = 0; i < 4; ++i) { const float h = gelu_tanh(acc[m][n][i] + bb); *(LAS bf16_t*)(Hs + (16 * m + 4 * kq + i) * 528 + col * 2) = (bf16_t)(cvt_pk_bf16(h, 0.f) & 0xffffu); } }
    __syncthreads();
    constexpr int NT2 = 4 * (DH / 16);
    for (int idx = wave; idx < NT2; idx += 8) {
        const int m2 = idx & 3, n2 = idx >> 2;
        f32x4 a2 = {0.f, 0.f, 0.f, 0.f};
#pragma unroll
        for (int ks = 0; ks < 8; ++ks) { const bf16x8 a = *(const LAS bf16x8*)(Hs + (16 * m2 + c) * 528 + (32 * ks + 8 * kq) * 2);
            const bf16x8 bb = *(const bf16x8*)(w2t + (size_t)(16 * n2 + c) * 256 + 32 * ks + 8 * kq);
            a2 = __builtin_amdgcn_mfma_f32_16x16x32_bf16(a, bb, a2, 0, 0, 0); }
#pragma unroll
        for (int i = 0; i < 4; ++i) outp[((size_t)(b * NG + m2) * NCMP + n0 + 4 * kq + i) * DH + 16 * n2 + c] = (bf16_t)(cvt_pk_bf16(a2[i], 0.f) & 0xffffu);
    }
    __syncthreads();
}

__device__ __forceinline__ void phase_compress(const Params& p, LAS unsigned char* lds) {
    unsigned char* ws = p.ws;
    for (int u = blockIdx.x; u < 256; u += gridDim.x) {
        const int which = u >> 7, b = (u >> 6) & 1, n0 = (u & 63) * 16;
        if (which == 0) compress_unit<DK>(p, lds, b, n0, C_KC, p.pos_k, (const bf16_t*)(ws + WS_CK1), p.ck_b1, (const bf16_t*)(ws + WS_CK2), (bf16_t*)(ws + WS_KCMP));
        else compress_unit<DV>(p, lds, b, n0, C_VC, p.pos_v, (const bf16_t*)(ws + WS_CV1), p.cv_b1, (const bf16_t*)(ws + WS_CV2), (bf16_t*)(ws + WS_VCMP));
    }
    { const bf16_t* proj = (const bf16_t*)(ws + WS_BIG); unsigned* kmaxp = (unsigned*)(ws + WS_KMAX); const int lane = threadIdx.x & 63;
      for (int it = blockIdx.x * NTHR + threadIdx.x; it < MT * 8; it += gridDim.x * NTHR) { const int row = it >> 3, sg = it & 7, br = sg >> 2, g = sg & 3;
        const u32x4* kp = (const u32x4*)(proj + (size_t)row * NPROJ + (br ? C_KW : C_KS) + g * DK); float n2 = 0.f;
#pragma unroll
        for (int ch = 0; ch < 12; ++ch) { const u32x4 w = kp[ch];
            n2 += bf_lo(w.x) * bf_lo(w.x) + bf_hi(w.x) * bf_hi(w.x) + bf_lo(w.y) * bf_lo(w.y) + bf_hi(w.y) * bf_hi(w.y) + bf_lo(w.z) * bf_lo(w.z) + bf_hi(w.z) * bf_hi(w.z) + bf_lo(w.w) * bf_lo(w.w) + bf_hi(w.w) * bf_hi(w.w); }
        n2 = fmaxf(n2, __shfl_xor(n2, 8)); n2 = fmaxf(n2, __shfl_xor(n2, 16)); n2 = fmaxf(n2, __shfl_xor(n2, 32));
        if (lane < 8) atomicMax(kmaxp + br * 8 + (row >> 14) * 4 + g, __float_as_uint(sqrtf(n2))); } }
}

constexpr int KT_STRIDE = 208, SLOT_K = 64 * KT_STRIDE;
constexpr int VT_STRIDE = 144, SLOT_V = 64 * VT_STRIDE;
constexpr int SLOT_BYTES = SLOT_K + SLOT_V, RING = 5, PD = RING - 1;
constexpr int RING_WS = 6;
constexpr int L_RING = 0, L_IMP = RING * SLOT_BYTES, L_BIAS = LDS_BYTES - 4 * 8 * 132 * 4, L_SELM = L_BIAS - 2048;
static_assert(L_IMP + 32 * 256 * 4 <= L_BIAS && RING_WS * SLOT_BYTES <= L_SELM, "attention LDS map");

struct PairState { f32x4 o[4]; float m, l; bf16x8 q[3]; };
struct TileSrc { const bf16_t* K; const bf16_t* V; int kld, vld; };
struct DmaPlan { int off[3]; };

__device__ __forceinline__ void glds16(const void* gsrc, unsigned lds_dst) { unsigned keep;
    asm volatile("s_mov_b32 %0, m0\n\ts_mov_b32 m0, %2\n\ts_nop 0\n\tglobal_load_lds_dwordx4 %1, off\n\ts_mov_b32 m0, %0" : "=&s"(keep) : "v"(gsrc), "s"(lds_dst) : "memory"); }
#define ATT_WAIT_BAR(N) asm volatile("s_waitcnt vmcnt(" #N ") lgkmcnt(0)\n\ts_barrier" ::: "memory")
__device__ __forceinline__ void att_wait_bar(int rem) { if (rem <= 0) ATT_WAIT_BAR(0); else if (rem == 1) ATT_WAIT_BAR(3); else if (rem == 2) ATT_WAIT_BAR(6); else ATT_WAIT_BAR(9); }
__device__ __forceinline__ bool piece_is_k(int s) { return s < 13 || s >= 22; }
__device__ __forceinline__ int piece_grp(int s) { return s < 13 ? s : (s >= 22 ? s - 22 : s - 13); }
__device__ __forceinline__ void make_plan(DmaPlan& pl, const TileSrc& src, int wave, int lane) {
#pragma unroll
    for (int j = 0; j < 3; ++j) { const int sidx = wave + 8 * j, ci = 64 * piece_grp(sidx) + lane;
        if (piece_is_k(sidx)) { const int key = ci / 13, ch = ci % 13; pl.off[j] = key * src.kld + (ch < 12 ? ch : 11) * 8; }
        else { const int key = ci / 9, ch = ci % 9; pl.off[j] = key * src.vld + (ch < 8 ? ch : 7) * 8; } }
}
__device__ __forceinline__ void issue_tile(const DmaPlan& pl, const TileSrc& src, int key0, unsigned slot_addr, int wave) {
#pragma unroll
    for (int j = 0; j < 3; ++j) { const int sidx = wave + 8 * j; const bool isk = piece_is_k(sidx);
        const bf16_t* gp = (isk ? src.K + (size_t)key0 * src.kld : src.V + (size_t)key0 * src.vld) + pl.off[j];
        glds16(gp, slot_addr + (isk ? 0u : (unsigned)SLOT_K) + 1024u * (unsigned)piece_grp(sidx)); }
}
typedef short s16x4 __attribute__((ext_vector_type(4)));
__device__ __forceinline__ s16x4 vtr(const LAS unsigned char* p) { return __builtin_bit_cast(s16x4, __builtin_amdgcn_ds_read_tr16_b64_v4i16((LAS s16x4*)p)); }

__device__ __forceinline__ float sum8_dpp(float x) {
    x += __builtin_bit_cast(float, __builtin_amdgcn_update_dpp(0, __builtin_bit_cast(int, x), 0xB1, 0xF, 0xF, true));
    x += __builtin_bit_cast(float, __builtin_amdgcn_update_dpp(0, __builtin_bit_cast(int, x), 0x4E, 0xF, 0xF, true));
    x += __builtin_bit_cast(float, __builtin_amdgcn_update_dpp(0, __builtin_bit_cast(int, x), 0x141, 0xF, 0xF, true));
    return x;
}
template <int MODE, bool FAR>
__device__ __forceinline__ void pair_tile(PairState& st, const LAS unsigned char* Kt, const LAS unsigned char* Vt, int tadj, int kstride, int maxdist, bool rowsel,
                                          const LAS float* biasrow, float bias_far, LAS float* improw, int jj0, int lane) {
    const int c = lane & 15, kq = lane >> 4;
    f32x4 s[4];
    float bv[4][4];
    if (!FAR) {
#pragma unroll
        for (int kt = 0; kt < 4; ++kt)
#pragma unroll
            for (int i = 0; i < 4; ++i) { const int d = tadj - (16 * kt + 4 * kq + i) * kstride; const int bi = d < 0 ? 0 : (d > 128 ? 128 : d); bv[kt][i] = biasrow[bi]; }
    }
    const float init = FAR ? (rowsel ? bias_far - st.m : NEGF) : -st.m;
    const f32x4 initv = {init, init, init, init};
#pragma unroll
    for (int kt = 0; kt < 4; ++kt) {
#pragma unroll
        for (int ds = 0; ds < 3; ++ds) { const bf16x8 a = *(const LAS bf16x8*)(Kt + (16 * kt + c) * KT_STRIDE + (32 * ds + 8 * kq) * 2);
            s[kt] = __builtin_amdgcn_mfma_f32_16x16x32_bf16(a, st.q[ds], ds == 0 ? initv : s[kt], 0, 0, 0); } }
    if (!FAR) {
#pragma unroll
        for (int kt = 0; kt < 4; ++kt)
#pragma unroll
            for (int i = 0; i < 4; ++i) { const int d = tadj - (16 * kt + 4 * kq + i) * kstride; const bool valid = ((unsigned)d < (unsigned)maxdist) && rowsel;
                s[kt][i] = valid ? s[kt][i] + bv[kt][i] : NEGF; }
    }
    float psum = 0.f;
#pragma unroll
    for (int kt = 0; kt < 4; ++kt)
#pragma unroll
        for (int i = 0; i < 4; ++i) { const float pv = __builtin_amdgcn_exp2f(s[kt][i]); s[kt][i] = pv; psum += pv; }
    if (MODE != 1) st.l += psum;
    if (MODE == 0) return;
#pragma unroll
    for (int s2 = 0; s2 < 2; ++s2) {
        u32x4 pw; pw.x = cvt_pk_bf16(s[2 * s2][0], s[2 * s2][1]); pw.y = cvt_pk_bf16(s[2 * s2][2], s[2 * s2][3]); pw.z = cvt_pk_bf16(s[2 * s2 + 1][0], s[2 * s2 + 1][1]); pw.w = cvt_pk_bf16(s[2 * s2 + 1][2], s[2 * s2 + 1][3]);
        const bf16x8 pb = __builtin_bit_cast(bf16x8, pw);
#pragma unroll
        for (int dt = 0; dt < 4; ++dt) { const LAS unsigned char* vp = Vt + (32 * s2 + 4 * kq + (c >> 2)) * VT_STRIDE + (16 * dt + 4 * (c & 3)) * 2;
            const s16x4 lo = vtr(vp), hi = vtr(vp + 16 * VT_STRIDE); const bf16x8 a = {lo[0], lo[1], lo[2], lo[3], hi[0], hi[1], hi[2], hi[3]};
            st.o[dt] = __builtin_amdgcn_mfma_f32_16x16x32_bf16(a, pb, st.o[dt], 0, 0, 0); }
    }
    if (MODE == 1) {
#pragma unroll
        for (int kt = 0; kt < 4; ++kt) {
            float u0 = 2.0f * (s[kt][0] + s[kt][1] + s[kt][2]) + s[kt][3], u1 = s[kt][3];
            u0 = sum8_dpp(u0); u1 = sum8_dpp(u1);
            if ((lane & 7) == 0) { const int jj = jj0 + 4 * kt + kq;
                __hip_atomic_fetch_add(improw + jj, u0, __ATOMIC_RELAXED, __HIP_MEMORY_SCOPE_WORKGROUP);
                if (jj + 1 < 256) __hip_atomic_fetch_add(improw + jj + 1, u1, __ATOMIC_RELAXED, __HIP_MEMORY_SCOPE_WORKGROUP); }
        }
    }
}
#define PAIR_TILE(MODE, far, ...) do { if (far) pair_tile<MODE, true>(__VA_ARGS__); else pair_tile<MODE, false>(__VA_ARGS__); } while (0)

__device__ __forceinline__ int t5_bucket(int n) {
    if (n < 16) return n;
    int bk = 16;
    bk += (n >= 19); bk += (n >= 21); bk += (n >= 24); bk += (n >= 27); bk += (n >= 31); bk += (n >= 35); bk += (n >= 40); bk += (n >= 46);
    bk += (n >= 52); bk += (n >= 59); bk += (n >= 67); bk += (n >= 77); bk += (n >= 87); bk += (n >= 99); bk += (n >= 113);
    return bk;
}
__device__ __forceinline__ void build_bias(const Params& p, LAS unsigned char* lds) {
    LAS float* bt = (LAS float*)(lds + L_BIAS);
    for (int i = threadIdx.x; i < 32 * 129; i += NTHR) { const int h = i / 129, d = i % 129; bt[h * 132 + d] = p.rel_bias[t5_bucket(d) * 32 + h] * 1.4426950408889634f; }
    __syncthreads();
    if (threadIdx.x < 32) { float mx = bt[threadIdx.x * 132]; for (int d = 1; d < 129; ++d) mx = fmaxf(mx, bt[threadIdx.x * 132 + d]); bt[threadIdx.x * 132 + 129] = mx; }
    __syncthreads();
}

__device__ __forceinline__ void load_q(PairState& st, const bf16_t* proj, int b, int g, int tq0, int lane, float kmx, float bmax) {
    const int c = lane & 15, kq = lane >> 4; const size_t row = (size_t)b * SEQ + tq0 + (c >> 3);
#pragma unroll
    for (int ds = 0; ds < 3; ++ds) st.q[ds] = *(const bf16x8*)(proj + row * NPROJ + (g * 8 + (c & 7)) * DK + 32 * ds + 8 * kq);
    asm volatile("" : "+v"(st.q[0]), "+v"(st.q[1]), "+v"(st.q[2]));
    float qq = 0.f;
#pragma unroll
    for (int ds = 0; ds < 3; ++ds) { const u32x4 w = __builtin_bit_cast(u32x4, st.q[ds]);
        qq += bf_lo(w.x) * bf_lo(w.x) + bf_hi(w.x) * bf_hi(w.x) + bf_lo(w.y) * bf_lo(w.y) + bf_hi(w.y) * bf_hi(w.y) + bf_lo(w.z) * bf_lo(w.z) + bf_hi(w.z) * bf_hi(w.z) + bf_lo(w.w) * bf_lo(w.w) + bf_hi(w.w) * bf_hi(w.w); }
    qq += __shfl_xor(qq, 16); qq += __shfl_xor(qq, 32);
    st.m = sqrtf(qq) * kmx + bmax + 0.25f;
}
__device__ __forceinline__ void reset_state(PairState& st) {
#pragma unroll
    for (int dt = 0; dt < 4; ++dt) st.o[dt] = (f32x4){0.f, 0.f, 0.f, 0.f};
    st.l = 0.f;
}
template <bool ACCUM>
__device__ __forceinline__ void write_out(const PairState& st, float inv, const bf16_t* proj, bf16_t* obuf, int b, int g, int tq0, int br, int lane) {
    const int c = lane & 15, kq = lane >> 4; const size_t row = (size_t)b * SEQ + tq0 + (c >> 3);
    const float gl = bf_lo((unsigned)proj[row * NPROJ + C_GATE + br * 32 + g * 8 + (c & 7)]);
    const float sc = inv * __builtin_amdgcn_rcpf(1.0f + __expf(-gl));
    bf16_t* op = obuf + row * DM + (g * 8 + (c & 7)) * DV + 4 * kq;
#pragma unroll
    for (int dt = 0; dt < 4; ++dt) { f32x4 v = st.o[dt] * sc;
        if (ACCUM) { const u32x2 old = *(const u32x2*)(op + 16 * dt); v[0] += bf_lo(old.x); v[1] += bf_hi(old.x); v[2] += bf_lo(old.y); v[3] += bf_hi(old.y); }
        u32x2 w; w.x = cvt_pk_bf16(v[0], v[1]); w.y = cvt_pk_bf16(v[2], v[3]); *(u32x2*)(op + 16 * dt) = w; }
}

constexpr size_t WS_UCTR = WS_XBAR + 14336;
#define UNIT_LOOP_BEGIN(ctrptr, NU) \
    { LAS unsigned* ubox_ = (LAS unsigned*)(lds + 146440); unsigned nxt_ = 0u; \
      if (threadIdx.x == 0) ubox_[0] = atomicAdd((ctrptr), 1u); \
      __syncthreads(); \
      for (;;) { const unsigned ul = ubox_[0]; if (ul >= (unsigned)(NU)) break; \
          __syncthreads();
#define UNIT_PREFETCH(ctrptr) do { if (threadIdx.x == 0) nxt_ = atomicAdd((ctrptr), 1u); } while (0)
#define UNIT_LOOP_END() \
          if (threadIdx.x == 0) ubox_[0] = nxt_; \
          __syncthreads(); } }

__device__ __forceinline__ void phase_cmp(const Params& p, LAS unsigned char* lds) {
    const int tid = threadIdx.x, lane = tid & 63, wave = __builtin_amdgcn_readfirstlane(tid >> 6), c = lane & 15;
    const bf16_t* proj = (const bf16_t*)(p.ws + WS_BIG); bf16_t* obuf = (bf16_t*)(p.ws + WS_O); unsigned* selm = (unsigned*)(p.ws + WS_SELM);
    build_bias(p, lds);
    { LAS float* bt = (LAS float*)(lds + L_BIAS); const u32x4* kc = (const u32x4*)(p.ws + WS_KCMP) + (size_t)wave * NCMP * 12; float n2m = 0.f;
#pragma unroll 4
      for (int r = lane; r < NCMP; r += 64) { float n2 = 0.f;
#pragma unroll
        for (int ch = 0; ch < 12; ++ch) { const u32x4 w = kc[r * 12 + ch];
            n2 += bf_lo(w.x) * bf_lo(w.x) + bf_hi(w.x) * bf_hi(w.x) + bf_lo(w.y) * bf_lo(w.y) + bf_hi(w.y) * bf_hi(w.y) + bf_lo(w.z) * bf_lo(w.z) + bf_hi(w.z) * bf_hi(w.z) + bf_lo(w.w) * bf_lo(w.w) + bf_hi(w.w) * bf_hi(w.w); }
        n2m = fmaxf(n2m, n2); }
#pragma unroll
      for (int o = 1; o < 64; o <<= 1) n2m = fmaxf(n2m, __shfl_xor(n2m, o));
      if (lane == 0) bt[wave * 132 + 130] = sqrtf(n2m);
      __syncthreads(); }
    LAS float* imp = (LAS float*)(lds + L_IMP);
    UNIT_LOOP_BEGIN((unsigned*)(p.ws + WS_UCTR) + (blockIdx.x & 7), 512)
        const int bg = blockIdx.x & 7, b = bg >> 2, g = bg & 3, t0 = (511 - (int)ul) * 32;
        TileSrc src; src.K = (const bf16_t*)(p.ws + WS_KCMP) + (size_t)bg * NCMP * DK; src.V = (const bf16_t*)(p.ws + WS_VCMP) + (size_t)bg * NCMP * DV; src.kld = DK; src.vld = DV;
        const int nt = t0 / 1024 + 1;
        const LAS float* biasrow = (const LAS float*)(lds + L_BIAS) + (g * 8 + (c & 7)) * 132; const float bias_far = biasrow[128];
        PairState st[2];
#pragma unroll
        for (int pi = 0; pi < 2; ++pi) { reset_state(st[pi]); load_q(st[pi], proj, b, g, t0 + 4 * wave + 2 * pi, lane, ((const LAS float*)(lds + L_BIAS))[bg * 132 + 130], biasrow[129]); }
#pragma unroll
        for (int i = 0; i < 16; ++i) imp[(4 * wave) * 256 + i * 64 + lane] = 0.f;
        DmaPlan pl; make_plan(pl, src, wave, lane);
        const unsigned ring = (unsigned)(size_t)(lds + L_RING);
#pragma unroll 1
        for (int pass = 0; pass < 2; ++pass) {
            if (pass == 1) {
#pragma unroll
                for (int pi = 0; pi < 2; ++pi) { float lt = st[pi].l; lt += __shfl_xor(lt, 16); lt += __shfl_xor(lt, 32); if (lt > 0.f) st[pi].m += __builtin_amdgcn_logf(lt); }
            }
            for (int d = 0; d < PD && d < nt; ++d) issue_tile(pl, src, 64 * d, ring + d * SLOT_BYTES, wave);
            if (pass == 0) UNIT_PREFETCH((unsigned*)(p.ws + WS_UCTR) + (blockIdx.x & 7));
            int slot = 0, islot = PD;
#pragma unroll 1
            for (int i = 0; i < nt; ++i) {
                { int rem = nt - 1 - i; rem = rem < PD - 1 ? rem : PD - 1; att_wait_bar(rem); }
                if (i + PD < nt) issue_tile(pl, src, 64 * (i + PD), ring + islot * SLOT_BYTES, wave);
                const LAS unsigned char* Kt = lds + L_RING + slot * SLOT_BYTES; const LAS unsigned char* Vt = Kt + SLOT_K;
#pragma unroll
                for (int pi = 0; pi < 2; ++pi) { const int tq0 = t0 + 4 * wave + 2 * pi; const int P0 = 16 * 64 * i + 31;
                    if (tq0 + 1 < P0) continue;
                    const bool far = (tq0 - (P0 + 63 * 16)) >= 113;
                    const int tadj = tq0 + (c >> 3) - P0;
                    if (pass == 0) PAIR_TILE(0, far, st[pi], Kt, Vt, tadj, 16, 1 << 30, true, biasrow, bias_far, nullptr, 0, lane);
                    else PAIR_TILE(1, far, st[pi], Kt, Vt, tadj, 16, 1 << 30, true, biasrow, bias_far, imp + (4 * wave + 2 * pi + (c >> 3)) * 256, 16 * i, lane); }
                slot = slot + 1 == RING ? 0 : slot + 1; islot = islot + 1 == RING ? 0 : islot + 1;
            }
            ATT_WAIT_BAR(0);
        }
#pragma unroll
        for (int pi = 0; pi < 2; ++pi) write_out<false>(st[pi], 1.0f, proj, obuf, b, g, t0 + 4 * wave + 2 * pi, 0, lane);
        asm volatile("s_waitcnt lgkmcnt(0)" ::: "memory");
        {
            unsigned key[4][4]; unsigned T[4]; int need[4];
            const int cur = (t0 + 4 * wave) >> 6;
#pragma unroll
            for (int qq = 0; qq < 4; ++qq) { T[qq] = 0u; need[qq] = 16 - (1 + (cur >= 1) + (cur >= 2));
#pragma unroll
                for (int i = 0; i < 4; ++i) { const int j = lane + 64 * i; const float v = imp[(4 * wave + qq) * 256 + j];
                    const bool cand = (j >= 1) && (j <= cur - 2);
                    key[qq][i] = cand ? (__float_as_uint(v) + 1u) : 0u; } }
#pragma unroll 1
            for (int bit = 31; bit >= 0; --bit) {
#pragma unroll
                for (int qq = 0; qq < 4; ++qq) { const unsigned cand = T[qq] | (1u << bit);
                    const int cnt = __popcll(__ballot(key[qq][0] >= cand)) + __popcll(__ballot(key[qq][1] >= cand)) + __popcll(__ballot(key[qq][2] >= cand)) + __popcll(__ballot(key[qq][3] >= cand));
                    if (cnt >= need[qq]) T[qq] = cand; } }
#pragma unroll
            for (int qq = 0; qq < 4; ++qq) { const int t = t0 + 4 * wave + qq;
                unsigned Tq = T[qq]; if (Tq == 0u) Tq = 1u;
                int above = 0;
#pragma unroll
                for (int i = 0; i < 4; ++i) above += __popcll(__ballot(key[qq][i] > Tq));
                int room = need[qq] - above;
                unsigned* mrow = selm + ((size_t)bg * SEQ + t) * 8;
#pragma unroll
                for (int i = 0; i < 4; ++i) { const int j = lane + 64 * i; const unsigned long long eq = __ballot(key[qq][i] == Tq); const int rank = __popcll(eq & ((1ull << lane) - 1ull));
                    const bool sl = (j == 0) || (j == cur) || (j == cur - 1) || (key[qq][i] > Tq) || (key[qq][i] == Tq && rank < room); room -= __popcll(eq);
                    const unsigned long long bal = __ballot(sl); if (lane == 0) { mrow[2 * i] = (unsigned)bal; mrow[2 * i + 1] = (unsigned)(bal >> 32); } } }
        }
    UNIT_LOOP_END()
}

__device__ __forceinline__ void build_order(const LAS unsigned* lsel, LAS unsigned char* ord, LAS int* cnt, int cb, int nq, int lane) {
    int base = 0;
#pragma unroll 1
    for (int r = 0; 64 * r <= cb; ++r) { const int j = lane + 64 * r; unsigned m = 0u;
        for (int q = 0; q < nq; ++q) m |= lsel[q * 8 + (j >> 5)];
        const bool need = (j <= cb) && ((m >> (j & 31)) & 1u);
        const unsigned long long bal = __ballot(need);
        if (need) ord[base + __popcll(bal & ((1ull << lane) - 1ull))] = (unsigned char)j;
        base += __popcll(bal); }
    if (lane == 0) *cnt = base;
}

template <bool WIN, int NP>
__device__ __forceinline__ void phase_ws(const Params& p, LAS unsigned char* lds) {
    constexpr int QW = 2 * NP, QU = 8 * QW, NUNIT = MT * NG / QU;
    const int tid = threadIdx.x, lane = tid & 63, wave = __builtin_amdgcn_readfirstlane(tid >> 6), c = lane & 15;
    const bf16_t* proj = (const bf16_t*)(p.ws + WS_BIG); bf16_t* obuf = (bf16_t*)(p.ws + WS_O); const unsigned* selm = (const unsigned*)(p.ws + WS_SELM);
    build_bias(p, lds);
    LAS unsigned* lsel = (LAS unsigned*)(lds + L_SELM);
    UNIT_LOOP_BEGIN((unsigned*)(p.ws + WS_UCTR) + (WIN ? 8 : 16) + (blockIdx.x & 7), NUNIT / 8)
        const int bg = blockIdx.x & 7, b = bg >> 2, g = bg & 3, t0 = (SEQ / QU - 1 - (int)ul) * QU;
        TileSrc src; src.kld = NPROJ; src.vld = NPROJ;
        src.K = proj + (size_t)b * SEQ * NPROJ + (WIN ? C_KW : C_KS) + g * DK; src.V = proj + (size_t)b * SEQ * NPROJ + (WIN ? C_VW : C_VS) + g * DV;
        const int cb = t0 >> 6;
        const int kstart = WIN ? (cb >= 8 ? (cb - 8) * 64 : 0) : 0;
        const int nt = cb + 1 - kstart / 64;
        const LAS float* biasrow = (const LAS float*)(lds + L_BIAS) + (g * 8 + (c & 7)) * 132; const float bias_far = biasrow[128];
        const float kmx = __uint_as_float(((const unsigned*)(p.ws + WS_KMAX))[(WIN ? 8 : 0) + bg]);
        LAS unsigned char* ord = (LAS unsigned char*)(lds + L_SELM + 1024);
        int npos = nt;
        if (!WIN) { if (tid < QU * 8) lsel[tid] = selm[((size_t)bg * SEQ + t0) * 8 + tid];
            __syncthreads();
            if (wave == 0) build_order(lsel, ord, (LAS int*)(lds + L_SELM + 1024 + 256), cb, QU, lane);
            __syncthreads();
            npos = *(LAS int*)(lds + L_SELM + 1024 + 256); }
        PairState st[NP];
#pragma unroll
        for (int pi = 0; pi < NP; ++pi) { reset_state(st[pi]); load_q(st[pi], proj, b, g, t0 + QW * wave + 2 * pi, lane, kmx, biasrow[129]); }
        DmaPlan pl; make_plan(pl, src, wave, lane);
        const unsigned ring = (unsigned)(size_t)(lds + L_RING);
#define WS_TILE(pos) (WIN ? (pos) : (int)ord[pos])
        constexpr int TI = WIN ? 2 : 3, PRE = WIN ? 4 : 6;
        for (int d = 0; d < PRE && d < npos; ++d) issue_tile(pl, src, kstart + 64 * WS_TILE(d), ring + d * SLOT_BYTES, wave);
        UNIT_PREFETCH((unsigned*)(p.ws + WS_UCTR) + (WIN ? 8 : 16) + (blockIdx.x & 7));
        int slot = 0, islot = WIN ? 4 : 0;
#pragma unroll 1
        for (int i0 = 0; i0 < npos; i0 += TI) {
            { int rem;
              if (WIN) { const int issued = npos < i0 + 4 ? npos : i0 + 4, done = npos < i0 + 2 ? npos : i0 + 2; rem = issued - done; }
              else rem = (i0 == 0) ? ((npos < 6 ? npos : 6) - (npos < 3 ? npos : 3)) : 0;
              att_wait_bar(rem); }
#pragma unroll 1
            for (int e = 0; e < TI; ++e) { if (i0 + e >= npos) break; const int i = WS_TILE(i0 + e);
                const LAS unsigned char* Kt = lds + L_RING + slot * SLOT_BYTES; const LAS unsigned char* Vt = Kt + SLOT_K;
                slot = slot + 1 == RING_WS ? 0 : slot + 1;
                const int P0 = kstart + 64 * i;
#pragma unroll
                for (int pi = 0; pi < NP; ++pi) { const int tq0 = t0 + QW * wave + 2 * pi;
                    bool rowsel = true; bool allsel = true;
                    if (!WIN) { const unsigned w = lsel[(QW * wave + 2 * pi + (c >> 3)) * 8 + (i >> 5)]; rowsel = (w >> (i & 31)) & 1u;
                        const unsigned long long bal = __ballot(rowsel); if (bal == 0ull) continue; allsel = (bal == ~0ull); }
                    else { if (tq0 + 1 < P0 || tq0 - (P0 + 63) >= 512) continue; }
                    const bool far = (tq0 - (P0 + 63) >= 113) && (!WIN || (tq0 + 1 - P0 < 512));
                    PAIR_TILE(2, far, st[pi], Kt, Vt, tq0 + (c >> 3) - P0, 1, WIN ? 512 : (1 << 30), rowsel, biasrow, bias_far, nullptr, 0, lane); } }
            if (WIN) {
#pragma unroll
            for (int e = 0; e < 2; ++e) { if (i0 + 4 + e < npos) issue_tile(pl, src, kstart + 64 * WS_TILE(i0 + 4 + e), ring + islot * SLOT_BYTES, wave); islot = islot + 1 == RING_WS ? 0 : islot + 1; }
            } else if (i0 >= 3) {
#pragma unroll
            for (int e = 0; e < 3; ++e) { if (i0 + 3 + e < npos) issue_tile(pl, src, kstart + 64 * WS_TILE(i0 + 3 + e), ring + islot * SLOT_BYTES, wave); islot = islot + 1 == RING_WS ? 0 : islot + 1; }
            }
        }
#undef WS_TILE
        ATT_WAIT_BAR(0);
#pragma unroll
        for (int pi = 0; pi < NP; ++pi) { float lt = st[pi].l; lt += __shfl_xor(lt, 16); lt += __shfl_xor(lt, 32);
            write_out<true>(st[pi], lt > 0.f ? 1.0f / lt : 0.f, proj, obuf, b, g, t0 + QW * wave + 2 * pi, WIN ? 2 : 1, lane); }
    UNIT_LOOP_END()
}

template <int W>
__device__ __forceinline__ void pool_item(const bf16_t* ub, bf16_t* pooled, int row, int t, int ch) {
    u32x4 v[W];
#pragma unroll
    for (int k = 0; k < W; ++k) v[k] = *(const u32x4*)(ub + (size_t)(k <= t ? row - k : row) * DM + ch * 8);
    const int cnt = (t + 1 < W) ? t + 1 : W;
    float acc[8] = {0.f, 0.f, 0.f, 0.f, 0.f, 0.f, 0.f, 0.f};
#pragma unroll
    for (int k = 0; k < W; ++k) { const float m = k < cnt ? 1.0f : 0.0f;
        acc[0] += m * bf_lo(v[k].x); acc[1] += m * bf_hi(v[k].x); acc[2] += m * bf_lo(v[k].y); acc[3] += m * bf_hi(v[k].y); acc[4] += m * bf_lo(v[k].z); acc[5] += m * bf_hi(v[k].z); acc[6] += m * bf_lo(v[k].w); acc[7] += m * bf_hi(v[k].w); }
    const float ic = 1.0f / (float)cnt; const u32x4 self = v[0];
    u32x4 o; o.x = cvt_pk_bf16(acc[0] * ic - bf_lo(self.x), acc[1] * ic - bf_hi(self.x)); o.y = cvt_pk_bf16(acc[2] * ic - bf_lo(self.y), acc[3] * ic - bf_hi(self.y));
    o.z = cvt_pk_bf16(acc[4] * ic - bf_lo(self.z), acc[5] * ic - bf_hi(self.z)); o.w = cvt_pk_bf16(acc[6] * ic - bf_lo(self.w), acc[7] * ic - bf_hi(self.w));
    *(u32x4*)(pooled + (size_t)row * DM + ch * 8) = o;
}
__device__ __forceinline__ void phase_pool(const Params& p) {
    const bf16_t* ub = (const bf16_t*)(p.ws + WS_BIG); bf16_t* pooled = (bf16_t*)(p.ws + WS_BIG + 128 * MiB);
    const int nthr = gridDim.x * NTHR;
    for (int it = blockIdx.x * NTHR + threadIdx.x; it < MT * 256; it += nthr) {
        const int row = it >> 8, ch = it & 255, t = row & (SEQ - 1); const int gi = ch >> 6;
        if (gi == 0) pool_item<2>(ub, pooled, row, t, ch); else if (gi == 1) pool_item<4>(ub, pooled, row, t, ch);
        else if (gi == 2) pool_item<8>(ub, pooled, row, t, ch); else pool_item<16>(ub, pooled, row, t, ch);
    }
}
__device__ __forceinline__ void phase_final(const Params& p) {
    const int lane = threadIdx.x & 63, wave = threadIdx.x >> 6; const int gw = blockIdx.x * NWAVES + wave, ngw = gridDim.x * NWAVES;
    const float* ssq = (const float*)(p.ws + WS_SSQ) + 4 * (size_t)MT;
    for (int row = gw; row < MT; row += ngw) { const float rs = rsqrtf(ssq[row] * (1.0f / DM) + EPS);
        f32x4* xr = (f32x4*)(p.out + (size_t)row * DM) + lane; const f32x4* gr = (const f32x4*)p.norm_final + lane;
#pragma unroll
        for (int j = 0; j < 8; ++j) xr[64 * j] = xr[64 * j] * rs * gr[64 * j]; }
}

#define XB_TMO      128
#define XB_XCNT(j)  (256  + 64 * (j))
#define XB_XSUB(j)  (1280 + 64 * (j))
#define XB_XGEN(j)  (2304 + 64 * (j))
#define XB_TOP      3328
#define XB_TOPGEN   3392
#define XCD_BAR_WORDS 3456
#define XB_SPIN_CAP (1u << 18)

__device__ __forceinline__ unsigned xb_ld(unsigned* p)              { return __hip_atomic_load(p, __ATOMIC_RELAXED, __HIP_MEMORY_SCOPE_AGENT); }
__device__ __forceinline__ unsigned xb_add(unsigned* p, unsigned v) { return __hip_atomic_fetch_add(p, v, __ATOMIC_RELAXED, __HIP_MEMORY_SCOPE_AGENT); }
__device__ __forceinline__ unsigned xb_xcc_id() { return (unsigned)__builtin_amdgcn_s_getreg((3 << 11) | 20) & 0xFu; }
#define XB_SPIN(cond, bar) do { unsigned _sp = 0; while (cond) { __builtin_amdgcn_s_sleep(1); \
    if ((++_sp & 255u) == 0u) { if (xb_ld(&(bar)[XB_TMO])) break; if (_sp > XB_SPIN_CAP) { atomicAdd(&(bar)[XB_TMO], 1u); break; } } } } while (0)

struct XcdBarrier {
    unsigned* bar; unsigned x;
    volatile LAS unsigned* st;
};

__device__ __forceinline__ XcdBarrier xcd_barrier_post(unsigned* bar, volatile LAS unsigned* st) {
    XcdBarrier b; b.bar = bar; b.x = xb_xcc_id(); b.st = st;
    if (threadIdx.x == 0) (void)xb_add(&bar[XB_XCNT(b.x)], 1u);
    return b;
}
__device__ __forceinline__ void xcd_barrier_complete(unsigned* bar, unsigned x, unsigned& nloc, unsigned& nx) {
    const unsigned G = gridDim.x * gridDim.y * gridDim.z;
    unsigned sum, cnt, mine, sp = 0u;
    for (;;) {
        sum = 0u; cnt = 0u; mine = 0u;
#pragma unroll
        for (unsigned j = 0; j < 16; ++j) { const unsigned c = xb_ld(&bar[XB_XCNT(j)]); sum += c; cnt += (c > 0u) ? 1u : 0u; mine = (j == x) ? c : mine; }
        if (sum == G) break;
        __builtin_amdgcn_s_sleep(1);
        if ((++sp & 255u) == 0u) { if (xb_ld(&bar[XB_TMO])) break; if (sp > XB_SPIN_CAP) { atomicAdd(&bar[XB_TMO], 1u); break; } }
    }
    nloc = mine > 0u ? mine : 1u; nx = cnt > 0u ? cnt : 1u;
}

__device__ __forceinline__ void xcd_barrier(const XcdBarrier& b) {
    asm volatile("s_waitcnt vmcnt(0)" ::: "memory");
    __syncthreads();
    if (threadIdx.x == 0) {
        unsigned* bar = b.bar;
        __builtin_amdgcn_s_waitcnt(0);
        unsigned nloc = b.st[0], nx = b.st[1];
        if (nloc == 0u) { xcd_barrier_complete(bar, b.x, nloc, nx); b.st[0] = nloc; b.st[1] = nx; }
        const unsigned old = xb_add(&bar[XB_XSUB(b.x)], 1u);
        const unsigned gen = old / nloc;
        if (old + 1u == (gen + 1u) * nloc) {
            __builtin_amdgcn_fence(__ATOMIC_RELEASE, "agent");
            asm volatile("s_waitcnt vmcnt(0)" ::: "memory");
            const unsigned og = xb_add(&bar[XB_TOP], 1u);
            const unsigned tg = og / nx;
            if (og + 1u == (tg + 1u) * nx) xb_add(&bar[XB_TOPGEN], 1u);
            else XB_SPIN(xb_ld(&bar[XB_TOPGEN]) == tg, bar);
            __builtin_amdgcn_fence(__ATOMIC_ACQUIRE, "agent");
            xb_add(&bar[XB_XGEN(b.x)], 1u);
            asm volatile("s_waitcnt vmcnt(0)" ::: "memory");
        } else {
            XB_SPIN(xb_ld(&bar[XB_XGEN(b.x)]) == gen, bar);
            __builtin_amdgcn_fence(__ATOMIC_ACQUIRE, "agent");
            asm volatile("s_waitcnt vmcnt(0)" ::: "memory");
        }
    }
    __syncthreads();
}

#define GSYNC_() do { asm volatile("s_waitcnt vmcnt(0) lgkmcnt(0)" ::: "memory"); __builtin_amdgcn_fence(__ATOMIC_RELEASE, "agent"); grid.sync(); __builtin_amdgcn_fence(__ATOMIC_ACQUIRE, "agent"); } while (0)
#define GSYNC() xcd_barrier(xbar)
__global__ void __launch_bounds__(NTHR, 2) fwd_megakernel(Params p) {
    extern __shared__ __attribute__((aligned(16))) unsigned char lds_raw[];
    LAS unsigned char* lds = (LAS unsigned char*)lds_raw;
    cg::grid_group grid = cg::this_grid();
    volatile LAS unsigned* xst = (volatile LAS unsigned*)(lds + 146432);
    if (threadIdx.x < 2) xst[threadIdx.x] = 0u;
    __syncthreads();
    const XcdBarrier xbar = xcd_barrier_post((unsigned*)(p.ws + WS_XBAR), xst);
    unsigned char* ws = p.ws;
    float* ssq = (float*)(ws + WS_SSQ);
    bf16_t* xb = (bf16_t*)(ws + WS_XB); bf16_t* obuf = (bf16_t*)(ws + WS_O); bf16_t* big = (bf16_t*)(ws + WS_BIG);
    const int G = gridDim.x, cidx = blockIdx.x;
    pg8::StaticOrder S;

    phase_prologue(p, lds);
    if (p.ws == nullptr) GSYNC_();
    GSYNC();
    { pg8::Gemm g{xb, (const bf16_t*)(ws + WS_W_IN), DM, DM, MT, NPROJ, DM, 0}; S.init(MT, NPROJ, G, cidx); pg8::EpiProj E{big, ssq}; pg8::gemm_phase(lds, g, S, E); }
    GSYNC();
    phase_compress(p, lds);
    GSYNC();
    phase_cmp(p, lds);
    GSYNC();
    phase_ws<true, 2>(p, lds);
    GSYNC();
    phase_ws<false, 2>(p, lds);
    GSYNC();
    { pg8::Gemm g{obuf, (const bf16_t*)(ws + WS_W_OUT), DM, DM, MT, DM, DM, 0}; S.init(MT, DM, G, cidx); pg8::EpiRes E{p.x, p.out, xb, ssq + MT}; pg8::gemm_phase(lds, g, S, E); }
    GSYNC();
    { pg8::Gemm g{xb, (const bf16_t*)(ws + WS_W_GU0), DM, DM, MT, 2 * DFF, DM, 0}; S.init(MT, 2 * DFF, G, cidx); pg8::EpiSwiglu E{big, ssq + MT}; pg8::gemm_phase(lds, g, S, E); }
    GSYNC();
    { pg8::Gemm g{big, (const bf16_t*)(ws + WS_W_DN0), DFF, DFF, MT, DM, DFF, 0}; S.init(MT, DM, G, cidx); pg8::EpiRes E{p.out, p.out, xb, ssq + 2 * MT}; pg8::gemm_phase(lds, g, S, E); }
    GSYNC();
    { pg8::Gemm g{xb, (const bf16_t*)(ws + WS_P_IN), DM, DM, MT, DM, DM, 0}; S.init(MT, DM, G, cidx); pg8::EpiRowScale E{big, ssq + 2 * MT}; pg8::gemm_phase(lds, g, S, E); }
    GSYNC();
    phase_pool(p);
    GSYNC();
    { pg8::Gemm g{(const bf16_t*)(ws + WS_BIG + 128 * MiB), (const bf16_t*)(ws + WS_P_GRP), DM, 512, MT, DM, 512, 1024}; S.init(MT, DM, G, cidx); pg8::EpiColScale E{obuf, p.pool_scale}; pg8::gemm_phase(lds, g, S, E); }
    GSYNC();
    { pg8::Gemm g{obuf, (const bf16_t*)(ws + WS_P_OUT), DM, DM, MT, DM, DM, 0}; S.init(MT, DM, G, cidx); pg8::EpiRes E{p.out, p.out, xb, ssq + 3 * MT}; pg8::gemm_phase(lds, g, S, E); }
    GSYNC();
    { pg8::Gemm g{xb, (const bf16_t*)(ws + WS_W_GU1), DM, DM, MT, 2 * DFF, DM, 0}; S.init(MT, 2 * DFF, G, cidx); pg8::EpiSwiglu E{big, ssq + 3 * MT}; pg8::gemm_phase(lds, g, S, E); }
    GSYNC();
    { pg8::Gemm g{big, (const bf16_t*)(ws + WS_W_DN1), DFF, DFF, MT, DM, DFF, 0}; S.init(MT, DM, G, cidx); pg8::EpiRes E{p.out, p.out, nullptr, ssq + 4 * MT};     pg8::gemm_phase(lds, g, S, E); }
    GSYNC();
    phase_final(p);
}

extern "C" void kernel_launch(void* const* d_in, const int* in_sizes, int n_in, void* d_out, int out_size, void* d_ws, size_t ws_size, hipStream_t stream) {
    static int grid_blocks = 0;
    if (grid_blocks == 0) {
        if (n_in != 21 || ws_size < WS_END) { fprintf(stderr, "kernel_launch: unexpected inputs (n_in %d, ws %zu)\n", n_in, ws_size); grid_blocks = -1; return; }
        int dev = 0, cus = 0, per_cu = 0;
        hipGetDevice(&dev); hipDeviceGetAttribute(&cus, hipDeviceAttributeMultiprocessorCount, dev);
        if (hipFuncSetAttribute((const void*)fwd_megakernel, hipFuncAttributeMaxDynamicSharedMemorySize, LDS_BYTES) != hipSuccess) { fprintf(stderr, "kernel_launch: hipFuncSetAttribute failed\n"); grid_blocks = -1; return; }
        if (hipOccupancyMaxActiveBlocksPerMultiprocessor(&per_cu, (const void*)fwd_megakernel, NTHR, LDS_BYTES) != hipSuccess || per_cu < 1) { fprintf(stderr, "kernel_launch: occupancy query failed (%d)\n", per_cu); (void)hipGetLastError(); per_cu = 1; }
        grid_blocks = cus * 1;
    }
    if (grid_blocks < 0) return;
    Params p{};
    p.x = (const float*)d_in[0]; p.norm_mix = (const float*)d_in[1]; p.norm_ffn = (const float*)d_in[2]; p.norm_final = (const float*)d_in[3]; p.rel_bias = (const float*)d_in[4];
    p.nsa_w_in = (const float*)d_in[5]; p.pos_k = (const float*)d_in[6]; p.pos_v = (const float*)d_in[7]; p.ck_w1 = (const float*)d_in[8]; p.ck_b1 = (const float*)d_in[9]; p.ck_w2 = (const float*)d_in[10];
    p.cv_w1 = (const float*)d_in[11]; p.cv_b1 = (const float*)d_in[12]; p.cv_w2 = (const float*)d_in[13]; p.nsa_w_out = (const float*)d_in[14];
    p.pool_w_in = (const float*)d_in[15]; p.pool_w_grp = (const float*)d_in[16]; p.pool_scale = (const float*)d_in[17]; p.pool_w_out = (const float*)d_in[18]; p.ffn_w_gu = (const float*)d_in[19]; p.ffn_w_down = (const float*)d_in[20];
    p.out = (float*)d_out; p.ws = (unsigned char*)d_ws;
    if (hipMemsetAsync((char*)d_ws + WS_XBAR, 0, 16384, stream) != hipSuccess) { fprintf(stderr, "kernel_launch: hipMemsetAsync failed\n"); return; }
    void* args[] = {&p};
    hipError_t e = hipLaunchCooperativeKernel((const void*)fwd_megakernel, dim3(grid_blocks), dim3(NTHR), args, LDS_BYTES, stream);
    if (e != hipSuccess) fprintf(stderr, "cooperative launch failed: %s (grid %d)\n", hipGetErrorString(e), grid_blocks);
}
```

```cpp
#include <hip/hip_runtime.h>
#include <hip/hip_cooperative_groups.h>
#include <cstdio>
#include <cstdint>
namespace cg = cooperative_groups;

#define LAS __attribute__((address_space(3)))
typedef unsigned short bf16_t;
typedef short bf16x8 __attribute__((ext_vector_type(8)));
typedef float f32x4 __attribute__((ext_vector_type(4)));
typedef float f32x2 __attribute__((ext_vector_type(2)));
typedef unsigned u32x4 __attribute__((ext_vector_type(4)));
typedef unsigned u32x2 __attribute__((ext_vector_type(2)));

constexpr int BATCH = 2, SEQ = 16384, DM = 2048, MT = BATCH * SEQ;
constexpr int NG = 4, HG = 8, DK = 96, DV = 64;
constexpr int NPROJ = 5120;
constexpr int C_VC = 3072, C_VS = 3328, C_VW = 3584, C_KC = 3840, C_KS = 4224, C_KW = 4608, C_GATE = 4992;
constexpr int DFF = 5632;
constexpr int NCMP = 1024;
constexpr float EPS = 1e-6f;
constexpr float NEGF = -1e30f;

constexpr size_t MiB = 1u << 20;
constexpr size_t WS_SSQ = 0;
constexpr size_t WS_XBAR = 768 * 1024;
constexpr size_t WS_KMAX = 900 * 1024;
constexpr size_t WS_W_IN = 1 * MiB;
constexpr size_t WS_W_OUT = 21 * MiB;
constexpr size_t WS_W_GU0 = 29 * MiB, WS_W_GU1 = 73 * MiB;
constexpr size_t WS_W_DN0 = 117 * MiB, WS_W_DN1 = 139 * MiB;
constexpr size_t WS_P_IN = 161 * MiB, WS_P_GRP = 169 * MiB, WS_P_OUT = 171 * MiB;
constexpr size_t WS_CK1 = 179 * MiB, WS_CV1 = 181 * MiB, WS_CK2 = 182 * MiB, WS_CV2 = 182 * MiB + 65536;
constexpr size_t WS_KCMP = 183 * MiB, WS_VCMP = 185 * MiB, WS_SELM = 186 * MiB;
constexpr size_t WS_XB = 190 * MiB;
constexpr size_t WS_O = 318 * MiB;
constexpr size_t WS_BIG = 446 * MiB;
constexpr size_t WS_END = 798 * MiB;

typedef __bf16 bf16x2_t __attribute__((ext_vector_type(2)));
__device__ __forceinline__ unsigned cvt_pk_bf16(float lo, float hi) { const f32x2 v = {lo, hi}; const bf16x2_t b = __builtin_convertvector(v, bf16x2_t); return __builtin_bit_cast(unsigned, b); }
__device__ __forceinline__ float bf_lo(unsigned u) { return __uint_as_float(u << 16); }
__device__ __forceinline__ float bf_hi(unsigned u) { return __uint_as_float(u & 0xffff0000u); }
__device__ __forceinline__ float wave_sum(float v) {
#pragma unroll
    for (int o = 1; o < 64; o <<= 1) v += __shfl_xor(v, o);
    return v;
}

namespace pg8 {
constexpr int BM = 256, BK = 64, HALF = 128, HTB = HALF * BK * 2, STAGE_BYTES = 8 * HTB, NXCD = 8, WGM = 8;
__host__ __device__ __forceinline__ int lds_byte(int r, int c) { const int st = (r >> 4) * 2 + (c >> 5), rr = r & 15, cc = c & 31, ob = rr * 64 + cc * 2; return st * 1024 + (ob ^ (((ob >> 9) & 1) << 5)); }
__host__ __device__ __forceinline__ void stage_rc(int b, int& R, int& C) { const int st = b / 1024, sb = b % 1024, swz = sb ^ (((sb >> 9) & 1) << 5); R = (st >> 1) * 16 + swz / 64; C = (st & 1) * 32 + (swz % 64) / 2; }
__host__ __device__ __forceinline__ int perm32(int rho) { const int n = rho >> 4, i = rho & 15; return 8 * (i >> 2) + 4 * n + (i & 3); }

struct Unit { int pm, pn; };
struct Gemm { const bf16_t* A; const bf16_t* Bt; int lda, ldb, M, N, K; int acolb; };

struct StaticOrder {
    int nM, nN, nwg, G, c;
    __device__ void init(int M, int N, int G_, int c_) { nM = M / BM; nN = N / BM; nwg = nM * nN; G = G_; c = c_; }
    __device__ bool next(int i, Unit& u) const {
        const long L = (long)i * G + c; if (L >= nwg) return false;
        int wgid = (int)L; { const int q = nwg / NXCD, r = nwg % NXCD, xcd = wgid % NXCD, off = wgid / NXCD; wgid = (xcd < r ? xcd * (q + 1) : r * (q + 1) + (xcd - r) * q) + off; }
        const int nig = WGM * nN, gid = wgid / nig, fm = gid * WGM, gsz = (nM - fm) < WGM ? (nM - fm) : WGM;
        u.pm = fm + ((wgid % nig) % gsz); u.pn = (wgid % nig) / gsz; return true;
    }
};

template <class Epi>
__device__ __forceinline__ void gemm_phase(LAS unsigned char* lds, const Gemm g, const StaticOrder& S, const Epi& E) {
    const int tid = threadIdx.x, wid = __builtin_amdgcn_readfirstlane(tid >> 6), lane = tid & 63, wr = wid >> 2, wc = wid & 3, fr = lane & 15, fq = lane >> 4;
    const int K = g.K, nt = K / BK;
    unsigned voffA[2], voffB[2];
#pragma unroll
    for (int i = 0; i < 2; ++i) { int R, C; stage_rc(tid * 16 + i * 8192, R, C); const int Rb = (R & ~31) + perm32(R & 31);
        voffA[i] = (unsigned)(R * g.lda + C) * 2u; voffB[i] = (unsigned)(Rb * g.ldb + C) * 2u; }
    const size_t kstep = (size_t)(BK * 2);
    const size_t hstepA = (size_t)HALF * g.lda * 2, hstepB = (size_t)HALF * g.ldb * 2;
    const size_t tstepA = 2 * hstepA, tstepB = 2 * hstepB;
    const unsigned ldsw = (unsigned)wid * 1024u;
    const int aoff = lds_byte(wr * 64 + fr, fq * 8), boff = lds_byte(wc * 32 + fr, fq * 8);
#define PG8_SA(b, h) (((b) * 2 + (h)) * HTB)
#define PG8_SB(b, h) ((4 + (b) * 2 + (h)) * HTB)
#define PG8_STAGE(bufoff, gbase, voff) do { _Pragma("unroll") for (int _i = 0; _i < 2; ++_i) \
        __builtin_amdgcn_global_load_lds((const unsigned*)((const char*)(gbase) + (voff)[_i]), (LAS unsigned*)(lds + (bufoff) + ldsw + _i * 8192), 16, 0, 0); } while (0)
#define PG8_LDA(dst, b, h) do { _Pragma("unroll") for (int m = 0; m < 4; ++m) _Pragma("unroll") for (int k = 0; k < 2; ++k) dst[m][k] = *(const LAS bf16x8*)(lds + PG8_SA(b, h) + aoff + m * 2048 + k * 1024); } while (0)
#define PG8_LDB(dst, b, h) do { _Pragma("unroll") for (int n = 0; n < 2; ++n) _Pragma("unroll") for (int k = 0; k < 2; ++k) dst[n][k] = *(const LAS bf16x8*)(lds + PG8_SB(b, h) + boff + n * 2048 + k * 1024); } while (0)
#define PG8_MMA(ai, bj, At, Bt) do { __builtin_amdgcn_s_setprio(1); _Pragma("unroll") for (int m = 0; m < 4; ++m) _Pragma("unroll") for (int n = 0; n < 2; ++n) _Pragma("unroll") for (int k = 0; k < 2; ++k) \
        acc[ai][bj][m][n] = __builtin_amdgcn_mfma_f32_16x16x32_bf16(Bt[n][k], At[m][k], acc[ai][bj][m][n], 0, 0, 0); __builtin_amdgcn_s_setprio(0); } while (0)
#define PG8_WAIT_V(n) asm volatile("s_waitcnt vmcnt(" #n ")" ::: "memory")
#define PG8_WAIT_L(n) asm volatile("s_waitcnt lgkmcnt(" #n ")" ::: "memory")
#define PG8_BAR __builtin_amdgcn_s_barrier()
#define PG8_SCHED __builtin_amdgcn_sched_barrier(0)
#define PG8_APTR(u) ((const char*)g.A + (size_t)(u).pm * tstepA + (size_t)((u).pn >> 1) * (size_t)g.acolb)
#define PG8_BPTR(u) ((const char*)g.Bt + (size_t)(u).pn * tstepB)
    Unit cur, nxt; int ui = 0;
    if (!S.next(0, cur)) return;
    f32x4 acc[2][2][4][2];
#pragma unroll
    for (int a = 0; a < 2; ++a)
#pragma unroll
        for (int b = 0; b < 2; ++b)
#pragma unroll
            for (int m = 0; m < 4; ++m)
#pragma unroll
                for (int n = 0; n < 2; ++n) acc[a][b][m][n] = (f32x4){0.f, 0.f, 0.f, 0.f};
    bf16x8 At[4][2], B0[2][2], B1[2][2];
    const char* cA = PG8_APTR(cur); const char* cB = PG8_BPTR(cur);
    PG8_STAGE(PG8_SB(0, 0), cB, voffB); PG8_STAGE(PG8_SB(0, 1), cB + hstepB, voffB); PG8_STAGE(PG8_SA(0, 0), cA, voffA); PG8_STAGE(PG8_SA(0, 1), cA + hstepA, voffA);
    if (wr == 1) PG8_BAR;
    PG8_WAIT_V(2); PG8_BAR;
    PG8_STAGE(PG8_SB(1, 0), cB + kstep, voffB); PG8_STAGE(PG8_SA(1, 0), cA + kstep, voffA); PG8_STAGE(PG8_SB(1, 1), cB + hstepB + kstep, voffB);
    PG8_WAIT_V(6); PG8_BAR;
    for (;;) {
        const bool has_next = S.next(ui + 1, nxt);
        const char* nA = has_next ? PG8_APTR(nxt) : cA; const char* nB = has_next ? PG8_BPTR(nxt) : cB;
        for (int t = 0; t < nt; t += 2) {
            const bool last = (t == nt - 2);
            const char* a1 = cA + (size_t)(t + 1) * kstep;
            const char* a2 = last ? nA : cA + (size_t)(t + 2) * kstep; const char* b2 = last ? nB : cB + (size_t)(t + 2) * kstep;
            const char* a3 = a2 + kstep; const char* b3 = b2 + kstep;
            PG8_LDB(B0, 0, 0); PG8_LDB(B1, 0, 1); PG8_SCHED; PG8_LDA(At, 0, 0); PG8_STAGE(PG8_SA(1, 1), a1 + hstepA, voffA);
            PG8_WAIT_V(8); PG8_WAIT_L(0); PG8_BAR; PG8_MMA(0, 0, At, B0); PG8_MMA(0, 1, At, B1); PG8_BAR; PG8_SCHED;
            PG8_LDA(At, 0, 1); PG8_STAGE(PG8_SB(0, 0), b2, voffB); PG8_STAGE(PG8_SB(0, 1), b2 + hstepB, voffB); PG8_STAGE(PG8_SA(0, 0), a2, voffA);
            PG8_WAIT_V(8); PG8_WAIT_L(0); PG8_BAR; PG8_MMA(1, 0, At, B0); PG8_MMA(1, 1, At, B1); PG8_BAR; PG8_SCHED;
            PG8_LDB(B0, 1, 0); PG8_LDB(B1, 1, 1); PG8_SCHED; PG8_LDA(At, 1, 0); PG8_STAGE(PG8_SA(0, 1), a2 + hstepA, voffA);
            PG8_WAIT_V(8); PG8_WAIT_L(0); PG8_BAR; PG8_MMA(0, 0, At, B0); PG8_MMA(0, 1, At, B1); PG8_BAR; PG8_SCHED;
            PG8_LDA(At, 1, 1); PG8_STAGE(PG8_SB(1, 0), b3, voffB); PG8_STAGE(PG8_SB(1, 1), b3 + hstepB, voffB); PG8_STAGE(PG8_SA(1, 0), a3, voffA);
            PG8_WAIT_V(8); PG8_WAIT_L(0); PG8_BAR; PG8_MMA(1, 0, At, B0); PG8_MMA(1, 1, At, B1); PG8_BAR; PG8_SCHED;
        }
        if (wr == 0) PG8_BAR;
        E(acc, cur, wr, wc, fr, fq);
        if (!has_next) break;
#pragma unroll
        for (int a = 0; a < 2; ++a)
#pragma unroll
            for (int b = 0; b < 2; ++b)
#pragma unroll
                for (int m = 0; m < 4; ++m)
#pragma unroll
                    for (int n = 0; n < 2; ++n) acc[a][b][m][n] = (f32x4){0.f, 0.f, 0.f, 0.f};
        cur = nxt; cA = nA; cB = nB; ++ui;
        if (wr == 1) PG8_BAR;
    }
    PG8_WAIT_V(0);
    PG8_BAR;
#undef PG8_SA
#undef PG8_SB
#undef PG8_STAGE
#undef PG8_LDA
#undef PG8_LDB
#undef PG8_MMA
#undef PG8_WAIT_V
#undef PG8_WAIT_L
#undef PG8_BAR
#undef PG8_SCHED
#undef PG8_APTR
#undef PG8_BPTR
}

#define EPI_ROW(u, ai, m) ((u).pm * BM + (ai) * HALF + wr * 64 + (m) * 16 + fr)
__device__ __forceinline__ u32x4 pack8(f32x4 v0, f32x4 v1) { u32x4 w; w.x = cvt_pk_bf16(v0[0], v0[1]); w.y = cvt_pk_bf16(v0[2], v0[3]); w.z = cvt_pk_bf16(v1[0], v1[1]); w.w = cvt_pk_bf16(v1[2], v1[3]); return w; }

struct EpiProj {
    bf16_t* O; const float* ssq;
    __device__ __forceinline__ void operator()(const f32x4 (&acc)[2][2][4][2], const Unit& u, int wr, int wc, int fr, int fq) const {
        const float qs = (u.pn < 12) ? 0.10206207261596577f * 1.4426950408889634f : 1.0f;
#pragma unroll
        for (int ai = 0; ai < 2; ++ai)
#pragma unroll
            for (int m = 0; m < 4; ++m) { const int row = EPI_ROW(u, ai, m); const float rs = rsqrtf(ssq[row] * (1.0f / DM) + EPS) * qs;
#pragma unroll
                for (int bj = 0; bj < 2; ++bj) { const int c0 = u.pn * BM + bj * HALF + wc * 32 + 8 * fq;
                    *(u32x4*)(O + (size_t)row * NPROJ + c0) = pack8(acc[ai][bj][m][0] * rs, acc[ai][bj][m][1] * rs); } }
    }
};
struct EpiRowScale {
    bf16_t* O; const float* ssq;
    __device__ __forceinline__ void operator()(const f32x4 (&acc)[2][2][4][2], const Unit& u, int wr, int wc, int fr, int fq) const {
#pragma unroll
        for (int ai = 0; ai < 2; ++ai)
#pragma unroll
            for (int m = 0; m < 4; ++m) { const int row = EPI_ROW(u, ai, m); const float rs = rsqrtf(ssq[row] * (1.0f / DM) + EPS);
#pragma unroll
                for (int bj = 0; bj < 2; ++bj) { const int c0 = u.pn * BM + bj * HALF + wc * 32 + 8 * fq;
                    *(u32x4*)(O + (size_t)row * DM + c0) = pack8(acc[ai][bj][m][0] * rs, acc[ai][bj][m][1] * rs); } }
    }
};
struct EpiColScale {
    bf16_t* O; const float* scale;
    __device__ __forceinline__ void operator()(const f32x4 (&acc)[2][2][4][2], const Unit& u, int wr, int wc, int fr, int fq) const {
#pragma unroll
        for (int bj = 0; bj < 2; ++bj) { const int c0 = u.pn * BM + bj * HALF + wc * 32 + 8 * fq;
            const f32x4 s0 = *(const f32x4*)(scale + c0), s1 = *(const f32x4*)(scale + c0 + 4);
#pragma unroll
            for (int ai = 0; ai < 2; ++ai)
#pragma unroll
                for (int m = 0; m < 4; ++m) { const int row = EPI_ROW(u, ai, m);
                    *(u32x4*)(O + (size_t)row * DM + c0) = pack8(acc[ai][bj][m][0] * s0, acc[ai][bj][m][1] * s1); } }
    }
};
struct EpiSwiglu {
    bf16_t* O; const float* ssq;
    __device__ __forceinline__ void operator()(const f32x4 (&acc)[2][2][4][2], const Unit& u, int wr, int wc, int fr, int fq) const {
        const int c0 = u.pn * HALF + wc * 32 + 8 * fq;
#pragma unroll
        for (int ai = 0; ai < 2; ++ai)
#pragma unroll
            for (int m = 0; m < 4; ++m) { const int row = EPI_ROW(u, ai, m); const float rs = rsqrtf(ssq[row] * (1.0f / DM) + EPS);
                f32x4 r[2];
#pragma unroll
                for (int n = 0; n < 2; ++n)
#pragma unroll
                    for (int j = 0; j < 4; ++j) { const float gt = acc[ai][0][m][n][j] * rs, up = acc[ai][1][m][n][j] * rs; r[n][j] = gt * up * __builtin_amdgcn_rcpf(1.0f + __expf(-gt)); }
                *(u32x4*)(O + (size_t)row * DFF + c0) = pack8(r[0], r[1]); }
    }
};
struct EpiRes {
    const float* src; float* dst; bf16_t* xb; float* ssq_out;
    __device__ __forceinline__ void operator()(const f32x4 (&acc)[2][2][4][2], const Unit& u, int wr, int wc, int fr, int fq) const {
#pragma unroll
        for (int ai = 0; ai < 2; ++ai)
#pragma unroll
            for (int m = 0; m < 4; ++m) { const int row = EPI_ROW(u, ai, m); float ss = 0.f;
#pragma unroll
                for (int bj = 0; bj < 2; ++bj) { const size_t off = (size_t)row * DM + u.pn * BM + bj * HALF + wc * 32 + 8 * fq;
                    const f32x4 x0 = *(const f32x4*)(src + off) + acc[ai][bj][m][0], x1 = *(const f32x4*)(src + off + 4) + acc[ai][bj][m][1];
                    *(f32x4*)(dst + off) = x0; *(f32x4*)(dst + off + 4) = x1; if (xb) *(u32x4*)(xb + off) = pack8(x0, x1);
                    ss += (x0[0] * x0[0] + x0[1] * x0[1]) + (x0[2] * x0[2] + x0[3] * x0[3]) + (x1[0] * x1[0] + x1[1] * x1[1]) + (x1[2] * x1[2] + x1[3] * x1[3]); }
                ss += __shfl_xor(ss, 16); ss += __shfl_xor(ss, 32);
                if (fq == 0) atomicAdd(ssq_out + row, ss); }
    }
};
}

struct Params {
    const float* x; const float* norm_mix; const float* norm_ffn; const float* norm_final; const float* rel_bias;
    const float* nsa_w_in; const float* pos_k; const float* pos_v; const float* ck_w1; const float* ck_b1; const float* ck_w2;
    const float* cv_w1; const float* cv_b1; const float* cv_w2; const float* nsa_w_out;
    const float* pool_w_in; const float* pool_w_grp; const float* pool_scale; const float* pool_w_out; const float* ffn_w_gu; const float* ffn_w_down;
    float* out; unsigned char* ws;
};

constexpr int NTHR = 512, NWAVES = 8;
constexpr int LDS_BYTES = 163840;

__device__ __forceinline__ int nsa_map(int n0) {
    if (n0 < 3072) return n0;
    if (n0 < 3456) return C_KC + (n0 - 3072);
    if (n0 < 3712) return C_VC + (n0 - 3456);
    if (n0 < 4096) return C_KS + (n0 - 3712);
    if (n0 < 4352) return C_VS + (n0 - 4096);
    if (n0 < 4736) return C_KW + (n0 - 4352);
    if (n0 < 4992) return C_VW + (n0 - 4736);
    return C_GATE + (n0 - 4992);
}
__device__ __forceinline__ int gu_map(int n0) { return n0 < DFF ? (n0 >> 7) * 256 + (n0 & 127) : ((n0 - DFF) >> 7) * 256 + 128 + ((n0 - DFF) & 127); }

template <int MAP>
__device__ __forceinline__ void transpose_items(const float* W, int K, int N, bf16_t* WT, int ldd, int row_off, const float* fold, LAS float* scr, int gw, int ngw, int lane) {
    const int nblk = N / 32, nitems = (K / 64) * nblk;
    for (int item = gw; item < nitems; item += ngw) {
        const int kb = item / nblk, nb = item % nblk, k0 = 64 * kb, n0 = 32 * nb;
        const int d0 = row_off + (MAP == 1 ? nsa_map(n0) : (MAP == 2 ? gu_map(n0) : n0));
        float wv[32];
#pragma unroll
        for (int i = 0; i < 32; ++i) wv[i] = W[(size_t)(k0 + 2 * i + (lane >> 5)) * N + n0 + (lane & 31)];
#pragma unroll
        for (int i = 0; i < 32; ++i) { const int kk = 2 * i + (lane >> 5); float v = wv[i]; if (fold) v *= fold[k0 + kk]; scr[kk * 33 + (lane & 31)] = v; }
        asm volatile("s_waitcnt lgkmcnt(0)" ::: "memory");
        const int c = lane & 7;
#pragma unroll
        for (int j = 0; j < 4; ++j) { const int n = (lane >> 3) + 8 * j; const LAS float* s = scr + (8 * c) * 33 + n;
            u32x4 o; o.x = cvt_pk_bf16(s[0 * 33], s[1 * 33]); o.y = cvt_pk_bf16(s[2 * 33], s[3 * 33]); o.z = cvt_pk_bf16(s[4 * 33], s[5 * 33]); o.w = cvt_pk_bf16(s[6 * 33], s[7 * 33]);
            *(u32x4*)(WT + (size_t)(d0 + n) * ldd + k0 + 8 * c) = o; }
        asm volatile("s_waitcnt lgkmcnt(0)" ::: "memory");
    }
}

__device__ __forceinline__ void phase_prologue(const Params& p, LAS unsigned char* lds) {
    const int tid = threadIdx.x, lane = tid & 63, wave = tid >> 6;
    const int gw = blockIdx.x * NWAVES + wave, ngw = gridDim.x * NWAVES;
    LAS float* scr = (LAS float*)(lds + wave * 8704);
    unsigned char* ws = p.ws;
    if (blockIdx.x == 0 && tid < 16) ((unsigned*)(ws + WS_KMAX))[tid] = 0u;
    { float* ssq = (float*)(ws + WS_SSQ); for (int i = blockIdx.x * NTHR + tid; i < 4 * MT; i += gridDim.x * NTHR) ssq[MT + i] = 0.f; }
    transpose_items<1>(p.nsa_w_in, DM, 5088, (bf16_t*)(ws + WS_W_IN), DM, 0, p.norm_mix, scr, gw, ngw, lane);
    transpose_items<0>(p.nsa_w_out, DM, DM, (bf16_t*)(ws + WS_W_OUT), DM, 0, nullptr, scr, gw, ngw, lane);
    transpose_items<2>(p.ffn_w_gu, DM, 2 * DFF, (bf16_t*)(ws + WS_W_GU0), DM, 0, p.norm_ffn, scr, gw, ngw, lane);
    transpose_items<2>(p.ffn_w_gu + (size_t)DM * 2 * DFF, DM, 2 * DFF, (bf16_t*)(ws + WS_W_GU1), DM, 0, p.norm_ffn + DM, scr, gw, ngw, lane);
    transpose_items<0>(p.ffn_w_down, DFF, DM, (bf16_t*)(ws + WS_W_DN0), DFF, 0, nullptr, scr, gw, ngw, lane);
    transpose_items<0>(p.ffn_w_down + (size_t)DFF * DM, DFF, DM, (bf16_t*)(ws + WS_W_DN1), DFF, 0, nullptr, scr, gw, ngw, lane);
    transpose_items<0>(p.pool_w_in, DM, DM, (bf16_t*)(ws + WS_P_IN), DM, 0, p.norm_mix + DM, scr, gw, ngw, lane);
#pragma unroll 1
    for (int gi = 0; gi < 4; ++gi) transpose_items<0>(p.pool_w_grp + (size_t)gi * 512 * 512, 512, 512, (bf16_t*)(ws + WS_P_GRP), 512, gi * 512, nullptr, scr, gw, ngw, lane);
    transpose_items<0>(p.pool_w_out, DM, DM, (bf16_t*)(ws + WS_P_OUT), DM, 0, nullptr, scr, gw, ngw, lane);
    transpose_items<0>(p.ck_w1, 32 * DK, 256, (bf16_t*)(ws + WS_CK1), 32 * DK, 0, nullptr, scr, gw, ngw, lane);
    transpose_items<0>(p.cv_w1, 32 * DV, 256, (bf16_t*)(ws + WS_CV1), 32 * DV, 0, nullptr, scr, gw, ngw, lane);
    transpose_items<0>(p.ck_w2, 256, DK, (bf16_t*)(ws + WS_CK2), 256, 0, nullptr, scr, gw, ngw, lane);
    transpose_items<0>(p.cv_w2, 256, DV, (bf16_t*)(ws + WS_CV2), 256, 0, nullptr, scr, gw, ngw, lane);
    float* ssq0 = (float*)(ws + WS_SSQ); bf16_t* xb = (bf16_t*)(ws + WS_XB);
    for (int row = gw; row < MT; row += ngw) {
        const f32x4* xr = (const f32x4*)(p.x + (size_t)row * DM) + lane; u32x2* o = (u32x2*)(xb + (size_t)row * DM) + lane;
        float s = 0.f;
#pragma unroll
        for (int j = 0; j < 8; ++j) { const f32x4 v = xr[64 * j]; s += (v[0] * v[0] + v[1] * v[1]) + (v[2] * v[2] + v[3] * v[3]); u32x2 w; w.x = cvt_pk_bf16(v[0], v[1]); w.y = cvt_pk_bf16(v[2], v[3]); o[64 * j] = w; }
        s = wave_sum(s);
        if (lane == 0) ssq0[row] = s;
    }
}

__device__ __forceinline__ float gelu_tanh(float x) { const float u = 0.7978845608028654f * (x + 0.044715f * x * x * x); return 0.5f * x * (1.0f + tanhf(u)); }

template <int DH>
__device__ __forceinline__ void compress_unit(const Params& p, LAS unsigned char* lds, int b, int n0, int colbase, const float* pos, const bf16_t* w1t, const float* b1, const bf16_t* w2t, bf16_t* outp) {
    constexpr int KC = 32 * DH;
    const int tid = threadIdx.x, lane = tid & 63, wave = __builtin_amdgcn_readfirstlane(tid >> 6), c = lane & 15, kq = lane >> 4;
    const bf16_t* proj = (const bf16_t*)(p.ws + WS_BIG);
    LAS unsigned char* As = lds; LAS unsigned char* Bs = lds + 5120; LAS unsigned char* Hs = lds + 32768;
    const int arow = tid >> 2, ach = tid & 3;
    const int ag = arow >> 4, an = n0 + (arow & 15);
    u32x4 areg = {0, 0, 0, 0}, breg[2];
#define CMP_LOAD(k0_) do { const int k0v = (k0_); \
        if (tid < 256) { const int kk = k0v + ach * 8, l = kk / DH, d = kk % DH; int tok = 16 * an + l; tok = tok < SEQ ? tok : SEQ - 1; \
            const u32x4 raw = *(const u32x4*)(proj + (size_t)(b * SEQ + tok) * NPROJ + colbase + ag * DH + d); \
            const f32x4 p0 = *(const f32x4*)(pos + l * DH + d), p1 = *(const f32x4*)(pos + l * DH + d + 4); \
            areg.x = cvt_pk_bf16(bf_lo(raw.x) + p0[0], bf_hi(raw.x) + p0[1]); areg.y = cvt_pk_bf16(bf_lo(raw.y) + p0[2], bf_hi(raw.y) + p0[3]); \
            areg.z = cvt_pk_bf16(bf_lo(raw.z) + p1[0], bf_hi(raw.z) + p1[1]); areg.w = cvt_pk_bf16(bf_lo(raw.w) + p1[2], bf_hi(raw.w) + p1[3]); } \
        _Pragma("unroll") for (int i_ = 0; i_ < 2; ++i_) { const int idx = tid + 512 * i_; breg[i_] = *(const u32x4*)(w1t + (size_t)(idx >> 2) * KC + k0v + (idx & 3) * 8); } } while (0)
    f32x4 acc[4][2];
#pragma unroll
    for (int m = 0; m < 4; ++m) { acc[m][0] = (f32x4){0.f, 0.f, 0.f, 0.f}; acc[m][1] = (f32x4){0.f, 0.f, 0.f, 0.f}; }
    CMP_LOAD(0);
    for (int k0 = 0; k0 < KC; k0 += 32) {
        __syncthreads();
        if (tid < 256) *(LAS u32x4*)(As + arow * 80 + ach * 16) = areg;
#pragma unroll
        for (int i = 0; i < 2; ++i) { const int idx = tid + 512 * i; *(LAS u32x4*)(Bs + (idx >> 2) * 80 + (idx & 3) * 16) = breg[i]; }
        __syncthreads();
        if (k0 + 32 < KC) CMP_LOAD(k0 + 32);
        bf16x8 af[4], bfr[2];
#pragma unroll
        for (int m = 0; m < 4; ++m) af[m] = *(const LAS bf16x8*)(As + (16 * m + c) * 80 + kq * 16);
#pragma unroll
        for (int n = 0; n < 2; ++n) bfr[n] = *(const LAS bf16x8*)(Bs + (32 * wave + 16 * n + c) * 80 + kq * 16);
#pragma unroll
        for (int m = 0; m < 4; ++m)
#pragma unroll
            for (int n = 0; n < 2; ++n) acc[m][n] = __builtin_amdgcn_mfma_f32_16x16x32_bf16(af[m], bfr[n], acc[m][n], 0, 0, 0);
    }
#pragma unroll
    for (int n = 0; n < 2; ++n) { const int col = 32 * wave + 16 * n + c; const float bb = b1[col];
#pragma unroll
        for (int m = 0; m < 4; ++m)
#pragma unroll
            for (int i = 0; i < 4; ++i) { const float h = gelu_tanh(acc[m][n][i] + bb); *(LAS bf16_t*)(Hs + (16 * m + 4 * kq + i) * 528 + col * 2) = (bf16_t)(cvt_pk_bf16(h, 0.f) & 0xffffu); } }
    __syncthreads();
    constexpr int NT2 = 4 * (DH / 16);
    for (int idx = wave; idx < NT2; idx += 8) {
        const int m2 = idx & 3, n2 = idx >> 2;
        f32x4 a2 = {0.f, 0.f, 0.f, 0.f};
#pragma unroll
        for (int ks = 0; ks < 8; ++ks) { const bf16x8 a = *(const LAS bf16x8*)(Hs + (16 * m2 + c) * 528 + (32 * ks + 8 * kq) * 2);
            const bf16x8 bb = *(const bf16x8*)(w2t + (size_t)(16 * n2 + c) * 256 + 32 * ks + 8 * kq);
            a2 = __builtin_amdgcn_mfma_f32_16x16x32_bf16(a, bb, a2, 0, 0, 0); }
#pragma unroll
        for (int i = 0; i < 4; ++i) outp[((size_t)(b * NG + m2) * NCMP + n0 + 4 * kq + i) * DH + 16 * n2 + c] = (bf16_t)(cvt_pk_bf16(a2[i], 0.f) & 0xffffu);
    }
    __syncthreads();
}

__device__ __forceinline__ void phase_compress(const Params& p, LAS unsigned char* lds) {
    unsigned char* ws = p.ws;
    for (int u = blockIdx.x; u < 256; u += gridDim.x) {
        const int which = u >> 7, b = (u >> 6) & 1, n0 = (u & 63) * 16;
        if (which == 0) compress_unit<DK>(p, lds, b, n0, C_KC, p.pos_k, (const bf16_t*)(ws + WS_CK1), p.ck_b1, (const bf16_t*)(ws + WS_CK2), (bf16_t*)(ws + WS_KCMP));
        else compress_unit<DV>(p, lds, b, n0, C_VC, p.pos_v, (const bf16_t*)(ws + WS_CV1), p.cv_b1, (const bf16_t*)(ws + WS_CV2), (bf16_t*)(ws + WS_VCMP));
    }
    { const bf16_t* proj = (const bf16_t*)(ws + WS_BIG); unsigned* kmaxp = (unsigned*)(ws + WS_KMAX); const int lane = threadIdx.x & 63;
      for (int it = blockIdx.x * NTHR + threadIdx.x; it < MT * 8; it += gridDim.x * NTHR) { const int row = it >> 3, sg = it & 7, br = sg >> 2, g = sg & 3;
        const u32x4* kp = (const u32x4*)(proj + (size_t)row * NPROJ + (br ? C_KW : C_KS) + g * DK); float n2 = 0.f;
#pragma unroll
        for (int ch = 0; ch < 12; ++ch) { const u32x4 w = kp[ch];
            n2 += bf_lo(w.x) * bf_lo(w.x) + bf_hi(w.x) * bf_hi(w.x) + bf_lo(w.y) * bf_lo(w.y) + bf_hi(w.y) * bf_hi(w.y) + bf_lo(w.z) * bf_lo(w.z) + bf_hi(w.z) * bf_hi(w.z) + bf_lo(w.w) * bf_lo(w.w) + bf_hi(w.w) * bf_hi(w.w); }
        n2 = fmaxf(n2, __shfl_xor(n2, 8)); n2 = fmaxf(n2, __shfl_xor(n2, 16)); n2 = fmaxf(n2, __shfl_xor(n2, 32));
        if (lane < 8) atomicMax(kmaxp + br * 8 + (row >> 14) * 4 + g, __float_as_uint(sqrtf(n2))); } }
}

constexpr int KT_STRIDE = 208, SLOT_K = 64 * KT_STRIDE;
constexpr int VT_STRIDE = 144, SLOT_V = 64 * VT_STRIDE;
constexpr int SLOT_BYTES = SLOT_K + SLOT_V, RING = 5, PD = RING - 1;
constexpr int RING_WS = 6;
constexpr int L_RING = 0, L_IMP = RING * SLOT_BYTES, L_BIAS = LDS_BYTES - 4 * 8 * 132 * 4, L_SELM = L_BIAS - 2048;
static_assert(L_IMP + 32 * 256 * 4 <= L_BIAS && RING_WS * SLOT_BYTES <= L_SELM, "attention LDS map");

struct PairState { f32x4 o[4]; float m, l; bf16x8 q[3]; };
struct TileSrc { const bf16_t* K; const bf16_t* V; int kld, vld; };
struct DmaPlan { int off[3]; };

__device__ __forceinline__ void glds16(const void* gsrc, unsigned lds_dst) { unsigned keep;
    asm volatile("s_mov_b32 %0, m0\n\ts_mov_b32 m0, %2\n\ts_nop 0\n\tglobal_load_lds_dwordx4 %1, off\n\ts_mov_b32 m0, %0" : "=&s"(keep) : "v"(gsrc), "s"(lds_dst) : "memory"); }
#define ATT_WAIT_BAR(N) asm volatile("s_waitcnt vmcnt(" #N ") lgkmcnt(0)\n\ts_barrier" ::: "memory")
__device__ __forceinline__ void att_wait_bar(int rem) { if (rem <= 0) ATT_WAIT_BAR(0); else if (rem == 1) ATT_WAIT_BAR(3); else if (rem == 2) ATT_WAIT_BAR(6); else ATT_WAIT_BAR(9); }
__device__ __forceinline__ bool piece_is_k(int s) { return s < 13 || s >= 22; }
__device__ __forceinline__ int piece_grp(int s) { return s < 13 ? s : (s >= 22 ? s - 22 : s - 13); }
__device__ __forceinline__ void make_plan(DmaPlan& pl, const TileSrc& src, int wave, int lane) {
#pragma unroll
    for (int j = 0; j < 3; ++j) { const int sidx = wave + 8 * j, ci = 64 * piece_grp(sidx) + lane;
        if (piece_is_k(sidx)) { const int key = ci / 13, ch = ci % 13; pl.off[j] = key * src.kld + (ch < 12 ? ch : 11) * 8; }
        else { const int key = ci / 9, ch = ci % 9; pl.off[j] = key * src.vld + (ch < 8 ? ch : 7) * 8; } }
}
__device__ __forceinline__ void issue_tile(const DmaPlan& pl, const TileSrc& src, int key0, unsigned slot_addr, int wave) {
#pragma unroll
    for (int j = 0; j < 3; ++j) { const int sidx = wave + 8 * j; const bool isk = piece_is_k(sidx);
        const bf16_t* gp = (isk ? src.K + (size_t)key0 * src.kld : src.V + (size_t)key0 * src.vld) + pl.off[j];
        glds16(gp, slot_addr + (isk ? 0u : (unsigned)SLOT_K) + 1024u * (unsigned)piece_grp(sidx)); }
}
typedef short s16x4 __attribute__((ext_vector_type(4)));
__device__ __forceinline__ s16x4 vtr(const LAS unsigned char* p) { return __builtin_bit_cast(s16x4, __builtin_amdgcn_ds_read_tr16_b64_v4i16((LAS s16x4*)p)); }

__device__ __forceinline__ float sum8_dpp(float x) {
    x += __builtin_bit_cast(float, __builtin_amdgcn_update_dpp(0, __builtin_bit_cast(int, x), 0xB1, 0xF, 0xF, true));
    x += __builtin_bit_cast(float, __builtin_amdgcn_update_dpp(0, __builtin_bit_cast(int, x), 0x4E, 0xF, 0xF, true));
    x += __builtin_bit_cast(float, __builtin_amdgcn_update_dpp(0, __builtin_bit_cast(int, x), 0x141, 0xF, 0xF, true));
    return x;
}
template <int MODE, bool FAR>
__device__ __forceinline__ void pair_tile(PairState& st, const LAS unsigned char* Kt, const LAS unsigned char* Vt, int tadj, int kstride, int maxdist, bool rowsel,
                                          const LAS float* biasrow, float bias_far, LAS float* improw, int jj0, int lane) {
    const int c = lane & 15, kq = lane >> 4;
    f32x4 s[4];
    float bv[4][4];
    if (!FAR) {
#pragma unroll
        for (int kt = 0; kt < 4; ++kt)
#pragma unroll
            for (int i = 0; i < 4; ++i) { const int d = tadj - (16 * kt + 4 * kq + i) * kstride; const int bi = d < 0 ? 0 : (d > 128 ? 128 : d); bv[kt][i] = biasrow[bi]; }
    }
    const float init = FAR ? (rowsel ? bias_far - st.m : NEGF) : -st.m;
    const f32x4 initv = {init, init, init, init};
#pragma unroll
    for (int kt = 0; kt < 4; ++kt) {
#pragma unroll
        for (int ds = 0; ds < 3; ++ds) { const bf16x8 a = *(const LAS bf16x8*)(Kt + (16 * kt + c) * KT_STRIDE + (32 * ds + 8 * kq) * 2);
            s[kt] = __builtin_amdgcn_mfma_f32_16x16x32_bf16(a, st.q[ds], ds == 0 ? initv : s[kt], 0, 0, 0); } }
    if (!FAR) {
#pragma unroll
        for (int kt = 0; kt < 4; ++kt)
#pragma unroll
            for (int i = 0; i < 4; ++i) { const int d = tadj - (16 * kt + 4 * kq + i) * kstride; const bool valid = ((unsigned)d < (unsigned)maxdist) && rowsel;
                s[kt][i] = valid ? s[kt][i] + bv[kt][i] : NEGF; }
    }
    float psum = 0.f;
#pragma unroll
    for (int kt = 0; kt < 4; ++kt)
#pragma unroll
        for (int i = 0; i < 4; ++i) { const float pv = __builtin_amdgcn_exp2f(s[kt][i]); s[kt][i] = pv; psum += pv; }
    if (MODE != 1) st.l += psum;
    if (MODE == 0) return;
#pragma unroll
    for (int s2 = 0; s2 < 2; ++s2) {
        u32x4 pw; pw.x = cvt_pk_bf16(s[2 * s2][0], s[2 * s2][1]); pw.y = cvt_pk_bf16(s[2 * s2][2], s[2 * s2][3]); pw.z = cvt_pk_bf16(s[2 * s2 + 1][0], s[2 * s2 + 1][1]); pw.w = cvt_pk_bf16(s[2 * s2 + 1][2], s[2 * s2 + 1][3]);
        const bf16x8 pb = __builtin_bit_cast(bf16x8, pw);
#pragma unroll
        for (int dt = 0; dt < 4; ++dt) { const LAS unsigned char* vp = Vt + (32 * s2 + 4 * kq + (c >> 2)) * VT_STRIDE + (16 * dt + 4 * (c & 3)) * 2;
            const s16x4 lo = vtr(vp), hi = vtr(vp + 16 * VT_STRIDE); const bf16x8 a = {lo[0], lo[1], lo[2], lo[3], hi[0], hi[1], hi[2], hi[3]};
            st.o[dt] = __builtin_amdgcn_mfma_f32_16x16x32_bf16(a, pb, st.o[dt], 0, 0, 0); }
    }
    if (MODE == 1) {
#pragma unroll
        for (int kt = 0; kt < 4; ++kt) {
            float u0 = 2.0f * (s[kt][0] + s[kt][1] + s[kt][2]) + s[kt][3], u1 = s[kt][3];
            u0 = sum8_dpp(u0); u1 = sum8_dpp(u1);
            if ((lane & 7) == 0) { const int jj = jj0 + 4 * kt + kq;
                __hip_atomic_fetch_add(improw + jj, u0, __ATOMIC_RELAXED, __HIP_MEMORY_SCOPE_WORKGROUP);
                if (jj + 1 < 256) __hip_atomic_fetch_add(improw + jj + 1, u1, __ATOMIC_RELAXED, __HIP_MEMORY_SCOPE_WORKGROUP); }
        }
    }
}
#define PAIR_TILE(MODE, far, ...) do { if (far) pair_tile<MODE, true>(__VA_ARGS__); else pair_tile<MODE, false>(__VA_ARGS__); } while (0)

__device__ __forceinline__ int t5_bucket(int n) {
    if (n < 16) return n;
    int bk = 16;
    bk += (n >= 19); bk += (n >= 21); bk += (n >= 24); bk += (n >= 27); bk += (n >= 31); bk += (n >= 35); bk += (n >= 40); bk += (n >= 46);
    bk += (n >= 52); bk += (n >= 59); bk += (n >= 67); bk += (n >= 77); bk += (n >= 87); bk += (n >= 99); bk += (n >= 113);
    return bk;
}
__device__ __forceinline__ void build_bias(const Params& p, LAS unsigned char* lds) {
    LAS float* bt = (LAS float*)(lds + L_BIAS);
    for (int i = threadIdx.x; i < 32 * 129; i += NTHR) { const int h = i / 129, d = i % 129; bt[h * 132 + d] = p.rel_bias[t5_bucket(d) * 32 + h] * 1.4426950408889634f; }
    __syncthreads();
    if (threadIdx.x < 32) { float mx = bt[threadIdx.x * 132]; for (int d = 1; d < 129; ++d) mx = fmaxf(mx, bt[threadIdx.x * 132 + d]); bt[threadIdx.x * 132 + 129] = mx; }
    __syncthreads();
}

__device__ __forceinline__ void load_q(PairState& st, const bf16_t* proj, int b, int g, int tq0, int lane, float kmx, float bmax) {
    const int c = lane & 15, kq = lane >> 4; const size_t row = (size_t)b * SEQ + tq0 + (c >> 3);
#pragma unroll
    for (int ds = 0; ds < 3; ++ds) st.q[ds] = *(const bf16x8*)(proj + row * NPROJ + (g * 8 + (c & 7)) * DK + 32 * ds + 8 * kq);
    asm volatile("" : "+v"(st.q[0]), "+v"(st.q[1]), "+v"(st.q[2]));
    float qq = 0.f;
#pragma unroll
    for (int ds = 0; ds < 3; ++ds) { const u32x4 w = __builtin_bit_cast(u32x4, st.q[ds]);
        qq += bf_lo(w.x) * bf_lo(w.x) + bf_hi(w.x) * bf_hi(w.x) + bf_lo(w.y) * bf_lo(w.y) + bf_hi(w.y) * bf_hi(w.y) + bf_lo(w.z) * bf_lo(w.z) + bf_hi(w.z) * bf_hi(w.z) + bf_lo(w.w) * bf_lo(w.w) + bf_hi(w.w) * bf_hi(w.w); }
    qq += __shfl_xor(qq, 16); qq += __shfl_xor(qq, 32);
    st.m = sqrtf(qq) * kmx + bmax + 0.25f;
}
__device__ __forceinline__ void reset_state(PairState& st) {
#pragma unroll
    for (int dt = 0; dt < 4; ++dt) st.o[dt] = (f32x4){0.f, 0.f, 0.f, 0.f};
    st.l = 0.f;
}
template <bool ACCUM>
__device__ __forceinline__ void write_out(const PairState& st, float inv, const bf16_t* proj, bf16_t* obuf, int b, int g, int tq0, int br, int lane) {
    const int c = lane & 15, kq = lane >> 4; const size_t row = (size_t)b * SEQ + tq0 + (c >> 3);
    const float gl = bf_lo((unsigned)proj[row * NPROJ + C_GATE + br * 32 + g * 8 + (c & 7)]);
    const float sc = inv * __builtin_amdgcn_rcpf(1.0f + __expf(-gl));
    bf16_t* op = obuf + row * DM + (g * 8 + (c & 7)) * DV + 4 * kq;
#pragma unroll
    for (int dt = 0; dt < 4; ++dt) { f32x4 v = st.o[dt] * sc;
        if (ACCUM) { const u32x2 old = *(const u32x2*)(op + 16 * dt); v[0] += bf_lo(old.x); v[1] += bf_hi(old.x); v[2] += bf_lo(old.y); v[3] += bf_hi(old.y); }
        u32x2 w; w.x = cvt_pk_bf16(v[0], v[1]); w.y = cvt_pk_bf16(v[2], v[3]); *(u32x2*)(op + 16 * dt) = w; }
}

constexpr size_t WS_UCTR = WS_XBAR + 14336;
#define UNIT_LOOP_BEGIN(ctrptr, NU) \
    { LAS unsigned* ubox_ = (LAS unsigned*)(lds + 146440); unsigned nxt_ = 0u; \
      if (threadIdx.x == 0) ubox_[0] = atomicAdd((ctrptr), 1u); \
      __syncthreads(); \
      for (;;) { const unsigned ul = ubox_[0]; if (ul >= (unsigned)(NU)) break; \
          __syncthreads();
#define UNIT_PREFETCH(ctrptr) do { if (threadIdx.x == 0) nxt_ = atomicAdd((ctrptr), 1u); } while (0)
#define UNIT_LOOP_END() \
          if (threadIdx.x == 0) ubox_[0] = nxt_; \
          __syncthreads(); } }

__device__ __forceinline__ void phase_cmp(const Params& p, LAS unsigned char* lds) {
    const int tid = threadIdx.x, lane = tid & 63, wave = __builtin_amdgcn_readfirstlane(tid >> 6), c = lane & 15;
    const bf16_t* proj = (const bf16_t*)(p.ws + WS_BIG); bf16_t* obuf = (bf16_t*)(p.ws + WS_O); unsigned* selm = (unsigned*)(p.ws + WS_SELM);
    build_bias(p, lds);
    { LAS float* bt = (LAS float*)(lds + L_BIAS); const u32x4* kc = (const u32x4*)(p.ws + WS_KCMP) + (size_t)wave * NCMP * 12; float n2m = 0.f;
#pragma unroll 4
      for (int r = lane; r < NCMP; r += 64) { float n2 = 0.f;
#pragma unroll
        for (int ch = 0; ch < 12; ++ch) { const u32x4 w = kc[r * 12 + ch];
            n2 += bf_lo(w.x) * bf_lo(w.x) + bf_hi(w.x) * bf_hi(w.x) + bf_lo(w.y) * bf_lo(w.y) + bf_hi(w.y) * bf_hi(w.y) + bf_lo(w.z) * bf_lo(w.z) + bf_hi(w.z) * bf_hi(w.z) + bf_lo(w.w) * bf_lo(w.w) + bf_hi(w.w) * bf_hi(w.w); }
        n2m = fmaxf(n2m, n2); }
#pragma unroll
      for (int o = 1; o < 64; o <<= 1) n2m = fmaxf(n2m, __shfl_xor(n2m, o));
      if (lane == 0) bt[wave * 132 + 130] = sqrtf(n2m);
      __syncthreads(); }
    LAS float* imp = (LAS float*)(lds + L_IMP);
    UNIT_LOOP_BEGIN((unsigned*)(p.ws + WS_UCTR) + (blockIdx.x & 7), 512)
        const int bg = blockIdx.x & 7, b = bg >> 2, g = bg & 3, t0 = (511 - (int)ul) * 32;
        TileSrc src; src.K = (const bf16_t*)(p.ws + WS_KCMP) + (size_t)bg * NCMP * DK; src.V = (const bf16_t*)(p.ws + WS_VCMP) + (size_t)bg * NCMP * DV; src.kld = DK; src.vld = DV;
        const int nt = t0 / 1024 + 1;
        const LAS float* biasrow = (const LAS float*)(lds + L_BIAS) + (g * 8 + (c & 7)) * 132; const float bias_far = biasrow[128];
        PairState st[2];
#pragma unroll
        for (int pi = 0; pi < 2; ++pi) { reset_state(st[pi]); load_q(st[pi], proj, b, g, t0 + 4 * wave + 2 * pi, lane, ((const LAS float*)(lds + L_BIAS))[bg * 132 + 130], biasrow[129]); }
#pragma unroll
        for (int i = 0; i < 16; ++i) imp[(4 * wave) * 256 + i * 64 + lane] = 0.f;
        DmaPlan pl; make_plan(pl, src, wave, lane);
        const unsigned ring = (unsigned)(size_t)(lds + L_RING);
#pragma unroll 1
        for (int pass = 0; pass < 2; ++pass) {
            if (pass == 1) {
#pragma unroll
                for (int pi = 0; pi < 2; ++pi) { float lt = st[pi].l; lt += __shfl_xor(lt, 16); lt += __shfl_xor(lt, 32); if (lt > 0.f) st[pi].m += __builtin_amdgcn_logf(lt); }
            }
            for (int d = 0; d < PD && d < nt; ++d) issue_tile(pl, src, 64 * d, ring + d * SLOT_BYTES, wave);
            if (pass == 0) UNIT_PREFETCH((unsigned*)(p.ws + WS_UCTR) + (blockIdx.x & 7));
            int slot = 0, islot = PD;
#pragma unroll 1
            for (int i = 0; i < nt; ++i) {
                { int rem = nt - 1 - i; rem = rem < PD - 1 ? rem : PD - 1; att_wait_bar(rem); }
                if (i + PD < nt) issue_tile(pl, src, 64 * (i + PD), ring + islot * SLOT_BYTES, wave);
                const LAS unsigned char* Kt = lds + L_RING + slot * SLOT_BYTES; const LAS unsigned char* Vt = Kt + SLOT_K;
#pragma unroll
                for (int pi = 0; pi < 2; ++pi) { const int tq0 = t0 + 4 * wave + 2 * pi; const int P0 = 16 * 64 * i + 31;
                    if (tq0 + 1 < P0) continue;
                    const bool far = (tq0 - (P0 + 63 * 16)) >= 113;
                    const int tadj = tq0 + (c >> 3) - P0;
                    if (pass == 0) PAIR_TILE(0, far, st[pi], Kt, Vt, tadj, 16, 1 << 30, true, biasrow, bias_far, nullptr, 0, lane);
                    else PAIR_TILE(1, far, st[pi], Kt, Vt, tadj, 16, 1 << 30, true, biasrow, bias_far, imp + (4 * wave + 2 * pi + (c >> 3)) * 256, 16 * i, lane); }
                slot = slot + 1 == RING ? 0 : slot + 1; islot = islot + 1 == RING ? 0 : islot + 1;
            }
            ATT_WAIT_BAR(0);
        }
#pragma unroll
        for (int pi = 0; pi < 2; ++pi) write_out<false>(st[pi], 1.0f, proj, obuf, b, g, t0 + 4 * wave + 2 * pi, 0, lane);
        asm volatile("s_waitcnt lgkmcnt(0)" ::: "memory");
        {
            unsigned key[4][4]; unsigned T[4]; int need[4];
            const int cur = (t0 + 4 * wave) >> 6;
#pragma unroll
            for (int qq = 0; qq < 4; ++qq) { T[qq] = 0u; need[qq] = 16 - (1 + (cur >= 1) + (cur >= 2));
#pragma unroll
                for (int i = 0; i < 4; ++i) { const int j = lane + 64 * i; const float v = imp[(4 * wave + qq) * 256 + j];
                    const bool cand = (j >= 1) && (j <= cur - 2);
                    key[qq][i] = cand ? (__float_as_uint(v) + 1u) : 0u; } }
#pragma unroll 1
            for (int bit = 31; bit >= 0; --bit) {
#pragma unroll
                for (int qq = 0; qq < 4; ++qq) { const unsigned cand = T[qq] | (1u << bit);
                    const int cnt = __popcll(__ballot(key[qq][0] >= cand)) + __popcll(__ballot(key[qq][1] >= cand)) + __popcll(__ballot(key[qq][2] >= cand)) + __popcll(__ballot(key[qq][3] >= cand));
                    if (cnt >= need[qq]) T[qq] = cand; } }
#pragma unroll
            for (int qq = 0; qq < 4; ++qq) { const int t = t0 + 4 * wave + qq;
                unsigned Tq = T[qq]; if (Tq == 0u) Tq = 1u;
                int above = 0;
#pragma unroll
                for (int i = 0; i < 4; ++i) above += __popcll(__ballot(key[qq][i] > Tq));
                int room = need[qq] - above;
                unsigned* mrow = selm + ((size_t)bg * SEQ + t) * 8;
#pragma unroll
                for (int i = 0; i < 4; ++i) { const int j = lane + 64 * i; const unsigned long long eq = __ballot(key[qq][i] == Tq); const int rank = __popcll(eq & ((1ull << lane) - 1ull));
                    const bool sl = (j == 0) || (j == cur) || (j == cur - 1) || (key[qq][i] > Tq) || (key[qq][i] == Tq && rank < room); room -= __popcll(eq);
                    const unsigned long long bal = __ballot(sl); if (lane == 0) { mrow[2 * i] = (unsigned)bal; mrow[2 * i + 1] = (unsigned)(bal >> 32); } } }
        }
    UNIT_LOOP_END()
}

__device__ __forceinline__ void build_order(const LAS unsigned* lsel, LAS unsigned char* ord, LAS int* cnt, int cb, int nq, int lane) {
    int base = 0;
#pragma unroll 1
    for (int r = 0; 64 * r <= cb; ++r) { const int j = lane + 64 * r; unsigned m = 0u;
        for (int q = 0; q < nq; ++q) m |= lsel[q * 8 + (j >> 5)];
        const bool need = (j <= cb) && ((m >> (j & 31)) & 1u);
        const unsigned long long bal = __ballot(need);
        if (need) ord[base + __popcll(bal & ((1ull << lane) - 1ull))] = (unsigned char)j;
        base += __popcll(bal); }
    if (lane == 0) *cnt = base;
}

template <bool WIN, int NP>
__device__ __forceinline__ void phase_ws(const Params& p, LAS unsigned char* lds) {
    constexpr int QW = 2 * NP, QU = 8 * QW, NUNIT = MT * NG / QU;
    const int tid = threadIdx.x, lane = tid & 63, wave = __builtin_amdgcn_readfirstlane(tid >> 6), c = lane & 15;
    const bf16_t* proj = (const bf16_t*)(p.ws + WS_BIG); bf16_t* obuf = (bf16_t*)(p.ws + WS_O); const unsigned* selm = (const unsigned*)(p.ws + WS_SELM);
    build_bias(p, lds);
    LAS unsigned* lsel = (LAS unsigned*)(lds + L_SELM);
    UNIT_LOOP_BEGIN((unsigned*)(p.ws + WS_UCTR) + (WIN ? 8 : 16) + (blockIdx.x & 7), NUNIT / 8)
        const int bg = blockIdx.x & 7, b = bg >> 2, g = bg & 3, t0 = (SEQ / QU - 1 - (int)ul) * QU;
        TileSrc src; src.kld = NPROJ; src.vld = NPROJ;
        src.K = proj + (size_t)b * SEQ * NPROJ + (WIN ? C_KW : C_KS) + g * DK; src.V = proj + (size_t)b * SEQ * NPROJ + (WIN ? C_VW : C_VS) + g * DV;
        const int cb = t0 >> 6;
        const int kstart = WIN ? (cb >= 8 ? (cb - 8) * 64 : 0) : 0;
        const int nt = cb + 1 - kstart / 64;
        const LAS float* biasrow = (const LAS float*)(lds + L_BIAS) + (g * 8 + (c & 7)) * 132; const float bias_far = biasrow[128];
        const float kmx = __uint_as_float(((const unsigned*)(p.ws + WS_KMAX))[(WIN ? 8 : 0) + bg]);
        LAS unsigned char* ord = (LAS unsigned char*)(lds + L_SELM + 1024);
        int npos = nt;
        if (!WIN) { if (tid < QU * 8) lsel[tid] = selm[((size_t)bg * SEQ + t0) * 8 + tid];
            __syncthreads();
            if (wave == 0) build_order(lsel, ord, (LAS int*)(lds + L_SELM + 1024 + 256), cb, QU, lane);
            __syncthreads();
            npos = *(LAS int*)(lds + L_SELM + 1024 + 256); }
        PairState st[NP];
#pragma unroll
        for (int pi = 0; pi < NP; ++pi) { reset_state(st[pi]); load_q(st[pi], proj, b, g, t0 + QW * wave + 2 * pi, lane, kmx, biasrow[129]); }
        DmaPlan pl; make_plan(pl, src, wave, lane);
        const unsigned ring = (unsigned)(size_t)(lds + L_RING);
#define WS_TILE(pos) (WIN ? (pos) : (int)ord[pos])
        constexpr int TI = 3, PRE = 6;
        for (int d = 0; d < PRE && d < npos; ++d) issue_tile(pl, src, kstart + 64 * WS_TILE(d), ring + d * SLOT_BYTES, wave);
        UNIT_PREFETCH((unsigned*)(p.ws + WS_UCTR) + (WIN ? 8 : 16) + (blockIdx.x & 7));
        int slot = 0, islot = 0;
#pragma unroll 1
        for (int i0 = 0; i0 < npos; i0 += TI) {
            { int rem;
              rem = (i0 == 0) ? ((npos < 6 ? npos : 6) - (npos < 3 ? npos : 3)) : 0;
              att_wait_bar(rem); }
#pragma unroll 1
            for (int e = 0; e < TI; ++e) { if (i0 + e >= npos) break; const int i = WS_TILE(i0 + e);
                const LAS unsigned char* Kt = lds + L_RING + slot * SLOT_BYTES; const LAS unsigned char* Vt = Kt + SLOT_K;
                slot = slot + 1 == RING_WS ? 0 : slot + 1;
                const int P0 = kstart + 64 * i;
#pragma unroll
                for (int pi = 0; pi < NP; ++pi) { const int tq0 = t0 + QW * wave + 2 * pi;
                    bool rowsel = true; bool allsel = true;
                    if (!WIN) { const unsigned w = lsel[(QW * wave + 2 * pi + (c >> 3)) * 8 + (i >> 5)]; rowsel = (w >> (i & 31)) & 1u;
                        const unsigned long long bal = __ballot(rowsel); if (bal == 0ull) continue; allsel = (bal == ~0ull); }
                    else { if (tq0 + 1 < P0 || tq0 - (P0 + 63) >= 512) continue; }
                    const bool far = (tq0 - (P0 + 63) >= 113) && (!WIN || (tq0 + 1 - P0 < 512));
                    PAIR_TILE(2, far, st[pi], Kt, Vt, tq0 + (c >> 3) - P0, 1, WIN ? 512 : (1 << 30), rowsel, biasrow, bias_far, nullptr, 0, lane); } }
            if (i0 >= 3) {
#pragma unroll
            for (int e = 0; e < 3; ++e) { if (i0 + 3 + e < npos) issue_tile(pl, src, kstart + 64 * WS_TILE(i0 + 3 + e), ring + islot * SLOT_BYTES, wave); islot = islot + 1 == RING_WS ? 0 : islot + 1; }
            }
        }
#undef WS_TILE
        ATT_WAIT_BAR(0);
#pragma unroll
        for (int pi = 0; pi < NP; ++pi) { float lt = st[pi].l; lt += __shfl_xor(lt, 16); lt += __shfl_xor(lt, 32);
            write_out<true>(st[pi], lt > 0.f ? 1.0f / lt : 0.f, proj, obuf, b, g, t0 + QW * wave + 2 * pi, WIN ? 2 : 1, lane); }
    UNIT_LOOP_END()
}

template <int W>
__device__ __forceinline__ void pool_item(const bf16_t* ub, bf16_t* pooled, int row, int t, int ch) {
    u32x4 v[W];
#pragma unroll
    for (int k = 0; k < W; ++k) v[k] = *(const u32x4*)(ub + (size_t)(k <= t ? row - k : row) * DM + ch * 8);
    const int cnt = (t + 1 < W) ? t + 1 : W;
    float acc[8] = {0.f, 0.f, 0.f, 0.f, 0.f, 0.f, 0.f, 0.f};
#pragma unroll
    for (int k = 0; k < W; ++k) { const float m = k < cnt ? 1.0f : 0.0f;
        acc[0] += m * bf_lo(v[k].x); acc[1] += m * bf_hi(v[k].x); acc[2] += m * bf_lo(v[k].y); acc[3] += m * bf_hi(v[k].y); acc[4] += m * bf_lo(v[k].z); acc[5] += m * bf_hi(v[k].z); acc[6] += m * bf_lo(v[k].w); acc[7] += m * bf_hi(v[k].w); }
    const float ic = 1.0f / (float)cnt; const u32x4 self = v[0];
    u32x4 o; o.x = cvt_pk_bf16(acc[0] * ic - bf_lo(self.x), acc[1] * ic - bf_hi(self.x)); o.y = cvt_pk_bf16(acc[2] * ic - bf_lo(self.y), acc[3] * ic - bf_hi(self.y));
    o.z = cvt_pk_bf16(acc[4] * ic - bf_lo(self.z), acc[5] * ic - bf_hi(self.z)); o.w = cvt_pk_bf16(acc[6] * ic - bf_lo(self.w), acc[7] * ic - bf_hi(self.w));
    *(u32x4*)(pooled + (size_t)row * DM + ch * 8) = o;
}
__device__ __forceinline__ void phase_pool(const Params& p) {
    const bf16_t* ub = (const bf16_t*)(p.ws + WS_BIG); bf16_t* pooled = (bf16_t*)(p.ws + WS_BIG + 128 * MiB);
    const int nthr = gridDim.x * NTHR;
    for (int it = blockIdx.x * NTHR + threadIdx.x; it < MT * 256; it += nthr) {
        const int row = it >> 8, ch = it & 255, t = row & (SEQ - 1); const int gi = ch >> 6;
        if (gi == 0) pool_item<2>(ub, pooled, row, t, ch); else if (gi == 1) pool_item<4>(ub, pooled, row, t, ch);
        else if (gi == 2) pool_item<8>(ub, pooled, row, t, ch); else pool_item<16>(ub, pooled, row, t, ch);
    }
}
__device__ __forceinline__ void phase_final(const Params& p) {
    const int lane = threadIdx.x & 63, wave = threadIdx.x >> 6; const int gw = blockIdx.x * NWAVES + wave, ngw = gridDim.x * NWAVES;
    const float* ssq = (const float*)(p.ws + WS_SSQ) + 4 * (size_t)MT;
    for (int row = gw; row < MT; row += ngw) { const float rs = rsqrtf(ssq[row] * (1.0f / DM) + EPS);
        f32x4* xr = (f32x4*)(p.out + (size_t)row * DM) + lane; const f32x4* gr = (const f32x4*)p.norm_final + lane;
#pragma unroll
        for (int j = 0; j < 8; ++j) xr[64 * j] = xr[64 * j] * rs * gr[64 * j]; }
}

#define XB_TMO      128
#define XB_XCNT(j)  (256  + 64 * (j))
#define XB_XSUB(j)  (1280 + 64 * (j))
#define XB_XGEN(j)  (2304 + 64 * (j))
#define XB_TOP      3328
#define XB_TOPGEN   3392
#define XCD_BAR_WORDS 3456
#define XB_SPIN_CAP (1u << 18)

__device__ __forceinline__ unsigned xb_ld(unsigned* p)              { return __hip_atomic_load(p, __ATOMIC_RELAXED, __HIP_MEMORY_SCOPE_AGENT); }
__device__ __forceinline__ unsigned xb_add(unsigned* p, unsigned v) { return __hip_atomic_fetch_add(p, v, __ATOMIC_RELAXED, __HIP_MEMORY_SCOPE_AGENT); }
__device__ __forceinline__ unsigned xb_xcc_id() { return (unsigned)__builtin_amdgcn_s_getreg((3 << 11) | 20) & 0xFu; }
#define XB_SPIN(cond, bar) do { unsigned _sp = 0; while (cond) { __builtin_amdgcn_s_sleep(1); \
    if ((++_sp & 255u) == 0u) { if (xb_ld(&(bar)[XB_TMO])) break; if (_sp > XB_SPIN_CAP) { atomicAdd(&(bar)[XB_TMO], 1u); break; } } } } while (0)

struct XcdBarrier {
    unsigned* bar; unsigned x;
    volatile LAS unsigned* st;
};

__device__ __forceinline__ XcdBarrier xcd_barrier_post(unsigned* bar, volatile LAS unsigned* st) {
    XcdBarrier b; b.bar = bar; b.x = xb_xcc_id(); b.st = st;
    if (threadIdx.x == 0) (void)xb_add(&bar[XB_XCNT(b.x)], 1u);
    return b;
}
__device__ __forceinline__ void xcd_barrier_complete(unsigned* bar, unsigned x, unsigned& nloc, unsigned& nx) {
    const unsigned G = gridDim.x * gridDim.y * gridDim.z;
    unsigned sum, cnt, mine, sp = 0u;
    for (;;) {
        sum = 0u; cnt = 0u; mine = 0u;
#pragma unroll
        for (unsigned j = 0; j < 16; ++j) { const unsigned c = xb_ld(&bar[XB_XCNT(j)]); sum += c; cnt += (c > 0u) ? 1u : 0u; mine = (j == x) ? c : mine; }
        if (sum == G) break;
        __builtin_amdgcn_s_sleep(1);
        if ((++sp & 255u) == 0u) { if (xb_ld(&bar[XB_TMO])) break; if (sp > XB_SPIN_CAP) { atomicAdd(&bar[XB_TMO], 1u); break; } }
    }
    nloc = mine > 0u ? mine : 1u; nx = cnt > 0u ? cnt : 1u;
}

__device__ __forceinline__ void xcd_barrier(const XcdBarrier& b) {
    asm volatile("s_waitcnt vmcnt(0)" ::: "memory");
    __syncthreads();
    if (threadIdx.x == 0) {
        unsigned* bar = b.bar;
        __builtin_amdgcn_s_waitcnt(0);
        unsigned nloc = b.st[0], nx = b.st[1];
        if (nloc == 0u) { xcd_barrier_complete(bar, b.x, nloc, nx); b.st[0] = nloc; b.st[1] = nx; }
        const unsigned old = xb_add(&bar[XB_XSUB(b.x)], 1u);
        const unsigned gen = old / nloc;
        if (old + 1u == (gen + 1u) * nloc) {
            __builtin_amdgcn_fence(__ATOMIC_RELEASE, "agent");
            asm volatile("s_waitcnt vmcnt(0)" ::: "memory");
            const unsigned og = xb_add(&bar[XB_TOP], 1u);
            const unsigned tg = og / nx;
            if (og + 1u == (tg + 1u) * nx) xb_add(&bar[XB_TOPGEN], 1u);
            else XB_SPIN(xb_ld(&bar[XB_TOPGEN]) == tg, bar);
            __builtin_amdgcn_fence(__ATOMIC_ACQUIRE, "agent");
            xb_add(&bar[XB_XGEN(b.x)], 1u);
            asm volatile("s_waitcnt vmcnt(0)" ::: "memory");
        } else {
            XB_SPIN(xb_ld(&bar[XB_XGEN(b.x)]) == gen, bar);
            __builtin_amdgcn_fence(__ATOMIC_ACQUIRE, "agent");
            asm volatile("s_waitcnt vmcnt(0)" ::: "memory");
        }
    }
    __syncthreads();
}

#define GSYNC_() do { asm volatile("s_waitcnt vmcnt(0) lgkmcnt(0)" ::: "memory"); __builtin_amdgcn_fence(__ATOMIC_RELEASE, "agent"); grid.sync(); __builtin_amdgcn_fence(__ATOMIC_ACQUIRE, "agent"); } while (0)
#define GSYNC() xcd_barrier(xbar)
__global__ void __launch_bounds__(NTHR, 2) fwd_megakernel(Params p) {
    extern __shared__ __attribute__((aligned(16))) unsigned char lds_raw[];
    LAS unsigned char* lds = (LAS unsigned char*)lds_raw;
    cg::grid_group grid = cg::this_grid();
    volatile LAS unsigned* xst = (volatile LAS unsigned*)(lds + 146432);
    if (threadIdx.x < 2) xst[threadIdx.x] = 0u;
    __syncthreads();
    const XcdBarrier xbar = xcd_barrier_post((unsigned*)(p.ws + WS_XBAR), xst);
    unsigned char* ws = p.ws;
    float* ssq = (float*)(ws + WS_SSQ);
    bf16_t* xb = (bf16_t*)(ws + WS_XB); bf16_t* obuf = (bf16_t*)(ws + WS_O); bf16_t* big = (bf16_t*)(ws + WS_BIG);
    const int G = gridDim.x, cidx = blockIdx.x;
    pg8::StaticOrder S;

    phase_prologue(p, lds);
    if (p.ws == nullptr) GSYNC_();
    GSYNC();
    { pg8::Gemm g{xb, (const bf16_t*)(ws + WS_W_IN), DM, DM, MT, NPROJ, DM, 0}; S.init(MT, NPROJ, G, cidx); pg8::EpiProj E{big, ssq}; pg8::gemm_phase(lds, g, S, E); }
    GSYNC();
    phase_compress(p, lds);
    GSYNC();
    phase_cmp(p, lds);
    GSYNC();
    phase_ws<true, 2>(p, lds);
    GSYNC();
    phase_ws<false, 2>(p, lds);
    GSYNC();
    { pg8::Gemm g{obuf, (const bf16_t*)(ws + WS_W_OUT), DM, DM, MT, DM, DM, 0}; S.init(MT, DM, G, cidx); pg8::EpiRes E{p.x, p.out, xb, ssq + MT}; pg8::gemm_phase(lds, g, S, E); }
    GSYNC();
    { pg8::Gemm g{xb, (const bf16_t*)(ws + WS_W_GU0), DM, DM, MT, 2 * DFF, DM, 0}; S.init(MT, 2 * DFF, G, cidx); pg8::EpiSwiglu E{big, ssq + MT}; pg8::gemm_phase(lds, g, S, E); }
    GSYNC();
    { pg8::Gemm g{big, (const bf16_t*)(ws + WS_W_DN0), DFF, DFF, MT, DM, DFF, 0}; S.init(MT, DM, G, cidx); pg8::EpiRes E{p.out, p.out, xb, ssq + 2 * MT}; pg8::gemm_phase(lds, g, S, E); }
    GSYNC();
    { pg8::Gemm g{xb, (const bf16_t*)(ws + WS_P_IN), DM, DM, MT, DM, DM, 0}; S.init(MT, DM, G, cidx); pg8::EpiRowScale E{big, ssq + 2 * MT}; pg8::gemm_phase(lds, g, S, E); }
    GSYNC();
    phase_pool(p);
    GSYNC();
    { pg8::Gemm g{(const bf16_t*)(ws + WS_BIG + 128 * MiB), (const bf16_t*)(ws + WS_P_GRP), DM, 512, MT, DM, 512, 1024}; S.init(MT, DM, G, cidx); pg8::EpiColScale E{obuf, p.pool_scale}; pg8::gemm_phase(lds, g, S, E); }
    GSYNC();
    { pg8::Gemm g{obuf, (const bf16_t*)(ws + WS_P_OUT), DM, DM, MT, DM, DM, 0}; S.init(MT, DM, G, cidx); pg8::EpiRes E{p.out, p.out, xb, ssq + 3 * MT}; pg8::gemm_phase(lds, g, S, E); }
    GSYNC();
    { pg8::Gemm g{xb, (const bf16_t*)(ws + WS_W_GU1), DM, DM, MT, 2 * DFF, DM, 0}; S.init(MT, 2 * DFF, G, cidx); pg8::EpiSwiglu E{big, ssq + 3 * MT}; pg8::gemm_phase(lds, g, S, E); }
    GSYNC();
    { pg8::Gemm g{big, (const bf16_t*)(ws + WS_W_DN1), DFF, DFF, MT, DM, DFF, 0}; S.init(MT, DM, G, cidx); pg8::EpiRes E{p.out, p.out, nullptr, ssq + 4 * MT};     pg8::gemm_phase(lds, g, S, E); }
    GSYNC();
    phase_final(p);
}

extern "C" void kernel_launch(void* const* d_in, const int* in_sizes, int n_in, void* d_out, int out_size, void* d_ws, size_t ws_size, hipStream_t stream) {
    static int grid_blocks = 0;
    if (grid_blocks == 0) {
        if (n_in != 21 || ws_size < WS_END) { fprintf(stderr, "kernel_launch: unexpected inputs (n_in %d, ws %zu)\n", n_in, ws_size); grid_blocks = -1; return; }
        int dev = 0, cus = 0, per_cu = 0;
        hipGetDevice(&dev); hipDeviceGetAttribute(&cus, hipDeviceAttributeMultiprocessorCount, dev);
        if (hipFuncSetAttribute((const void*)fwd_megakernel, hipFuncAttributeMaxDynamicSharedMemorySize, LDS_BYTES) != hipSuccess) { fprintf(stderr, "kernel_launch: hipFuncSetAttribute failed\n"); grid_blocks = -1; return; }
        if (hipOccupancyMaxActiveBlocksPerMultiprocessor(&per_cu, (const void*)fwd_megakernel, NTHR, LDS_BYTES) != hipSuccess || per_cu < 1) { fprintf(stderr, "kernel_launch: occupancy query failed (%d)\n", per_cu); (void)hipGetLastError(); per_cu = 1; }
        grid_blocks = cus * 1;
    }
    if (grid_blocks < 0) return;
    Params p{};
    p.x = (const float*)d_in[0]; p.norm_mix = (const float*)d_in[1]; p.norm_ffn = (const float*)d_in[2]; p.norm_final = (const float*)d_in[3]; p.rel_bias = (const float*)d_in[4];
    p.nsa_w_in = (const float*)d_in[5]; p.pos_k = (const float*)d_in[6]; p.pos_v = (const float*)d_in[7]; p.ck_w1 = (const float*)d_in[8]; p.ck_b1 = (const float*)d_in[9]; p.ck_w2 = (const float*)d_in[10];
    p.cv_w1 = (const float*)d_in[11]; p.cv_b1 = (const float*)d_in[12]; p.cv_w2 = (const float*)d_in[13]; p.nsa_w_out = (const float*)d_in[14];
    p.pool_w_in = (const float*)d_in[15]; p.pool_w_grp = (const float*)d_in[16]; p.pool_scale = (const float*)d_in[17]; p.pool_w_out = (const float*)d_in[18]; p.ffn_w_gu = (const float*)d_in[19]; p.ffn_w_down = (const float*)d_in[20];
    p.out = (float*)d_out; p.ws = (unsigned char*)d_ws;
    if (hipMemsetAsync((char*)d_ws + WS_XBAR, 0, 16384, stream) != hipSuccess) { fprintf(stderr, "kernel_launch: hipMemsetAsync failed\n"); return; }
    void* args[] = {&p};
    hipError_t e = hipLaunchCooperativeKernel((const void*)fwd_megakernel, dim3(grid_blocks), dim3(NTHR), args, LDS_BYTES, stream);
    if (e != hipSuccess) fprintf(stderr, "cooperative launch failed: %s (grid %d)\n", hipGetErrorString(e), grid_blocks);
}
```
